# Optimizing an MI355X kernel written in HIP

```python
import math
import jax, jax.numpy as jnp
from jax import lax
import numpy as np

D_MODEL = 1024
BATCH = 2
SEQ = 8192
DEPTH = 1

N_META = 16
SSM_WIDTH = D_MODEL // 2
SSM_GROUP = 16
SSM_GROUPS = SSM_WIDTH // SSM_GROUP
SSM_STATE = 64
DT_MIN = 1e-3
DT_MAX = 1e-1
A_RE_MAX = -1e-4
ATTN_HEADS = 4
HEAD_DIM = 64
ATTN_WIDTH = ATTN_HEADS * 2 * HEAD_DIM
Q_BLOCK = 128
ATTN_PAD = Q_BLOCK - N_META
NEG_INF = -1e30
N_BRANCH = 2
IN_WIDTH = SSM_WIDTH + 3 * ATTN_WIDTH + N_BRANCH * D_MODEL
N_EXPERTS = 32
TOP_K = 4
D_EXPERT = D_MODEL
SWIGLU_LIMIT = 7.0
SWIGLU_ALPHA = 1.702
ROW_BLOCK = 128
EPS = 1e-6

kernel_name = 'hybrid_s5_diffattn_gated_moe'


def rmsnorm(x, g):
    xf = x.astype(jnp.float32)
    y = xf * lax.rsqrt(jnp.mean(xf * xf, axis=-1, keepdims=True) + EPS)
    return (y * g.astype(jnp.float32)).astype(x.dtype)


def lambda_init_fn(layer):
    return 0.8 - 0.6 * math.exp(-0.3 * layer)


def s5_mixer(u, a_re, a_im, log_dt, b_re, b_im, c_re, c_im, d):
    B, L, _ = u.shape
    f32 = jnp.float32
    uf = u.astype(f32).reshape(B, L, SSM_GROUPS, SSM_GROUP)
    lr = jnp.minimum(a_re.astype(f32), A_RE_MAX)
    li = a_im.astype(f32)
    dt = jnp.exp(log_dt.astype(f32))[:, None]
    mag = jnp.exp(lr * dt)
    ar = mag * jnp.cos(li * dt)
    ai = mag * jnp.sin(li * dt)
    den = lr * lr + li * li
    fr = ((ar - 1.0) * lr + ai * li) / den
    fi = (ai * lr - (ar - 1.0) * li) / den
    fr = fr[..., None]
    fi = fi[..., None]
    br = b_re.astype(f32)
    bi = b_im.astype(f32)
    bbr = fr * br - fi * bi
    bbi = fr * bi + fi * br
    bur = jnp.einsum('blgc,gpc->blgp', uf, bbr)
    bui = jnp.einsum('blgc,gpc->blgp', uf, bbi)
    arb = jnp.broadcast_to(ar, bur.shape)
    aib = jnp.broadcast_to(ai, bur.shape)

    def combine(e1, e2):
        a1r, a1i, b1r, b1i = e1
        a2r, a2i, b2r, b2i = e2
        return (a2r * a1r - a2i * a1i,
                a2r * a1i + a2i * a1r,
                a2r * b1r - a2i * b1i + b2r,
                a2r * b1i + a2i * b1r + b2i)

    _, _, sr, si = lax.associative_scan(combine, (arb, aib, bur, bui), axis=1)
    y = (jnp.einsum('blgp,gcp->blgc', sr, c_re.astype(f32))
         - jnp.einsum('blgp,gcp->blgc', si, c_im.astype(f32)))
    y = y.reshape(B, L, SSM_WIDTH) + d.astype(f32) * uf.reshape(B, L, SSM_WIDTH)
    return y.astype(u.dtype)


def diff_attention(q, k, v, lam, q_g, k_g, sub_g, lambda_init):
    B, L = q.shape[0], q.shape[1]
    H = ATTN_HEADS
    q = rmsnorm(q, q_g)
    k = rmsnorm(k, k_g)
    padf = lambda t: jnp.pad(t, [(0, 0), (ATTN_PAD, 0)] + [(0, 0)] * (t.ndim - 2))
    q, k, v = padf(q), padf(k), padf(v)
    Lp = L + ATTN_PAD
    nb = Lp // Q_BLOCK
    qb = q.reshape(B, nb, Q_BLOCK, H, 2, HEAD_DIM).transpose(1, 0, 3, 4, 2, 5)
    kt = k.transpose(0, 2, 3, 1, 4)
    vt = v.transpose(0, 2, 1, 3)
    kpos = jnp.arange(Lp)
    scale = HEAD_DIM ** -0.5

    def block(args):
        qblk, bi = args
        qpos = bi * Q_BLOCK + jnp.arange(Q_BLOCK)
        mask = (kpos[None, :] <= qpos[:, None]) & (kpos[None, :] >= ATTN_PAD)
        s = jnp.einsum('bhmqd,bhmkd->bhmqk', qblk, kt).astype(jnp.float32) * scale
        s = jnp.where(mask, s, NEG_INF)
        p = jax.nn.softmax(s, axis=-1)
        a = (p[:, :, 0] - lam * p[:, :, 1]).astype(vt.dtype)
        return jnp.einsum('bhqk,bhkv->bhqv', a, vt)

    o = lax.map(block, (qb, jnp.arange(nb)))
    o = o.transpose(1, 0, 3, 2, 4).reshape(B, Lp, H, 2 * HEAD_DIM)[:, ATTN_PAD:]
    o = rmsnorm(o, sub_g) * (1.0 - lambda_init)
    return o.reshape(B, L, ATTN_WIDTH)


def moe_ffn(xn, w_router, b_router, w_gate, b_gate, w_up, b_up, w_down, b_down):
    B, L, D = xn.shape
    T = B * L
    xt = xn.reshape(T, D)
    logits = (xt @ w_router + b_router).astype(jnp.float32)
    top_val, top_idx = lax.top_k(logits, TOP_K)
    gates = jax.nn.softmax(top_val, axis=-1).astype(xn.dtype)
    A = T * TOP_K
    flat_e = top_idx.reshape(A)
    flat_tok = jnp.arange(A, dtype=jnp.int32) // TOP_K
    flat_g = gates.reshape(A)
    order = jnp.argsort(flat_e)
    se = flat_e[order]
    counts = jnp.bincount(flat_e, length=N_EXPERTS)
    padded = (counts + ROW_BLOCK - 1) // ROW_BLOCK * ROW_BLOCK
    start = jnp.cumsum(counts) - counts
    pend = jnp.cumsum(padded)
    pstart = pend - padded
    dest = pstart[se] + jnp.arange(A) - start[se]
    n_blocks = -(-A // ROW_BLOCK) + N_EXPERTS
    n_rows = n_blocks * ROW_BLOCK
    row_tok = jnp.full((n_rows,), T, jnp.int32).at[dest].set(flat_tok[order])
    row_gate = jnp.zeros((n_rows,), xn.dtype).at[dest].set(flat_g[order])
    blk_e = jnp.minimum(jnp.searchsorted(pend, jnp.arange(n_blocks) * ROW_BLOCK, side='right'),
                        N_EXPERTS - 1)
    x_src = jnp.concatenate([xt, jnp.zeros((1, D), xt.dtype)], axis=0)

    def block(args):
        tok, e = args
        hb = x_src[tok]
        g = jnp.minimum(hb @ w_gate[e] + b_gate[e], SWIGLU_LIMIT)
        u = jnp.clip(hb @ w_up[e] + b_up[e], -SWIGLU_LIMIT, SWIGLU_LIMIT)
        a = (u + 1.0) * (g * jax.nn.sigmoid(SWIGLU_ALPHA * g))
        return a @ w_down[e] + b_down[e]

    y = lax.map(block, (row_tok.reshape(n_blocks, ROW_BLOCK), blk_e))
    y = y.reshape(n_rows, D) * row_gate[:, None]
    out = jnp.zeros((T + 1, D), y.dtype).at[row_tok].add(y)[:T]
    return out.reshape(B, L, D)


def setup_inputs(seed: int = 0) -> dict:
    key = jax.random.key(seed)
    ks = jax.random.split(key, 40)
    f = jnp.float32
    nrm = lambda k, shape, s: jax.random.normal(k, shape, f) * s
    G, P, C = SSM_GROUPS, SSM_STATE, SSM_GROUP
    E, F, D = N_EXPERTS, D_EXPERT, D_MODEL
    return {
        'x': nrm(ks[0], (BATCH, SEQ, D), 1.0),
        'meta_tokens': nrm(ks[1], (N_META, D), 1.0),
        'norm_mix_g': 1.0 + nrm(ks[2], (DEPTH, D), 0.02),
        'w_in': nrm(ks[3], (DEPTH, D, IN_WIDTH), D ** -0.5),
        'ssm_a_re': -0.5 + nrm(ks[4], (DEPTH, G, P), 0.01),
        'ssm_a_im': math.pi * jnp.arange(P, dtype=f) + nrm(ks[5], (DEPTH, G, P), 0.01),
        'ssm_log_dt': jax.random.uniform(ks[6], (DEPTH, G), f, math.log(DT_MIN), math.log(DT_MAX)),
        'ssm_b_re': nrm(ks[7], (DEPTH, G, P, C), (2 * C) ** -0.5),
        'ssm_b_im': nrm(ks[8], (DEPTH, G, P, C), (2 * C) ** -0.5),
        'ssm_c_re': nrm(ks[9], (DEPTH, G, C, P), (2 * P) ** -0.5),
        'ssm_c_im': nrm(ks[10], (DEPTH, G, C, P), (2 * P) ** -0.5),
        'ssm_d': nrm(ks[11], (DEPTH, SSM_WIDTH), 1.0),
        'w_glu': nrm(ks[12], (DEPTH, SSM_WIDTH, SSM_WIDTH), SSM_WIDTH ** -0.5),
        'b_glu': nrm(ks[13], (DEPTH, SSM_WIDTH), 0.01),
        'q_norm_g': 1.0 + nrm(ks[14], (DEPTH, HEAD_DIM), 0.02),
        'k_norm_g': 1.0 + nrm(ks[15], (DEPTH, HEAD_DIM), 0.02),
        'lambda_q1': nrm(ks[16], (DEPTH, HEAD_DIM), 0.1),
        'lambda_k1': nrm(ks[17], (DEPTH, HEAD_DIM), 0.1),
        'lambda_q2': nrm(ks[18], (DEPTH, HEAD_DIM), 0.1),
        'lambda_k2': nrm(ks[19], (DEPTH, HEAD_DIM), 0.1),
        'subln_g': 1.0 + nrm(ks[20], (DEPTH, 2 * HEAD_DIM), 0.02),
        'w_ssm_out': nrm(ks[21], (DEPTH, SSM_WIDTH, D), SSM_WIDTH ** -0.5),
        'w_attn_out': nrm(ks[22], (DEPTH, ATTN_WIDTH, D), ATTN_WIDTH ** -0.5),
        'w_o': nrm(ks[23], (DEPTH, D, D), D ** -0.5),
        'norm_ffn_g': 1.0 + nrm(ks[24], (DEPTH, D), 0.02),
        'w_router': nrm(ks[25], (DEPTH, D, E), D ** -0.5),
        'b_router': nrm(ks[26], (DEPTH, E), 0.01),
        'w_gate': nrm(ks[27], (DEPTH, E, D, F), D ** -0.5),
        'b_gate': nrm(ks[28], (DEPTH, E, F), 0.01),
        'w_up': nrm(ks[29], (DEPTH, E, D, F), D ** -0.5),
        'b_up': nrm(ks[30], (DEPTH, E, F), 0.01),
        'w_down': nrm(ks[31], (DEPTH, E, F, D), F ** -0.5),
        'b_down': nrm(ks[32], (DEPTH, E, D), 0.01),
    }


def reference(x, meta_tokens, norm_mix_g, w_in, ssm_a_re, ssm_a_im, ssm_log_dt, ssm_b_re, ssm_b_im,
              ssm_c_re, ssm_c_im, ssm_d, w_glu, b_glu, q_norm_g, k_norm_g, lambda_q1, lambda_k1,
              lambda_q2, lambda_k2, subln_g, w_ssm_out, w_attn_out, w_o, norm_ffn_g, w_router,
              b_router, w_gate, b_gate, w_up, b_up, w_down, b_down):
    B = x.shape[0]
    meta = jnp.broadcast_to(meta_tokens[None].astype(x.dtype), (B, N_META, D_MODEL))
    h = jnp.concatenate([meta, x], axis=1)
    L = h.shape[1]
    o_q = SSM_WIDTH
    o_k = o_q + ATTN_WIDTH
    o_v = o_k + ATTN_WIDTH
    o_g = o_v + ATTN_WIDTH
    for l in range(DEPTH):
        lambda_init = lambda_init_fn(l)
        n = rmsnorm(h, norm_mix_g[l])
        z = n @ w_in[l]
        u = z[..., :o_q]
        q = z[..., o_q:o_k].reshape(B, L, ATTN_HEADS, 2, HEAD_DIM)
        k = z[..., o_k:o_v].reshape(B, L, ATTN_HEADS, 2, HEAD_DIM)
        v = z[..., o_v:o_g].reshape(B, L, ATTN_HEADS, 2 * HEAD_DIM)
        gate_logits = z[..., o_g:].reshape(B, L, N_BRANCH, D_MODEL)
        y_s = s5_mixer(u, ssm_a_re[l], ssm_a_im[l], ssm_log_dt[l], ssm_b_re[l], ssm_b_im[l],
                       ssm_c_re[l], ssm_c_im[l], ssm_d[l])
        y_s = jax.nn.gelu(y_s)
        y_s = y_s * jax.nn.sigmoid(y_s @ w_glu[l] + b_glu[l])
        y_s = y_s @ w_ssm_out[l]
        lam = (jnp.exp(jnp.sum(lambda_q1[l].astype(jnp.float32) * lambda_k1[l].astype(jnp.float32)))
               - jnp.exp(jnp.sum(lambda_q2[l].astype(jnp.float32) * lambda_k2[l].astype(jnp.float32)))
               + lambda_init)
        y_a = diff_attention(q, k, v, lam, q_norm_g[l], k_norm_g[l], subln_g[l], lambda_init)
        y_a = y_a @ w_attn_out[l]
        g = jax.nn.sigmoid(gate_logits)
        mixed = g[:, :, 0] * y_s + g[:, :, 1] * y_a
        h = h + mixed @ w_o[l]
        h = h + moe_ffn(rmsnorm(h, norm_ffn_g[l]), w_router[l], b_router[l], w_gate[l], b_gate[l],
                        w_up[l], b_up[l], w_down[l], b_down[l])
    return h[:, N_META:]
```

```cpp
#include <hip/hip_runtime.h>
#include <cstdio>
#include <cstdint>

typedef unsigned short bf16_t;
typedef short bf16x8 __attribute__((ext_vector_type(8)));
typedef float f32x4 __attribute__((ext_vector_type(4)));

constexpr int D = 1024, BATCH = 2, SEQ = 8192, NMETA = 16, LTOK = SEQ + NMETA;
constexpr int RS = 8256, ROFF = 48;
constexpr int NR = BATCH * RS;
constexpr int MP = 16640;
constexpr int INW = 4096;
constexpr int SW = 512;
constexpr int NG = 32, NP = 64, NC = 16;
constexpr int NCHUNK = RS / 64;
constexpr int AW = 512;
constexpr int NE = 32, TOPK = 4;
constexpr int NTOK = BATCH * SEQ;
constexpr int NASSIGN = NTOK * TOPK;
constexpr int MOE_ROWS = NASSIGN + NE * 256;
constexpr float EPS = 1e-6f;

constexpr size_t MiB = 1u << 20;
constexpr size_t al(size_t x) { return (x + 255) & ~(size_t)255; }
constexpr size_t WS_XN = 0;
constexpr size_t WS_Z = WS_XN + al((size_t)MP * D * 2);
constexpr size_t WS_YS = WS_Z + al((size_t)MP * INW * 2);
constexpr size_t WS_YS2 = WS_YS + al((size_t)MP * SW * 2);
constexpr size_t WS_QKN = WS_YS2 + al((size_t)MP * SW * 2);
constexpr size_t WS_YA = WS_QKN + al((size_t)MP * D * 2);
constexpr size_t WS_MIX = WS_YA + al((size_t)MP * AW * 2);
constexpr size_t WS_A_END = WS_MIX + al((size_t)MP * D * 2);
constexpr size_t WS_ACT = 0;
constexpr size_t WS_Y = WS_ACT + al((size_t)MOE_ROWS * D * 2);
constexpr size_t WS_B0 = (WS_Y + al((size_t)MOE_ROWS * D * 2)) > WS_A_END ? (WS_Y + al((size_t)MOE_ROWS * D * 2)) : WS_A_END;
constexpr size_t WS_H1 = WS_B0;
constexpr size_t WS_XN2 = WS_H1 + al((size_t)MP * D * 4);
constexpr size_t WS_SM = WS_XN2 + al((size_t)MP * D * 2);
constexpr size_t SM_BB = 0;
constexpr size_t SM_AA = SM_BB + al((size_t)NG * NP * 32 * 4);
constexpr size_t SM_E = SM_AA + al((size_t)NG * NP * 4 * 4);
constexpr size_t SM_SIN = SM_E + al((size_t)BATCH * NCHUNK * NG * NP * 2 * 4);
constexpr size_t SM_LAM = SM_SIN + al((size_t)BATCH * NCHUNK * NG * NP * 2 * 4);
constexpr size_t SM_IDX = SM_LAM + 256;
constexpr size_t SM_GATE = SM_IDX + al((size_t)NASSIGN * 4);
constexpr size_t SM_POS = SM_GATE + al((size_t)NASSIGN * 4);
constexpr size_t SM_CNT = SM_POS + al((size_t)NASSIGN * 4);
constexpr size_t SM_OFF = SM_CNT + 256;
constexpr size_t SM_ROWTOK = SM_OFF + 256;
constexpr size_t SM_END = SM_ROWTOK + al((size_t)MOE_ROWS * 4);
constexpr size_t WS_END = WS_SM + SM_END;

__device__ __forceinline__ unsigned f2bf(float f) { unsigned u = __builtin_bit_cast(unsigned, f); return (u + 0x7fffu + ((u >> 16) & 1u)) >> 16; }
__device__ __forceinline__ float bf2f(unsigned h) { return __builtin_bit_cast(float, h << 16); }
__device__ __forceinline__ float wave_sum(float v) {
#pragma unroll
    for (int o = 1; o < 64; o <<= 1) v += __shfl_xor(v, o);
    return v;
}
__device__ __forceinline__ float sigmoidf_(float x) { return 1.f / (1.f + __expf(-x)); }
__device__ __forceinline__ float gelu_tanh(float x) { const float t = 0.7978845608028654f * (x + 0.044715f * x * x * x); return 0.5f * x * (1.f + tanhf(t)); }

__device__ __forceinline__ const float* h_row(const float* x, const float* meta, int r) {
    if (r >= NR) return nullptr;
    const int b = r / RS, l = r % RS - ROFF;
    if (l < 0) return nullptr;
    return l < NMETA ? meta + (size_t)l * D : x + ((size_t)b * SEQ + (l - NMETA)) * D;
}

__global__ void __launch_bounds__(256) k_prep_rows(const float* __restrict__ x, const float* __restrict__ meta, const float* __restrict__ g, bf16_t* __restrict__ XN) {
    const int lane = threadIdx.x & 63, row = blockIdx.x * 4 + (threadIdx.x >> 6);
    const float* src = h_row(x, meta, row);
    f32x4 v[4]; float ss = 0.f;
#pragma unroll
    for (int j = 0; j < 4; ++j) { v[j] = src ? *(const f32x4*)(src + 256 * j + 4 * lane) : (f32x4){0.f, 0.f, 0.f, 0.f}; ss += v[j][0] * v[j][0] + v[j][1] * v[j][1] + v[j][2] * v[j][2] + v[j][3] * v[j][3]; }
    ss = wave_sum(ss);
    const float rs = rsqrtf(ss * (1.f / D) + EPS);
#pragma unroll
    for (int j = 0; j < 4; ++j) {
        const f32x4 gg = *(const f32x4*)(g + 256 * j + 4 * lane);
        const unsigned lo = f2bf(v[j][0] * rs * gg[0]) | (f2bf(v[j][1] * rs * gg[1]) << 16), hi = f2bf(v[j][2] * rs * gg[2]) | (f2bf(v[j][3] * rs * gg[3]) << 16);
        *(uint2*)(XN + (size_t)row * D + 256 * j + 4 * lane) = make_uint2(lo, hi);
    }
}

template <bool GATHER>
__device__ __forceinline__ void gemm_core(f32x4 (&acc)[2][2], const bf16_t* __restrict__ A, int lda, const int* __restrict__ rowidx, int m0,
                                          const float* __restrict__ B, int ldb, int n0, int K, bf16_t* As, bf16_t* Bs) {
    const int tid = threadIdx.x, lane = tid & 63, w = tid >> 6, wm = w >> 1, wn = w & 1;
    const int ar = tid >> 2, ak = (tid & 3) * 8, bk = tid >> 3, bn = (tid & 7) * 8;
    int arow = m0 + ar; if (GATHER) arow = rowidx[m0 + ar];
#pragma unroll
    for (int i = 0; i < 2; ++i)
#pragma unroll
        for (int j = 0; j < 2; ++j) acc[i][j] = (f32x4){0.f, 0.f, 0.f, 0.f};
    for (int k0 = 0; k0 < K; k0 += 32) {
        uint4 av = make_uint4(0, 0, 0, 0);
        if (arow >= 0) av = *(const uint4*)(A + (size_t)arow * lda + k0 + ak);
        const f32x4 b0 = *(const f32x4*)(B + (size_t)(k0 + bk) * ldb + n0 + bn), b1 = *(const f32x4*)(B + (size_t)(k0 + bk) * ldb + n0 + bn + 4);
        __syncthreads();
        *(uint4*)(As + ar * 40 + ak) = av;
#pragma unroll
        for (int i = 0; i < 4; ++i) { Bs[(bn + i) * 40 + bk] = (bf16_t)f2bf(b0[i]); Bs[(bn + 4 + i) * 40 + bk] = (bf16_t)f2bf(b1[i]); }
        __syncthreads();
        bf16x8 a[2], b[2];
#pragma unroll
        for (int i = 0; i < 2; ++i) { a[i] = *(const bf16x8*)(As + (wm * 32 + i * 16 + (lane & 15)) * 40 + 8 * (lane >> 4)); b[i] = *(const bf16x8*)(Bs + (wn * 32 + i * 16 + (lane & 15)) * 40 + 8 * (lane >> 4)); }
#pragma unroll
        for (int i = 0; i < 2; ++i)
#pragma unroll
            for (int j = 0; j < 2; ++j) acc[i][j] = __builtin_amdgcn_mfma_f32_16x16x32_bf16(a[i], b[j], acc[i][j], 0, 0, 0);
    }
}
#define EPI_LOOP(...) \
    { const int lane_ = threadIdx.x & 63, w_ = threadIdx.x >> 6, wm_ = w_ >> 1, wn_ = w_ & 1; \
      _Pragma("unroll") for (int mi = 0; mi < 2; ++mi) _Pragma("unroll") for (int ni = 0; ni < 2; ++ni) _Pragma("unroll") for (int r = 0; r < 4; ++r) { \
        const int row = m0 + wm_ * 32 + mi * 16 + (lane_ >> 4) * 4 + r, col = n0 + wn_ * 32 + ni * 16 + (lane_ & 15); __VA_ARGS__ } }

__global__ void __launch_bounds__(256) k_gemm_z(const bf16_t* __restrict__ XN, const float* __restrict__ w_in, bf16_t* __restrict__ Z) {
    __shared__ __attribute__((aligned(16))) bf16_t As[64 * 40]; __shared__ __attribute__((aligned(16))) bf16_t Bs[64 * 40];
    const int m0 = blockIdx.x * 64, n0 = blockIdx.y * 64; f32x4 acc[2][2];
    gemm_core<false>(acc, XN, D, nullptr, m0, w_in, INW, n0, D, As, Bs);
    EPI_LOOP({ Z[(size_t)row * INW + col] = (bf16_t)f2bf(acc[mi][ni][r]); })
}
__global__ void __launch_bounds__(256) k_gemm_glu(const bf16_t* __restrict__ YS, const float* __restrict__ w_glu, const float* __restrict__ b_glu, bf16_t* __restrict__ YS2) {
    __shared__ __attribute__((aligned(16))) bf16_t As[64 * 40]; __shared__ __attribute__((aligned(16))) bf16_t Bs[64 * 40];
    const int m0 = blockIdx.x * 64, n0 = blockIdx.y * 64; f32x4 acc[2][2];
    gemm_core<false>(acc, YS, SW, nullptr, m0, w_glu, SW, n0, SW, As, Bs);
    EPI_LOOP({ const float ys = bf2f(YS[(size_t)row * SW + col]); YS2[(size_t)row * SW + col] = (bf16_t)f2bf(ys * sigmoidf_(acc[mi][ni][r] + b_glu[col])); })
}
__global__ void __launch_bounds__(256) k_gemm_mix(const bf16_t* __restrict__ YS2, const float* __restrict__ w_so, const bf16_t* __restrict__ YA, const float* __restrict__ w_ao,
                                                  const bf16_t* __restrict__ Z, bf16_t* __restrict__ MIX) {
    __shared__ __attribute__((aligned(16))) bf16_t As[64 * 40]; __shared__ __attribute__((aligned(16))) bf16_t Bs[64 * 40];
    const int m0 = blockIdx.x * 64, n0 = blockIdx.y * 64; f32x4 acc[2][2], acc2[2][2];
    gemm_core<false>(acc, YS2, SW, nullptr, m0, w_so, D, n0, SW, As, Bs);
    gemm_core<false>(acc2, YA, AW, nullptr, m0, w_ao, D, n0, AW, As, Bs);
    EPI_LOOP({ const float g0 = sigmoidf_(bf2f(Z[(size_t)row * INW + 2048 + col])), g1 = sigmoidf_(bf2f(Z[(size_t)row * INW + 3072 + col]));
               MIX[(size_t)row * D + col] = (bf16_t)f2bf(g0 * acc[mi][ni][r] + g1 * acc2[mi][ni][r]); })
}
__global__ void __launch_bounds__(256) k_gemm_wo(const bf16_t* __restrict__ MIX, const float* __restrict__ w_o, const float* __restrict__ x, const float* __restrict__ meta, float* __restrict__ H1) {
    __shared__ __attribute__((aligned(16))) bf16_t As[64 * 40]; __shared__ __attribute__((aligned(16))) bf16_t Bs[64 * 40];
    const int m0 = blockIdx.x * 64, n0 = blockIdx.y * 64; f32x4 acc[2][2];
    gemm_core<false>(acc, MIX, D, nullptr, m0, w_o, D, n0, D, As, Bs);
    EPI_LOOP({ const float* hr = h_row(x, meta, row); H1[(size_t)row * D + col] = hr ? hr[col] + acc[mi][ni][r] : 0.f; })
}

__global__ void __launch_bounds__(64) k_s5_params(const float* __restrict__ a_re, const float* __restrict__ a_im, const float* __restrict__ log_dt, const float* __restrict__ b_re, const float* __restrict__ b_im,
                                                  float* __restrict__ BB, float* __restrict__ AA) {
    const int g = blockIdx.x, p = threadIdx.x, gp = g * NP + p;
    const float lr = fminf(a_re[gp], -1e-4f), li = a_im[gp], dt = expf(log_dt[g]);
    const float mag = expf(lr * dt), ar = mag * cosf(li * dt), ai = mag * sinf(li * dt);
    const float den = lr * lr + li * li, fr = ((ar - 1.f) * lr + ai * li) / den, fi = (ai * lr - (ar - 1.f) * li) / den;
    for (int c = 0; c < NC; ++c) { const float br = b_re[gp * NC + c], bi = b_im[gp * NC + c]; BB[gp * 32 + c] = fr * br - fi * bi; BB[gp * 32 + 16 + c] = fr * bi + fi * br; }
    float pr = ar, pi = ai;
    for (int i = 0; i < 6; ++i) { const float nr = pr * pr - pi * pi, ni = 2.f * pr * pi; pr = nr; pi = ni; }
    AA[gp * 4 + 0] = ar; AA[gp * 4 + 1] = ai; AA[gp * 4 + 2] = pr; AA[gp * 4 + 3] = pi;
}
template <bool FINAL>
__global__ void __launch_bounds__(64) k_s5_scan(const bf16_t* __restrict__ Z, const float* __restrict__ BB, const float* __restrict__ AA, float* __restrict__ E, const float* __restrict__ SIN,
                                                const float* __restrict__ c_re, const float* __restrict__ c_im, const float* __restrict__ dvec, bf16_t* __restrict__ YS) {
    __shared__ float Ssh[64 * 128]; __shared__ float Csh[16 * 129]; __shared__ float Ush[64 * 16];
    const int bc = blockIdx.x, g = blockIdx.y, p = threadIdx.x, gp = g * NP + p;
    const int b = bc / NCHUNK, chunk = bc % NCHUNK, row0 = b * RS + chunk * 64;
    float bbr[16], bbi[16];
#pragma unroll
    for (int c = 0; c < 16; ++c) { bbr[c] = BB[gp * 32 + c]; bbi[c] = BB[gp * 32 + 16 + c]; }
    const float ar = AA[gp * 4], ai = AA[gp * 4 + 1];
    float sr = 0.f, si = 0.f;
    const size_t eidx = ((size_t)bc * NG + g) * NP + p;
    if (FINAL) { sr = SIN[eidx * 2]; si = SIN[eidx * 2 + 1]; }
    for (int t = 0; t < 64; ++t) {
        const bf16_t* zr = Z + (size_t)(row0 + t) * INW + g * NC;
        const uint4 u0 = *(const uint4*)zr, u1 = *(const uint4*)(zr + 8);
        const unsigned uw[8] = {u0.x, u0.y, u0.z, u0.w, u1.x, u1.y, u1.z, u1.w};
        float bur = 0.f, bui = 0.f;
#pragma unroll
        for (int c = 0; c < 8; ++c) { const float ua = bf2f(uw[c] & 0xffffu), ub = bf2f(uw[c] >> 16); bur += bbr[2 * c] * ua + bbr[2 * c + 1] * ub; bui += bbi[2 * c] * ua + bbi[2 * c + 1] * ub;
            if (FINAL && p == 0) { Ush[t * 16 + 2 * c] = ua; Ush[t * 16 + 2 * c + 1] = ub; } }
        const float nr = ar * sr - ai * si + bur, ni = ar * si + ai * sr + bui; sr = nr; si = ni;
        if (FINAL) { Ssh[t * 128 + p] = sr; Ssh[t * 128 + 64 + p] = si; }
    }
    if (!FINAL) { E[eidx * 2] = sr; E[eidx * 2 + 1] = si; return; }
    for (int i = p; i < 16 * 64; i += 64) { const int c = i >> 6, pp = i & 63; Csh[c * 129 + pp] = c_re[(g * NC + c) * NP + pp]; Csh[c * 129 + 64 + pp] = -c_im[(g * NC + c) * NP + pp]; }
    __syncthreads();
    const int c = p & 15, tq = p >> 4; const float dd = dvec[g * NC + c];
    for (int k = 0; k < 16; ++k) {
        const int t = tq + 4 * k; float y = 0.f;
        for (int pp = 0; pp < 128; ++pp) y += Csh[c * 129 + pp] * Ssh[t * 128 + pp];
        y += dd * Ush[t * 16 + c];
        YS[(size_t)(row0 + t) * SW + g * NC + c] = (bf16_t)f2bf(gelu_tanh(y));
    }
}
__global__ void __launch_bounds__(256) k_s5_carry(const float* __restrict__ AA, const float* __restrict__ E, float* __restrict__ SIN) {
    const int i = blockIdx.x * 256 + threadIdx.x;
    const int b = i / (NG * NP), gp = i % (NG * NP);
    const float a64r = AA[gp * 4 + 2], a64i = AA[gp * 4 + 3];
    float sr = 0.f, si = 0.f;
    for (int c = 0; c < NCHUNK; ++c) {
        const size_t e = ((size_t)(b * NCHUNK + c) * NG * NP + gp) * 2;
        SIN[e] = sr; SIN[e + 1] = si;
        const float er = E[e], ei = E[e + 1];
        const float nr = a64r * sr - a64i * si + er, ni = a64r * si + a64i * sr + ei; sr = nr; si = ni;
    }
}

__global__ void __launch_bounds__(256) k_qkn(const bf16_t* __restrict__ Z, const float* __restrict__ q_g, const float* __restrict__ k_g, bf16_t* __restrict__ QKN) {
    const int lane = threadIdx.x & 63, row = blockIdx.x * 4 + (threadIdx.x >> 6);
    const bf16_t* zr = Z + (size_t)row * INW + 512 + 16 * lane;
    const uint4 u0 = *(const uint4*)zr, u1 = *(const uint4*)(zr + 8);
    const unsigned uw[8] = {u0.x, u0.y, u0.z, u0.w, u1.x, u1.y, u1.z, u1.w};
    float v[16]; float ss = 0.f;
#pragma unroll
    for (int c = 0; c < 8; ++c) { v[2 * c] = bf2f(uw[c] & 0xffffu); v[2 * c + 1] = bf2f(uw[c] >> 16); ss += v[2 * c] * v[2 * c] + v[2 * c + 1] * v[2 * c + 1]; }
    ss += __shfl_xor(ss, 1); ss += __shfl_xor(ss, 2);
    const float rs = rsqrtf(ss * (1.f / 64.f) + EPS);
    const float* gg = (lane < 32 ? q_g : k_g) + 16 * (lane & 3);
    unsigned o[8];
#pragma unroll
    for (int c = 0; c < 8; ++c) o[c] = f2bf(v[2 * c] * rs * gg[2 * c]) | (f2bf(v[2 * c + 1] * rs * gg[2 * c + 1]) << 16);
    bf16_t* qr = QKN + (size_t)row * D + 16 * lane;
    *(uint4*)qr = make_uint4(o[0], o[1], o[2], o[3]); *(uint4*)(qr + 8) = make_uint4(o[4], o[5], o[6], o[7]);
}
__global__ void k_lam(const float* q1, const float* k1, const float* q2, const float* k2, float* lam) {
    float s1 = 0.f, s2 = 0.f;
    for (int i = 0; i < 64; ++i) { s1 += q1[i] * k1[i]; s2 += q2[i] * k2[i]; }
    lam[0] = expf(s1) - expf(s2) + 0.2f;
}
__global__ void __launch_bounds__(256) k_attn(const bf16_t* __restrict__ QKN, const bf16_t* __restrict__ Z, const float* __restrict__ lamp, const float* __restrict__ sub_g, bf16_t* __restrict__ YA) {
    __shared__ float Ks[64 * 132]; __shared__ float Vs[64 * 132];
    const int tid = threadIdx.x, qrow = tid >> 2, part = tid & 3;
    const int qb = blockIdx.x, h = blockIdx.y, b = blockIdx.z;
    const int lq = qb * 64 + qrow; const bool qvalid = lq < LTOK;
    const size_t rbase = (size_t)b * RS + ROFF;
    float q0[16], q1[16];
    {
        const bf16_t* qp = QKN + (rbase + (qvalid ? lq : 0)) * D + h * 128 + 16 * part;
#pragma unroll
        for (int d = 0; d < 16; ++d) { q0[d] = bf2f(qp[d]) * 0.125f; q1[d] = bf2f(qp[64 + d]) * 0.125f; }
    }
    float m0 = -1e30f, m1 = -1e30f, l0 = 0.f, l1 = 0.f, o0[32], o1[32];
#pragma unroll
    for (int d = 0; d < 32; ++d) { o0[d] = 0.f; o1[d] = 0.f; }
    for (int kt = 0; kt <= qb; ++kt) {
        __syncthreads();
        for (int i = tid; i < 64 * 128; i += 256) {
            const int j = i >> 7, c = i & 127, lk = kt * 64 + j;
            float kv = 0.f, vv = 0.f;
            if (lk < LTOK) { kv = bf2f(QKN[(rbase + lk) * D + 512 + h * 128 + c]); vv = bf2f(Z[(rbase + lk) * INW + 1536 + h * 128 + c]); }
            Ks[j * 132 + c] = kv; Vs[j * 132 + c] = vv;
        }
        __syncthreads();
        const int jmax = (kt == qb) ? 64 : 64;
        for (int j = 0; j < jmax; ++j) {
            const int lk = kt * 64 + j;
            float s0 = 0.f, s1 = 0.f;
#pragma unroll
            for (int d = 0; d < 16; ++d) { s0 += q0[d] * Ks[j * 132 + 16 * part + d]; s1 += q1[d] * Ks[j * 132 + 64 + 16 * part + d]; }
            s0 += __shfl_xor(s0, 1); s0 += __shfl_xor(s0, 2); s1 += __shfl_xor(s1, 1); s1 += __shfl_xor(s1, 2);
            if (lk <= lq && qvalid) {
                if (s0 > m0) { const float sc = __expf(m0 - s0); l0 *= sc;
#pragma unroll
                    for (int d = 0; d < 32; ++d) o0[d] *= sc; m0 = s0; }
                if (s1 > m1) { const float sc = __expf(m1 - s1); l1 *= sc;
#pragma unroll
                    for (int d = 0; d < 32; ++d) o1[d] *= sc; m1 = s1; }
                const float p0 = __expf(s0 - m0), p1 = __expf(s1 - m1); l0 += p0; l1 += p1;
#pragma unroll
                for (int d = 0; d < 32; ++d) { const float v = Vs[j * 132 + 32 * part + d]; o0[d] += p0 * v; o1[d] += p1 * v; }
            }
        }
    }
    const float lam = lamp[0], i0 = qvalid ? 1.f / l0 : 0.f, i1 = qvalid ? lam / l1 : 0.f;
    float ss = 0.f;
#pragma unroll
    for (int d = 0; d < 32; ++d) { o0[d] = o0[d] * i0 - o1[d] * i1; ss += o0[d] * o0[d]; }
    ss += __shfl_xor(ss, 1); ss += __shfl_xor(ss, 2);
    const float rs = rsqrtf(ss * (1.f / 128.f) + EPS) * 0.8f;
    if (qvalid) {
        bf16_t* op = YA + (rbase + lq) * AW + h * 128 + 32 * part;
#pragma unroll
        for (int d = 0; d < 32; ++d) op[d] = (bf16_t)f2bf(o0[d] * rs * sub_g[32 * part + d]);
    }
}
__global__ void __launch_bounds__(256) k_zero_bf16(bf16_t* p, size_t n) { for (size_t i = (size_t)blockIdx.x * 256 + threadIdx.x; i < n; i += (size_t)gridDim.x * 256) p[i] = 0; }

__global__ void __launch_bounds__(256) k_router(const float* __restrict__ H1, const float* __restrict__ g, const float* __restrict__ w_router, const float* __restrict__ b_router,
                                                bf16_t* __restrict__ XN2, int* __restrict__ IDX, float* __restrict__ GATE, int* __restrict__ POS, int* __restrict__ CNT) {
    const int lane = threadIdx.x & 63, t = blockIdx.x * 4 + (threadIdx.x >> 6);
    const int b = t / SEQ, i = t % SEQ, row = b * RS + 64 + i;
    const float* hr = H1 + (size_t)row * D;
    float v[16]; float ss = 0.f;
#pragma unroll
    for (int j = 0; j < 4; ++j) { const f32x4 a = *(const f32x4*)(hr + 256 * j + 4 * lane); v[4 * j] = a[0]; v[4 * j + 1] = a[1]; v[4 * j + 2] = a[2]; v[4 * j + 3] = a[3]; ss += a[0] * a[0] + a[1] * a[1] + a[2] * a[2] + a[3] * a[3]; }
    ss = wave_sum(ss);
    const float rs = rsqrtf(ss * (1.f / D) + EPS);
#pragma unroll
    for (int j = 0; j < 4; ++j) {
        const f32x4 gg = *(const f32x4*)(g + 256 * j + 4 * lane);
#pragma unroll
        for (int q = 0; q < 4; ++q) v[4 * j + q] = v[4 * j + q] * rs * gg[q];
        *(uint2*)(XN2 + (size_t)row * D + 256 * j + 4 * lane) = make_uint2(f2bf(v[4 * j]) | (f2bf(v[4 * j + 1]) << 16), f2bf(v[4 * j + 2]) | (f2bf(v[4 * j + 3]) << 16));
    }
    float lg[NE];
#pragma unroll
    for (int e = 0; e < NE; ++e) lg[e] = 0.f;
#pragma unroll
    for (int j = 0; j < 4; ++j)
#pragma unroll
        for (int q = 0; q < 4; ++q) {
            const float* wr = w_router + (size_t)(256 * j + 4 * lane + q) * NE; const float xv = v[4 * j + q];
#pragma unroll
            for (int e = 0; e < NE; e += 4) { const f32x4 w4 = *(const f32x4*)(wr + e); lg[e] += xv * w4[0]; lg[e + 1] += xv * w4[1]; lg[e + 2] += xv * w4[2]; lg[e + 3] += xv * w4[3]; }
        }
#pragma unroll
    for (int e = 0; e < NE; ++e) lg[e] = wave_sum(lg[e]) + b_router[e];
    if (lane == 0) {
        int id[4]; float tv[4];
#pragma unroll
        for (int k = 0; k < 4; ++k) {
            float best = -3.4e38f; int bi = 0;
#pragma unroll
            for (int e = 0; e < NE; ++e) { const bool taken = (k > 0 && id[0] == e) || (k > 1 && id[1] == e) || (k > 2 && id[2] == e); if (!taken && lg[e] > best) { best = lg[e]; bi = e; } }
            id[k] = bi; tv[k] = best;
        }
        const float e0 = 1.f, e1 = __expf(tv[1] - tv[0]), e2 = __expf(tv[2] - tv[0]), e3 = __expf(tv[3] - tv[0]), inv = 1.f / (e0 + e1 + e2 + e3);
        const float gw[4] = {e0 * inv, e1 * inv, e2 * inv, e3 * inv};
#pragma unroll
        for (int k = 0; k < 4; ++k) { IDX[t * 4 + k] = id[k]; GATE[t * 4 + k] = gw[k]; POS[t * 4 + k] = atomicAdd(&CNT[id[k]], 1); }
    }
}
__global__ void k_offsets(const int* CNT, int* OFF) { int o = 0; for (int e = 0; e < NE; ++e) { OFF[e] = o; o += (CNT[e] + 255) / 256 * 256; } OFF[NE] = o; }
__global__ void __launch_bounds__(256) k_scatter(const int* __restrict__ IDX, const int* __restrict__ POS, const int* __restrict__ OFF, int* __restrict__ ROWTOK) {
    const int a = blockIdx.x * 256 + threadIdx.x; const int t = a >> 2;
    const int b = t / SEQ, i = t % SEQ;
    ROWTOK[OFF[IDX[a]] + POS[a]] = b * RS + 64 + i;
}
__device__ __forceinline__ int tile_expert(const int* OFF, int m0) { int e = 0; while (e < NE - 1 && OFF[e + 1] <= m0) ++e; return e; }
__global__ void __launch_bounds__(256) k_moe1(const bf16_t* __restrict__ XN2, const int* __restrict__ ROWTOK, const int* __restrict__ OFF, const float* __restrict__ w_gate, const float* __restrict__ b_gate,
                                              const float* __restrict__ w_up, const float* __restrict__ b_up, bf16_t* __restrict__ ACT) {
    __shared__ __attribute__((aligned(16))) bf16_t As[64 * 40]; __shared__ __attribute__((aligned(16))) bf16_t Bs[64 * 40];
    const int m0 = blockIdx.x * 64, n0 = blockIdx.y * 64;
    if (m0 >= OFF[NE]) return;
    const int e = tile_expert(OFF, m0);
    f32x4 acc[2][2], acc2[2][2];
    gemm_core<true>(acc, XN2, D, ROWTOK, m0, w_gate + (size_t)e * D * D, D, n0, D, As, Bs);
    gemm_core<true>(acc2, XN2, D, ROWTOK, m0, w_up + (size_t)e * D * D, D, n0, D, As, Bs);
    EPI_LOOP({ const float gg = fminf(acc[mi][ni][r] + b_gate[e * D + col], 7.f), uu = fminf(fmaxf(acc2[mi][ni][r] + b_up[e * D + col], -7.f), 7.f);
               ACT[(size_t)row * D + col] = (bf16_t)f2bf((uu + 1.f) * (gg * sigmoidf_(1.702f * gg))); })
}
__global__ void __launch_bounds__(256) k_moe2(const bf16_t* __restrict__ ACT, const int* __restrict__ OFF, const float* __restrict__ w_down, const float* __restrict__ b_down, bf16_t* __restrict__ Y) {
    __shared__ __attribute__((aligned(16))) bf16_t As[64 * 40]; __shared__ __attribute__((aligned(16))) bf16_t Bs[64 * 40];
    const int m0 = blockIdx.x * 64, n0 = blockIdx.y * 64;
    if (m0 >= OFF[NE]) return;
    const int e = tile_expert(OFF, m0);
    f32x4 acc[2][2];
    gemm_core<false>(acc, ACT, D, nullptr, m0, w_down + (size_t)e * D * D, D, n0, D, As, Bs);
    EPI_LOOP({ Y[(size_t)row * D + col] = (bf16_t)f2bf(acc[mi][ni][r] + b_down[e * D + col]); })
}
__global__ void __launch_bounds__(256) k_combine(const float* __restrict__ H1, const bf16_t* __restrict__ Y, const int* __restrict__ IDX, const float* __restrict__ GATE, const int* __restrict__ POS, const int* __restrict__ OFF, float* __restrict__ out) {
    const int t = blockIdx.x; const int b = t / SEQ, i = t % SEQ, row = b * RS + 64 + i, c = threadIdx.x * 4;
    f32x4 o = *(const f32x4*)(H1 + (size_t)row * D + c);
#pragma unroll
    for (int k = 0; k < 4; ++k) {
        const int yr = OFF[IDX[t * 4 + k]] + POS[t * 4 + k]; const float gw = GATE[t * 4 + k];
        const uint2 u = *(const uint2*)(Y + (size_t)yr * D + c);
        o[0] += gw * bf2f(u.x & 0xffffu); o[1] += gw * bf2f(u.x >> 16); o[2] += gw * bf2f(u.y & 0xffffu); o[3] += gw * bf2f(u.y >> 16);
    }
    *(f32x4*)(out + (size_t)t * D + c) = o;
}

extern "C" void kernel_launch(void* const* d_in, const int* in_sizes, int n_in, void* d_out, int out_size, void* d_ws, size_t ws_size, hipStream_t stream) {
    if (n_in != 33 || ws_size < WS_END) { fprintf(stderr, "kernel_launch: need 33 inputs and %zu bytes of workspace (got %d, %zu)\n", (size_t)WS_END, n_in, ws_size); return; }
    const float* const* in = (const float* const*)d_in;
    const float *x = in[0], *meta = in[1], *norm_mix_g = in[2], *w_in = in[3], *a_re = in[4], *a_im = in[5], *log_dt = in[6], *b_re = in[7], *b_im = in[8], *c_re = in[9], *c_im = in[10], *ssm_d = in[11],
                *w_glu = in[12], *b_glu = in[13], *q_g = in[14], *k_g = in[15], *lq1 = in[16], *lk1 = in[17], *lq2 = in[18], *lk2 = in[19], *sub_g = in[20], *w_so = in[21], *w_ao = in[22], *w_o = in[23],
                *norm_ffn_g = in[24], *w_router = in[25], *b_router = in[26], *w_gate = in[27], *b_gate = in[28], *w_up = in[29], *b_up = in[30], *w_down = in[31], *b_down = in[32];
    unsigned char* ws = (unsigned char*)d_ws;
    bf16_t *XN = (bf16_t*)(ws + WS_XN), *Z = (bf16_t*)(ws + WS_Z), *YS = (bf16_t*)(ws + WS_YS), *YS2 = (bf16_t*)(ws + WS_YS2), *QKN = (bf16_t*)(ws + WS_QKN), *YA = (bf16_t*)(ws + WS_YA), *MIX = (bf16_t*)(ws + WS_MIX);
    bf16_t *ACT = (bf16_t*)(ws + WS_ACT), *Y = (bf16_t*)(ws + WS_Y), *XN2 = (bf16_t*)(ws + WS_XN2);
    float* H1 = (float*)(ws + WS_H1);
    unsigned char* sm = ws + WS_SM;
    float *BB = (float*)(sm + SM_BB), *AA = (float*)(sm + SM_AA), *E = (float*)(sm + SM_E), *SIN = (float*)(sm + SM_SIN), *LAM = (float*)(sm + SM_LAM), *GATE = (float*)(sm + SM_GATE);
    int *IDX = (int*)(sm + SM_IDX), *POS = (int*)(sm + SM_POS), *CNT = (int*)(sm + SM_CNT), *OFF = (int*)(sm + SM_OFF), *ROWTOK = (int*)(sm + SM_ROWTOK);

    (void)hipMemsetAsync(CNT, 0, 256, stream);
    (void)hipMemsetAsync(ROWTOK, 0xFF, (size_t)MOE_ROWS * 4, stream);
    k_prep_rows<<<MP / 4, 256, 0, stream>>>(x, meta, norm_mix_g, XN);
    k_gemm_z<<<dim3(MP / 64, INW / 64), 256, 0, stream>>>(XN, w_in, Z);
    k_s5_params<<<NG, 64, 0, stream>>>(a_re, a_im, log_dt, b_re, b_im, BB, AA);
    k_s5_scan<false><<<dim3(BATCH * NCHUNK, NG), 64, 0, stream>>>(Z, BB, AA, E, nullptr, nullptr, nullptr, nullptr, nullptr);
    k_s5_carry<<<BATCH * NG * NP / 256, 256, 0, stream>>>(AA, E, SIN);
    k_zero_bf16<<<1024, 256, 0, stream>>>(YS, (size_t)MP * SW);
    k_s5_scan<true><<<dim3(BATCH * NCHUNK, NG), 64, 0, stream>>>(Z, BB, AA, nullptr, SIN, c_re, c_im, ssm_d, YS);
    k_gemm_glu<<<dim3(MP / 64, SW / 64), 256, 0, stream>>>(YS, w_glu, b_glu, YS2);
    k_qkn<<<MP / 4, 256, 0, stream>>>(Z, q_g, k_g, QKN);
    k_lam<<<1, 1, 0, stream>>>(lq1, lk1, lq2, lk2, LAM);
    k_zero_bf16<<<1024, 256, 0, stream>>>(YA, (size_t)MP * AW);
    k_attn<<<dim3((LTOK + 63) / 64, 4, BATCH), 256, 0, stream>>>(QKN, Z, LAM, sub_g, YA);
    k_gemm_mix<<<dim3(MP / 64, D / 64), 256, 0, stream>>>(YS2, w_so, YA, w_ao, Z, MIX);
    k_gemm_wo<<<dim3(MP / 64, D / 64), 256, 0, stream>>>(MIX, w_o, x, meta, H1);
    k_router<<<NTOK / 4, 256, 0, stream>>>(H1, norm_ffn_g, w_router, b_router, XN2, IDX, GATE, POS, CNT);
    k_offsets<<<1, 1, 0, stream>>>(CNT, OFF);
    k_scatter<<<NASSIGN / 256, 256, 0, stream>>>(IDX, POS, OFF, ROWTOK);
    k_moe1<<<dim3(MOE_ROWS / 64, D / 64), 256, 0, stream>>>(XN2, ROWTOK, OFF, w_gate, b_gate, w_up, b_up, ACT);
    k_moe2<<<dim3(MOE_ROWS / 64, D / 64), 256, 0, stream>>>(ACT, OFF, w_down, b_down, Y);
    k_combine<<<NTOK, 256, 0, stream>>>(H1, Y, IDX, GATE, POS, OFF, (float*)d_out);
}
```

```cpp
#include <hip/hip_runtime.h>
#include <hip/hip_cooperative_groups.h>
#include <cstdio>
#include <cstdint>
namespace cg = cooperative_groups;

typedef unsigned short bf16_t;
typedef short bf16x8 __attribute__((ext_vector_type(8)));
typedef float f32x4 __attribute__((ext_vector_type(4)));
#define LAS __attribute__((address_space(3)))

constexpr int D = 1024, BATCH = 2, SEQ = 8192, NMETA = 16;
constexpr int M = BATCH * SEQ;
constexpr int INW = 4096;
constexpr int SW = 512;
constexpr int NG = 32, NP = 64, NC = 16;
constexpr int NCHUNK = SEQ / 64;
constexpr int AW = 512;
constexpr int NE = 32, TOPK = 4;
constexpr int NASSIGN = M * TOPK;
constexpr int MOE_ROWS = NASSIGN + NE * 256;
constexpr float EPS = 1e-6f;
constexpr int NWAVES = 8, NTHR = 512;
constexpr int KVS = 64 + SEQ;

constexpr size_t MiB = 1u << 20;
constexpr size_t al(size_t x) { return (x + 255) & ~(size_t)255; }
constexpr size_t WS_CTL = 0, CTL_ZERO_BYTES = 1 * MiB;
constexpr int CW_BAR = 4096;
constexpr int CW_CNT = 16384;
constexpr size_t WS_SM = 1 * MiB;
constexpr size_t SM_BB = 0;
constexpr size_t SM_AA = SM_BB + al((size_t)NG * NP * 32 * 4);
constexpr size_t SM_E = SM_AA + al((size_t)NG * NP * 4 * 4);
constexpr size_t SM_SIN = SM_E + al((size_t)BATCH * NCHUNK * NG * NP * 2 * 4);
constexpr size_t SM_LAM = SM_SIN + al((size_t)BATCH * NCHUNK * NG * NP * 2 * 4);
constexpr size_t SM_IDX = SM_LAM + 256;
constexpr size_t SM_GATE = SM_IDX + al((size_t)NASSIGN * 4);
constexpr size_t SM_POS = SM_GATE + al((size_t)NASSIGN * 4);
constexpr size_t SM_OFF = SM_POS + al((size_t)NASSIGN * 4);
constexpr size_t SM_ROWTOK = SM_OFF + 256;
constexpr size_t SM_ROWTK = SM_ROWTOK + al((size_t)MOE_ROWS * 4);
constexpr size_t SM_ZM = SM_ROWTK + al((size_t)MOE_ROWS * 4);
constexpr size_t SM_QKNM = SM_ZM + al((size_t)NMETA * INW * 2);
constexpr size_t SM_TEXP = SM_QKNM + al((size_t)NMETA * D * 2);
constexpr size_t SM_BBH = SM_TEXP + al((size_t)(MOE_ROWS / 256) * 4);
constexpr size_t SM_CMT = SM_BBH + al((size_t)NG * NP * 32 * 2);
constexpr size_t SM_TCNT = SM_CMT + al((size_t)NG * NC * 128 * 2);
constexpr size_t SM_END = SM_TCNT + al((size_t)(M / 32) * NE * 4);
static_assert(SM_END <= 13 * MiB, "small region");
constexpr size_t WS_WD = 14 * MiB;
constexpr size_t WD_IN = 0, WD_GLU = WD_IN + (size_t)INW * D * 2, WD_SO = WD_GLU + (size_t)SW * SW * 2, WD_AO = WD_SO + (size_t)D * SW * 2, WD_O = WD_AO + (size_t)D * AW * 2, WD_END = WD_O + (size_t)D * D * 2;
static_assert(WD_END <= 13 * MiB, "dense weight copies");
constexpr size_t WS_WGU = 27 * MiB;
constexpr size_t WS_WDN = WS_WGU + 128 * MiB;
constexpr size_t RSZ = 34078720;
constexpr size_t WS_R0 = WS_WDN + 64 * MiB;
constexpr size_t WS_R1 = WS_R0 + RSZ;
constexpr size_t WS_R2 = WS_R1 + RSZ;
constexpr size_t WS_R3 = WS_R2 + RSZ;
constexpr size_t WS_END = WS_R3 + al((size_t)MOE_ROWS * D * 2);
static_assert((size_t)M * INW * 2 <= (size_t)MOE_ROWS * D * 2 && (size_t)BATCH * KVS * D * 2 <= RSZ, "region sizes");

constexpr int LDS_BYTES = 147456;
constexpr int MISC_OFF = LDS_BYTES - 256;

__device__ __forceinline__ unsigned f2bf(float f) { unsigned u = __builtin_bit_cast(unsigned, f); return (u + 0x7fffu + ((u >> 16) & 1u)) >> 16; }
__device__ __forceinline__ float bf2f(unsigned h) { return __builtin_bit_cast(float, h << 16); }
__device__ __forceinline__ unsigned pk2(float lo, float hi) { return f2bf(lo) | (f2bf(hi) << 16); }
__device__ __forceinline__ float wave_sum(float v) {
#pragma unroll
    for (int o = 1; o < 64; o <<= 1) v += __shfl_xor(v, o);
    return v;
}
__device__ __forceinline__ float sigmoidf_(float x) { return 1.f / (1.f + __expf(-x)); }
__device__ __forceinline__ float gelu_tanh(float x) { const float t = 0.7978845608028654f * (x + 0.044715f * x * x * x); return 0.5f * x * (1.f + tanhf(t)); }

#define XB_TMO      128
#define XB_XCNT(j)  (256  + 64 * (j))
#define XB_XSUB(j)  (1280 + 64 * (j))
#define XB_XGEN(j)  (2304 + 64 * (j))
#define XB_TOP      3328
#define XB_TOPGEN   3392
#define XCD_BAR_WORDS 3456
#define XB_SPIN_CAP (1u << 22)
__device__ __forceinline__ unsigned xb_ld(unsigned* p)              { return __hip_atomic_load(p, __ATOMIC_RELAXED, __HIP_MEMORY_SCOPE_AGENT); }
__device__ __forceinline__ unsigned xb_add(unsigned* p, unsigned v) { return __hip_atomic_fetch_add(p, v, __ATOMIC_RELAXED, __HIP_MEMORY_SCOPE_AGENT); }
__device__ __forceinline__ unsigned xb_xcc_id() { return (unsigned)__builtin_amdgcn_s_getreg((3 << 11) | 20) & 0xFu; }
#define XB_SPIN(cond, bar) do { unsigned _sp = 0; while (cond) { __builtin_amdgcn_s_sleep(1); \
    if ((++_sp & 255u) == 0u) { if (xb_ld(&(bar)[XB_TMO])) break; if (_sp > XB_SPIN_CAP) { atomicAdd(&(bar)[XB_TMO], 1u); break; } } } } while (0)
struct XcdBarrier { unsigned* bar; unsigned x; volatile LAS unsigned* st; };
__device__ __forceinline__ XcdBarrier xcd_barrier_post(unsigned* bar, volatile LAS unsigned* st) {
    XcdBarrier b; b.bar = bar; b.x = xb_xcc_id(); b.st = st;
    if (threadIdx.x == 0) (void)xb_add(&bar[XB_XCNT(b.x)], 1u);
    return b;
}
__device__ __forceinline__ void xcd_barrier_complete(unsigned* bar, unsigned x, unsigned& nloc, unsigned& nx) {
    const unsigned G = gridDim.x * gridDim.y * gridDim.z;
    unsigned sum, cnt, mine, sp = 0u;
    for (;;) {
        sum = 0u; cnt = 0u; mine = 0u;
#pragma unroll
        for (unsigned j = 0; j < 16; ++j) { const unsigned c = xb_ld(&bar[XB_XCNT(j)]); sum += c; cnt += (c > 0u) ? 1u : 0u; mine = (j == x) ? c : mine; }
        if (sum == G) break;
        __builtin_amdgcn_s_sleep(1);
        if ((++sp & 255u) == 0u) { if (xb_ld(&bar[XB_TMO])) break; if (sp > XB_SPIN_CAP) { atomicAdd(&bar[XB_TMO], 1u); break; } }
    }
    nloc = mine > 0u ? mine : 1u; nx = cnt > 0u ? cnt : 1u;
}
__device__ __forceinline__ void xcd_barrier(const XcdBarrier& b) {
    asm volatile("s_waitcnt vmcnt(0)" ::: "memory");
    __syncthreads();
    if (threadIdx.x == 0) {
        unsigned* bar = b.bar;
        __builtin_amdgcn_s_waitcnt(0);
        unsigned nloc = b.st[0], nx = b.st[1];
        if (nloc == 0u) { xcd_barrier_complete(bar, b.x, nloc, nx); b.st[0] = nloc; b.st[1] = nx; }
        const unsigned old = xb_add(&bar[XB_XSUB(b.x)], 1u);
        const unsigned gen = old / nloc;
        if (old + 1u == (gen + 1u) * nloc) {
            __builtin_amdgcn_fence(__ATOMIC_RELEASE, "agent");
            asm volatile("s_waitcnt vmcnt(0)" ::: "memory");
            const unsigned og = xb_add(&bar[XB_TOP], 1u);
            const unsigned tg = og / nx;
            if (og + 1u == (tg + 1u) * nx) xb_add(&bar[XB_TOPGEN], 1u);
            else XB_SPIN(xb_ld(&bar[XB_TOPGEN]) == tg, bar);
            __builtin_amdgcn_fence(__ATOMIC_ACQUIRE, "agent");
            xb_add(&bar[XB_XGEN(b.x)], 1u);
            asm volatile("s_waitcnt vmcnt(0)" ::: "memory");
        } else {
            XB_SPIN(xb_ld(&bar[XB_XGEN(b.x)]) == gen, bar);
            __builtin_amdgcn_fence(__ATOMIC_ACQUIRE, "agent");
            asm volatile("s_waitcnt vmcnt(0)" ::: "memory");
        }
    }
    __syncthreads();
}

struct Args { const float* in[33]; float* out; unsigned char* ws; int ph_lo, ph_hi, mode, pad; };
struct Frame {
    unsigned char* lds; LAS unsigned char* lds3; int tid, lane, wave, vcu, G, mode;
    const float *x, *meta, *norm_mix_g, *w_in, *a_re, *a_im, *log_dt, *b_re, *b_im, *c_re, *c_im, *ssm_d, *w_glu, *b_glu, *q_g, *k_g, *lq1, *lk1, *lq2, *lk2, *sub_g, *w_so, *w_ao, *w_o,
                *norm_ffn_g, *w_router, *b_router, *w_gate, *b_gate, *w_up, *b_up, *w_down, *b_down;
    float* out;
    bf16_t *XN, *Z, *YS, *YS2, *QKN, *YA, *MIX, *ACT, *Y2, *XN2, *ZM, *QKNM, *BBH, *CMT, *XN8, *Wt_in8, *H1B;
    bf16_t *Wt_in, *Wt_glu, *Wt_so, *Wt_ao, *Wt_o, *Wt_gu, *Wt_dn;
    float *BB, *AA, *E, *SIN, *LAM, *GATE; int *IDX, *POS, *CNT, *OFF, *ROWTOK, *ROWTK, *TEXP, *TCNT;
};
namespace pg8 {
#define PG8_LAS __attribute__((address_space(3)))
typedef unsigned short bf16_t;
typedef short bf16x8 __attribute__((ext_vector_type(8)));
typedef float f32x4 __attribute__((ext_vector_type(4)));
typedef unsigned u32x4 __attribute__((ext_vector_type(4)));
typedef int i32x8 __attribute__((ext_vector_type(8))); typedef int i32x4 __attribute__((ext_vector_type(4)));
__device__ __forceinline__ i32x8 cat8(bf16x8 a, bf16x8 b) { const i32x4 x = __builtin_bit_cast(i32x4, a), y = __builtin_bit_cast(i32x4, b); return (i32x8){x[0], x[1], x[2], x[3], y[0], y[1], y[2], y[3]}; }
constexpr int BM = 256, BK = 64, HALF = 128, HTB = HALF * BK * 2  , STAGE_BYTES = 8 * HTB, NXCD = 8, WGM = 8;

__host__ __device__ __forceinline__ int lds_byte(int r, int c) { const int st = (r >> 4) * 2 + (c >> 5), rr = r & 15, cc = c & 31, ob = rr * 64 + cc * 2; return st * 1024 + (ob ^ (((ob >> 9) & 1) << 5)); }
__host__ __device__ __forceinline__ void stage_rc(int b, int& R, int& C) { const int st = b / 1024, sb = b % 1024, swz = sb ^ (((sb >> 9) & 1) << 5); R = (st >> 1) * 16 + swz / 64; C = (st & 1) * 32 + (swz % 64) / 2; }
__host__ __device__ __forceinline__ int perm32(int rho) { const int n = rho >> 4, i = rho & 15; return 8 * (i >> 2) + 4 * n + (i & 3); }

struct Unit { int pm, pn; };
struct Gemm { const bf16_t* A; const bf16_t* Bt; int M, N, K; const PG8_LAS int* rowidx; };

struct StaticOrder {
    int nM, nN, nwg, G, c;
    __host__ __device__ void init(int M, int N, int G_, int c_) { nM = M / BM; nN = N / BM; nwg = nM * nN; G = G_; c = c_; }
    __host__ __device__ bool next(int i, Unit& u) const {
        const long L = (long)i * G + c; if (L >= nwg) return false;
        int wgid = (int)L; { const int q = nwg / NXCD, r = nwg % NXCD, xcd = wgid % NXCD, off = wgid / NXCD; wgid = (xcd < r ? xcd * (q + 1) : r * (q + 1) + (xcd - r) * q) + off; }
        const int nig = WGM * nN, gid = wgid / nig, fm = gid * WGM, gsz = (nM - fm) < WGM ? (nM - fm) : WGM;
        u.pm = fm + ((wgid % nig) % gsz); u.pn = (wgid % nig) / gsz; return true;
    }
    __device__ __forceinline__ void a_ready(const Unit&) const {}
    __device__ __forceinline__ void done(const Unit&) const {}
};

__device__ __forceinline__ unsigned cvt_pk_bf16(float lo, float hi) { unsigned r; asm volatile("v_cvt_pk_bf16_f32 %0, %1, %2" : "=v"(r) : "v"(lo), "v"(hi)); return r; }
typedef float f32x2 __attribute__((ext_vector_type(2)));
__device__ __forceinline__ f32x2 gelu_pk(f32x2 v) {
    const f32x2 av = __builtin_elementwise_abs(v), d = av * 0.2316418882f + 1.0f;
    f32x2 t; t.x = __builtin_amdgcn_rcpf(d.x); t.y = __builtin_amdgcn_rcpf(d.y);
    f32x2 q = t * 0.5307027145f + (-0.7265760135f); q = q * t + 0.7107068705f; q = q * t + (-0.142248368f); q = q * t + 0.127414796f; q = q * t;
    const f32x2 s = (v * v) * (-0.72134752044f);
    f32x2 e; e.x = __builtin_amdgcn_exp2f(s.x); e.y = __builtin_amdgcn_exp2f(s.y);
    const f32x2 m = v * (q * e), r = v - m;
    f32x2 o; o.x = v.x < 0.f ? m.x : r.x; o.y = v.y < 0.f ? m.y : r.y; return o;
}

template <int ACT  > struct EpiBf16 {
    static constexpr bool PERM = true, AFTER_DRAIN = false; static_assert(ACT == 0 || ACT == 1, "EpiBf16: ACT is 0 (none) or 1 (gelu_pk)");
    bf16_t* O; int ldc; const float* bias; int split_cols; size_t split_stride; float scale0; int nt_from;
    __device__ __forceinline__ void operator()(const f32x4 (&acc)[2][2][4][2], const Unit& u, int wr, int wc, int fr, int fq) const {
        const int row0 = u.pm * BM + wr * 64 + fr; int colt = u.pn * BM; bf16_t* base = O;
        float sc = 1.f; if (split_cols) { const int t = colt / split_cols; base += (size_t)t * split_stride; colt -= t * split_cols; if (t == 0) sc = scale0; }
        const int col0 = colt + wc * 32 + 8 * fq, bcol0 = u.pn * BM + wc * 32 + 8 * fq;
        f32x4 bv[2][2];
#pragma unroll
        for (int bj = 0; bj < 2; ++bj)
#pragma unroll
            for (int n = 0; n < 2; ++n) bv[bj][n] = bias ? *(const f32x4*)(bias + bcol0 + bj * HALF + 4 * n) : (f32x4){0.f, 0.f, 0.f, 0.f};
#pragma unroll
        for (int ai = 0; ai < 2; ++ai)
#pragma unroll
            for (int m = 0; m < 4; ++m) { bf16_t* rowp = base + (size_t)(row0 + ai * HALF + m * 16) * ldc + col0;
#pragma unroll
                for (int bj = 0; bj < 2; ++bj) { f32x4 v0 = acc[ai][bj][m][0] + bv[bj][0], v1 = acc[ai][bj][m][1] + bv[bj][1];
                    if (ACT == 1) { f32x2 a = gelu_pk((f32x2){v0[0], v0[1]}), b = gelu_pk((f32x2){v0[2], v0[3]}), c = gelu_pk((f32x2){v1[0], v1[1]}), d = gelu_pk((f32x2){v1[2], v1[3]});
                        v0 = (f32x4){a.x, a.y, b.x, b.y}; v1 = (f32x4){c.x, c.y, d.x, d.y}; }
                    v0 = v0 * sc; v1 = v1 * sc; u32x4 w; w.x = cvt_pk_bf16(v0[0], v0[1]); w.y = cvt_pk_bf16(v0[2], v0[3]); w.z = cvt_pk_bf16(v1[0], v1[1]); w.w = cvt_pk_bf16(v1[2], v1[3]);
                    if (nt_from && bcol0 >= nt_from) __builtin_nontemporal_store(w, (u32x4*)(rowp + bj * HALF)); else *(u32x4*)(rowp + bj * HALF) = w; } }
    }
};
__device__ __forceinline__ unsigned pk4_fp8(float a, float b, float c, float d) { int w = __builtin_amdgcn_cvt_pk_fp8_f32(a, b, 0, false); w = __builtin_amdgcn_cvt_pk_fp8_f32(c, d, w, true); return (unsigned)w; }
__device__ __forceinline__ float sigm(float x) { return __builtin_amdgcn_rcpf(1.f + __builtin_amdgcn_exp2f(-1.4426950408889634f * x)); }
__device__ __forceinline__ float bflo(unsigned w) { return __builtin_bit_cast(float, w << 16); }
__device__ __forceinline__ float bfhi(unsigned w) { return __builtin_bit_cast(float, w & 0xffff0000u); }
struct EpiGlu {
    static constexpr bool PERM = true, AFTER_DRAIN = false;
    const bf16_t* YS; bf16_t* O; const float* bias; int ldc, ldo;
    __device__ __forceinline__ void operator()(const f32x4 (&acc)[2][2][4][2], const Unit& u, int wr, int wc, int fr, int fq) const {
        const int row0 = u.pm * BM + wr * 64 + fr, col0 = u.pn * BM + wc * 32 + 8 * fq;
#pragma unroll
        for (int bj = 0; bj < 2; ++bj) {
            const f32x4 b0 = *(const f32x4*)(bias + col0 + bj * HALF), b1 = *(const f32x4*)(bias + col0 + bj * HALF + 4);
#pragma unroll
            for (int ai = 0; ai < 2; ++ai)
#pragma unroll
                for (int m = 0; m < 4; ++m) {
                    const size_t off = (size_t)(row0 + ai * HALF + m * 16) * ldc + col0 + bj * HALF;
                    const u32x4 y = *(const u32x4*)(YS + off);
                    const f32x4 v0 = acc[ai][bj][m][0] + b0, v1 = acc[ai][bj][m][1] + b1;
                    u32x4 w;
                    w.x = cvt_pk_bf16(bflo(y.x) * sigm(v0[0]), bfhi(y.x) * sigm(v0[1])); w.y = cvt_pk_bf16(bflo(y.y) * sigm(v0[2]), bfhi(y.y) * sigm(v0[3]));
                    w.z = cvt_pk_bf16(bflo(y.z) * sigm(v1[0]), bfhi(y.z) * sigm(v1[1])); w.w = cvt_pk_bf16(bflo(y.w) * sigm(v1[2]), bfhi(y.w) * sigm(v1[3]));
                    *(u32x4*)(O + (size_t)(row0 + ai * HALF + m * 16) * ldo + col0 + bj * HALF) = w;
                }
        }
    }
};
template <bool FIRST, bool OUT8 = false> struct EpiMix {
    static constexpr bool PERM = true, AFTER_DRAIN = false;
    const bf16_t* Zg; bf16_t* O; unsigned char* O8;
    __device__ __forceinline__ void operator()(const f32x4 (&acc)[2][2][4][2], const Unit& u, int wr, int wc, int fr, int fq) const {
        const int row0 = u.pm * BM + wr * 64 + fr, col0 = u.pn * BM + wc * 32 + 8 * fq;
#pragma unroll
        for (int ai = 0; ai < 2; ++ai)
#pragma unroll
            for (int m = 0; m < 4; ++m)
#pragma unroll
                for (int bj = 0; bj < 2; ++bj) {
                    const size_t row = (size_t)(row0 + ai * HALF + m * 16); const int col = col0 + bj * HALF;
                    const u32x4 z = *(const u32x4*)(Zg + row * 4096 + col);
                    const f32x4 a0 = acc[ai][bj][m][0], a1 = acc[ai][bj][m][1];
                    float v[8] = {sigm(bflo(z.x)) * a0[0], sigm(bfhi(z.x)) * a0[1], sigm(bflo(z.y)) * a0[2], sigm(bfhi(z.y)) * a0[3],
                                  sigm(bflo(z.z)) * a1[0], sigm(bfhi(z.z)) * a1[1], sigm(bflo(z.w)) * a1[2], sigm(bfhi(z.w)) * a1[3]};
                    if (!FIRST) { const u32x4 o = *(const u32x4*)(O + row * 1024 + col);
                        v[0] += bflo(o.x); v[1] += bfhi(o.x); v[2] += bflo(o.y); v[3] += bfhi(o.y); v[4] += bflo(o.z); v[5] += bfhi(o.z); v[6] += bflo(o.w); v[7] += bfhi(o.w); }
                    if constexpr (OUT8) { typedef unsigned u32x2 __attribute__((ext_vector_type(2))); *(u32x2*)(O8 + row * 1024 + col) = (u32x2){pk4_fp8(v[0], v[1], v[2], v[3]), pk4_fp8(v[4], v[5], v[6], v[7])}; }
                    else { u32x4 w; w.x = cvt_pk_bf16(v[0], v[1]); w.y = cvt_pk_bf16(v[2], v[3]); w.z = cvt_pk_bf16(v[4], v[5]); w.w = cvt_pk_bf16(v[6], v[7]);
                    *(u32x4*)(O + row * 1024 + col) = w; }
                }
    }
};
struct EpiMixCat {
    static constexpr bool PERM = true, AFTER_DRAIN = false;
    const bf16_t* Z; bf16_t* O;
    __device__ __forceinline__ void mid(f32x4 (&acc)[2][2][4][2], const Unit& u, int wr, int wc, int fr, int fq) const {
        int row0 = u.pm * BM + wr * 64 + fr, col0 = u.pn * BM + wc * 32 + 8 * fq;
        asm volatile("" : "+v"(row0), "+v"(col0));
#pragma unroll
        for (int ai = 0; ai < 2; ++ai)
#pragma unroll
            for (int m = 0; m < 4; ++m)
#pragma unroll
                for (int bj = 0; bj < 2; ++bj) {
                    const bf16_t* zp = Z + (size_t)(row0 + ai * HALF + m * 16) * 4096 + col0 + bj * HALF;
                    const u32x4 z0 = *(const u32x4*)(zp + 2048), z1 = *(const u32x4*)(zp + 3072);
                    const float a0[8] = {bflo(z0.x), bfhi(z0.x), bflo(z0.y), bfhi(z0.y), bflo(z0.z), bfhi(z0.z), bflo(z0.w), bfhi(z0.w)};
                    const float a1[8] = {bflo(z1.x), bfhi(z1.x), bflo(z1.y), bfhi(z1.y), bflo(z1.z), bfhi(z1.z), bflo(z1.w), bfhi(z1.w)};
#pragma unroll
                    for (int i = 0; i < 8; ++i) {
                        const float r = (1.f + __builtin_amdgcn_exp2f(-1.4426950408889634f * a0[i])) * __builtin_amdgcn_rcpf(1.f + __builtin_amdgcn_exp2f(-1.4426950408889634f * a1[i]));
                        acc[ai][bj][m][i >> 2][i & 3] *= r; }
                }
    }
    __device__ __forceinline__ void operator()(const f32x4 (&acc)[2][2][4][2], const Unit& u, int wr, int wc, int fr, int fq) const {
        const int row0 = u.pm * BM + wr * 64 + fr, col0 = u.pn * BM + wc * 32 + 8 * fq;
#pragma unroll
        for (int ai = 0; ai < 2; ++ai)
#pragma unroll
            for (int m = 0; m < 4; ++m)
#pragma unroll
                for (int bj = 0; bj < 2; ++bj) {
                    const size_t row = (size_t)(row0 + ai * HALF + m * 16); const int col = col0 + bj * HALF;
                    const u32x4 z = *(const u32x4*)(Z + row * 4096 + 2048 + col);
                    const f32x4 a0 = acc[ai][bj][m][0], a1 = acc[ai][bj][m][1];
                    u32x4 w; w.x = cvt_pk_bf16(sigm(bflo(z.x)) * a0[0], sigm(bfhi(z.x)) * a0[1]); w.y = cvt_pk_bf16(sigm(bflo(z.y)) * a0[2], sigm(bfhi(z.y)) * a0[3]);
                    w.z = cvt_pk_bf16(sigm(bflo(z.z)) * a1[0], sigm(bfhi(z.z)) * a1[1]); w.w = cvt_pk_bf16(sigm(bflo(z.w)) * a1[2], sigm(bfhi(z.w)) * a1[3]);
                    *(u32x4*)(O + row * 1024 + col) = w;
                }
    }
};
struct EpiWoB {
    static constexpr bool PERM = true, AFTER_DRAIN = false;
    const float* x; bf16_t* O;
    __device__ __forceinline__ void operator()(const f32x4 (&acc)[2][2][4][2], const Unit& u, int wr, int wc, int fr, int fq) const {
        const int row0 = u.pm * BM + wr * 64 + fr, col0 = u.pn * BM + wc * 32 + 8 * fq;
#pragma unroll
        for (int ai = 0; ai < 2; ++ai)
#pragma unroll
            for (int m = 0; m < 4; ++m)
#pragma unroll
                for (int bj = 0; bj < 2; ++bj) {
                    const size_t off = (size_t)(row0 + ai * HALF + m * 16) * 1024 + col0 + bj * HALF;
                    const f32x4 v0 = *(const f32x4*)(x + off) + acc[ai][bj][m][0], v1 = *(const f32x4*)(x + off + 4) + acc[ai][bj][m][1];
                    u32x4 w; w.x = cvt_pk_bf16(v0[0], v0[1]); w.y = cvt_pk_bf16(v0[2], v0[3]); w.z = cvt_pk_bf16(v1[0], v1[1]); w.w = cvt_pk_bf16(v1[2], v1[3]);
                    *(u32x4*)(O + off) = w;
                }
    }
};
struct EpiWo {
    static constexpr bool PERM = false, AFTER_DRAIN = false;
    const float* x; float* out; float sc;
    __device__ __forceinline__ void operator()(const f32x4 (&acc)[2][2][4][2], const Unit& u, int wr, int wc, int fr, int fq) const {
        const int row0 = u.pm * BM + wr * 64 + fr, col0 = u.pn * BM + wc * 32 + 4 * fq;
#pragma unroll
        for (int ai = 0; ai < 2; ++ai)
#pragma unroll
            for (int m = 0; m < 4; ++m)
#pragma unroll
                for (int bj = 0; bj < 2; ++bj)
#pragma unroll
                    for (int n = 0; n < 2; ++n) {
                        const size_t off = (size_t)(row0 + ai * HALF + m * 16) * 1024 + col0 + bj * HALF + n * 16;
                        *(f32x4*)(out + off) = *(const f32x4*)(x + off) + acc[ai][bj][m][n] * sc;
                    }
    }
};
struct EpiScaleBf16 {
    static constexpr bool PERM = true, AFTER_DRAIN = false;
    bf16_t* O; int ldc; float s;
    __device__ __forceinline__ void operator()(const f32x4 (&acc)[2][2][4][2], const Unit& u, int wr, int wc, int fr, int fq) const {
        const int row0 = u.pm * BM + wr * 64 + fr, col0 = u.pn * BM + wc * 32 + 8 * fq;
#pragma unroll
        for (int ai = 0; ai < 2; ++ai)
#pragma unroll
            for (int m = 0; m < 4; ++m)
#pragma unroll
                for (int bj = 0; bj < 2; ++bj) { const f32x4 v0 = acc[ai][bj][m][0] * s, v1 = acc[ai][bj][m][1] * s;
                    u32x4 w; w.x = cvt_pk_bf16(v0[0], v0[1]); w.y = cvt_pk_bf16(v0[2], v0[3]); w.z = cvt_pk_bf16(v1[0], v1[1]); w.w = cvt_pk_bf16(v1[2], v1[3]);
                    *(u32x4*)(O + (size_t)(row0 + ai * HALF + m * 16) * ldc + col0 + bj * HALF) = w; }
    }
};
struct MoeOrder {
    const int* texp; int ntiles, NT, G, v;
    __device__ __forceinline__ bool next(int i, Unit& u) const {
        const int L = i * G + v; if (L >= ntiles * NT) return false;
        const int mt = L / NT; u.pm = mt; u.pn = texp[mt] * NT + (L % NT); return true;
    }
    __device__ __forceinline__ void a_ready(const Unit&) const {}
    __device__ __forceinline__ void done(const Unit&) const {}
};
template <bool FP8> struct EpiMoe1 {
    static constexpr bool PERM = true, AFTER_DRAIN = false;
    bf16_t* ACT; const float* bg; const float* bu;
    __device__ __forceinline__ void operator()(const f32x4 (&acc)[2][2][4][2], const Unit& u, int wr, int wc, int fr, int fq) const {
        const int e = u.pn >> 3, pnl = u.pn & 7;
        const int row0 = u.pm * BM + wr * 64 + fr, oc = pnl * HALF + wc * 32 + 8 * fq;
        const f32x4 g0 = *(const f32x4*)(bg + e * 1024 + oc), g1 = *(const f32x4*)(bg + e * 1024 + oc + 4), u0 = *(const f32x4*)(bu + e * 1024 + oc), u1 = *(const f32x4*)(bu + e * 1024 + oc + 4);
#pragma unroll
        for (int ai = 0; ai < 2; ++ai)
#pragma unroll
            for (int m = 0; m < 4; ++m) {
                const float sc = FP8 ? 0.03125f : 1.f;
                const f32x4 ga = acc[ai][0][m][0] * sc + g0, gb = acc[ai][0][m][1] * sc + g1, ua = acc[ai][1][m][0] * sc + u0, ub = acc[ai][1][m][1] * sc + u1;
                float v[8];
#pragma unroll
                for (int i = 0; i < 4; ++i) { const float gg = fminf(ga[i], 7.f), uu = fminf(fmaxf(ua[i], -7.f), 7.f); v[i] = (uu + 1.f) * gg * sigm(1.702f * gg);
                                              const float g2 = fminf(gb[i], 7.f), u2 = fminf(fmaxf(ub[i], -7.f), 7.f); v[4 + i] = (u2 + 1.f) * g2 * sigm(1.702f * g2); }
                if constexpr (FP8) { typedef unsigned u32x2 __attribute__((ext_vector_type(2)));
                    *(u32x2*)((unsigned char*)ACT + (size_t)(row0 + ai * HALF + m * 16) * 1024 + oc) = (u32x2){pk4_fp8(v[0], v[1], v[2], v[3]), pk4_fp8(v[4], v[5], v[6], v[7])}; }
                else { u32x4 w; w.x = cvt_pk_bf16(v[0], v[1]); w.y = cvt_pk_bf16(v[2], v[3]); w.z = cvt_pk_bf16(v[4], v[5]); w.w = cvt_pk_bf16(v[6], v[7]);
                    *(u32x4*)(ACT + (size_t)(row0 + ai * HALF + m * 16) * 1024 + oc) = w; }
            }
    }
};
template <bool FP8> struct EpiMoe2 {
    static constexpr bool PERM = true, AFTER_DRAIN = false;
    bf16_t* Y2; const float* bd; const int* rowtk;
    __device__ __forceinline__ void operator()(const f32x4 (&acc)[2][2][4][2], const Unit& u, int wr, int wc, int fr, int fq) const {
        const int e = u.pn >> 2, pnl = u.pn & 3;
        const int row0 = u.pm * BM + wr * 64 + fr, col0 = pnl * BM + wc * 32 + 8 * fq;
        f32x4 bv[2][2];
#pragma unroll
        for (int bj = 0; bj < 2; ++bj)
#pragma unroll
            for (int n = 0; n < 2; ++n) bv[bj][n] = *(const f32x4*)(bd + e * 1024 + col0 + bj * HALF + 4 * n);
#pragma unroll
        for (int ai = 0; ai < 2; ++ai)
#pragma unroll
            for (int m = 0; m < 4; ++m) {
                const int tk = rowtk[row0 + ai * HALF + m * 16];
                if (tk >= 0) {
#pragma unroll
                    for (int bj = 0; bj < 2; ++bj) { const float sc = FP8 ? 0.03125f : 1.f; const f32x4 v0 = acc[ai][bj][m][0] * sc + bv[bj][0], v1 = acc[ai][bj][m][1] * sc + bv[bj][1];
                        if constexpr (FP8) { typedef unsigned u32x2 __attribute__((ext_vector_type(2)));
                            *(u32x2*)((unsigned char*)Y2 + (size_t)tk * 1024 + col0 + bj * HALF) = (u32x2){pk4_fp8(v0[0], v0[1], v0[2], v0[3]), pk4_fp8(v1[0], v1[1], v1[2], v1[3])}; }
                        else { u32x4 w; w.x = cvt_pk_bf16(v0[0], v0[1]); w.y = cvt_pk_bf16(v0[2], v0[3]); w.z = cvt_pk_bf16(v1[0], v1[1]); w.w = cvt_pk_bf16(v1[2], v1[3]);
                        *(u32x4*)(Y2 + (size_t)tk * 1024 + col0 + bj * HALF) = w; } }
                }
            }
    }
};
template <class Epi, class Sched, bool ALIGN_EPI = false, bool SP2 = false, bool GATHER = false, bool FP8 = false, bool MID = false>
__device__ __forceinline__ void gemm_phase(PG8_LAS unsigned char* lds, const Gemm g, const Sched& S, const Epi& E) {
    static_assert(!GATHER || SP2, "the gathered A operand is wired into the SP2 loop only");
    const int tid = threadIdx.x, wid = __builtin_amdgcn_readfirstlane(tid >> 6), lane = tid & 63, wr = wid >> 2, wc = wid & 3, fr = lane & 15, fq = lane >> 4;
    const int K = g.K, nt = K / BK;
    unsigned voffA[2], voffB[2];
#pragma unroll
    for (int i = 0; i < 2; ++i) { int R, C; stage_rc(tid * 16 + i * 8192, R, C); const int Rb = Epi::PERM ? ((R & ~31) + perm32(R & 31)) : R;
        voffA[i] = (unsigned)(R * K + C) * 2u; voffB[i] = (unsigned)(Rb * K + C) * 2u; }
    const size_t kstep = (size_t)(BK * 2);
    const size_t hstep = (size_t)HALF * K * 2;
    const size_t tstep = 2 * hstep;
    const unsigned ldsw = (unsigned)wid * 1024u;
    const int aoff = lds_byte(wr * 64 + fr, fq * 8), boff = lds_byte(wc * 32 + fr, fq * 8);
#define PG8_SA(b, h) (((b) * 2 + (h)) * HTB)
#define PG8_SB(b, h) ((4 + (b) * 2 + (h)) * HTB)
#define PG8_STAGE(bufoff, gbase, voff) do { _Pragma("unroll") for (int _i = 0; _i < 2; ++_i) \
        __builtin_amdgcn_global_load_lds((const unsigned*)((const char*)(gbase) + (voff)[_i]), (PG8_LAS unsigned*)(lds + (bufoff) + ldsw + _i * 8192), 16, 0, 0); } while (0)
#define PG8_STAGE_A(bufoff, nx, h, koff, dptr) do { if constexpr (GATHER) { _Pragma("unroll") for (int _i = 0; _i < 2; ++_i) \
        __builtin_amdgcn_global_load_lds((const unsigned*)((const char*)g.A + (koff) + ((nx) ? nga[h][_i] : cga[h][_i])), (PG8_LAS unsigned*)(lds + (bufoff) + ldsw + _i * 8192), 16, 0, 0); } \
    else { PG8_STAGE(bufoff, dptr, voffA); } } while (0)
#define PG8_GATH(ord, o) do { _Pragma("unroll") for (int _h = 0; _h < 2; ++_h) _Pragma("unroll") for (int _i = 0; _i < 2; ++_i) { int R_, C_, t_ = tid; asm volatile("" : "+v"(t_)); stage_rc(t_ * 16 + _i * 8192, R_, C_);   \
        o[_h][_i] = ((unsigned)g.rowidx[(ord) * 256 + _h * HALF + R_] * (unsigned)K + (unsigned)C_) * 2u; } } while (0)
#define PG8_LDA(dst, b, h) do { if constexpr (FP8) { _Pragma("unroll") for (int m = 0; m < 4; ++m) dst##8[m] = cat8(*(const PG8_LAS bf16x8*)(lds + PG8_SA(b, h) + aoff + m * 2048), *(const PG8_LAS bf16x8*)(lds + PG8_SA(b, h) + aoff + m * 2048 + 1024)); } \
    else { _Pragma("unroll") for (int m = 0; m < 4; ++m) _Pragma("unroll") for (int k = 0; k < 2; ++k) dst[m][k] = *(const PG8_LAS bf16x8*)(lds + PG8_SA(b, h) + aoff + m * 2048 + k * 1024); } } while (0)
#define PG8_LDB(dst, b, h) do { if constexpr (FP8) { _Pragma("unroll") for (int n = 0; n < 2; ++n) dst##8[n] = cat8(*(const PG8_LAS bf16x8*)(lds + PG8_SB(b, h) + boff + n * 2048), *(const PG8_LAS bf16x8*)(lds + PG8_SB(b, h) + boff + n * 2048 + 1024)); } \
    else { _Pragma("unroll") for (int n = 0; n < 2; ++n) _Pragma("unroll") for (int k = 0; k < 2; ++k) dst[n][k] = *(const PG8_LAS bf16x8*)(lds + PG8_SB(b, h) + boff + n * 2048 + k * 1024); } } while (0)
#define PG8_MMA(ai, bj, At, Bt) do { __builtin_amdgcn_s_setprio(1); if constexpr (FP8) { _Pragma("unroll") for (int m = 0; m < 4; ++m) _Pragma("unroll") for (int n = 0; n < 2; ++n) \
        asm volatile("v_mfma_f32_16x16x128_f8f6f4 %0, %1, %2, %0" : "+v"(acc[ai][bj][m][n]) : "v"(Bt##8[n]), "v"(At##8[m]));   } \
    else { _Pragma("unroll") for (int m = 0; m < 4; ++m) _Pragma("unroll") for (int n = 0; n < 2; ++n) _Pragma("unroll") for (int k = 0; k < 2; ++k) \
        acc[ai][bj][m][n] = __builtin_amdgcn_mfma_f32_16x16x32_bf16(Bt[n][k], At[m][k], acc[ai][bj][m][n], 0, 0, 0); } __builtin_amdgcn_s_setprio(0); } while (0)
#define PG8_WAIT_V(n) asm volatile("s_waitcnt vmcnt(" #n ")" ::: "memory")
#define PG8_WAIT_L(n) asm volatile("s_waitcnt lgkmcnt(" #n ")" ::: "memory")
#define PG8_BAR __builtin_amdgcn_s_barrier()
#define PG8_SCHED __builtin_amdgcn_sched_barrier(0)
    Unit cur, nxt; int ui = 0;
    if (!S.next(0, cur)) return;
    f32x4 acc[2][2][4][2];
#pragma unroll
    for (int a = 0; a < 2; ++a)
#pragma unroll
        for (int b = 0; b < 2; ++b)
#pragma unroll
            for (int m = 0; m < 4; ++m)
#pragma unroll
                for (int n = 0; n < 2; ++n) acc[a][b][m][n] = (f32x4){0.f, 0.f, 0.f, 0.f};
    bf16x8 At[4][2], B0[2][2], B1[2][2]; i32x8 At8[4], B08[2], B18[2];
    const char* cA = (const char*)g.A + (size_t)cur.pm * tstep; const char* cB = (const char*)g.Bt + (size_t)cur.pn * tstep;
    S.a_ready(cur);
    unsigned cga[2][2] = {{0u, 0u}, {0u, 0u}}, nga[2][2] = {{0u, 0u}, {0u, 0u}};
    if constexpr (GATHER) PG8_GATH(0, cga);
    if constexpr (SP2) {
        PG8_STAGE(PG8_SB(0, 0), cB, voffB); PG8_STAGE(PG8_SB(0, 1), cB + hstep, voffB); PG8_STAGE_A(PG8_SA(0, 0), false, 0, 0, cA); PG8_STAGE_A(PG8_SA(0, 1), false, 1, 0, cA + hstep);
        if (wr == 1) PG8_BAR;
        PG8_WAIT_V(2); PG8_BAR;
        PG8_STAGE(PG8_SB(1, 0), cB + kstep, voffB); PG8_STAGE_A(PG8_SA(1, 0), false, 0, kstep, cA + kstep); PG8_STAGE(PG8_SB(1, 1), cB + hstep + kstep, voffB);
        PG8_WAIT_V(6); PG8_BAR;
    } else {
        PG8_STAGE(PG8_SB(0, 0), cB, voffB); PG8_STAGE(PG8_SA(0, 0), cA, voffA); PG8_STAGE(PG8_SB(0, 1), cB + hstep, voffB); PG8_STAGE(PG8_SA(0, 1), cA + hstep, voffA);
        if (wr == 1) PG8_BAR;
        PG8_WAIT_V(4); PG8_BAR;
        PG8_STAGE(PG8_SB(1, 0), cB + kstep, voffB); PG8_STAGE(PG8_SA(1, 0), cA + kstep, voffA); PG8_STAGE(PG8_SB(1, 1), cB + hstep + kstep, voffB);
        PG8_WAIT_V(6); PG8_BAR;
    }
    for (;;) {
        const bool has_next = S.next(ui + 1, nxt);
        if constexpr (GATHER) { if (has_next) PG8_GATH(ui + 1, nga); else { nga[0][0] = cga[0][0]; nga[0][1] = cga[0][1]; nga[1][0] = cga[1][0]; nga[1][1] = cga[1][1]; } }
        const char* nA = has_next ? (const char*)g.A + (size_t)nxt.pm * tstep : cA; const char* nB = has_next ? (const char*)g.Bt + (size_t)nxt.pn * tstep : cB;
#pragma unroll 1
        for (int t = 0; t < nt; t += 2) {
            if constexpr (MID) { if (t == nt / 2) { PG8_SCHED; E.mid(acc, cur, wr, wc, fr, fq); PG8_SCHED; } }
            const bool last = (t == nt - 2);
            const char* a1 = cA + (size_t)(t + 1) * kstep;
            const char* a2 = last ? nA : cA + (size_t)(t + 2) * kstep; const char* b2 = last ? nB : cB + (size_t)(t + 2) * kstep;
            const char* a3 = a2 + kstep; const char* b3 = b2 + kstep;
            if (last && has_next) S.a_ready(nxt);
            const size_t k1 = (size_t)(t + 1) * kstep, k2 = last ? (size_t)0 : (size_t)(t + 2) * kstep, k3 = k2 + kstep; (void)k1; (void)k2; (void)k3;
            if constexpr (SP2) {
            PG8_LDB(B0, 0, 0); PG8_LDB(B1, 0, 1); PG8_SCHED; PG8_LDA(At, 0, 0); PG8_STAGE_A(PG8_SA(1, 1), false, 1, k1, a1 + hstep);
            PG8_WAIT_V(8); PG8_WAIT_L(0); PG8_BAR; PG8_MMA(0, 0, At, B0); PG8_MMA(0, 1, At, B1); PG8_BAR; PG8_SCHED;
            PG8_LDA(At, 0, 1); PG8_STAGE(PG8_SB(0, 0), b2, voffB); PG8_STAGE(PG8_SB(0, 1), b2 + hstep, voffB); PG8_STAGE_A(PG8_SA(0, 0), last, 0, k2, a2);
            PG8_WAIT_V(8); PG8_WAIT_L(0); PG8_BAR; PG8_MMA(1, 0, At, B0); PG8_MMA(1, 1, At, B1); PG8_BAR; PG8_SCHED;
            PG8_LDB(B0, 1, 0); PG8_LDB(B1, 1, 1); PG8_SCHED; PG8_LDA(At, 1, 0); PG8_STAGE_A(PG8_SA(0, 1), last, 1, k2, a2 + hstep);
            PG8_WAIT_V(8); PG8_WAIT_L(0); PG8_BAR; PG8_MMA(0, 0, At, B0); PG8_MMA(0, 1, At, B1); PG8_BAR; PG8_SCHED;
            PG8_LDA(At, 1, 1); PG8_STAGE(PG8_SB(1, 0), b3, voffB); PG8_STAGE(PG8_SB(1, 1), b3 + hstep, voffB); PG8_STAGE_A(PG8_SA(1, 0), last, 0, k3, a3);
            PG8_WAIT_V(8); PG8_WAIT_L(0); PG8_BAR; PG8_MMA(1, 0, At, B0); PG8_MMA(1, 1, At, B1); PG8_BAR; PG8_SCHED;
            } else {
            PG8_LDB(B0, 0, 0); PG8_SCHED; PG8_LDA(At, 0, 0); PG8_STAGE(PG8_SA(1, 1), a1 + hstep, voffA);
            PG8_WAIT_L(8); PG8_BAR; PG8_WAIT_L(0); PG8_MMA(0, 0, At, B0); PG8_BAR; PG8_SCHED;
            PG8_LDB(B1, 0, 1); PG8_STAGE(PG8_SB(0, 0), b2, voffB);
            PG8_BAR; PG8_WAIT_L(0); PG8_MMA(0, 1, At, B1); PG8_BAR;
            PG8_LDA(At, 0, 1); PG8_STAGE(PG8_SA(0, 0), a2, voffA);
            PG8_BAR; PG8_WAIT_L(0); PG8_MMA(1, 0, At, B0); PG8_BAR; PG8_SCHED;
            PG8_STAGE(PG8_SB(0, 1), b2 + hstep, voffB);
            PG8_WAIT_V(6); PG8_BAR; PG8_MMA(1, 1, At, B1); PG8_BAR;
            PG8_LDB(B0, 1, 0); PG8_SCHED; PG8_LDA(At, 1, 0); PG8_STAGE(PG8_SA(0, 1), a2 + hstep, voffA);
            PG8_WAIT_L(8); PG8_BAR; PG8_WAIT_L(0); PG8_MMA(0, 0, At, B0); PG8_BAR; PG8_SCHED;
            PG8_LDB(B1, 1, 1); PG8_STAGE(PG8_SB(1, 0), b3, voffB);
            PG8_BAR; PG8_WAIT_L(0); PG8_MMA(0, 1, At, B1); PG8_BAR;
            PG8_LDA(At, 1, 1); PG8_STAGE(PG8_SA(1, 0), a3, voffA);
            PG8_BAR; PG8_WAIT_L(0); PG8_MMA(1, 0, At, B0); PG8_BAR; PG8_SCHED;
            PG8_STAGE(PG8_SB(1, 1), b3 + hstep, voffB);
            PG8_WAIT_V(6); PG8_BAR; PG8_MMA(1, 1, At, B1); PG8_BAR;
            }
        }
        if constexpr (ALIGN_EPI) { if (wr == 0) PG8_BAR; }
        if constexpr (FP8) asm volatile("s_nop 15\n\ts_nop 15" ::: "memory");
        if constexpr (!Epi::AFTER_DRAIN) { E(acc, cur, wr, wc, fr, fq); S.done(cur); }
        if (!has_next) break;
#pragma unroll
        for (int a = 0; a < 2; ++a)
#pragma unroll
            for (int b = 0; b < 2; ++b)
#pragma unroll
                for (int m = 0; m < 4; ++m)
#pragma unroll
                    for (int n = 0; n < 2; ++n) acc[a][b][m][n] = (f32x4){0.f, 0.f, 0.f, 0.f};
        cur = nxt; cA = nA; cB = nB; ++ui;
        if constexpr (GATHER) { cga[0][0] = nga[0][0]; cga[0][1] = nga[0][1]; cga[1][0] = nga[1][0]; cga[1][1] = nga[1][1]; }
        if constexpr (ALIGN_EPI) { if (wr == 1) PG8_BAR; }
    }
    PG8_WAIT_V(0);
    if constexpr (!ALIGN_EPI) { if (wr == 0) PG8_BAR; }
    PG8_BAR;
    if constexpr (Epi::AFTER_DRAIN) { E.fused(acc, cur, wr, wc, fr, fq, lds, wid, lane); S.done(cur); }
#undef PG8_SA
#undef PG8_SB
#undef PG8_STAGE
#undef PG8_STAGE_A
#undef PG8_GATH
#undef PG8_LDA
#undef PG8_LDB
#undef PG8_MMA
#undef PG8_WAIT_V
#undef PG8_WAIT_L
#undef PG8_BAR
#undef PG8_SCHED
}
}
#include <hip/hip_bf16.h>
#include <cmath>
namespace attn_body {
using bf16=__hip_bfloat16;
using bf16x8=__attribute__((ext_vector_type(8)))short;
using s16x4=__attribute__((ext_vector_type(4)))short;
using f32x16=__attribute__((ext_vector_type(16)))float;
using u32x4=__attribute__((ext_vector_type(4)))unsigned;
constexpr int BATCH=2,NHEAD=16,SEQ=8192,D=64,DM=NHEAD*D,KVSEQ=SEQ+64;
constexpr int NW=8,QBLK=32,QB=QBLK*NW,KVBLK=64,NQB=SEQ/QB;
constexpr int ATTN_PITCH=DM, ATTN_UNIT_ROWS=QB;
__device__ __forceinline__ int crow(int r,int hi){return (r&3)+8*(r>>2)+4*hi;}
#define SBAR() __builtin_amdgcn_sched_barrier(0)
__device__ __forceinline__ void cmask(f32x16&p0,f32x16&p1,int jb,int qrel,int hi){
  const float NEG=-INFINITY; int kb=64*jb+4*hi;
  #pragma unroll
  for(int r=0;r<16;++r){int kv=kb+(r&3)+8*(r>>2); if(kv>qrel)p0[r]=NEG; if(kv+32>qrel)p1[r]=NEG;}
}

constexpr int NSLOT=3, SLOTB=8192;
constexpr int LDS_K=0, LDS_V=NSLOT*SLOTB, LDS_WS=2*NSLOT*SLOTB, LDS_OST=LDS_WS+NW*64*4, LDS_BYTES=LDS_OST+NW*4096;
constexpr float C2=0.125f*1.4426950408889634f;
__device__ __forceinline__ void glds16(const void*gsrc,unsigned lds_dst){unsigned keep;
  asm volatile("s_mov_b32 %0, m0\n\ts_mov_b32 m0, %2\n\ts_nop 0\n\tglobal_load_lds_dwordx4 %1, off\n\ts_mov_b32 m0, %0":"=&s"(keep):"v"(gsrc),"s"(lds_dst):"memory");}
__device__ __forceinline__ float max3f(float a,float b,float c){float r;asm("v_max3_f32 %0, %1, %2, %3":"=v"(r):"v"(a),"v"(b),"v"(c));return r;}
__device__ __forceinline__ float max2f(float a,float b){float r;asm("v_max_f32_e32 %0, %1, %2":"=v"(r):"v"(a),"v"(b));return r;}
__device__ __forceinline__ float fadd_s(float a,float b){float r;asm("v_add_f32_e32 %0, %1, %2":"=v"(r):"v"(a),"v"(b));return r;}
__device__ __forceinline__ float fsub_s(float a,float b){float r;asm("v_sub_f32_e32 %0, %1, %2":"=v"(r):"v"(a),"v"(b));return r;}
typedef float f32x2_t __attribute__((ext_vector_type(2))); typedef __bf16 bf16x2_t __attribute__((ext_vector_type(2)));
__device__ __forceinline__ unsigned cvtpk_s(float lo,float hi){f32x2_t v={lo,hi};bf16x2_t b=__builtin_convertvector(v,bf16x2_t);return __builtin_bit_cast(unsigned,b);}
#define WAIT_BAR(N) asm volatile("s_waitcnt vmcnt(" #N ") lgkmcnt(0)\n\ts_barrier":::"memory")

__device__ __forceinline__ void qkt(f32x16&p0,f32x16&p1,const char*Kslot,const bf16x8*qr,const f32x16&negm,int r32,int hi){
  const char*kb=Kslot+hi*1024+r32*16;
  #pragma unroll
  for(int d0=0;d0<4;++d0){
    const bf16x8 b0=*reinterpret_cast<const bf16x8*>(kb+d0*2048);
    const bf16x8 b1=*reinterpret_cast<const bf16x8*>(kb+d0*2048+512);
    if(d0==0){p0=__builtin_amdgcn_mfma_f32_32x32x16_bf16(b0,qr[0],negm,0,0,0);p1=__builtin_amdgcn_mfma_f32_32x32x16_bf16(b1,qr[0],negm,0,0,0);}
    else{p0=__builtin_amdgcn_mfma_f32_32x32x16_bf16(b0,qr[d0],p0,0,0,0);p1=__builtin_amdgcn_mfma_f32_32x32x16_bf16(b1,qr[d0],p1,0,0,0);}}
}
typedef __attribute__((address_space(3))) const char* lds_cptr;
typedef short v4i16_t __attribute__((ext_vector_type(4)));
__device__ __forceinline__ void kload8(bf16x8*kf,lds_cptr kp){
  kf[0]=*(const __attribute__((address_space(3))) bf16x8*)(kp);      kf[1]=*(const __attribute__((address_space(3))) bf16x8*)(kp+512);
  kf[2]=*(const __attribute__((address_space(3))) bf16x8*)(kp+2048); kf[3]=*(const __attribute__((address_space(3))) bf16x8*)(kp+2560);
  kf[4]=*(const __attribute__((address_space(3))) bf16x8*)(kp+4096); kf[5]=*(const __attribute__((address_space(3))) bf16x8*)(kp+4608);
  kf[6]=*(const __attribute__((address_space(3))) bf16x8*)(kp+6144); kf[7]=*(const __attribute__((address_space(3))) bf16x8*)(kp+6656);
}
__device__ __forceinline__ void kload2(bf16x8*kf,lds_cptr kp,int j){ kf[2*j]=*(const __attribute__((address_space(3))) bf16x8*)(kp+j*2048); kf[2*j+1]=*(const __attribute__((address_space(3))) bf16x8*)(kp+j*2048+512); }
__device__ __forceinline__ s16x4 vtr(lds_cptr p){ return __builtin_bit_cast(s16x4,__builtin_amdgcn_ds_read_tr16_b64_v4i16((__attribute__((address_space(3))) v4i16_t*)p)); }
__device__ __forceinline__ float rowmax(const f32x16&p0,const f32x16&p1){
  float a=max3f(p0[0],p0[1],p1[0]),b=max3f(p0[2],p0[3],p1[1]);a=max3f(a,p1[2],p1[3]);
  #pragma unroll
  for(int r=4;r<16;r+=4){a=max3f(a,p0[r],p0[r+1]);b=max3f(b,p0[r+2],p0[r+3]);a=max3f(a,p1[r],p1[r+1]);b=max3f(b,p1[r+2],p1[r+3]);}
  const float m=max2f(a,b);
  auto rr=__builtin_amdgcn_permlane32_swap(__float_as_uint(m),__float_as_uint(m),false,false);
  return max2f(__uint_as_float(rr[0]),__uint_as_float(rr[1]));
}
__device__ __forceinline__ void pv(f32x16*o,int vb,bf16x8 pa0,bf16x8 pa1,bf16x8 pa2,bf16x8 pa3){
  #pragma unroll
  for(int d0=0;d0<2;++d0){s16x4 lo[4],hi[4];
    #pragma unroll
    for(int ks=0;ks<4;++ks){
      asm volatile("ds_read_b64_tr_b16 %0,%1 offset:%c2":"=&v"(lo[ks]):"v"(vb),"i"(d0*4096+ks*1024):"memory");
      asm volatile("ds_read_b64_tr_b16 %0,%1 offset:%c2":"=&v"(hi[ks]):"v"(vb),"i"(d0*4096+ks*1024+512):"memory");}
    asm volatile("s_waitcnt lgkmcnt(0)":::"memory");SBAR();
    #define PK(k) (bf16x8){lo[k][0],lo[k][1],lo[k][2],lo[k][3],hi[k][0],hi[k][1],hi[k][2],hi[k][3]}
    o[d0]=__builtin_amdgcn_mfma_f32_32x32x16_bf16(pa0,PK(0),o[d0],0,0,0);
    o[d0]=__builtin_amdgcn_mfma_f32_32x32x16_bf16(pa1,PK(1),o[d0],0,0,0);
    o[d0]=__builtin_amdgcn_mfma_f32_32x32x16_bf16(pa2,PK(2),o[d0],0,0,0);
    o[d0]=__builtin_amdgcn_mfma_f32_32x32x16_bf16(pa3,PK(3),o[d0],0,0,0);
    #undef PK
  }
}

#ifndef ATTN_STORE16
#define ATTN_STORE16(p,v) (*(u32x4*)(p)=(v))
#endif
template<int THRL> __device__ __forceinline__ void attn_unit(int b,int h,int qb,const bf16*Q,const bf16*__restrict__ K,const bf16*__restrict__ V,bf16*O,char*shm){
  const int tid=threadIdx.x,lane=tid&63,r32=lane&31,hi=lane>>5; const int wid=__builtin_amdgcn_readfirstlane(tid>>6);
  const long rowbase=(long)b*SEQ; const int q0=qb*QB;
  const bf16*Qw=Q+(rowbase+q0+wid*QBLK)*DM+h*D;
  const bf16*Kh=K+(long)b*KVSEQ*DM+h*D,*Vh=V+(long)b*KVSEQ*DM+h*D;
  const unsigned lds0=(unsigned)(uintptr_t)shm;
  float*wsf=(float*)(shm+LDS_WS)+wid*64;
  const bf16*ksrc=Kh+(long)lane*DM+wid*8;
  const bf16*vsrc=Vh+(long)(16*(wid&3)+(lane>>2))*DM+(wid>>2)*32+(lane&3)*8;
  const unsigned kdst=lds0+LDS_K+wid*1024, vdst=lds0+LDS_V+wid*1024;
  #define DMA_K(t,slot) glds16(ksrc+(long)(t)*KVBLK*DM,(unsigned)__builtin_amdgcn_readfirstlane(kdst+(slot)))
  #define DMA_V(t,slot) glds16(vsrc+(long)(t)*KVBLK*DM,(unsigned)__builtin_amdgcn_readfirstlane(vdst+(slot)))
  const int vb0=(int)(lds0+LDS_V)+((lane>>4)&1)*32+(lane&3)*8+(4*hi+((lane&15)>>2))*64;
  const char*Kbase=shm+LDS_K; bf16x8 kf[8];
  const lds_cptr shm3=(lds_cptr)shm; const lds_cptr kp0=shm3+LDS_K+hi*1024+r32*16; const lds_cptr vp0=shm3+LDS_V+((lane>>4)&1)*32+(lane&3)*8+(4*hi+((lane&15)>>2))*64;
  const int NT=(q0+QB)/KVBLK+1;
  DMA_K(0,0);DMA_V(0,0);DMA_K(1,SLOTB);
  bf16x8 qr[4];
  #pragma unroll
  for(int d0=0;d0<4;++d0)qr[d0]=*reinterpret_cast<const bf16x8*>(&Qw[(long)r32*DM+d0*16+hi*8]);
  float mhat=0.f,l_reg=0.f;f32x16 o[2];o[0]=f32x16{};o[1]=f32x16{};f32x16 negm=f32x16{};asm volatile("":"+v"(negm));
  const int qrel=wid*QBLK+r32;
  #define CMASK(P0,P1,t) do{int jb_=(t)-(NT-4); if(jb_>=0)cmask(P0,P1,jb_,qrel,hi);}while(0)
  bool resc=false;
  #define START(P0,P1) do{ const float rm=rowmax(P0,P1); resc=false; \
    { const float dl=rm; mhat=fadd_s(mhat,dl); \
      _Pragma("unroll") for(int r=0;r<16;++r){P0[r]=fsub_s(P0[r],dl);P1[r]=fsub_s(P1[r],dl);} \
      _Pragma("unroll") for(int r=0;r<16;++r)negm[r]=-mhat; asm volatile("":"+v"(negm)); } \
    _Pragma("unroll") for(int r=0;r<16;++r)P0[r]=__builtin_amdgcn_exp2f(P0[r]); }while(0)
  #define RESC() do{ if(resc){ asm volatile("s_waitcnt lgkmcnt(0)":::"memory"); \
      _Pragma("unroll") for(int d_=0;d_<2;++d_) _Pragma("unroll") for(int r=0;r<16;++r)o[d_][r]*=wsf[crow(r,hi)]; } }while(0)
  f32x16 pA0,pA1,pB0,pB1;
  int sl_prev=0,sl_cur=0,sl_next=SLOTB;
  #define ROT() do{sl_prev=sl_cur;sl_cur=sl_next;sl_next=(sl_next==(NSLOT-1)*SLOTB)?0:sl_next+SLOTB;}while(0)
  DMA_K(2,2*SLOTB);
  WAIT_BAR(3);
  qkt(pA0,pA1,Kbase,qr,negm,r32,hi);asm volatile("s_nop 15\n\ts_nop 7":"+v"(pA0),"+v"(pA1));CMASK(pA0,pA1,0);
  _Pragma("unroll") for(int r=0;r<16;++r){ pA0[r]=-INFINITY; if(r<8)pA1[r]=-INFINITY; }
  START(pA0,pA1);
  _Pragma("unroll") for(int r=0;r<16;++r)pA1[r]=__builtin_amdgcn_exp2f(pA1[r]);
  WAIT_BAR(0);
  DMA_K(3,0);DMA_V(1,SLOTB);
  ROT();
  kload8(kf,kp0+sl_cur);
  WAIT_BAR(2);
  s16x4 vlo[8],vhi[8]; u32x4 pw0,pw1,pw2,pw3;
  #define PKW(P,B) cvtpk_s(P[B],P[B+1])
  #define PAF(k) __builtin_bit_cast(bf16x8,pw##k)
  #define VFR(i) (bf16x8){vlo[i][0],vlo[i][1],vlo[i][2],vlo[i][3],vhi[i][0],vhi[i][1],vhi[i][2],vhi[i][3]}
  #define PIN(x) asm volatile("":"+v"(x))
  #define MX3(a,b,c) __builtin_fmaxf(__builtin_fmaxf((a),(b)),(c))
  #define GAPA(MF,A0,A1,A2,A3,W0,W1,PW) do{ MF; sacc+=A0; sacc+=A1; sacc+=A2; sacc+=A3; PIN(sacc); W0; W1; PIN(PW); SBAR(); }while(0)
  #define EX(v) __builtin_amdgcn_exp2f(v)
  #define GAPB(MF,X,B) do{ MF; X[B]=EX(X[B]); X[B+1]=EX(X[B+1]); X[B+2]=EX(X[B+2]); X[B+3]=EX(X[B+3]); PIN(X); SBAR(); }while(0)
  #define VRD(i) do{ vlo[i]=vtr(vp_+(((i)>>2)*4096+((i)&3)*1024)); vhi[i]=vtr(vp_+(((i)>>2)*4096+((i)&3)*1024+512)); }while(0)
  #define KRD(G,j) do{ if(G){ kload2(kf,kp0+sl_next,j); SBAR(); } }while(0)
  #define STEP(C0,C1,P0,P1,t,GK,GV,GL) do{ SBAR(); \
    const lds_cptr vp_=vp0+sl_prev; \
    VRD(0); SBAR(); float sacc=(P0[0]+P0[1]); \
    GAPA(C0=__builtin_amdgcn_mfma_f32_32x32x16_bf16(kf[0],qr[0],negm,0,0,0), P0[2],P0[3],P0[4],P0[5],     pw0[0]=PKW(P0,0), pw0[1]=PKW(P0,2), pw0); \
    VRD(4); SBAR(); GAPA(C1=__builtin_amdgcn_mfma_f32_32x32x16_bf16(kf[1],qr[0],negm,0,0,0), P0[6],P0[7],P0[8],P0[9],     pw0[2]=PKW(P0,4), pw0[3]=PKW(P0,6), pw0); \
    VRD(1); SBAR(); GAPA(C0=__builtin_amdgcn_mfma_f32_32x32x16_bf16(kf[2],qr[1],C0,0,0,0),   P0[10],P0[11],P0[12],P0[13], pw1[0]=PKW(P0,8), pw1[1]=PKW(P0,10), pw1); \
    VRD(5); SBAR(); GAPA(C1=__builtin_amdgcn_mfma_f32_32x32x16_bf16(kf[3],qr[1],C1,0,0,0),   P0[14],P0[15],P1[0],P1[1],   pw1[2]=PKW(P0,12),pw1[3]=PKW(P0,14), pw1); \
    VRD(2); SBAR(); GAPA(C0=__builtin_amdgcn_mfma_f32_32x32x16_bf16(kf[4],qr[2],C0,0,0,0),   P1[2],P1[3],P1[4],P1[5],     pw2[0]=PKW(P1,0), pw2[1]=PKW(P1,2), pw2); \
    VRD(6); SBAR(); GAPA(C1=__builtin_amdgcn_mfma_f32_32x32x16_bf16(kf[5],qr[2],C1,0,0,0),   P1[6],P1[7],P1[8],P1[9],     pw2[2]=PKW(P1,4), pw2[3]=PKW(P1,6), pw2); \
    VRD(3); SBAR(); GAPA(C0=__builtin_amdgcn_mfma_f32_32x32x16_bf16(kf[6],qr[3],C0,0,0,0),   P1[10],P1[11],P1[12],P1[13], pw3[0]=PKW(P1,8), pw3[1]=PKW(P1,10), pw3); \
    VRD(7); SBAR(); GAPA(C1=__builtin_amdgcn_mfma_f32_32x32x16_bf16(kf[7],qr[3],C1,0,0,0),   P1[14],P1[15],0.f,0.f,       pw3[2]=PKW(P1,12),pw3[3]=PKW(P1,14), pw3); \
    l_reg+=sacc; \
    if(GK){DMA_K((t)+3,sl_cur);} if(GV){DMA_V((t)+1,sl_next);} \
    CMASK(C0,C1,t); \
    { float a=MX3(C0[0],C0[1],C1[0]),b=MX3(C0[2],C0[3],C1[1]); a=MX3(a,C1[2],C1[3]); \
      _Pragma("unroll") for(int r=4;r<16;r+=4){a=MX3(a,C0[r],C0[r+1]);b=MX3(b,C0[r+2],C0[r+3]);a=MX3(a,C1[r],C1[r+1]);b=MX3(b,C1[r+2],C1[r+3]);} \
      float rm=__builtin_fmaxf(a,b); { auto rr=__builtin_amdgcn_permlane32_swap(__float_as_uint(rm),__float_as_uint(rm),false,false); rm=__builtin_fmaxf(__uint_as_float(rr[0]),__uint_as_float(rr[1])); } \
      resc=false; \
      if(__builtin_expect(__any(rm>(float)THRL),0)){ const float dl=__builtin_fmaxf(rm,0.f); mhat+=dl; \
        _Pragma("unroll") for(int r=0;r<16;++r){C0[r]-=dl;C1[r]-=dl;} \
        _Pragma("unroll") for(int r=0;r<16;++r)negm[r]=-mhat; asm volatile("":"+v"(negm)); \
        const float f=__builtin_amdgcn_exp2f(-dl); l_reg*=f; if(hi==0)wsf[r32]=f; resc=true; } } \
    SBAR(); \
    GAPB(o[0]=__builtin_amdgcn_mfma_f32_32x32x16_bf16(PAF(0),VFR(0),o[0],0,0,0), C0,0); \
    GAPB(o[1]=__builtin_amdgcn_mfma_f32_32x32x16_bf16(PAF(0),VFR(4),o[1],0,0,0), C0,4); \
    KRD(GL,0); GAPB(o[0]=__builtin_amdgcn_mfma_f32_32x32x16_bf16(PAF(1),VFR(1),o[0],0,0,0), C0,8); \
    KRD(GL,1); GAPB(o[1]=__builtin_amdgcn_mfma_f32_32x32x16_bf16(PAF(1),VFR(5),o[1],0,0,0), C0,12); \
    KRD(GL,2); GAPB(o[0]=__builtin_amdgcn_mfma_f32_32x32x16_bf16(PAF(2),VFR(2),o[0],0,0,0), C1,0); \
    KRD(GL,3); GAPB(o[1]=__builtin_amdgcn_mfma_f32_32x32x16_bf16(PAF(2),VFR(6),o[1],0,0,0), C1,4); \
    GAPB(o[0]=__builtin_amdgcn_mfma_f32_32x32x16_bf16(PAF(3),VFR(3),o[0],0,0,0), C1,8); \
    GAPB(o[1]=__builtin_amdgcn_mfma_f32_32x32x16_bf16(PAF(3),VFR(7),o[1],0,0,0), C1,12); \
    }while(0)
  int t=1;
  #undef CMASK
  #define CMASK(P0,P1,t) do{}while(0)
  for(;t+5<NT;t+=2){
    STEP(pB0,pB1,pA0,pA1,t,true,true,true);     WAIT_BAR(2); RESC(); ROT();
    STEP(pA0,pA1,pB0,pB1,t+1,true,true,true);   WAIT_BAR(2); RESC(); ROT();
  }
  #undef CMASK
  #define CMASK(P0,P1,t) do{int jb_=(t)-(NT-4); if(jb_>=0)cmask(P0,P1,jb_,qrel,hi);}while(0)
  #define ENDW(tt) do{ if((tt)+3<NT){WAIT_BAR(2);} else if((tt)+2<NT){WAIT_BAR(1);} else {WAIT_BAR(0);} }while(0)
  for(;t+2<NT;t+=2){
    STEP(pB0,pB1,pA0,pA1,t,(t+3<NT),(t+1<NT),(t+1<NT));       ENDW(t);   RESC(); ROT();
    STEP(pA0,pA1,pB0,pB1,t+1,(t+4<NT),(t+2<NT),(t+2<NT));     ENDW(t+1); RESC(); ROT();
  }
  STEP(pB0,pB1,pA0,pA1,t,false,true,true); WAIT_BAR(0); RESC(); ROT();
  STEP(pA0,pA1,pB0,pB1,NT-1,false,false,false); RESC();
  { float sacc=pA0[0]+pA0[1]; _Pragma("unroll") for(int r=2;r<16;++r)sacc+=pA0[r]; _Pragma("unroll") for(int r=0;r<16;++r)sacc+=pA1[r]; l_reg+=sacc;
    pw0=(u32x4){PKW(pA0,0),PKW(pA0,2),PKW(pA0,4),PKW(pA0,6)};pw1=(u32x4){PKW(pA0,8),PKW(pA0,10),PKW(pA0,12),PKW(pA0,14)};pw2=(u32x4){PKW(pA1,0),PKW(pA1,2),PKW(pA1,4),PKW(pA1,6)};pw3=(u32x4){PKW(pA1,8),PKW(pA1,10),PKW(pA1,12),PKW(pA1,14)};
    SBAR(); pv(o,vb0+sl_cur,PAF(0),PAF(1),PAF(2),PAF(3)); }
  #undef PKW
  #undef PAF
  #undef VFR
  #undef PIN
  #undef MX3
  #undef GAPA
  #undef GAPB
  #undef EX
  #undef VRD
  #undef KRD
  #undef STEP
  #undef ENDW
  {auto rr=__builtin_amdgcn_permlane32_swap(__float_as_uint(l_reg),__float_as_uint(l_reg),false,false);l_reg=__uint_as_float(rr[0])+__uint_as_float(rr[1]);}
  if(hi==0)wsf[32+r32]=l_reg;asm volatile("s_waitcnt lgkmcnt(0)":::"memory");
  float rli[16];
  #pragma unroll
  for(int r=0;r<16;++r)rli[r]=__builtin_amdgcn_rcpf(wsf[32+crow(r,hi)]);
  bf16*Ow=O+(rowbase+q0+wid*QBLK)*DM+h*D;
  { bf16*stg=(bf16*)(shm+LDS_OST)+wid*2048;
    #pragma unroll
    for(int r=0;r<16;++r){const int orow=crow(r,hi);
      #pragma unroll
      for(int d0=0;d0<2;++d0)stg[orow*64+d0*32+r32]=__float2bfloat16(o[d0][r]*rli[r]);}
    asm volatile("s_waitcnt lgkmcnt(0)":::"memory");
    #pragma unroll
    for(int i=0;i<4;++i){const int row=i*8+(lane>>3),ch=lane&7; const u32x4 v=*(const u32x4*)(stg+row*64+ch*8); ATTN_STORE16(Ow+(long)row*DM+ch*8,v);} }
  asm volatile("s_waitcnt lgkmcnt(0)\n\ts_barrier":::"memory");
  #undef DMA_K
  #undef DMA_V
  #undef CMASK
  #undef START
  #undef RESC
  #undef ROT
}
constexpr int ATTN_LDS_BYTES=LDS_BYTES;
struct AttnTensors { const bf16* Q; const bf16* K; const bf16* V; bf16* O; };
struct AttnUnit { int bh; int qb; };
struct StaticOrder {
  int vcu;
  __device__ __forceinline__ explicit StaticOrder(int grid,int block):vcu((block%8)*(grid/8)+block/8){}
  __device__ __forceinline__ bool next(int i,AttnUnit&u)const{ if(i>=4)return false; const int s=vcu&7; u.bh=vcu>>3; u.qb=(i==0)?s:(i==1)?15-s:(i==2)?16+s:31-s; return true; }
  __device__ __forceinline__ void a_ready(const AttnUnit&)const{}
  __device__ __forceinline__ void done(const AttnUnit&)const{}
};
template<class Sched,int THRL=8> __device__ __forceinline__ void attn_phase(char*lds,const AttnTensors&T,const Sched&S){
  AttnUnit u;
  for(int i=0;S.next(i,u);++i){ S.a_ready(u); attn_unit<THRL>(u.bh/NHEAD,u.bh%NHEAD,u.qb,T.Q,T.K,T.V,T.O,lds); S.done(u); }
}
#undef SBAR
#undef WAIT_BAR
}
namespace attn2 {
using bf16=__hip_bfloat16;
using bf16x8=__attribute__((ext_vector_type(8)))short;
using s16x4=__attribute__((ext_vector_type(4)))short;
using f32x16=__attribute__((ext_vector_type(16)))float;
using u32x4=__attribute__((ext_vector_type(4)))unsigned;
constexpr int BATCH=2,NHEAD=8,SEQ=8192,D=64,DQK=NHEAD*D,DVP=512,DOP=1024,DM=DQK,KVSEQ=SEQ+64;
constexpr int NW=8,QBLK=32,QB=QBLK*NW,KVBLK=64,NQB=SEQ/QB;
constexpr int ATTN_PITCH=DM, ATTN_UNIT_ROWS=QB;
__device__ __forceinline__ int crow(int r,int hi){return (r&3)+8*(r>>2)+4*hi;}
#define SBAR() __builtin_amdgcn_sched_barrier(0)
__device__ __forceinline__ void cmask(f32x16&p0,f32x16&p1,int jb,int qrel,int hi){
  const float NEG=-INFINITY; int kb=64*jb+4*hi;
  #pragma unroll
  for(int r=0;r<16;++r){int kv=kb+(r&3)+8*(r>>2); if(kv>qrel)p0[r]=NEG; if(kv+32>qrel)p1[r]=NEG;}
}

constexpr int NSLOT=3, SLOTB=8192;
constexpr int LDS_K=0, LDS_V=NSLOT*SLOTB, LDS_WS=3*NSLOT*SLOTB, LDS_OST=LDS_WS+NW*64*4, LDS_BYTES=LDS_OST+NW*8192;
constexpr float C2=0.125f*1.4426950408889634f;
__device__ __forceinline__ void glds16(const void*gsrc,unsigned lds_dst){unsigned keep;
  asm volatile("s_mov_b32 %0, m0\n\ts_mov_b32 m0, %2\n\ts_nop 0\n\tglobal_load_lds_dwordx4 %1, off\n\ts_mov_b32 m0, %0":"=&s"(keep):"v"(gsrc),"s"(lds_dst):"memory");}
__device__ __forceinline__ float max3f(float a,float b,float c){float r;asm("v_max3_f32 %0, %1, %2, %3":"=v"(r):"v"(a),"v"(b),"v"(c));return r;}
__device__ __forceinline__ float max2f(float a,float b){float r;asm("v_max_f32_e32 %0, %1, %2":"=v"(r):"v"(a),"v"(b));return r;}
__device__ __forceinline__ float fadd_s(float a,float b){float r;asm("v_add_f32_e32 %0, %1, %2":"=v"(r):"v"(a),"v"(b));return r;}
__device__ __forceinline__ float fsub_s(float a,float b){float r;asm("v_sub_f32_e32 %0, %1, %2":"=v"(r):"v"(a),"v"(b));return r;}
typedef float f32x2_t __attribute__((ext_vector_type(2))); typedef __bf16 bf16x2_t __attribute__((ext_vector_type(2)));
__device__ __forceinline__ unsigned cvtpk_s(float lo,float hi){f32x2_t v={lo,hi};bf16x2_t b=__builtin_convertvector(v,bf16x2_t);return __builtin_bit_cast(unsigned,b);}
#define WAIT_BAR(N) asm volatile("s_waitcnt vmcnt(" #N ") lgkmcnt(0)\n\ts_barrier":::"memory")

__device__ __forceinline__ void qkt(f32x16&p0,f32x16&p1,const char*Kslot,const bf16x8*qr,const f32x16&negm,int r32,int hi){
  const char*kb=Kslot+hi*1024+r32*16;
  #pragma unroll
  for(int d0=0;d0<4;++d0){
    const bf16x8 b0=*reinterpret_cast<const bf16x8*>(kb+d0*2048);
    const bf16x8 b1=*reinterpret_cast<const bf16x8*>(kb+d0*2048+512);
    if(d0==0){p0=__builtin_amdgcn_mfma_f32_32x32x16_bf16(b0,qr[0],negm,0,0,0);p1=__builtin_amdgcn_mfma_f32_32x32x16_bf16(b1,qr[0],negm,0,0,0);}
    else{p0=__builtin_amdgcn_mfma_f32_32x32x16_bf16(b0,qr[d0],p0,0,0,0);p1=__builtin_amdgcn_mfma_f32_32x32x16_bf16(b1,qr[d0],p1,0,0,0);}}
}
typedef __attribute__((address_space(3))) const char* lds_cptr;
typedef short v4i16_t __attribute__((ext_vector_type(4)));
__device__ __forceinline__ void kload8(bf16x8*kf,lds_cptr kp){
  kf[0]=*(const __attribute__((address_space(3))) bf16x8*)(kp);      kf[1]=*(const __attribute__((address_space(3))) bf16x8*)(kp+512);
  kf[2]=*(const __attribute__((address_space(3))) bf16x8*)(kp+2048); kf[3]=*(const __attribute__((address_space(3))) bf16x8*)(kp+2560);
  kf[4]=*(const __attribute__((address_space(3))) bf16x8*)(kp+4096); kf[5]=*(const __attribute__((address_space(3))) bf16x8*)(kp+4608);
  kf[6]=*(const __attribute__((address_space(3))) bf16x8*)(kp+6144); kf[7]=*(const __attribute__((address_space(3))) bf16x8*)(kp+6656);
}
__device__ __forceinline__ void kload2(bf16x8*kf,lds_cptr kp,int j){ kf[2*j]=*(const __attribute__((address_space(3))) bf16x8*)(kp+j*2048); kf[2*j+1]=*(const __attribute__((address_space(3))) bf16x8*)(kp+j*2048+512); }
__device__ __forceinline__ s16x4 vtr(lds_cptr p){ return __builtin_bit_cast(s16x4,__builtin_amdgcn_ds_read_tr16_b64_v4i16((__attribute__((address_space(3))) v4i16_t*)p)); }
__device__ __forceinline__ float rowmax(const f32x16&p0,const f32x16&p1){
  float a=max3f(p0[0],p0[1],p1[0]),b=max3f(p0[2],p0[3],p1[1]);a=max3f(a,p1[2],p1[3]);
  #pragma unroll
  for(int r=4;r<16;r+=4){a=max3f(a,p0[r],p0[r+1]);b=max3f(b,p0[r+2],p0[r+3]);a=max3f(a,p1[r],p1[r+1]);b=max3f(b,p1[r+2],p1[r+3]);}
  const float m=max2f(a,b);
  auto rr=__builtin_amdgcn_permlane32_swap(__float_as_uint(m),__float_as_uint(m),false,false);
  return max2f(__uint_as_float(rr[0]),__uint_as_float(rr[1]));
}
__device__ __forceinline__ void pv(f32x16*o,int vb,bf16x8 pa0,bf16x8 pa1,bf16x8 pa2,bf16x8 pa3){
  #pragma unroll
  for(int d0=0;d0<4;++d0){s16x4 lo[4],hi[4];
    #pragma unroll
    for(int ks=0;ks<4;++ks){
      asm volatile("ds_read_b64_tr_b16 %0,%1 offset:%c2":"=&v"(lo[ks]):"v"(vb),"i"(d0*4096+ks*1024):"memory");
      asm volatile("ds_read_b64_tr_b16 %0,%1 offset:%c2":"=&v"(hi[ks]):"v"(vb),"i"(d0*4096+ks*1024+512):"memory");}
    asm volatile("s_waitcnt lgkmcnt(0)":::"memory");SBAR();
    #define PK(k) (bf16x8){lo[k][0],lo[k][1],lo[k][2],lo[k][3],hi[k][0],hi[k][1],hi[k][2],hi[k][3]}
    o[d0]=__builtin_amdgcn_mfma_f32_32x32x16_bf16(pa0,PK(0),o[d0],0,0,0);
    o[d0]=__builtin_amdgcn_mfma_f32_32x32x16_bf16(pa1,PK(1),o[d0],0,0,0);
    o[d0]=__builtin_amdgcn_mfma_f32_32x32x16_bf16(pa2,PK(2),o[d0],0,0,0);
    o[d0]=__builtin_amdgcn_mfma_f32_32x32x16_bf16(pa3,PK(3),o[d0],0,0,0);
    #undef PK
  }
}

#ifndef ATTN_STORE16
#define ATTN_STORE16(p,v) (*(u32x4*)(p)=(v))
#endif
template<int THRL> __device__ __forceinline__ void attn_unit(int b,int h,int qb,const bf16*Q,const bf16*__restrict__ K,const bf16*__restrict__ V,bf16*O,char*shm){
  int tid=threadIdx.x; asm volatile("":"+v"(tid));
  const int lane=tid&63,r32=lane&31,hi=lane>>5; const int wid=__builtin_amdgcn_readfirstlane(tid>>6);
  const long rowbase=(long)b*SEQ; const int q0=qb*QB;
  const bf16*Qw=Q+(rowbase+q0+wid*QBLK)*DQK+h*D;
  const bf16*Kh=K+(long)b*KVSEQ*DQK+h*D,*Vh=V+(long)b*KVSEQ*DVP+(h>>1)*128;
  const unsigned lds0=(unsigned)(uintptr_t)shm;
  float*wsf=(float*)(shm+LDS_WS)+wid*64;
  const bf16*ksrc=Kh+(long)lane*DQK+wid*8;
  const bf16*vsrc=Vh+(long)(16*(wid&3)+(lane>>2))*DVP+(wid>>2)*32+(lane&3)*8;
  const unsigned kdst=lds0+LDS_K+wid*1024, vdst=lds0+LDS_V+wid*1024;
  #define DMA_K(t,slot) glds16(ksrc+(long)(t)*KVBLK*DQK,(unsigned)__builtin_amdgcn_readfirstlane(kdst+(slot)))
  #define DMA_V(t,slot) do{ glds16(vsrc+(long)(t)*KVBLK*DVP,(unsigned)__builtin_amdgcn_readfirstlane(vdst+2*(slot))); glds16(vsrc+(long)(t)*KVBLK*DVP+64,(unsigned)__builtin_amdgcn_readfirstlane(vdst+2*(slot)+8192)); }while(0)
  const int vb0=(int)(lds0+LDS_V)+((lane>>4)&1)*32+(lane&3)*8+(4*hi+((lane&15)>>2))*64;
  const char*Kbase=shm+LDS_K; bf16x8 kf[8];
  const lds_cptr shm3=(lds_cptr)shm; const lds_cptr kp0=shm3+LDS_K+hi*1024+r32*16; const lds_cptr vp0=shm3+LDS_V+((lane>>4)&1)*32+(lane&3)*8+(4*hi+((lane&15)>>2))*64;
  const int NT=(q0+QB)/KVBLK+1;
  DMA_K(0,0);DMA_V(0,0);DMA_K(1,SLOTB);
  bf16x8 qr[4];
  #pragma unroll
  for(int d0=0;d0<4;++d0)qr[d0]=*reinterpret_cast<const bf16x8*>(&Qw[(long)r32*DQK+d0*16+hi*8]);
  float mhat=0.f,l_reg=0.f;f32x16 o[4];o[0]=f32x16{};o[1]=f32x16{};o[2]=f32x16{};o[3]=f32x16{};const f32x16 zero16=f32x16{};
  const int qrel=wid*QBLK+r32;
  #define CMASK(P0,P1,t) do{int jb_=(t)-(NT-4); if(jb_>=0)cmask(P0,P1,jb_,qrel,hi);}while(0)
  bool resc=false;
  #define START(P0,P1) do{ const float rm=rowmax(P0,P1); resc=false; \
    { const float dl=rm; mhat=fadd_s(mhat,dl); \
      _Pragma("unroll") for(int r=0;r<16;++r){P0[r]=fsub_s(P0[r],dl);P1[r]=fsub_s(P1[r],dl);} \
      } \
    _Pragma("unroll") for(int r=0;r<16;++r)P0[r]=__builtin_amdgcn_exp2f(P0[r]); }while(0)
  #define RESC() do{ if(resc){ asm volatile("s_waitcnt lgkmcnt(0)":::"memory"); \
      _Pragma("unroll") for(int d_=0;d_<4;++d_) _Pragma("unroll") for(int r=0;r<16;++r)o[d_][r]*=wsf[crow(r,hi)]; } }while(0)
  f32x16 pA0,pA1,pB0,pB1;
  int sl_prev=0,sl_cur=0,sl_next=SLOTB;
  #define ROT() do{sl_prev=sl_cur;sl_cur=sl_next;sl_next=(sl_next==(NSLOT-1)*SLOTB)?0:sl_next+SLOTB;}while(0)
  DMA_K(2,2*SLOTB);
  WAIT_BAR(4);
  qkt(pA0,pA1,Kbase,qr,zero16,r32,hi);asm volatile("s_nop 15\n\ts_nop 7":"+v"(pA0),"+v"(pA1));CMASK(pA0,pA1,0);
  _Pragma("unroll") for(int r=0;r<16;++r){ pA0[r]=-INFINITY; if(r<8)pA1[r]=-INFINITY; }
  _Pragma("unroll") for(int r=0;r<16;++r)pA0[r]=__builtin_amdgcn_exp2f(pA0[r]);
  _Pragma("unroll") for(int r=0;r<16;++r)pA1[r]=__builtin_amdgcn_exp2f(pA1[r]);
  WAIT_BAR(0);
  DMA_K(3,0);DMA_V(1,SLOTB);
  ROT();
  kload8(kf,kp0+sl_cur);
  WAIT_BAR(3);
  s16x4 vlo[4],vhi[4]; u32x4 pwa0,pwa1,pwa2,pwa3,pwb0,pwb1,pwb2,pwb3;
  #define PKW(P,B) cvtpk_s(P[B],P[B+1])
  #define PAFX(P,k) __builtin_bit_cast(bf16x8,P##k)
  #define VFR(i) (bf16x8){vlo[i][0],vlo[i][1],vlo[i][2],vlo[i][3],vhi[i][0],vhi[i][1],vhi[i][2],vhi[i][3]}
  #define PIN(x) asm volatile("":"+v"(x))
  #define MX3(a,b,c) __builtin_fmaxf(__builtin_fmaxf((a),(b)),(c))
  #define EX(v) __builtin_amdgcn_exp2f(v)
  #define VRD(s,i) do{ vlo[s]=vtr(vp_+(((i)>>2)*4096+((i)&3)*1024)); vhi[s]=vtr(vp_+(((i)>>2)*4096+((i)&3)*1024+512)); }while(0)
  #define KRD(G,j) do{ if(G){ kload2(kf,kp0+sl_next,j); SBAR(); } }while(0)
  #define GAPA(MF) do{ MF; SBAR(); }while(0)
  #define GAPB(MF,RD,X,B,PV_,W) do{ MF; RD; X[B]=EX(X[B]); X[B+1]=EX(X[B+1]); sacc+=X[B]; sacc+=X[B+1]; PIN(sacc); PV_[W]=cvtpk_s(X[B],X[B+1]); PIN(PV_); SBAR(); }while(0)
  #define STEP(C0,C1,PP,PC,t,GK,GV,GL) do{ SBAR(); \
    const lds_cptr vp_=vp0+2*sl_prev; \
    GAPA(C0=__builtin_amdgcn_mfma_f32_32x32x16_bf16(kf[0],qr[0],zero16,0,0,0)); GAPA(C1=__builtin_amdgcn_mfma_f32_32x32x16_bf16(kf[1],qr[0],zero16,0,0,0)); GAPA(C0=__builtin_amdgcn_mfma_f32_32x32x16_bf16(kf[2],qr[1],C0,0,0,0)); GAPA(C1=__builtin_amdgcn_mfma_f32_32x32x16_bf16(kf[3],qr[1],C1,0,0,0)); VRD(0,0); SBAR(); GAPA(C0=__builtin_amdgcn_mfma_f32_32x32x16_bf16(kf[4],qr[2],C0,0,0,0)); VRD(1,4); SBAR(); GAPA(C1=__builtin_amdgcn_mfma_f32_32x32x16_bf16(kf[5],qr[2],C1,0,0,0)); VRD(2,8); SBAR(); GAPA(C0=__builtin_amdgcn_mfma_f32_32x32x16_bf16(kf[6],qr[3],C0,0,0,0)); VRD(3,12); SBAR(); GAPA(C1=__builtin_amdgcn_mfma_f32_32x32x16_bf16(kf[7],qr[3],C1,0,0,0)); \
    if(GK){DMA_K((t)+3,sl_cur);} if(GV){DMA_V((t)+1,sl_next);} \
    CMASK(C0,C1,t); \
    SBAR(); float sacc=0.f; \
    GAPB(o[0]=__builtin_amdgcn_mfma_f32_32x32x16_bf16(PAFX(PP,0),VFR(0),o[0],0,0,0), VRD(0,1), C0,0, PC##0,0); \
    GAPB(o[1]=__builtin_amdgcn_mfma_f32_32x32x16_bf16(PAFX(PP,0),VFR(1),o[1],0,0,0), VRD(1,5), C0,2, PC##0,1); \
    GAPB(o[2]=__builtin_amdgcn_mfma_f32_32x32x16_bf16(PAFX(PP,0),VFR(2),o[2],0,0,0), VRD(2,9), C0,4, PC##0,2); \
    GAPB(o[3]=__builtin_amdgcn_mfma_f32_32x32x16_bf16(PAFX(PP,0),VFR(3),o[3],0,0,0), VRD(3,13), C0,6, PC##0,3); \
    GAPB(o[0]=__builtin_amdgcn_mfma_f32_32x32x16_bf16(PAFX(PP,1),VFR(0),o[0],0,0,0), VRD(0,2), C0,8, PC##1,0); \
    GAPB(o[1]=__builtin_amdgcn_mfma_f32_32x32x16_bf16(PAFX(PP,1),VFR(1),o[1],0,0,0), VRD(1,6), C0,10, PC##1,1); \
    GAPB(o[2]=__builtin_amdgcn_mfma_f32_32x32x16_bf16(PAFX(PP,1),VFR(2),o[2],0,0,0), VRD(2,10), C0,12, PC##1,2); \
    GAPB(o[3]=__builtin_amdgcn_mfma_f32_32x32x16_bf16(PAFX(PP,1),VFR(3),o[3],0,0,0), VRD(3,14), C0,14, PC##1,3); \
    GAPB(o[0]=__builtin_amdgcn_mfma_f32_32x32x16_bf16(PAFX(PP,2),VFR(0),o[0],0,0,0), VRD(0,3), C1,0, PC##2,0); \
    GAPB(o[1]=__builtin_amdgcn_mfma_f32_32x32x16_bf16(PAFX(PP,2),VFR(1),o[1],0,0,0), VRD(1,7), C1,2, PC##2,1); \
    GAPB(o[2]=__builtin_amdgcn_mfma_f32_32x32x16_bf16(PAFX(PP,2),VFR(2),o[2],0,0,0), VRD(2,11), C1,4, PC##2,2); \
    GAPB(o[3]=__builtin_amdgcn_mfma_f32_32x32x16_bf16(PAFX(PP,2),VFR(3),o[3],0,0,0), VRD(3,15), C1,6, PC##2,3); \
    KRD(GL,0); GAPB(o[0]=__builtin_amdgcn_mfma_f32_32x32x16_bf16(PAFX(PP,3),VFR(0),o[0],0,0,0), (void)0, C1,8, PC##3,0); \
    KRD(GL,1); GAPB(o[1]=__builtin_amdgcn_mfma_f32_32x32x16_bf16(PAFX(PP,3),VFR(1),o[1],0,0,0), (void)0, C1,10, PC##3,1); \
    KRD(GL,2); GAPB(o[2]=__builtin_amdgcn_mfma_f32_32x32x16_bf16(PAFX(PP,3),VFR(2),o[2],0,0,0), (void)0, C1,12, PC##3,2); \
    KRD(GL,3); GAPB(o[3]=__builtin_amdgcn_mfma_f32_32x32x16_bf16(PAFX(PP,3),VFR(3),o[3],0,0,0), (void)0, C1,14, PC##3,3); \
    l_reg+=sacc; \
    }while(0)
  { float sacc=pA0[0]+pA0[1]; _Pragma("unroll") for(int r=2;r<16;++r)sacc+=pA0[r]; _Pragma("unroll") for(int r=0;r<16;++r)sacc+=pA1[r]; l_reg+=sacc;
    pwa0=(u32x4){PKW(pA0,0),PKW(pA0,2),PKW(pA0,4),PKW(pA0,6)};pwa1=(u32x4){PKW(pA0,8),PKW(pA0,10),PKW(pA0,12),PKW(pA0,14)};pwa2=(u32x4){PKW(pA1,0),PKW(pA1,2),PKW(pA1,4),PKW(pA1,6)};pwa3=(u32x4){PKW(pA1,8),PKW(pA1,10),PKW(pA1,12),PKW(pA1,14)}; }
  pwb0=pwa0;pwb1=pwa1;pwb2=pwa2;pwb3=pwa3;
  int t=1;
  #undef CMASK
  #define CMASK(P0,P1,t) do{int jb_=(t)-(NT-4); if(jb_>=0)cmask(P0,P1,jb_,qrel,hi);}while(0)
  #define ENDW(tt) do{ if((tt)+3<NT){WAIT_BAR(3);} else if((tt)+2<NT){WAIT_BAR(2);} else {WAIT_BAR(0);} }while(0)
  for(;t+2<NT;t+=2){
    STEP(pA0,pA1,pwa,pwb,t,(t+3<NT),(t+1<NT),(t+1<NT));       ENDW(t);   ROT();
    STEP(pA0,pA1,pwb,pwa,t+1,(t+4<NT),(t+2<NT),(t+2<NT));     ENDW(t+1); ROT();
  }
  STEP(pA0,pA1,pwa,pwb,t,false,true,true); WAIT_BAR(0); ROT();
  STEP(pA0,pA1,pwb,pwa,NT-1,false,false,false);
  SBAR(); pv(o,vb0+2*sl_cur,PAFX(pwa,0),PAFX(pwa,1),PAFX(pwa,2),PAFX(pwa,3));
  #undef PAFX
  #undef PKW
  #undef VFR
  #undef PIN
  #undef MX3
  #undef GAPA
  #undef GAPB
  #undef EX
  #undef VRD
  #undef KRD
  #undef STEP
  #undef ENDW
  {auto rr=__builtin_amdgcn_permlane32_swap(__float_as_uint(l_reg),__float_as_uint(l_reg),false,false);l_reg=__uint_as_float(rr[0])+__uint_as_float(rr[1]);}
  if(hi==0)wsf[32+r32]=l_reg;asm volatile("s_waitcnt lgkmcnt(0)":::"memory");
  float rli[16];
  #pragma unroll
  for(int r=0;r<16;++r)rli[r]=__builtin_amdgcn_rcpf(wsf[32+crow(r,hi)]);
  bf16*Ow=O+(rowbase+q0+wid*QBLK)*DOP+h*128;
  { bf16*stg=(bf16*)(shm+LDS_OST)+wid*4096;
    #pragma unroll
    for(int r=0;r<16;++r){const int orow=crow(r,hi);
      #pragma unroll
      for(int d0=0;d0<4;++d0)stg[orow*128+d0*32+r32]=__float2bfloat16(o[d0][r]*rli[r]);}
    asm volatile("s_waitcnt lgkmcnt(0)":::"memory");
    #pragma unroll
    for(int i=0;i<8;++i){const int row=i*4+(lane>>4),ch=lane&15; const u32x4 v=*(const u32x4*)(stg+row*128+ch*8); ATTN_STORE16(Ow+(long)row*DOP+ch*8,v);} }
  asm volatile("s_waitcnt lgkmcnt(0)\n\ts_barrier":::"memory");
  #undef DMA_K
  #undef DMA_V
  #undef CMASK
  #undef START
  #undef RESC
  #undef ROT
}
constexpr int ATTN_LDS_BYTES=LDS_BYTES;
struct AttnTensors { const bf16* Q; const bf16* K; const bf16* V; bf16* O; };
struct AttnUnit { int bh; int qb; };
struct StaticOrder {
  int vcu;
  __device__ __forceinline__ explicit StaticOrder(int grid,int block):vcu((block%8)*(grid/8)+block/8){}
  __device__ __forceinline__ bool next(int i,AttnUnit&u)const{ if(i>=2)return false; const int s=vcu&15; u.bh=vcu>>4; u.qb=(i==0)?31-s:s; return true; }
  __device__ __forceinline__ void a_ready(const AttnUnit&)const{}
  __device__ __forceinline__ void done(const AttnUnit&)const{}
};
template<class Sched,int THRL=8> __device__ __forceinline__ void attn_phase(char*lds,const AttnTensors&T,const Sched&S){
  AttnUnit u;
  _Pragma("unroll 1") for(int i=0;S.next(i,u);++i){ S.a_ready(u); attn_unit<THRL>(u.bh/NHEAD,u.bh%NHEAD,u.qb,T.Q,T.K,T.V,T.O,lds); S.done(u); }
}
#undef SBAR
#undef WAIT_BAR
}
#define GAS __attribute__((address_space(1)))
typedef unsigned v4u __attribute__((ext_vector_type(4)));
#define LDS_WAIT() asm volatile("s_waitcnt lgkmcnt(0)" ::: "memory")

#ifndef T_GEMM_Z
#define T_GEMM_Z 1
#endif
#ifndef T_GEMM_GLU
#define T_GEMM_GLU 1
#endif
#ifndef T_GEMM_MIX
#define T_GEMM_MIX 1
#endif
#ifndef T_GEMM_WO
#define T_GEMM_WO 1
#endif
#ifndef T_MOE
#define T_MOE 1
#endif
#ifndef T_S5
#define T_S5 1
#endif
#ifndef T_ATTN
#define T_ATTN 2
#endif
#ifndef T_ROUTER
#define T_ROUTER 1
#endif
#ifndef COOP_LAUNCH
#define COOP_LAUNCH 0
#endif
#ifndef T_GATE8
#define T_GATE8 0
#endif
#ifndef T_WO8
#define T_WO8 0
#endif
#ifndef T_MIXCAT
#define T_MIXCAT 1
#endif
#ifndef T_H1B
#define T_H1B 0
#endif
#ifndef DN_LATE
#define DN_LATE 16
#endif
#ifndef DN_MID
#define DN_MID 8
#endif
#ifndef T_FP8
#define T_FP8 1
#endif

template <bool GATHER>
__device__ __forceinline__ void gemm_core(f32x4 (&acc)[2][2], bool act, const bf16_t* __restrict__ A, int lda, const int* __restrict__ rowidx, int m0,
                                          const float* __restrict__ B, int ldb, int n0, int K, bf16_t* As, bf16_t* Bs) {
    const int tid = threadIdx.x & 255, lane = tid & 63, w = tid >> 6, wm = w >> 1, wn = w & 1;
    const int ar = tid >> 2, ak = (tid & 3) * 8, bk = tid >> 3, bn = (tid & 7) * 8;
    int arow = m0 + ar; if (GATHER) arow = act ? rowidx[m0 + ar] : -1;
#pragma unroll
    for (int i = 0; i < 2; ++i)
#pragma unroll
        for (int j = 0; j < 2; ++j) acc[i][j] = (f32x4){0.f, 0.f, 0.f, 0.f};
    for (int k0 = 0; k0 < K; k0 += 32) {
        uint4 av = make_uint4(0, 0, 0, 0); f32x4 b0 = (f32x4){0.f, 0.f, 0.f, 0.f}, b1 = b0;
        if (act) {
            if (arow >= 0) av = *(const uint4*)(A + (size_t)arow * lda + k0 + ak);
            b0 = *(const f32x4*)(B + (size_t)(k0 + bk) * ldb + n0 + bn); b1 = *(const f32x4*)(B + (size_t)(k0 + bk) * ldb + n0 + bn + 4);
        }
        __syncthreads();
        *(uint4*)(As + ar * 40 + ak) = av;
#pragma unroll
        for (int i = 0; i < 4; ++i) { Bs[(bn + i) * 40 + bk] = (bf16_t)f2bf(b0[i]); Bs[(bn + 4 + i) * 40 + bk] = (bf16_t)f2bf(b1[i]); }
        __syncthreads();
        bf16x8 a[2], b[2];
#pragma unroll
        for (int i = 0; i < 2; ++i) { a[i] = *(const bf16x8*)(As + (wm * 32 + i * 16 + (lane & 15)) * 40 + 8 * (lane >> 4)); b[i] = *(const bf16x8*)(Bs + (wn * 32 + i * 16 + (lane & 15)) * 40 + 8 * (lane >> 4)); }
#pragma unroll
        for (int i = 0; i < 2; ++i)
#pragma unroll
            for (int j = 0; j < 2; ++j) acc[i][j] = __builtin_amdgcn_mfma_f32_16x16x32_bf16(a[i], b[j], acc[i][j], 0, 0, 0);
    }
}
#define SG_LOOP(ntm, ntn) \
    bf16_t* As = (bf16_t*)(F.lds + (F.tid >> 8) * 16384); bf16_t* Bs = As + 64 * 40; \
    const int ntiles_ = (ntm) * (ntn), stride_ = 2 * F.G; \
    for (int it_ = 0; it_ * stride_ < ntiles_; ++it_) { \
        int t_ = it_ * stride_ + F.vcu * 2 + (F.tid >> 8); const bool act = t_ < ntiles_; if (!act) t_ = ntiles_ - 1; \
        const int m0 = (t_ / (ntn)) * 64, n0 = (t_ % (ntn)) * 64; (void)m0; (void)n0;
#define SG_END } __syncthreads();
#define EPI_LOOP(...) \
    if (act) { const int lane_ = threadIdx.x & 63, w_ = (threadIdx.x >> 6) & 3, wm_ = w_ >> 1, wn_ = w_ & 1; \
      _Pragma("unroll") for (int mi = 0; mi < 2; ++mi) _Pragma("unroll") for (int ni = 0; ni < 2; ++ni) _Pragma("unroll") for (int r = 0; r < 4; ++r) { \
        const int row = m0 + wm_ * 32 + mi * 16 + (lane_ >> 4) * 4 + r, col = n0 + wn_ * 32 + ni * 16 + (lane_ & 15); __VA_ARGS__ } }

struct CpItem { const float* src; bf16_t* dst; };
__device__ __forceinline__ void cp_load(const CpItem& c, int N, float (&wv)[32], int lane) {
#pragma unroll
    for (int i = 0; i < 32; ++i) wv[i] = __builtin_nontemporal_load(c.src + (size_t)(2 * i + (lane >> 5)) * N + (lane & 31));
}
__device__ __forceinline__ void cp_store(const CpItem& c, int K, const float (&wv)[32], LAS float* scr, int lane) {
#pragma unroll
    for (int i = 0; i < 32; ++i) scr[(2 * i + (lane >> 5)) * 33 + (lane & 31)] = wv[i];
    LDS_WAIT(); asm volatile("" ::: "memory");
    const int cc = lane & 7;
#pragma unroll
    for (int j = 0; j < 4; ++j) { const int n = (lane >> 3) + 8 * j; const LAS float* sp = scr + (8 * cc) * 33 + n;
        v4u o; o.x = pk2(sp[0 * 33], sp[1 * 33]); o.y = pk2(sp[2 * 33], sp[3 * 33]); o.z = pk2(sp[4 * 33], sp[5 * 33]); o.w = pk2(sp[6 * 33], sp[7 * 33]);
        *(GAS v4u*)(c.dst + (size_t)n * K + 8 * cc) = o; }
    LDS_WAIT(); asm volatile("" ::: "memory");
}
__device__ __forceinline__ void cp_store8(const CpItem& c, int K, const float (&wv)[32], LAS float* scr, int lane) {
#pragma unroll
    for (int i = 0; i < 32; ++i) scr[(2 * i + (lane >> 5)) * 33 + (lane & 31)] = wv[i] * 32.f;
    LDS_WAIT(); asm volatile("" ::: "memory");
    const int cc = lane & 3;
#pragma unroll
    for (int j = 0; j < 2; ++j) { const int n = (lane >> 2) + 16 * j; const LAS float* sp = scr + (16 * cc) * 33 + n;
        v4u o; o.x = pg8::pk4_fp8(sp[0 * 33], sp[1 * 33], sp[2 * 33], sp[3 * 33]); o.y = pg8::pk4_fp8(sp[4 * 33], sp[5 * 33], sp[6 * 33], sp[7 * 33]);
        o.z = pg8::pk4_fp8(sp[8 * 33], sp[9 * 33], sp[10 * 33], sp[11 * 33]); o.w = pg8::pk4_fp8(sp[12 * 33], sp[13 * 33], sp[14 * 33], sp[15 * 33]);
        __builtin_nontemporal_store(o, (GAS v4u*)((unsigned char*)c.dst + (size_t)n * K + 16 * cc)); }
    LDS_WAIT(); asm volatile("" ::: "memory");
}
template <int MODE, bool FP8 = false>
__device__ __forceinline__ void cp_set(Frame& F, const float* W, int K, int N, bf16_t* WT, int ne, int ncols = 0, int dpitch = 0, int koff = 0, int gwo = -1, int ngwo = 0) {
    const int gw = gwo >= 0 ? gwo : F.vcu * NWAVES + F.wave, NGW = gwo >= 0 ? ngwo : F.G * NWAVES, lane = F.lane;
    LAS float* scr = (LAS float*)(F.lds3 + F.wave * 16384);
    const int nbn = (ncols ? ncols : N) / 32, ipm = (K / 64) * nbn, nitems = ne * ipm;
    auto dec = [&](int it) { CpItem c; const int e = it / ipm, q = it % ipm, kb = q / nbn, n0 = 32 * (q % nbn);
        const size_t drow = MODE == 0 ? (size_t)e * N + n0 : (size_t)e * 2048 + 256 * (n0 / 128) + 128 * (MODE - 1) + (n0 % 128);
        c.src = W + (size_t)e * K * N + (size_t)(64 * kb) * N + n0; c.dst = FP8 ? (bf16_t*)((unsigned char*)WT + drow * K + 64 * kb) : WT + drow * (dpitch ? dpitch : K) + koff + 64 * kb; return c; };
    int it = gw; if (it >= nitems) return;
    CpItem c0 = dec(it); float wa[32], wb[32];
    cp_load(c0, N, wa, lane);
    for (;;) {
        const int itn = it + NGW; const bool hn = itn < nitems; CpItem c1 = c0;
        if (hn) { c1 = dec(itn); cp_load(c1, N, wb, lane); }
        if constexpr (FP8) cp_store8(c0, K, wa, scr, lane); else cp_store(c0, dpitch ? dpitch : K, wa, scr, lane);
        if (!hn) break;
#pragma unroll
        for (int i = 0; i < 32; ++i) wa[i] = wb[i];
        c0 = c1; it = itn;
    }
}
__device__ __forceinline__ void cp_all(Frame& F) {
    cp_set<0>(F, F.w_in, D, INW, F.Wt_in, 1); if (T_GATE8) cp_set<0, true>(F, F.w_in + 2048, D, INW, F.Wt_in8, 1, 2048); cp_set<0>(F, F.w_glu, SW, SW, F.Wt_glu, 1); if (T_MIXCAT) { cp_set<0>(F, F.w_ao, AW, D, F.Wt_so, 1, 0, 1024, 0); cp_set<0>(F, F.w_so, SW, D, F.Wt_so, 1, 0, 1024, 512); }
    else { cp_set<0>(F, F.w_so, SW, D, F.Wt_so, 1); cp_set<0>(F, F.w_ao, AW, D, F.Wt_ao, 1); } cp_set<0, T_WO8>(F, F.w_o, D, D, F.Wt_o, 1);
    if (T_MOE) { cp_set<1, T_FP8>(F, F.w_gate, D, D, F.Wt_gu, NE); cp_set<2, T_FP8>(F, F.w_up, D, D, F.Wt_gu, NE); cp_set<0, T_FP8>(F, F.w_down, D, D, F.Wt_dn, NE - (T_GEMM_GLU ? DN_LATE : 0) - DN_MID); }
}
__device__ __forceinline__ void p0_meta(Frame& F) {
    float* xm = (float*)F.lds;
    float* red = xm + 16 * 1025;
    for (int rr = 0; rr < 2; ++rr) {
        const int row = 2 * F.wave + rr; const float* src = F.meta + (size_t)row * D;
        f32x4 v[4]; float ss = 0.f;
#pragma unroll
        for (int j = 0; j < 4; ++j) { v[j] = *(const f32x4*)(src + 256 * j + 4 * F.lane); ss += v[j][0] * v[j][0] + v[j][1] * v[j][1] + v[j][2] * v[j][2] + v[j][3] * v[j][3]; }
        ss = wave_sum(ss);
        const float rs = rsqrtf(ss * (1.f / D) + EPS);
#pragma unroll
        for (int j = 0; j < 4; ++j) { const f32x4 gg = *(const f32x4*)(F.norm_mix_g + 256 * j + 4 * F.lane);
#pragma unroll
            for (int q = 0; q < 4; ++q) xm[row * 1025 + 256 * j + 4 * F.lane + q] = v[j][q] * rs * gg[q]; }
    }
    __syncthreads();
    const int c = F.tid & 15, kq = F.tid >> 4;
    for (int cgp = F.vcu; cgp < INW / 16; cgp += F.G) {
        const int col = 16 * cgp + c;
        float wv[32];
#pragma unroll
        for (int i = 0; i < 32; ++i) wv[i] = F.w_in[(size_t)(32 * kq + i) * INW + col];
        float acc[16];
#pragma unroll
        for (int r = 0; r < 16; ++r) acc[r] = 0.f;
#pragma unroll
        for (int i = 0; i < 32; ++i)
#pragma unroll
            for (int r = 0; r < 16; ++r) acc[r] += xm[r * 1025 + 32 * kq + i] * wv[i];
#pragma unroll
        for (int r = 0; r < 16; ++r) red[(kq * 16 + r) * 16 + c] = acc[r];
        __syncthreads();
        if (F.tid < 256) { float v = 0.f;
#pragma unroll
            for (int q = 0; q < 32; ++q) v += red[q * 256 + F.tid];
            F.ZM[(F.tid >> 4) * INW + 16 * cgp + (F.tid & 15)] = (bf16_t)f2bf(v); }
        __syncthreads();
    }
}
__device__ __forceinline__ void s_prologue(Frame& F) {
    if (!(F.mode & 4)) p0_meta(F);
    const int gw = F.vcu * NWAVES + F.wave, NGW = F.G * NWAVES, lane = F.lane;
    if (!(F.mode & 8)) cp_all(F);
    if (!(F.mode & 16)) for (int row = gw; row < M; row += NGW) {
        const float* src = F.x + (size_t)row * D;
        f32x4 v[4]; float ss = 0.f;
#pragma unroll
        for (int j = 0; j < 4; ++j) { v[j] = __builtin_nontemporal_load((const f32x4*)(src + 256 * j + 4 * lane)); ss += v[j][0] * v[j][0] + v[j][1] * v[j][1] + v[j][2] * v[j][2] + v[j][3] * v[j][3]; }
        ss = wave_sum(ss);
        const float rs = rsqrtf(ss * (1.f / D) + EPS);
#pragma unroll
        for (int j = 0; j < 4; ++j) {
            const f32x4 gg = *(const f32x4*)(F.norm_mix_g + 256 * j + 4 * lane);
            *(uint2*)(F.XN + (size_t)row * D + 256 * j + 4 * lane) = make_uint2(pk2(v[j][0] * rs * gg[0], v[j][1] * rs * gg[1]), pk2(v[j][2] * rs * gg[2], v[j][3] * rs * gg[3]));
            if (T_GATE8) *(unsigned*)((unsigned char*)F.XN8 + (size_t)row * D + 256 * j + 4 * lane) = pg8::pk4_fp8(v[j][0] * rs * gg[0], v[j][1] * rs * gg[1], v[j][2] * rs * gg[2], v[j][3] * rs * gg[3]);
        }
    }
    const int gt = F.vcu * NTHR + F.tid, NGT = F.G * NTHR;
    for (int idx = gt; idx < NG * NP * NC; idx += NGT) {
        const int gp = idx / NC, c = idx % NC, g = gp / NP, p = gp % NP;
        const float lr = fminf(F.a_re[gp], -1e-4f), li = F.a_im[gp], dt = expf(F.log_dt[g]);
        const float mag = expf(lr * dt), ar = mag * cosf(li * dt), ai = mag * sinf(li * dt);
        const float den = lr * lr + li * li, fr = ((ar - 1.f) * lr + ai * li) / den, fi = (ai * lr - (ar - 1.f) * li) / den;
        const float br = F.b_re[gp * NC + c], bi = F.b_im[gp * NC + c]; const float bbr = fr * br - fi * bi, bbi = fr * bi + fi * br;
        F.BB[gp * 32 + c] = bbr; F.BB[gp * 32 + 16 + c] = bbi; F.BBH[gp * 32 + c] = (bf16_t)f2bf(bbr); F.BBH[gp * 32 + 16 + c] = (bf16_t)f2bf(bbi);
        F.CMT[(g * NC + c) * 128 + 2 * p] = (bf16_t)f2bf(F.c_re[(g * NC + c) * NP + p]); F.CMT[(g * NC + c) * 128 + 2 * p + 1] = (bf16_t)f2bf(-F.c_im[(g * NC + c) * NP + p]);
        if (c == 0) { float pr = ar, pi = ai;
            for (int i = 0; i < 6; ++i) { const float nr = pr * pr - pi * pi, ni = 2.f * pr * pi; pr = nr; pi = ni; }
            F.AA[gp * 4 + 0] = ar; F.AA[gp * 4 + 1] = ai; F.AA[gp * 4 + 2] = pr; F.AA[gp * 4 + 3] = pi; }
    }
    if (gt == 0) { float s1 = 0.f, s2 = 0.f; for (int i = 0; i < 64; ++i) { s1 += F.lq1[i] * F.lk1[i]; s2 += F.lq2[i] * F.lk2[i]; } F.LAM[0] = expf(s1) - expf(s2) + 0.2f; }
    for (int i = gt; i < MOE_ROWS; i += NGT) { F.ROWTOK[i] = 0; F.ROWTK[i] = -1; }
}
__device__ __forceinline__ void s_gemm_z(Frame& F) {
    SG_LOOP(M / 64, INW / 64)
        f32x4 acc[2][2];
        gemm_core<false>(acc, act, F.XN, D, nullptr, m0, F.w_in, INW, n0, D, As, Bs);
        EPI_LOOP({ F.Z[(size_t)row * INW + col] = (bf16_t)f2bf(acc[mi][ni][r]); })
    SG_END
}
template <bool FINAL>
__device__ __forceinline__ void s_s5_scan(Frame& F) {
    const int gw = F.vcu * NWAVES + F.wave, NGW = F.G * NWAVES, p = F.lane;
    for (int it = gw; it < BATCH * NCHUNK * NG; it += NGW) {
        const int bc = it / NG, g = it % NG, gp = g * NP + p;
        const int row0 = bc * 64;
        float bbr[16], bbi[16];
#pragma unroll
        for (int c = 0; c < 16; ++c) { bbr[c] = F.BB[gp * 32 + c]; bbi[c] = F.BB[gp * 32 + 16 + c]; }
        const float ar = F.AA[gp * 4], ai = F.AA[gp * 4 + 1];
        float sr = 0.f, si = 0.f;
        const size_t eidx = ((size_t)bc * NG + g) * NP + p;
        float cr[16], ci[16]; float dd = 0.f;
        if (FINAL) { sr = F.SIN[eidx * 2]; si = F.SIN[eidx * 2 + 1];
#pragma unroll
            for (int c = 0; c < 16; ++c) { cr[c] = F.c_re[(g * NC + c) * NP + p]; ci[c] = F.c_im[(g * NC + c) * NP + p]; }
            dd = F.ssm_d[g * NC + (p & 15)]; }
        for (int t = 0; t < 64; ++t) {
            const bf16_t* zr = F.Z + (size_t)(row0 + t) * INW + g * NC;
            const uint4 u0 = *(const uint4*)zr, u1 = *(const uint4*)(zr + 8);
            const unsigned uw[8] = {u0.x, u0.y, u0.z, u0.w, u1.x, u1.y, u1.z, u1.w};
            float bur = 0.f, bui = 0.f;
#pragma unroll
            for (int c = 0; c < 8; ++c) { const float ua = bf2f(uw[c] & 0xffffu), ub = bf2f(uw[c] >> 16); bur += bbr[2 * c] * ua + bbr[2 * c + 1] * ub; bui += bbi[2 * c] * ua + bbi[2 * c + 1] * ub; }
            const float nr = ar * sr - ai * si + bur, ni = ar * si + ai * sr + bui; sr = nr; si = ni;
            if (FINAL) {
                float ymine = 0.f;
#pragma unroll
                for (int c = 0; c < 16; ++c) { const float yc = wave_sum(cr[c] * sr - ci[c] * si); if ((p & 15) == c) ymine = yc; }
                if (p < 16) { const float uu = bf2f(F.Z[(size_t)(row0 + t) * INW + g * NC + p]); F.YS[(size_t)(row0 + t) * SW + g * NC + p] = (bf16_t)f2bf(gelu_tanh(ymine + dd * uu)); }
            }
        }
        if (!FINAL) { F.E[eidx * 2] = sr; F.E[eidx * 2 + 1] = si; }
    }
}
__device__ __forceinline__ void s_s5_carry(Frame& F) {
    const int gt = F.vcu * NTHR + F.tid;
    if (gt < BATCH * NG * NP) {
        const int b = gt / (NG * NP), gp = gt % (NG * NP), g = gp / NP;
        const float ar = F.AA[gp * 4], ai = F.AA[gp * 4 + 1], a64r = F.AA[gp * 4 + 2], a64i = F.AA[gp * 4 + 3];
        float sr = 0.f, si = 0.f;
        for (int t = 0; t < NMETA; ++t) {
            float bur = 0.f, bui = 0.f;
            for (int c = 0; c < NC; ++c) { const float u = bf2f(F.ZM[t * INW + g * NC + c]); bur += F.BB[gp * 32 + c] * u; bui += F.BB[gp * 32 + 16 + c] * u; }
            const float nr = ar * sr - ai * si + bur, ni = ar * si + ai * sr + bui; sr = nr; si = ni;
        }
        for (int c = 0; c < NCHUNK; ++c) {
            const size_t e = ((size_t)(b * NCHUNK + c) * NG * NP + gp) * 2;
            F.SIN[e] = sr; F.SIN[e + 1] = si;
            const float er = F.E[e], ei = F.E[e + 1];
            const float nr = a64r * sr - a64i * si + er, ni = a64r * si + a64i * sr + ei; sr = nr; si = ni;
        }
    }
}
__device__ __forceinline__ void s_qkn(Frame& F) {
    const int gw = F.vcu * NWAVES + F.wave, NGW = F.G * NWAVES, lane = F.lane;
    for (int row = gw; row < M + NMETA; row += NGW) {
        const bf16_t* zr = (row < M ? F.Z + (size_t)row * INW : F.ZM + (size_t)(row - M) * INW) + 512 + 16 * lane;
        const uint4 u0 = *(const uint4*)zr, u1 = *(const uint4*)(zr + 8);
        const unsigned uw[8] = {u0.x, u0.y, u0.z, u0.w, u1.x, u1.y, u1.z, u1.w};
        float v[16]; float ss = 0.f;
#pragma unroll
        for (int c = 0; c < 8; ++c) { v[2 * c] = bf2f(uw[c] & 0xffffu); v[2 * c + 1] = bf2f(uw[c] >> 16); ss += v[2 * c] * v[2 * c] + v[2 * c + 1] * v[2 * c + 1]; }
        ss += __shfl_xor(ss, 1); ss += __shfl_xor(ss, 2);
        const float rs = rsqrtf(ss * (1.f / 64.f) + EPS);
        const float* gg = (lane < 32 ? F.q_g : F.k_g) + 16 * (lane & 3);
        unsigned o[8];
#pragma unroll
        for (int c = 0; c < 8; ++c) o[c] = pk2(v[2 * c] * rs * gg[2 * c], v[2 * c + 1] * rs * gg[2 * c + 1]);
        bf16_t* qr = (row < M ? F.QKN + (size_t)row * D : F.QKNM + (size_t)(row - M) * D) + 16 * lane;
        *(uint4*)qr = make_uint4(o[0], o[1], o[2], o[3]); *(uint4*)(qr + 8) = make_uint4(o[4], o[5], o[6], o[7]);
    }
}
__device__ __forceinline__ void s_attn(Frame& F) {
    const int half = F.tid >> 8, tid = F.tid & 255, qrow = tid >> 2, part = tid & 3;
    float* Ks = (float*)(F.lds + half * 67584); float* Vs = Ks + 64 * 132;
    constexpr int NQB = SEQ / 64;
    for (int it = F.vcu; it < NQB * 2 * BATCH; it += F.G) {
        const int qb = NQB - 1 - it / (2 * BATCH), h = (it & 1) * 2 + half, b = (it >> 1) & 1;
        const int lq = qb * 64 + qrow + NMETA;
        const size_t tq = (size_t)b * SEQ + qb * 64 + qrow;
        float q0[16], q1[16];
        {
            const bf16_t* qp = F.QKN + tq * D + h * 128 + 16 * part;
#pragma unroll
            for (int d = 0; d < 16; ++d) { q0[d] = bf2f(qp[d]) * 0.125f; q1[d] = bf2f(qp[64 + d]) * 0.125f; }
        }
        float m0 = -1e30f, m1 = -1e30f, l0 = 0.f, l1 = 0.f, o0[32], o1[32];
#pragma unroll
        for (int d = 0; d < 32; ++d) { o0[d] = 0.f; o1[d] = 0.f; }
        for (int kt = 0; kt <= qb + 1; ++kt) {
            __syncthreads();
            for (int i = tid; i < 64 * 128; i += 256) {
                const int j = i >> 7, c = i & 127, lk = kt * 64 + j;
                float kv = 0.f, vv = 0.f;
                if (lk < NMETA) { kv = bf2f(F.QKNM[lk * D + 512 + h * 128 + c]); vv = bf2f(F.ZM[lk * INW + 1536 + h * 128 + c]); }
                else if (lk < NMETA + SEQ) { const size_t tk = (size_t)b * SEQ + lk - NMETA; kv = bf2f(F.QKN[tk * D + 512 + h * 128 + c]); vv = bf2f(F.Z[tk * INW + 1536 + h * 128 + c]); }
                Ks[j * 132 + c] = kv; Vs[j * 132 + c] = vv;
            }
            __syncthreads();
            for (int j = 0; j < 64; ++j) {
                const int lk = kt * 64 + j;
                float s0 = 0.f, s1 = 0.f;
#pragma unroll
                for (int d = 0; d < 16; ++d) { s0 += q0[d] * Ks[j * 132 + 16 * part + d]; s1 += q1[d] * Ks[j * 132 + 64 + 16 * part + d]; }
                s0 += __shfl_xor(s0, 1); s0 += __shfl_xor(s0, 2); s1 += __shfl_xor(s1, 1); s1 += __shfl_xor(s1, 2);
                if (lk <= lq) {
                    if (s0 > m0) { const float sc = __expf(m0 - s0); l0 *= sc;
#pragma unroll
                        for (int d = 0; d < 32; ++d) o0[d] *= sc; m0 = s0; }
                    if (s1 > m1) { const float sc = __expf(m1 - s1); l1 *= sc;
#pragma unroll
                        for (int d = 0; d < 32; ++d) o1[d] *= sc; m1 = s1; }
                    const float p0 = __expf(s0 - m0), p1 = __expf(s1 - m1); l0 += p0; l1 += p1;
#pragma unroll
                    for (int d = 0; d < 32; ++d) { const float v = Vs[j * 132 + 32 * part + d]; o0[d] += p0 * v; o1[d] += p1 * v; }
                }
            }
        }
        const float lam = F.LAM[0], i0 = 1.f / l0, i1 = lam / l1;
        float ss = 0.f;
#pragma unroll
        for (int d = 0; d < 32; ++d) { o0[d] = o0[d] * i0 - o1[d] * i1; ss += o0[d] * o0[d]; }
        ss += __shfl_xor(ss, 1); ss += __shfl_xor(ss, 2);
        const float rs = rsqrtf(ss * (1.f / 128.f) + EPS) * 0.8f;
        bf16_t* op = F.YA + tq * AW + h * 128 + 32 * part;
#pragma unroll
        for (int d = 0; d < 32; ++d) op[d] = (bf16_t)f2bf(o0[d] * rs * F.sub_g[32 * part + d]);
    }
    __syncthreads();
}
__device__ __forceinline__ void s_gemm_glu(Frame& F) {
    SG_LOOP(M / 64, SW / 64)
        f32x4 acc[2][2];
        gemm_core<false>(acc, act, F.YS, SW, nullptr, m0, F.w_glu, SW, n0, SW, As, Bs);
        EPI_LOOP({ const float ys = bf2f(F.YS[(size_t)row * SW + col]); F.YS2[(size_t)row * SW + col] = (bf16_t)f2bf(ys * sigmoidf_(acc[mi][ni][r] + F.b_glu[col])); })
    SG_END
}
__device__ __forceinline__ void s_gemm_mix(Frame& F) {
    SG_LOOP(M / 64, D / 64)
        f32x4 acc[2][2], acc2[2][2];
        gemm_core<false>(acc, act, F.YS2, SW, nullptr, m0, F.w_so, D, n0, SW, As, Bs);
        gemm_core<false>(acc2, act, F.YA, AW, nullptr, m0, F.w_ao, D, n0, AW, As, Bs);
        EPI_LOOP({ const float g0 = sigmoidf_(bf2f(F.Z[(size_t)row * INW + 2048 + col])), g1 = sigmoidf_(bf2f(F.Z[(size_t)row * INW + 3072 + col]));
                   F.MIX[(size_t)row * D + col] = (bf16_t)f2bf(g0 * acc[mi][ni][r] + g1 * acc2[mi][ni][r]); })
    SG_END
}
__device__ __forceinline__ void s_gemm_wo(Frame& F) {
    SG_LOOP(M / 64, D / 64)
        f32x4 acc[2][2];
        gemm_core<false>(acc, act, F.MIX, D, nullptr, m0, F.w_o, D, n0, D, As, Bs);
        EPI_LOOP({ const size_t o = (size_t)row * D + col; F.out[o] = F.x[o] + acc[mi][ni][r]; })
    SG_END
}
__device__ __forceinline__ void s_router(Frame& F) {
    const int gw = F.vcu * NWAVES + F.wave, NGW = F.G * NWAVES, lane = F.lane;
    for (int t = gw; t < M; t += NGW) {
        const float* hr = F.out + (size_t)t * D;
        float ss = 0.f;
#pragma unroll
        for (int j = 0; j < 4; ++j) { const f32x4 a = *(const f32x4*)(hr + 256 * j + 4 * lane); ss += a[0] * a[0] + a[1] * a[1] + a[2] * a[2] + a[3] * a[3]; }
        ss = wave_sum(ss);
        const float rs = rsqrtf(ss * (1.f / D) + EPS);
        float lg[NE];
#pragma unroll
        for (int e = 0; e < NE; ++e) lg[e] = 0.f;
#pragma unroll 1
        for (int j = 0; j < 4; ++j) {
            const f32x4 a = *(const f32x4*)(hr + 256 * j + 4 * lane), gg = *(const f32x4*)(F.norm_ffn_g + 256 * j + 4 * lane);
            const f32x4 v = a * rs * gg;
            *(uint2*)(F.XN2 + (size_t)t * D + 256 * j + 4 * lane) = make_uint2(pk2(v[0], v[1]), pk2(v[2], v[3]));
            const float* wr = F.w_router + (size_t)(256 * j + 4 * lane) * NE;
#pragma unroll
            for (int q = 0; q < 4; ++q)
#pragma unroll
                for (int e = 0; e < NE; e += 4) { const f32x4 w4 = *(const f32x4*)(wr + q * NE + e); lg[e] += v[q] * w4[0]; lg[e + 1] += v[q] * w4[1]; lg[e + 2] += v[q] * w4[2]; lg[e + 3] += v[q] * w4[3]; }
        }
#pragma unroll
        for (int e = 0; e < NE; ++e) lg[e] = wave_sum(lg[e]) + F.b_router[e];
        if (lane == 0) {
            int id[4]; float tv[4];
#pragma unroll
            for (int k = 0; k < 4; ++k) {
                float best = -3.4e38f; int bi = 0;
#pragma unroll
                for (int e = 0; e < NE; ++e) { const bool taken = (k > 0 && id[0] == e) || (k > 1 && id[1] == e) || (k > 2 && id[2] == e); if (!taken && lg[e] > best) { best = lg[e]; bi = e; } }
                id[k] = bi; tv[k] = best;
            }
            const float e0 = 1.f, e1 = __expf(tv[1] - tv[0]), e2 = __expf(tv[2] - tv[0]), e3 = __expf(tv[3] - tv[0]), inv = 1.f / (e0 + e1 + e2 + e3);
            const float gw4[4] = {e0 * inv, e1 * inv, e2 * inv, e3 * inv};
#pragma unroll
            for (int k = 0; k < 4; ++k) { F.IDX[t * 4 + k] = id[k]; F.GATE[t * 4 + k] = gw4[k]; F.POS[t * 4 + k] = atomicAdd(&F.CNT[id[k]], 1); }
        }
    }
}
__device__ __forceinline__ void s_scatter(Frame& F) {
    int* offs = (int*)F.lds;
    if (F.tid == 0) { int o = 0; for (int e = 0; e < NE; ++e) { offs[e] = o; o += (F.CNT[e] + 255) / 256 * 256; } offs[NE] = o; }
    __syncthreads();
    if (F.vcu == 0 && F.tid <= NE) F.OFF[F.tid] = offs[F.tid];
    if (F.vcu == 0) for (int mt = F.tid; mt < MOE_ROWS / 256; mt += NTHR) { int e = 0; while (e < NE - 1 && offs[e + 1] <= mt * 256) ++e; F.TEXP[mt] = e; }
    const int gt = F.vcu * NTHR + F.tid, NGT = F.G * NTHR;
    for (int a = gt; a < NASSIGN; a += NGT) { const int r = offs[F.IDX[a]] + F.POS[a]; F.ROWTOK[r] = a >> 2; F.ROWTK[r] = a; }
    __syncthreads();
}
__device__ __forceinline__ void t_scatter(Frame& F) {
    int* psum = (int*)F.lds;
    int* offs = psum + 512;
    int* base = offs + 64;
    { const int e = F.tid & 31, part = F.tid >> 5; int sacc = 0;
      for (int i = 0; i < 32; ++i) sacc += F.TCNT[(part * 32 + i) * NE + e];
      psum[part * 32 + e] = sacc; }
    __syncthreads();
    if (F.tid == 0) { int o = 0; for (int e = 0; e < NE; ++e) { int tot = 0; for (int p = 0; p < 16; ++p) tot += psum[p * 32 + e]; offs[e] = o; o += (tot + 255) / 256 * 256; } offs[NE] = o; }
    __syncthreads();
    if (F.vcu == 0 && F.tid <= NE) F.OFF[F.tid] = offs[F.tid];
    if (F.vcu == 0) for (int mt = F.tid; mt < MOE_ROWS / 256; mt += NTHR) { int e = 0; while (e < NE - 1 && offs[e + 1] <= mt * 256) ++e; F.TEXP[mt] = e; }
    for (int tile = F.vcu; tile < M / 32; tile += F.G) {
        if (F.tid < 32) { const int part = tile >> 5; int b = offs[F.tid];
            for (int p = 0; p < part; ++p) b += psum[p * 32 + F.tid];
            for (int t2 = part * 32; t2 < tile; ++t2) b += F.TCNT[t2 * NE + F.tid];
            base[F.tid] = b; }
        __syncthreads();
        if (F.tid < 128) { const int a = tile * 128 + F.tid, r = base[F.IDX[a]] + F.POS[a]; F.ROWTOK[r] = a >> 2; F.ROWTK[r] = a; }
        __syncthreads();
    }
}
__device__ __forceinline__ int tile_expert(const int* OFF, int m0) { int e = 0; while (e < NE - 1 && OFF[e + 1] <= m0) ++e; return e; }
__device__ __forceinline__ void s_moe1(Frame& F) {
    const int nrows = F.OFF[NE];
    SG_LOOP(nrows / 64, D / 64)
        const int e = tile_expert(F.OFF, m0);
        f32x4 acc[2][2], acc2[2][2];
        gemm_core<true>(acc, act, F.XN2, D, F.ROWTOK, m0, F.w_gate + (size_t)e * D * D, D, n0, D, As, Bs);
        gemm_core<true>(acc2, act, F.XN2, D, F.ROWTOK, m0, F.w_up + (size_t)e * D * D, D, n0, D, As, Bs);
        EPI_LOOP({ const float gg = fminf(acc[mi][ni][r] + F.b_gate[e * D + col], 7.f), uu = fminf(fmaxf(acc2[mi][ni][r] + F.b_up[e * D + col], -7.f), 7.f);
                   F.ACT[(size_t)row * D + col] = (bf16_t)f2bf((uu + 1.f) * (gg * sigmoidf_(1.702f * gg))); })
    SG_END
}
__device__ __forceinline__ void s_moe2(Frame& F) {
    const int nrows = F.OFF[NE];
    SG_LOOP(nrows / 64, D / 64)
        const int e = tile_expert(F.OFF, m0);
        f32x4 acc[2][2];
        gemm_core<false>(acc, act, F.ACT, D, nullptr, m0, F.w_down + (size_t)e * D * D, D, n0, D, As, Bs);
        EPI_LOOP({ const int tk = F.ROWTK[row]; if (tk >= 0) F.Y2[(size_t)tk * D + col] = (bf16_t)f2bf(acc[mi][ni][r] + F.b_down[e * D + col]); })
    SG_END
}
__device__ __forceinline__ void s_combine(Frame& F) {
    const int gw = F.vcu * NWAVES + F.wave, NGW = F.G * NWAVES, c = F.lane * 16;
    for (int t0 = gw * 2; t0 < M; t0 += NGW * 2) {
        f32x4 o[2][4]; uint4 y[2][4][2]; float gwt[2][4];
#pragma unroll
        for (int u = 0; u < 2; ++u) { const int t = t0 + u;
            if (T_H1B) { const uint4 h0 = *(const uint4*)(F.H1B + (size_t)t * D + c), h1 = *(const uint4*)(F.H1B + (size_t)t * D + c + 8);
                o[u][0] = (f32x4){bf2f(h0.x & 0xffffu), bf2f(h0.x >> 16), bf2f(h0.y & 0xffffu), bf2f(h0.y >> 16)}; o[u][1] = (f32x4){bf2f(h0.z & 0xffffu), bf2f(h0.z >> 16), bf2f(h0.w & 0xffffu), bf2f(h0.w >> 16)};
                o[u][2] = (f32x4){bf2f(h1.x & 0xffffu), bf2f(h1.x >> 16), bf2f(h1.y & 0xffffu), bf2f(h1.y >> 16)}; o[u][3] = (f32x4){bf2f(h1.z & 0xffffu), bf2f(h1.z >> 16), bf2f(h1.w & 0xffffu), bf2f(h1.w >> 16)}; }
            else
#pragma unroll
            for (int q = 0; q < 4; ++q) o[u][q] = *(const f32x4*)(F.out + (size_t)t * D + c + 4 * q);
#pragma unroll
            for (int k = 0; k < 4; ++k) { gwt[u][k] = F.GATE[t * 4 + k];
                if (T_FP8) { const v4u yv = __builtin_nontemporal_load((const v4u*)((const unsigned char*)F.Y2 + (size_t)(t * 4 + k) * D + c)); y[u][k][0] = make_uint4(yv[0], yv[1], yv[2], yv[3]); y[u][k][1] = y[u][k][0]; }
                else { y[u][k][0] = *(const uint4*)(F.Y2 + (size_t)(t * 4 + k) * D + c); y[u][k][1] = *(const uint4*)(F.Y2 + (size_t)(t * 4 + k) * D + c + 8); } } }
#pragma unroll
        for (int u = 0; u < 2; ++u) { const int t = t0 + u;
#pragma unroll
            for (int k = 0; k < 4; ++k) { const float gk = gwt[u][k];
                if (T_FP8) { const uint4 v = y[u][k][0]; const unsigned wv[4] = {v.x, v.y, v.z, v.w};
#pragma unroll
                    for (int q = 0; q < 4; ++q) { typedef float f32x2_ __attribute__((ext_vector_type(2)));
                        const f32x2_ lo = __builtin_amdgcn_cvt_pk_f32_fp8((int)wv[q], false), hi = __builtin_amdgcn_cvt_pk_f32_fp8((int)wv[q], true);
                        o[u][q][0] += gk * lo[0]; o[u][q][1] += gk * lo[1]; o[u][q][2] += gk * hi[0]; o[u][q][3] += gk * hi[1]; } }
                else {
#pragma unroll
                for (int hh = 0; hh < 2; ++hh) { const uint4 v = y[u][k][hh]; const unsigned wv[4] = {v.x, v.y, v.z, v.w};
#pragma unroll
                    for (int q = 0; q < 4; ++q) { o[u][2 * hh + (q >> 1)][2 * (q & 1)] += gk * bf2f(wv[q] & 0xffffu); o[u][2 * hh + (q >> 1)][2 * (q & 1) + 1] += gk * bf2f(wv[q] >> 16); } } } }
#pragma unroll
            for (int q = 0; q < 4; ++q) __builtin_nontemporal_store(o[u][q], (f32x4*)(F.out + (size_t)t * D + c + 4 * q)); }
    }
}

typedef float f32x16 __attribute__((ext_vector_type(16)));
__device__ __forceinline__ void cmul(float ar, float ai, float br, float bi, float& cr, float& ci) { cr = ar * br - ai * bi; ci = ar * bi + ai * br; }
template <bool FINAL>
__device__ __forceinline__ void t_s5_pass(Frame& F) {
    const int gw = F.vcu * NWAVES + F.wave, NGW = F.G * NWAVES, lane = F.lane, r32 = lane & 31, hi = lane >> 5;
    LAS unsigned char* sl = F.lds3 + F.wave * 17408;
    const int wpg = NGW / NG, g = gw / wpg, w0 = gw % wpg;
    if (g >= NG) return;
    bf16x8 bfr[4];
#pragma unroll
    for (int nt = 0; nt < 4; ++nt) bfr[nt] = *(const bf16x8*)(F.BBH + (size_t)(g * NP + 32 * (nt & 1) + r32) * 32 + 16 * (nt >> 1) + 8 * hi);
    float aar[2], aai[2];
#pragma unroll
    for (int set = 0; set < 2; ++set) { aar[set] = F.AA[(g * NP + 32 * set + r32) * 4]; aai[set] = F.AA[(g * NP + 32 * set + r32) * 4 + 1]; }
    bf16x8 afn[2];
    if (w0 < BATCH * NCHUNK) { afn[0] = *(const bf16x8*)(F.Z + ((size_t)w0 * 64 + r32) * INW + g * NC + 8 * hi); afn[1] = *(const bf16x8*)(F.Z + ((size_t)w0 * 64 + 32 + r32) * INW + g * NC + 8 * hi); }
    for (int bc = w0; bc < BATCH * NCHUNK; bc += wpg) {
        const size_t tok0 = (size_t)bc * 64;
        const bf16x8 afr0 = afn[0], afr1 = afn[1];
        if (bc + wpg < BATCH * NCHUNK) { const size_t tn = (size_t)(bc + wpg) * 64; afn[0] = *(const bf16x8*)(F.Z + (tn + r32) * INW + g * NC + 8 * hi); afn[1] = *(const bf16x8*)(F.Z + (tn + 32 + r32) * INW + g * NC + 8 * hi); }
        f32x16 bu[2][4];
#pragma unroll
        for (int nt = 0; nt < 4; ++nt) { f32x16 z = {}; bu[0][nt] = __builtin_amdgcn_mfma_f32_32x32x16_bf16(afr0, bfr[nt], z, 0, 0, 0); bu[1][nt] = __builtin_amdgcn_mfma_f32_32x32x16_bf16(afr1, bfr[nt], z, 0, 0, 0); }
        float ssr[2][2][16], ssi[2][2][16];
#pragma unroll
        for (int set = 0; set < 2; ++set) {
            const int p = 32 * set + r32, gp = g * NP + p;
            const float ar = aar[set], ai = aai[set];
            float a2r, a2i, a3r, a3i, a4r, a4i; cmul(ar, ai, ar, ai, a2r, a2i); cmul(a2r, a2i, ar, ai, a3r, a3i); cmul(a2r, a2i, a2r, a2i, a4r, a4i);
            float lr[8][4], li[8][4];
#pragma unroll
            for (int jj = 0; jj < 8; ++jj) {
                const int tt = jj >> 2, rb = jj & 3; float sr = 0.f, si = 0.f;
#pragma unroll
                for (int i = 0; i < 4; ++i) { const float br = bu[tt][set][4 * rb + i], bi = bu[tt][2 + set][4 * rb + i]; const float nr = ar * sr - ai * si + br, ni = ar * si + ai * sr + bi; sr = nr; si = ni; lr[jj][i] = sr; li[jj][i] = si; }
            }
            float cr = 0.f, ci = 0.f, sinr[8] = {0.f, 0.f, 0.f, 0.f, 0.f, 0.f, 0.f, 0.f}, sini[8] = {0.f, 0.f, 0.f, 0.f, 0.f, 0.f, 0.f, 0.f};
            if (FINAL) { const size_t e = ((size_t)bc * NG * NP + gp) * 2; cr = F.SIN[e]; ci = F.SIN[e + 1]; }
#pragma unroll
            for (int j = 0; j < 16; ++j) {
                const int jj = j >> 1; const bool mine = (hi == (j & 1));
                sinr[jj] = mine ? cr : sinr[jj]; sini[jj] = mine ? ci : sini[jj];
                const float mr = a4r * cr - a4i * ci + lr[jj][3], mi = a4r * ci + a4i * cr + li[jj][3];
                const auto sr2 = __builtin_amdgcn_permlane32_swap(__float_as_uint(mr), __float_as_uint(mr), false, false), si2 = __builtin_amdgcn_permlane32_swap(__float_as_uint(mi), __float_as_uint(mi), false, false);
                cr = __uint_as_float(sr2[j & 1]); ci = __uint_as_float(si2[j & 1]);
            }
            if (!FINAL) { if (hi == 0) { const size_t e = (((size_t)(bc / NCHUNK) * NG * NP + gp) * NCHUNK + (bc % NCHUNK)) * 2; F.E[e] = cr; F.E[e + 1] = ci; } }
            else {
#pragma unroll
                for (int jj = 0; jj < 8; ++jj) {
                    const int tt = jj >> 2, rb = jj & 3;
                    const float pw_r[4] = {ar, a2r, a3r, a4r}, pw_i[4] = {ai, a2i, a3i, a4i};
#pragma unroll
                    for (int i = 0; i < 4; ++i) { ssr[set][tt][4 * rb + i] = lr[jj][i] + pw_r[i] * sinr[jj] - pw_i[i] * sini[jj]; ssi[set][tt][4 * rb + i] = li[jj][i] + pw_r[i] * sini[jj] + pw_i[i] * sinr[jj]; }
                }
            }
        }
        if (FINAL) {
#pragma unroll
            for (int set = 0; set < 2; ++set)
#pragma unroll
                for (int tt = 0; tt < 2; ++tt)
#pragma unroll
                    for (int r = 0; r < 16; ++r) { const int t = 32 * tt + 8 * (r >> 2) + 4 * hi + (r & 3);
                        *(LAS unsigned*)(sl + t * 272 + (32 * set + r32) * 4) = pk2(ssr[set][tt][r], ssi[set][tt][r]); }
            LDS_WAIT();
            const int c16 = lane & 15, q = lane >> 4;
            f32x4 yacc[4];
#pragma unroll
            for (int t4 = 0; t4 < 4; ++t4) yacc[t4] = (f32x4){0.f, 0.f, 0.f, 0.f};
#pragma unroll
            for (int ks = 0; ks < 4; ++ks) {
                const bf16x8 cf = *(const bf16x8*)(F.CMT + (size_t)(g * NC + c16) * 128 + ks * 32 + 8 * q);
#pragma unroll
                for (int t4 = 0; t4 < 4; ++t4) { const bf16x8 sf = *(const LAS bf16x8*)(sl + (16 * t4 + c16) * 272 + (ks * 32 + 8 * q) * 2);
                    yacc[t4] = __builtin_amdgcn_mfma_f32_16x16x32_bf16(cf, sf, yacc[t4], 0, 0, 0); }
            }
            LDS_WAIT();
            const f32x4 dv = *(const f32x4*)(F.ssm_d + g * NC + 4 * q);
#pragma unroll
            for (int t4 = 0; t4 < 4; ++t4) {
                const size_t tok = tok0 + 16 * t4 + c16;
                const uint2 uu = *(const uint2*)(F.Z + tok * INW + g * NC + 4 * q);
                const float y0 = gelu_tanh(yacc[t4][0] + dv[0] * bf2f(uu.x & 0xffffu)), y1 = gelu_tanh(yacc[t4][1] + dv[1] * bf2f(uu.x >> 16)),
                            y2 = gelu_tanh(yacc[t4][2] + dv[2] * bf2f(uu.y & 0xffffu)), y3 = gelu_tanh(yacc[t4][3] + dv[3] * bf2f(uu.y >> 16));
                *(uint2*)(F.YS + tok * SW + g * NC + 4 * q) = make_uint2(pk2(y0, y1), pk2(y2, y3));
            }
        }
    }
}
__device__ __forceinline__ void t_s5_carry(Frame& F) {
    const int gw = F.vcu * NWAVES + F.wave, NGW = F.G * NWAVES, lane = F.lane;
    for (int ch = gw; ch < BATCH * NG * NP; ch += NGW) {
        const int b = ch / (NG * NP), gp = ch % (NG * NP), g = gp / NP;
        const float ar = F.AA[gp * 4], ai = F.AA[gp * 4 + 1], Ar = F.AA[gp * 4 + 2], Ai = F.AA[gp * 4 + 3];
        float mr = 0.f, mi = 0.f;
        for (int t = 0; t < NMETA; ++t) {
            float bur = 0.f, bui = 0.f;
            for (int c = 0; c < NC; ++c) { const float u = bf2f(F.ZM[t * INW + g * NC + c]); bur += F.BB[gp * 32 + c] * u; bui += F.BB[gp * 32 + 16 + c] * u; }
            const float nr = ar * mr - ai * mi + bur, ni = ar * mi + ai * mr + bui; mr = nr; mi = ni;
        }
        const float* e = F.E + (size_t)ch * NCHUNK * 2;
        float v0r = e[2 * lane], v0i = e[2 * lane + 1], v1r = e[2 * (64 + lane)], v1i = e[2 * (64 + lane) + 1];
        float pr = Ar, pi = Ai;
#pragma unroll
        for (int d = 1; d < 64; d <<= 1) {
            const float u0r = __shfl_up(v0r, d), u0i = __shfl_up(v0i, d), u1r = __shfl_up(v1r, d), u1i = __shfl_up(v1i, d);
            if (lane >= d) { v0r += pr * u0r - pi * u0i; v0i += pr * u0i + pi * u0r; v1r += pr * u1r - pi * u1i; v1i += pr * u1i + pi * u1r; }
            const float nr = pr * pr - pi * pi, ni = 2.f * pr * pi; pr = nr; pi = ni;
        }
        float qr = 1.f, qi = 0.f, br_ = Ar, bi_ = Ai;
#pragma unroll
        for (int bit = 0; bit < 7; ++bit) { if (((lane + 1) >> bit) & 1) { const float nr = qr * br_ - qi * bi_, ni = qr * bi_ + qi * br_; qr = nr; qi = ni; } const float nr = br_ * br_ - bi_ * bi_, ni = 2.f * br_ * bi_; br_ = nr; bi_ = ni; }
        const float x0r = v0r + qr * mr - qi * mi, x0i = v0i + qr * mi + qi * mr;
        const float t0r = __shfl(x0r, 63), t0i = __shfl(x0i, 63);
        const float x1r = v1r + qr * t0r - qi * t0i, x1i = v1i + qr * t0i + qi * t0r;
        float* so = F.SIN + ((size_t)b * NCHUNK * NG * NP + gp) * 2;
        const size_t cs = (size_t)NG * NP * 2;
        if (lane == 0) { so[0] = mr; so[1] = mi; }
        so[(size_t)(lane + 1) * cs] = x0r; so[(size_t)(lane + 1) * cs + 1] = x0i;
        if (lane < 63) { so[(size_t)(lane + 65) * cs] = x1r; so[(size_t)(lane + 65) * cs + 1] = x1i; }
    }
}

__device__ __forceinline__ void rt_split(const f32x4& x0, const f32x4& x1, bf16x8& hi, bf16x8& lo) {
    unsigned hw[4], lw[4];
#pragma unroll
    for (int p = 0; p < 4; ++p) { const float a = p < 2 ? x0[2 * p] : x1[2 * p - 4], b = p < 2 ? x0[2 * p + 1] : x1[2 * p - 3];
        const unsigned ha = f2bf(a), hb = f2bf(b); hw[p] = ha | (hb << 16); lw[p] = pk2(a - bf2f(ha), b - bf2f(hb)); }
    hi = __builtin_bit_cast(bf16x8, (v4u){hw[0], hw[1], hw[2], hw[3]}); lo = __builtin_bit_cast(bf16x8, (v4u){lw[0], lw[1], lw[2], lw[3]});
}
#ifndef T_ROUTER2
#define T_ROUTER2 1
#endif
#ifndef T_ALT
#define T_ALT 1
#endif
#if T_ROUTER2
__device__ __forceinline__ void t_router(Frame& F) {
    const int lane = F.lane, w = F.wave, i32 = lane & 31, h = lane >> 5, kb = 128 * w + 64 * h;
    constexpr int TP = 1028;
    float* tileb = (float*)F.lds;
    float* part = tileb;
    float* lgs = tileb + 32 * TP;
    float* rsv = lgs + 2 * 32 * 33;
    int* cntl = (int*)(rsv + 64);
    bf16x8 bhi[8], blo[8];
#pragma unroll
    for (int s8 = 0; s8 < 8; ++s8) { f32x4 b0, b1;
#pragma unroll
        for (int q = 0; q < 4; ++q) { b0[q] = F.norm_ffn_g[kb + 8 * s8 + q] * F.w_router[(size_t)(kb + 8 * s8 + q) * NE + i32]; b1[q] = F.norm_ffn_g[kb + 8 * s8 + 4 + q] * F.w_router[(size_t)(kb + 8 * s8 + 4 + q) * NE + i32]; }
        rt_split(b0, b1, bhi[s8], blo[s8]); }
    f32x4 gg[4];
#pragma unroll
    for (int j = 0; j < 4; ++j) gg[j] = *(const f32x4*)(F.norm_ffn_g + 256 * j + 4 * lane);
    f32x4 R[16];
    auto ld = [&](int tile) {
#pragma unroll
        for (int r = 0; r < 4; ++r)
#pragma unroll
            for (int j = 0; j < 4; ++j) R[4 * r + j] = *(const f32x4*)(F.out + (size_t)(tile * 32 + 4 * w + r) * D + 256 * j + 4 * lane); };
    if (F.vcu < M / 32) ld(F.vcu);
    for (int t0 = F.vcu; t0 < M / 32; t0 += 2 * F.G) {
        const int t1 = t0 + F.G; const bool has1 = t1 < M / 32;
        if (F.tid < 64) cntl[F.tid] = 0;
        for (int tl = 0; tl < 2; ++tl) {
            if (tl == 1 && !has1) break;
            const int tile = tl ? t1 : t0;
#pragma unroll
            for (int r = 0; r < 4; ++r) { float ss = 0.f;
#pragma unroll
                for (int j = 0; j < 4; ++j) { const f32x4 v = R[4 * r + j]; ss += v[0] * v[0] + v[1] * v[1] + v[2] * v[2] + v[3] * v[3]; *(f32x4*)(tileb + (4 * w + r) * TP + 256 * j + 4 * lane) = v; }
                ss = wave_sum(ss);
                const float rs = rsqrtf(ss * (1.f / D) + EPS);
                if (lane == 0) rsv[tl * 32 + 4 * w + r] = rs;
                if (!(F.mode & 2)) { const size_t tok = (size_t)tile * 32 + 4 * w + r;
#pragma unroll
                    for (int j = 0; j < 4; ++j) { const f32x4 xv = R[4 * r + j] * rs * gg[j];
                        if (T_FP8) *(unsigned*)((unsigned char*)F.XN2 + tok * D + 256 * j + 4 * lane) = pg8::pk4_fp8(xv[0], xv[1], xv[2], xv[3]);
                        else *(uint2*)(F.XN2 + tok * D + 256 * j + 4 * lane) = make_uint2(pk2(xv[0], xv[1]), pk2(xv[2], xv[3])); } }
            }
            { const int nt = tl == 0 ? (has1 ? t1 : -1) : (t0 + 2 * F.G < M / 32 ? t0 + 2 * F.G : -1); if (nt >= 0) ld(nt); }
            __syncthreads();
            f32x16 acc = {};
#pragma unroll
            for (int s8 = 0; s8 < 8; ++s8) { const float* ap = tileb + i32 * TP + kb + 8 * s8; bf16x8 ahi, alo; rt_split(*(const f32x4*)ap, *(const f32x4*)(ap + 4), ahi, alo);
                acc = __builtin_amdgcn_mfma_f32_32x32x16_bf16(ahi, bhi[s8], acc, 0, 0, 0); acc = __builtin_amdgcn_mfma_f32_32x32x16_bf16(ahi, blo[s8], acc, 0, 0, 0); acc = __builtin_amdgcn_mfma_f32_32x32x16_bf16(alo, bhi[s8], acc, 0, 0, 0); }
            __syncthreads();
#pragma unroll
            for (int r = 0; r < 16; ++r) part[(w * 32 + (r & 3) + 8 * (r >> 2) + 4 * h) * 33 + i32] = acc[r];
            __syncthreads();
#pragma unroll
            for (int rep = 0; rep < 2; ++rep) { const int idx = F.tid + 512 * rep, ti = idx >> 5, tj = idx & 31; float v = 0.f;
#pragma unroll
                for (int ww = 0; ww < 8; ++ww) v += part[(ww * 32 + ti) * 33 + tj];
                lgs[(tl * 32 + ti) * 33 + tj] = v; }
            __syncthreads();
        }
        if (w == 0 && (h == 0 || has1) && !(F.mode & 1)) {
            const int tile = h ? t1 : t0, t = tile * 32 + i32; const float rs = rsv[lane];
            float lg[NE];
#pragma unroll
            for (int e = 0; e < NE; ++e) lg[e] = lgs[lane * 33 + e] * rs + F.b_router[e];
            int id[4]; float tv[4];
#pragma unroll
            for (int k = 0; k < 4; ++k) {
                float best = -3.4e38f; int bi = 0;
#pragma unroll
                for (int e = 0; e < NE; ++e) { const bool taken = (k > 0 && id[0] == e) || (k > 1 && id[1] == e) || (k > 2 && id[2] == e); if (!taken && lg[e] > best) { best = lg[e]; bi = e; } }
                id[k] = bi; tv[k] = best;
            }
            const float e0 = 1.f, e1 = __expf(tv[1] - tv[0]), e2 = __expf(tv[2] - tv[0]), e3 = __expf(tv[3] - tv[0]), inv = 1.f / (e0 + e1 + e2 + e3);
            const float gw4[4] = {e0 * inv, e1 * inv, e2 * inv, e3 * inv};
#pragma unroll
            for (int k = 0; k < 4; ++k) { F.IDX[t * 4 + k] = id[k]; F.GATE[t * 4 + k] = gw4[k]; F.POS[t * 4 + k] = atomicAdd(&cntl[32 * h + id[k]], 1); }
            F.TCNT[tile * NE + i32] = cntl[lane];
        }
        __syncthreads();
    }
}
#else
__device__ __forceinline__ void t_router(Frame& F) {
    const int lane = F.lane, w = F.wave, i32 = lane & 31, h = lane >> 5, kb = 128 * w + 64 * h;
    float* part = (float*)F.lds;
    float* ssp = part + 8 * 32 * 33;
    float* lgs = ssp + 8 * 64;
    float* rsv = lgs + 32 * 33;
    int* cntl = (int*)(rsv + 32);
    bf16x8 bhi[8], blo[8];
#pragma unroll
    for (int s8 = 0; s8 < 8; ++s8) { f32x4 b0, b1;
#pragma unroll
        for (int q = 0; q < 4; ++q) { b0[q] = F.norm_ffn_g[kb + 8 * s8 + q] * F.w_router[(size_t)(kb + 8 * s8 + q) * NE + i32]; b1[q] = F.norm_ffn_g[kb + 8 * s8 + 4 + q] * F.w_router[(size_t)(kb + 8 * s8 + 4 + q) * NE + i32]; }
        rt_split(b0, b1, bhi[s8], blo[s8]); }
    f32x4 a[16];
    for (int tile = F.vcu; tile < M / 32; tile += F.G) {
        const int tok0 = tile * 32;
        if (T_H1B) { const bf16_t* hb = F.H1B + (size_t)(tok0 + i32) * D + kb;
#pragma unroll
          for (int q = 0; q < 8; ++q) { const uint4 v = *(const uint4*)(hb + 8 * q);
              a[2 * q] = (f32x4){bf2f(v.x & 0xffffu), bf2f(v.x >> 16), bf2f(v.y & 0xffffu), bf2f(v.y >> 16)}; a[2 * q + 1] = (f32x4){bf2f(v.z & 0xffffu), bf2f(v.z >> 16), bf2f(v.w & 0xffffu), bf2f(v.w >> 16)}; } }
        else { const float* hr = F.out + (size_t)(tok0 + i32) * D + kb;
#pragma unroll
          for (int q = 0; q < 16; ++q) a[q] = *(const f32x4*)(hr + 4 * q); }
        float ss = 0.f;
#pragma unroll
        for (int q = 0; q < 16; ++q) ss += a[q][0] * a[q][0] + a[q][1] * a[q][1] + a[q][2] * a[q][2] + a[q][3] * a[q][3];
        f32x16 acc = {};
#pragma unroll
        for (int s8 = 0; s8 < 8; ++s8) { bf16x8 ahi, alo; rt_split(a[2 * s8], a[2 * s8 + 1], ahi, alo);
            acc = __builtin_amdgcn_mfma_f32_32x32x16_bf16(ahi, bhi[s8], acc, 0, 0, 0); acc = __builtin_amdgcn_mfma_f32_32x32x16_bf16(ahi, blo[s8], acc, 0, 0, 0); acc = __builtin_amdgcn_mfma_f32_32x32x16_bf16(alo, bhi[s8], acc, 0, 0, 0); }
#pragma unroll
        for (int r = 0; r < 16; ++r) part[(w * 32 + (r & 3) + 8 * (r >> 2) + 4 * h) * 33 + i32] = acc[r];
        ssp[w * 64 + lane] = ss;
        if (F.tid < 32) cntl[F.tid] = 0;
        __syncthreads();
#pragma unroll
        for (int rep = 0; rep < 2; ++rep) { const int idx = F.tid + 512 * rep, ti = idx >> 5, tj = idx & 31; float v = 0.f;
#pragma unroll
            for (int ww = 0; ww < 8; ++ww) v += part[(ww * 32 + ti) * 33 + tj];
            lgs[ti * 33 + tj] = v; }
        if (F.tid < 32) { float v = 0.f;
#pragma unroll
            for (int ww = 0; ww < 8; ++ww) v += ssp[ww * 64 + F.tid] + ssp[ww * 64 + 32 + F.tid];
            rsv[F.tid] = rsqrtf(v * (1.f / D) + EPS); }
        __syncthreads();
        const float rs = rsv[i32];
        if (w == 0 && lane < 32 && !(F.mode & 1)) {
            const int t = tok0 + lane;
            float lg[NE];
#pragma unroll
            for (int e = 0; e < NE; ++e) lg[e] = lgs[lane * 33 + e] * rs + F.b_router[e];
            int id[4]; float tv[4];
#pragma unroll
            for (int k = 0; k < 4; ++k) {
                float best = -3.4e38f; int bi = 0;
#pragma unroll
                for (int e = 0; e < NE; ++e) { const bool taken = (k > 0 && id[0] == e) || (k > 1 && id[1] == e) || (k > 2 && id[2] == e); if (!taken && lg[e] > best) { best = lg[e]; bi = e; } }
                id[k] = bi; tv[k] = best;
            }
            const float e0 = 1.f, e1 = __expf(tv[1] - tv[0]), e2 = __expf(tv[2] - tv[0]), e3 = __expf(tv[3] - tv[0]), inv = 1.f / (e0 + e1 + e2 + e3);
            const float gw4[4] = {e0 * inv, e1 * inv, e2 * inv, e3 * inv};
#pragma unroll
            for (int k = 0; k < 4; ++k) { F.IDX[t * 4 + k] = id[k]; F.GATE[t * 4 + k] = gw4[k]; F.POS[t * 4 + k] = atomicAdd(&cntl[id[k]], 1); }
            F.TCNT[tile * NE + lane] = cntl[lane];
        }
        if (!(F.mode & 2)) {
            bf16_t* xo = F.XN2 + (size_t)(tok0 + i32) * D + kb;
#pragma unroll
            for (int q = 0; q < 16; q += 4) { f32x4 xv[4];
#pragma unroll
                for (int u = 0; u < 4; ++u) xv[u] = a[q + u] * rs * *(const f32x4*)(F.norm_ffn_g + kb + 4 * (q + u));
                if (T_FP8) *(uint4*)((unsigned char*)F.XN2 + (size_t)(tok0 + i32) * D + kb + 4 * q) = make_uint4(pg8::pk4_fp8(xv[0][0], xv[0][1], xv[0][2], xv[0][3]), pg8::pk4_fp8(xv[1][0], xv[1][1], xv[1][2], xv[1][3]),
                                                                                                               pg8::pk4_fp8(xv[2][0], xv[2][1], xv[2][2], xv[2][3]), pg8::pk4_fp8(xv[3][0], xv[3][1], xv[3][2], xv[3][3]));
                else { *(uint4*)(xo + 4 * q) = make_uint4(pk2(xv[0][0], xv[0][1]), pk2(xv[0][2], xv[0][3]), pk2(xv[1][0], xv[1][1]), pk2(xv[1][2], xv[1][3]));
                       *(uint4*)(xo + 4 * q + 8) = make_uint4(pk2(xv[2][0], xv[2][1]), pk2(xv[2][2], xv[2][3]), pk2(xv[3][0], xv[3][1]), pk2(xv[3][2], xv[3][3])); } }
        }
        __syncthreads();
    }
}

#endif
__device__ __forceinline__ void t_qkv_prep(Frame& F) {
    const int gw = F.vcu * NWAVES + F.wave, NGW = F.G * NWAVES, lane = F.lane;
    bf16_t* Qd = F.QKN; bf16_t* Kd = F.YS; bf16_t* Vd = F.YS2;
    for (int row = gw; row < M + BATCH * 64; row += NGW) {
        const bf16_t* zr; bf16_t *qo = nullptr, *ko, *vo; bool zero = false;
        if (row < M) { const int b = row / SEQ, i = row % SEQ; zr = F.Z + (size_t)row * INW; qo = Qd + (size_t)row * D; ko = Kd + ((size_t)b * KVS + 64 + i) * D; vo = Vd + ((size_t)b * KVS + 64 + i) * D; }
        else { const int r = row - M, b = r / 64, l = r % 64; zero = l < 48; zr = F.ZM + (size_t)(zero ? 0 : l - 48) * INW; ko = Kd + ((size_t)b * KVS + l) * D; vo = Vd + ((size_t)b * KVS + l) * D; }
        {
            const uint4 u0 = *(const uint4*)(zr + 512 + 16 * lane), u1 = *(const uint4*)(zr + 512 + 16 * lane + 8);
            const unsigned uw[8] = {u0.x, u0.y, u0.z, u0.w, u1.x, u1.y, u1.z, u1.w};
            float v[16]; float ss = 0.f;
#pragma unroll
            for (int c = 0; c < 8; ++c) { v[2 * c] = bf2f(uw[c] & 0xffffu); v[2 * c + 1] = bf2f(uw[c] >> 16); ss += v[2 * c] * v[2 * c] + v[2 * c + 1] * v[2 * c + 1]; }
            ss += __shfl_xor(ss, 1); ss += __shfl_xor(ss, 2);
            float rs = rsqrtf(ss * (1.f / 64.f) + EPS); if (lane < 32) rs *= 0.125f * 1.4426950408889634f; if (zero) rs = 0.f;
            const float* gg = (lane < 32 ? F.q_g : F.k_g) + 16 * (lane & 3);
            unsigned o[8];
#pragma unroll
            for (int c = 0; c < 8; ++c) o[c] = pk2(v[2 * c] * rs * gg[2 * c], v[2 * c + 1] * rs * gg[2 * c + 1]);
            const int sh = (lane & 31) >> 2, h = sh >> 1, j = sh & 1;
            bf16_t* dst = (lane < 32) ? qo : ko;
            if (dst) {
#pragma unroll
                for (int vh = 0; vh < 2; ++vh) { bf16_t* d = dst + (4 * h + 2 * j + vh) * 64 + 16 * (lane & 3); *(uint4*)d = make_uint4(o[0], o[1], o[2], o[3]); *(uint4*)(d + 8) = make_uint4(o[4], o[5], o[6], o[7]); }
            }
        }
        {
            uint4 u = *(const uint4*)(zr + 1536 + 8 * lane); if (zero) u = make_uint4(0, 0, 0, 0);
            const int h = lane >> 4, dv = 8 * (lane & 15), vh = dv >> 6, d = dv & 63;
#pragma unroll
            for (int j = 0; j < 2; ++j) *(uint4*)(vo + (4 * h + 2 * j + vh) * 64 + d) = u;
        }
    }
}
__device__ __forceinline__ void t_qkv_prep2(Frame& F) {
    const int gw = F.vcu * NWAVES + F.wave, NGW = F.G * NWAVES, lane = F.lane;
    bf16_t* Q2 = F.YS; bf16_t* K2 = F.YS + (size_t)M * 512; bf16_t* V2 = F.YS2;
    for (int row = gw; row < M + BATCH * 64; row += NGW) {
        const bf16_t* zr; bf16_t *qo = nullptr, *ko, *vo; bool zero = false;
        if (row < M) { const int b = row / SEQ, i = row % SEQ; zr = F.Z + (size_t)row * INW; qo = Q2 + (size_t)row * 512; ko = K2 + ((size_t)b * KVS + 64 + i) * 512; vo = V2 + ((size_t)b * KVS + 64 + i) * 512; }
        else { const int r = row - M, b = r / 64, l = r % 64; zero = l < 48; zr = F.ZM + (size_t)(zero ? 0 : l - 48) * INW; ko = K2 + ((size_t)b * KVS + l) * 512; vo = V2 + ((size_t)b * KVS + l) * 512; }
        const uint4 u0 = *(const uint4*)(zr + 512 + 16 * lane), u1 = *(const uint4*)(zr + 512 + 16 * lane + 8);
        uint4 uv = *(const uint4*)(zr + 1536 + 8 * lane);
        const unsigned uw[8] = {u0.x, u0.y, u0.z, u0.w, u1.x, u1.y, u1.z, u1.w};
        float v[16]; float ss = 0.f;
#pragma unroll
        for (int c = 0; c < 8; ++c) { v[2 * c] = bf2f(uw[c] & 0xffffu); v[2 * c + 1] = bf2f(uw[c] >> 16); ss += v[2 * c] * v[2 * c] + v[2 * c + 1] * v[2 * c + 1]; }
        ss += __shfl_xor(ss, 1); ss += __shfl_xor(ss, 2);
        float rs = rsqrtf(ss * (1.f / 64.f) + EPS); if (lane < 32) rs *= 0.125f * 1.4426950408889634f; if (zero) { rs = 0.f; uv = make_uint4(0, 0, 0, 0); }
        const float* gg = (lane < 32 ? F.q_g : F.k_g) + 16 * (lane & 3);
        unsigned o[8];
#pragma unroll
        for (int c = 0; c < 8; ++c) o[c] = pk2(v[2 * c] * rs * gg[2 * c], v[2 * c + 1] * rs * gg[2 * c + 1]);
        bf16_t* dst = (lane < 32) ? qo : ko;
        if (dst) { bf16_t* d = dst + 16 * (lane & 31); *(uint4*)d = make_uint4(o[0], o[1], o[2], o[3]); *(uint4*)(d + 8) = make_uint4(o[4], o[5], o[6], o[7]); }
        *(uint4*)(vo + 8 * lane) = uv;
    }
}
__device__ __forceinline__ void t_attn_post2(Frame& F) {
    const int gw = F.vcu * NWAVES + F.wave, NGW = F.G * NWAVES, lane = F.lane;
    const bf16_t* O = F.QKN; const float lam = F.LAM[0];
    const int h = lane >> 4, dv = 8 * (lane & 15);
    const f32x4 g0 = *(const f32x4*)(F.sub_g + dv), g1 = *(const f32x4*)(F.sub_g + dv + 4);
    for (int t = gw; t < M; t += NGW) {
        const uint4 a = *(const uint4*)(O + (size_t)t * D + 256 * h + dv), b = *(const uint4*)(O + (size_t)t * D + 256 * h + 128 + dv);
        const unsigned aw[4] = {a.x, a.y, a.z, a.w}, bw[4] = {b.x, b.y, b.z, b.w};
        float o[8]; float ss = 0.f;
#pragma unroll
        for (int c = 0; c < 4; ++c) { o[2 * c] = bf2f(aw[c] & 0xffffu) - lam * bf2f(bw[c] & 0xffffu); o[2 * c + 1] = bf2f(aw[c] >> 16) - lam * bf2f(bw[c] >> 16); ss += o[2 * c] * o[2 * c] + o[2 * c + 1] * o[2 * c + 1]; }
        ss += __shfl_xor(ss, 1); ss += __shfl_xor(ss, 2); ss += __shfl_xor(ss, 4); ss += __shfl_xor(ss, 8);
        const float rs = rsqrtf(ss * (1.f / 128.f) + EPS) * 0.8f;
        bf16_t* yo = T_MIXCAT ? F.YS2 + (size_t)t * 1024 + 128 * h + dv : F.YA + (size_t)t * AW + 128 * h + dv;
        *(uint4*)yo = make_uint4(pk2(o[0] * rs * g0[0], o[1] * rs * g0[1]), pk2(o[2] * rs * g0[2], o[3] * rs * g0[3]), pk2(o[4] * rs * g1[0], o[5] * rs * g1[1]), pk2(o[6] * rs * g1[2], o[7] * rs * g1[3]));
    }
}
__device__ __forceinline__ void t_attn_post(Frame& F) {
    const int gw = F.vcu * NWAVES + F.wave, NGW = F.G * NWAVES, lane = F.lane;
    const bf16_t* O = F.QKN; const float lam = F.LAM[0];
    const int h = lane >> 4, dv = 8 * (lane & 15), vh = dv >> 6, d = dv & 63;
    const f32x4 g0 = *(const f32x4*)(F.sub_g + dv), g1 = *(const f32x4*)(F.sub_g + dv + 4);
    for (int t = gw; t < M; t += NGW) {
        const uint4 a = *(const uint4*)(O + (size_t)t * D + (4 * h + vh) * 64 + d), b = *(const uint4*)(O + (size_t)t * D + (4 * h + 2 + vh) * 64 + d);
        const unsigned aw[4] = {a.x, a.y, a.z, a.w}, bw[4] = {b.x, b.y, b.z, b.w};
        float o[8]; float ss = 0.f;
#pragma unroll
        for (int c = 0; c < 4; ++c) { o[2 * c] = bf2f(aw[c] & 0xffffu) - lam * bf2f(bw[c] & 0xffffu); o[2 * c + 1] = bf2f(aw[c] >> 16) - lam * bf2f(bw[c] >> 16); ss += o[2 * c] * o[2 * c] + o[2 * c + 1] * o[2 * c + 1]; }
        ss += __shfl_xor(ss, 1); ss += __shfl_xor(ss, 2); ss += __shfl_xor(ss, 4); ss += __shfl_xor(ss, 8);
        const float rs = rsqrtf(ss * (1.f / 128.f) + EPS) * 0.8f;
        *(uint4*)(F.YA + (size_t)t * AW + 128 * h + dv) = make_uint4(pk2(o[0] * rs * g0[0], o[1] * rs * g0[1]), pk2(o[2] * rs * g0[2], o[3] * rs * g0[3]), pk2(o[4] * rs * g1[0], o[5] * rs * g1[1]), pk2(o[6] * rs * g1[2], o[7] * rs * g1[3]));
    }
}

__device__ __forceinline__ void t_gemm_z(Frame& F) {
    if (T_GATE8) {
        { pg8::Gemm g{F.XN, F.Wt_in, M, 2048, D}; pg8::StaticOrder S; S.init(M, 2048, F.G, (int)blockIdx.x);
          pg8::EpiBf16<0> E{F.Z, INW, nullptr, 0, 0, 1.f, 0};
          pg8::gemm_phase<pg8::EpiBf16<0>, pg8::StaticOrder, true, true>(F.lds3, g, S, E); }
        { pg8::Gemm g{F.XN8, F.Wt_in8, M, 2048, D / 2}; pg8::StaticOrder S; S.init(M, 2048, F.G, (int)blockIdx.x);
          pg8::EpiScaleBf16 E{F.Z + 2048, INW, 0.03125f};
          pg8::gemm_phase<pg8::EpiScaleBf16, pg8::StaticOrder, true, true, false, true>(F.lds3, g, S, E); }
        return;
    }
    pg8::Gemm g{F.XN, F.Wt_in, M, INW, D}; pg8::StaticOrder S; S.init(M, INW, F.G, (int)blockIdx.x);
    pg8::EpiBf16<0> E{F.Z, INW, nullptr, 0, 0, 1.f, 0};
    pg8::gemm_phase<pg8::EpiBf16<0>, pg8::StaticOrder, true, true>(F.lds3, g, S, E);
}
__device__ __forceinline__ void t_gemm_glu(Frame& F) {
    pg8::Gemm g{F.YS, F.Wt_glu, M, SW, SW}; pg8::StaticOrder S; S.init(M, SW, F.G, (int)blockIdx.x);
    pg8::EpiGlu E{F.YS, T_MIXCAT ? F.YS2 + 512 : F.YS2, F.b_glu, SW, T_MIXCAT ? 1024 : SW};
    pg8::gemm_phase<pg8::EpiGlu, pg8::StaticOrder, true, true>(F.lds3, g, S, E);
    if (T_MOE && DN_LATE > 0) {
        const int nun = (M / 256) * (SW / 256), idle = F.G - nun;
        if (idle > 0 && (int)blockIdx.x >= nun) { const int j = (int)blockIdx.x - nun; const size_t eo = (size_t)(NE - DN_LATE);
            cp_set<0, T_FP8>(F, F.w_down + eo * D * D, D, D, T_FP8 ? (bf16_t*)((unsigned char*)F.Wt_dn + eo * D * D) : F.Wt_dn + eo * D * D, DN_LATE, 0, 0, 0, j * NWAVES + F.wave, idle * NWAVES); }
        else if (idle <= 0) cp_set<0, T_FP8>(F, F.w_down + (size_t)(NE - DN_LATE) * D * D, D, D, T_FP8 ? (bf16_t*)((unsigned char*)F.Wt_dn + (size_t)(NE - DN_LATE) * D * D) : F.Wt_dn + (size_t)(NE - DN_LATE) * D * D, DN_LATE);
    }
}
__device__ __forceinline__ void t_gemm_mix(Frame& F) {
    if (T_MIXCAT) { pg8::Gemm g{F.YS2, F.Wt_so, M, D, D}; pg8::StaticOrder S; S.init(M, D, F.G, (int)blockIdx.x);
        pg8::EpiMixCat E{F.Z, F.MIX};
        pg8::gemm_phase<pg8::EpiMixCat, pg8::StaticOrder, true, true, false, false, true>(F.lds3, g, S, E); return; }
    { pg8::Gemm g{F.YS2, F.Wt_so, M, D, SW}; pg8::StaticOrder S; S.init(M, D, F.G, (int)blockIdx.x);
      pg8::EpiMix<true> E{F.Z + 2048, F.MIX, nullptr};
      pg8::gemm_phase<pg8::EpiMix<true>, pg8::StaticOrder, true, true>(F.lds3, g, S, E); }
    asm volatile("s_waitcnt vmcnt(0)" ::: "memory"); __syncthreads();
    { pg8::Gemm g{F.YA, F.Wt_ao, M, D, AW}; pg8::StaticOrder S; S.init(M, D, F.G, (int)blockIdx.x);
      pg8::EpiMix<false, T_WO8> E{F.Z + 3072, F.MIX, (unsigned char*)F.YS2 + (size_t)M * SW * 2};
      pg8::gemm_phase<pg8::EpiMix<false, T_WO8>, pg8::StaticOrder, true, true>(F.lds3, g, S, E); }
}
__device__ __forceinline__ void t_gemm_wo(Frame& F) {
    if (T_H1B) { pg8::Gemm g{F.MIX, F.Wt_o, M, D, D}; pg8::StaticOrder S; S.init(M, D, F.G, (int)blockIdx.x);
        pg8::EpiWoB E{F.x, F.H1B};
        pg8::gemm_phase<pg8::EpiWoB, pg8::StaticOrder, true, true>(F.lds3, g, S, E); return; }
    pg8::Gemm g{T_WO8 ? (const bf16_t*)((unsigned char*)F.YS2 + (size_t)M * SW * 2) : F.MIX, F.Wt_o, M, D, T_WO8 ? D / 2 : D}; pg8::StaticOrder S; S.init(M, D, F.G, (int)blockIdx.x);
    pg8::EpiWo E{F.x, F.out, T_WO8 ? 0.03125f : 1.f};
    pg8::gemm_phase<pg8::EpiWo, pg8::StaticOrder, true, true, false, T_WO8>(F.lds3, g, S, E);
}

__device__ __forceinline__ void t_moe1(Frame& F) {
    const int ntiles = F.OFF[NE] / 256;
    pg8::MoeOrder S{F.TEXP, ntiles, 8, F.G, F.vcu};
    LAS int* idx = (LAS int*)(F.lds3 + 131072);
    { pg8::Unit u; for (int i = 0; i < 12 && S.next(i, u); ++i) if (F.tid < 256) idx[i * 256 + F.tid] = F.ROWTOK[u.pm * 256 + F.tid]; }
    __syncthreads();
    pg8::Gemm g{F.XN2, F.Wt_gu, MOE_ROWS, NE * 2048, T_FP8 ? D / 2 : D, idx};
    pg8::EpiMoe1<T_FP8> E{F.ACT, F.b_gate, F.b_up};
    pg8::gemm_phase<pg8::EpiMoe1<T_FP8>, pg8::MoeOrder, true, true, true, T_FP8>(F.lds3, g, S, E);
    if (DN_MID > 0) {
        const int nu = ntiles * 8, rem = nu % F.G, nidle = rem ? F.G - rem : F.G, j = rem ? F.vcu - rem : F.vcu;
        if (j >= 0) { const size_t eo = (size_t)(NE - (T_GEMM_GLU ? DN_LATE : 0) - DN_MID);
            cp_set<0, T_FP8>(F, F.w_down + eo * D * D, D, D, T_FP8 ? (bf16_t*)((unsigned char*)F.Wt_dn + eo * D * D) : F.Wt_dn + eo * D * D, DN_MID, 0, 0, 0, j * NWAVES + F.wave, nidle * NWAVES); }
    }
}
__device__ __forceinline__ void t_moe2(Frame& F) {
    const int ntiles = F.OFF[NE] / 256;
    pg8::MoeOrder S{F.TEXP, ntiles, 4, F.G, F.vcu};
    pg8::Gemm g{F.ACT, F.Wt_dn, MOE_ROWS, NE * 1024, T_FP8 ? D / 2 : D, nullptr};
    pg8::EpiMoe2<T_FP8> E{F.Y2, F.b_down, F.ROWTK};
    pg8::gemm_phase<pg8::EpiMoe2<T_FP8>, pg8::MoeOrder, true, true, false, T_FP8>(F.lds3, g, S, E);
}

constexpr int NPHASE = 13;
__global__ void __launch_bounds__(NTHR, 2) mk_fwd(Args args) {
    extern __shared__ __attribute__((aligned(16))) unsigned char lds[];
    Frame F;
    F.lds = lds; F.lds3 = (LAS unsigned char*)lds; F.tid = threadIdx.x; F.lane = F.tid & 63; F.wave = __builtin_amdgcn_readfirstlane(F.tid >> 6);
    F.mode = args.mode; F.G = gridDim.x; { const int bx = blockIdx.x; F.vcu = (F.G % 8 == 0) ? (bx % 8) * (F.G / 8) + bx / 8 : bx; }
    const float* const* in = args.in;
    F.x = in[0]; F.meta = in[1]; F.norm_mix_g = in[2]; F.w_in = in[3]; F.a_re = in[4]; F.a_im = in[5]; F.log_dt = in[6]; F.b_re = in[7]; F.b_im = in[8]; F.c_re = in[9]; F.c_im = in[10]; F.ssm_d = in[11];
    F.w_glu = in[12]; F.b_glu = in[13]; F.q_g = in[14]; F.k_g = in[15]; F.lq1 = in[16]; F.lk1 = in[17]; F.lq2 = in[18]; F.lk2 = in[19]; F.sub_g = in[20]; F.w_so = in[21]; F.w_ao = in[22]; F.w_o = in[23];
    F.norm_ffn_g = in[24]; F.w_router = in[25]; F.b_router = in[26]; F.w_gate = in[27]; F.b_gate = in[28]; F.w_up = in[29]; F.b_up = in[30]; F.w_down = in[31]; F.b_down = in[32];
    F.out = args.out;
    unsigned char* ws = args.ws;
    F.XN = (bf16_t*)(ws + WS_R0); F.QKN = (bf16_t*)(ws + WS_R0); F.MIX = (bf16_t*)(ws + WS_R0);
    F.YS = (bf16_t*)(ws + WS_R1); F.YA = (bf16_t*)(ws + WS_R1 + (size_t)M * SW * 2); F.XN2 = (bf16_t*)(ws + WS_R1);
    F.YS2 = (bf16_t*)(ws + WS_R2); F.Z = (bf16_t*)(ws + WS_R3); F.ACT = (bf16_t*)(ws + WS_R3); F.Y2 = (bf16_t*)(ws + WS_WGU);
    F.Wt_in = (bf16_t*)(ws + WS_WD + WD_IN); F.Wt_glu = (bf16_t*)(ws + WS_WD + WD_GLU); F.Wt_so = (bf16_t*)(ws + WS_WD + WD_SO); F.Wt_ao = (bf16_t*)(ws + WS_WD + WD_AO); F.Wt_o = (bf16_t*)(ws + WS_WD + WD_O);
    F.XN8 = (bf16_t*)(ws + WS_R2); F.H1B = (bf16_t*)(ws + WS_R2); F.Wt_in8 = (bf16_t*)(ws + WS_WGU + 64 * MiB);     F.Wt_gu = (bf16_t*)(ws + WS_WGU); F.Wt_dn = (bf16_t*)(ws + WS_WDN);
    unsigned char* sm = ws + WS_SM;
    F.BB = (float*)(sm + SM_BB); F.AA = (float*)(sm + SM_AA); F.E = (float*)(sm + SM_E); F.SIN = (float*)(sm + SM_SIN); F.LAM = (float*)(sm + SM_LAM); F.GATE = (float*)(sm + SM_GATE);
    F.IDX = (int*)(sm + SM_IDX); F.POS = (int*)(sm + SM_POS); F.OFF = (int*)(sm + SM_OFF); F.ROWTOK = (int*)(sm + SM_ROWTOK); F.ROWTK = (int*)(sm + SM_ROWTK); F.TEXP = (int*)(sm + SM_TEXP); F.TCNT = (int*)(sm + SM_TCNT);
    F.ZM = (bf16_t*)(sm + SM_ZM); F.QKNM = (bf16_t*)(sm + SM_QKNM); F.BBH = (bf16_t*)(sm + SM_BBH); F.CMT = (bf16_t*)(sm + SM_CMT);
    unsigned* ctl = (unsigned*)(ws + WS_CTL);
    F.CNT = (int*)(ctl + CW_CNT);
    volatile LAS unsigned* MISC = (volatile LAS unsigned*)((LAS unsigned char*)lds + MISC_OFF);
    for (int u = F.tid; u < 64; u += NTHR) MISC[u] = 0u;
    __syncthreads();
    XcdBarrier bar = xcd_barrier_post(ctl + CW_BAR, MISC + 8);
#if COOP_LAUNCH
    cg::grid_group grid = cg::this_grid();
#endif
    const int lo = args.ph_lo, hi = args.ph_hi;
    bool first_seam = true; (void)first_seam;
#if COOP_LAUNCH
#define SEAM(k) do { if ((k) + 1 < hi) { if (first_seam) { grid.sync(); first_seam = false; } else xcd_barrier(bar); } } while (0)
#else
#define SEAM(k) do { if ((k) + 1 < hi) xcd_barrier(bar); } while (0)
#endif
#define IN(k) (lo <= (k) && (k) < hi)
#ifdef PROBE_LO
    if (F.mode & 2048) { for (int i = 0; i < 20; ++i) xcd_barrier(bar); }
#endif
    if (IN(0)) { s_prologue(F); SEAM(0); }
    if (IN(1)) { if (T_GEMM_Z) t_gemm_z(F); else s_gemm_z(F); SEAM(1); }
#if T_S5 && T_ATTN == 2 && T_ALT
    if (IN(2)) { if (F.wave & 1) { t_qkv_prep2(F); t_s5_pass<false>(F); } else { t_s5_pass<false>(F); t_qkv_prep2(F); } SEAM(2); }
#else
    if (IN(2)) { if (T_S5) { if (!(F.mode & 32)) t_s5_pass<false>(F); } else s_s5_scan<false>(F); if (F.mode & 64) {} else if (T_ATTN == 2) t_qkv_prep2(F); else if (T_ATTN) t_qkv_prep(F); else s_qkn(F); SEAM(2); }
#endif
    if (IN(3)) { if (T_S5) t_s5_carry(F); else s_s5_carry(F);
        if (T_ATTN == 2) { const attn2::AttnTensors AT{(const attn2::bf16*)F.YS, (const attn2::bf16*)(F.YS + (size_t)M * 512), (const attn2::bf16*)F.YS2, (attn2::bf16*)F.QKN};
                      const attn2::StaticOrder S((int)F.G, (int)blockIdx.x);
#ifdef PROBE_LO
                      if (F.mode & 256) attn2::attn_phase<attn2::StaticOrder, 8, 1>((char*)lds, AT, S); else if (F.mode & 512) attn2::attn_phase<attn2::StaticOrder, 8, 2>((char*)lds, AT, S); else if (F.mode & 1024) attn2::attn_phase<attn2::StaticOrder, 8, 4>((char*)lds, AT, S); else if (F.mode & 4096) attn2::attn_phase<attn2::StaticOrder, 8, 8>((char*)lds, AT, S); else if (F.mode & 8192) attn2::attn_phase<attn2::StaticOrder, 8, 16>((char*)lds, AT, S); else if (F.mode & 16384) attn2::attn_phase<attn2::StaticOrder, 8, 32>((char*)lds, AT, S); else
#endif
                      attn2::attn_phase<attn2::StaticOrder>((char*)lds, AT, S); }
        else if (T_ATTN) { const attn_body::AttnTensors AT{(const attn_body::bf16*)F.QKN, (const attn_body::bf16*)F.YS, (const attn_body::bf16*)F.YS2, (attn_body::bf16*)F.QKN};
                      const attn_body::StaticOrder S((int)F.G, (int)blockIdx.x); attn_body::attn_phase<attn_body::StaticOrder>((char*)lds, AT, S); }
        else s_attn(F);
        SEAM(3); }
#if T_S5 && T_ATTN == 2 && T_ALT
    if (IN(4)) { if (F.wave & 1) { t_attn_post2(F); t_s5_pass<true>(F); } else { t_s5_pass<true>(F); t_attn_post2(F); } SEAM(4); }
#else
    if (IN(4)) { if (T_S5) { if (!(F.mode & 32)) t_s5_pass<true>(F); } else s_s5_scan<true>(F); if (F.mode & 64) {} else if (T_ATTN == 2) t_attn_post2(F); else if (T_ATTN) t_attn_post(F); SEAM(4); }
#endif
    if (IN(5)) { if (T_GEMM_GLU) t_gemm_glu(F); else s_gemm_glu(F); SEAM(5); }
    if (IN(6)) { if (T_GEMM_MIX) t_gemm_mix(F); else s_gemm_mix(F); SEAM(6); }
    if (IN(7)) { if (T_GEMM_WO) t_gemm_wo(F); else s_gemm_wo(F); SEAM(7); }
#if defined(PROBE_DUP) && PROBE_DUP == 8
    if (IN(8)) {
#pragma unroll 1
        for (int rep = 0; rep < 2; ++rep) { t_router(F); if (rep == 0) xcd_barrier(bar); }
        SEAM(8); }
#else
    if (IN(8)) { if (T_ROUTER) t_router(F); else s_router(F); SEAM(8); }
#endif
    if (IN(9)) { if (T_ROUTER) t_scatter(F); else s_scatter(F); SEAM(9); }
    if (IN(10)) { if (T_MOE) t_moe1(F); else s_moe1(F); SEAM(10); }
    if (IN(11)) { if (T_MOE) t_moe2(F); else s_moe2(F); SEAM(11); }
#if defined(PROBE_DUP) && PROBE_DUP == 11
    if (IN(11)) { t_moe2(F); xcd_barrier(bar); }
#endif
#if defined(PROBE_DUP) && PROBE_DUP == 10
    if (IN(10)) { t_moe1(F); xcd_barrier(bar); }
#endif
    if (IN(12)) { s_combine(F); }
#undef IN
#undef SEAM
}

extern "C" void kernel_launch(void* const* d_in, const int* in_sizes, int n_in, void* d_out, int out_size, void* d_ws, size_t ws_size, hipStream_t stream) {
    static int grid = 0;
    if (grid == 0) {
        if (n_in != 33 || ws_size < WS_END || out_size != M * D) { fprintf(stderr, "kernel_launch: need 33 inputs, out %d and %zu bytes of workspace (got %d, %d, %zu)\n", M * D, (size_t)WS_END, n_in, out_size, ws_size); grid = -1; return; }
        int dev = 0, cus = 0, per_cu = 0;
        if (hipGetDevice(&dev) != hipSuccess || hipDeviceGetAttribute(&cus, hipDeviceAttributeMultiprocessorCount, dev) != hipSuccess) { grid = -1; return; }
        if (hipFuncSetAttribute((const void*)mk_fwd, hipFuncAttributeMaxDynamicSharedMemorySize, LDS_BYTES) != hipSuccess) { fprintf(stderr, "kernel_launch: hipFuncSetAttribute failed\n"); grid = -1; return; }
        if (hipOccupancyMaxActiveBlocksPerMultiprocessor(&per_cu, (const void*)mk_fwd, NTHR, LDS_BYTES) != hipSuccess || per_cu < 1) { fprintf(stderr, "kernel_launch: occupancy query failed (%d)\n", per_cu); (void)hipGetLastError(); grid = -1; return; }
        grid = cus * (per_cu < 1 ? 1 : 1);
    }
    if (grid < 0) return;
    (void)hipMemsetAsync((char*)d_ws + WS_CTL, 0, CTL_ZERO_BYTES, stream);
    Args a{};
    for (int i = 0; i < 33; ++i) a.in[i] = (const float*)d_in[i];
    a.out = (float*)d_out; a.ws = (unsigned char*)d_ws; a.ph_lo = 0; a.ph_hi = NPHASE;
    void* kargs[] = {&a};
#if COOP_LAUNCH
    const hipError_t e = hipLaunchCooperativeKernel((const void*)mk_fwd, dim3(grid), dim3(NTHR), kargs, LDS_BYTES, stream);
#else
    (void)kargs; hipLaunchKernelGGL(mk_fwd, dim3(grid), dim3(NTHR), LDS_BYTES, stream, a);
    const hipError_t e = hipPeekAtLastError();
#endif
    if (e != hipSuccess) fprintf(stderr, "kernel_launch: launch failed: %s (grid %d)\n", hipGetErrorString(e), grid);
#ifdef PROBE_LO
    a.ph_lo = PROBE_LO; a.ph_hi = PROBE_HI; a.mode = PROBE_MODE;
    (void)hipMemsetAsync((char*)d_ws + WS_CTL + CW_BAR * 4, 0, XCD_BAR_WORDS * 4, stream);
#if COOP_LAUNCH
    (void)hipLaunchCooperativeKernel((const void*)mk_fwd, dim3(grid), dim3(NTHR), kargs, LDS_BYTES, stream);
#else
    hipLaunchKernelGGL(mk_fwd, dim3(grid), dim3(NTHR), LDS_BYTES, stream, a);
#endif
#endif
}
```

```cpp
#include <hip/hip_runtime.h>
#include <hip/hip_cooperative_groups.h>
#include <cstdio>
#include <cstdint>
namespace cg = cooperative_groups;

typedef unsigned short bf16_t;
typedef short bf16x8 __attribute__((ext_vector_type(8)));
typedef float f32x4 __attribute__((ext_vector_type(4)));
#define LAS __attribute__((address_space(3)))

constexpr int D = 1024, BATCH = 2, SEQ = 8192, NMETA = 16;
constexpr int M = BATCH * SEQ;
constexpr int INW = 4096;
constexpr int SW = 512;
constexpr int NG = 32, NP = 64, NC = 16;
constexpr int NCHUNK = SEQ / 64;
constexpr int AW = 512;
constexpr int NE = 32, TOPK = 4;
constexpr int NASSIGN = M * TOPK;
constexpr int MOE_ROWS = NASSIGN + NE * 256;
constexpr float EPS = 1e-6f;
constexpr int NWAVES = 8, NTHR = 512;
constexpr int KVS = 64 + SEQ;

constexpr size_t MiB = 1u << 20;
constexpr size_t al(size_t x) { return (x + 255) & ~(size_t)255; }
constexpr size_t WS_CTL = 0, CTL_ZERO_BYTES = 1 * MiB;
constexpr int CW_BAR = 4096;
constexpr int CW_CNT = 16384;
constexpr size_t WS_SM = 1 * MiB;
constexpr size_t SM_BB = 0;
constexpr size_t SM_AA = SM_BB + al((size_t)NG * NP * 32 * 4);
constexpr size_t SM_E = SM_AA + al((size_t)NG * NP * 4 * 4);
constexpr size_t SM_SIN = SM_E + al((size_t)BATCH * NCHUNK * NG * NP * 2 * 4);
constexpr size_t SM_LAM = SM_SIN + al((size_t)BATCH * NCHUNK * NG * NP * 2 * 4);
constexpr size_t SM_IDX = SM_LAM + 256;
constexpr size_t SM_GATE = SM_IDX + al((size_t)NASSIGN * 4);
constexpr size_t SM_POS = SM_GATE + al((size_t)NASSIGN * 4);
constexpr size_t SM_OFF = SM_POS + al((size_t)NASSIGN * 4);
constexpr size_t SM_ROWTOK = SM_OFF + 256;
constexpr size_t SM_ROWTK = SM_ROWTOK + al((size_t)MOE_ROWS * 4);
constexpr size_t SM_ZM = SM_ROWTK + al((size_t)MOE_ROWS * 4);
constexpr size_t SM_QKNM = SM_ZM + al((size_t)NMETA * INW * 2);
constexpr size_t SM_TEXP = SM_QKNM + al((size_t)NMETA * D * 2);
constexpr size_t SM_BBH = SM_TEXP + al((size_t)(MOE_ROWS / 256) * 4);
constexpr size_t SM_CMT = SM_BBH + al((size_t)NG * NP * 32 * 2);
constexpr size_t SM_TCNT = SM_CMT + al((size_t)NG * NC * 128 * 2);
constexpr size_t SM_END = SM_TCNT + al((size_t)(M / 32) * NE * 4);
static_assert(SM_END <= 13 * MiB, "small region");
constexpr size_t WS_WD = 14 * MiB;
constexpr size_t WD_IN = 0, WD_GLU = WD_IN + (size_t)INW * D * 2, WD_SO = WD_GLU + (size_t)SW * SW * 2, WD_AO = WD_SO + (size_t)D * SW * 2, WD_O = WD_AO + (size_t)D * AW * 2, WD_END = WD_O + (size_t)D * D * 2;
static_assert(WD_END <= 13 * MiB, "dense weight copies");
constexpr size_t WS_WGU = 27 * MiB;
constexpr size_t WS_WDN = WS_WGU + 128 * MiB;
constexpr size_t RSZ = 34078720;
constexpr size_t WS_R0 = WS_WDN + 64 * MiB;
constexpr size_t WS_R1 = WS_R0 + RSZ;
constexpr size_t WS_R2 = WS_R1 + RSZ;
constexpr size_t WS_R3 = WS_R2 + RSZ;
constexpr size_t WS_END = WS_R3 + al((size_t)MOE_ROWS * D * 2);
static_assert((size_t)M * INW * 2 <= (size_t)MOE_ROWS * D * 2 && (size_t)BATCH * KVS * D * 2 <= RSZ, "region sizes");

constexpr int LDS_BYTES = 147456;
constexpr int MISC_OFF = LDS_BYTES - 256;

__device__ __forceinline__ unsigned f2bf(float f) { unsigned u = __builtin_bit_cast(unsigned, f); return (u + 0x7fffu + ((u >> 16) & 1u)) >> 16; }
__device__ __forceinline__ float bf2f(unsigned h) { return __builtin_bit_cast(float, h << 16); }
__device__ __forceinline__ unsigned pk2(float lo, float hi) { return f2bf(lo) | (f2bf(hi) << 16); }
__device__ __forceinline__ float wave_sum(float v) {
#pragma unroll
    for (int o = 1; o < 64; o <<= 1) v += __shfl_xor(v, o);
    return v;
}
__device__ __forceinline__ float sigmoidf_(float x) { return 1.f / (1.f + __expf(-x)); }
__device__ __forceinline__ float gelu_tanh(float x) { const float t = 0.7978845608028654f * (x + 0.044715f * x * x * x); return 0.5f * x * (1.f + tanhf(t)); }

#define XB_TMO      128
#define XB_XCNT(j)  (256  + 64 * (j))
#define XB_XSUB(j)  (1280 + 64 * (j))
#define XB_XGEN(j)  (2304 + 64 * (j))
#define XB_TOP      3328
#define XB_TOPGEN   3392
#define XCD_BAR_WORDS 3456
#define XB_SPIN_CAP (1u << 22)
__device__ __forceinline__ unsigned xb_ld(unsigned* p)              { return __hip_atomic_load(p, __ATOMIC_RELAXED, __HIP_MEMORY_SCOPE_AGENT); }
__device__ __forceinline__ unsigned xb_add(unsigned* p, unsigned v) { return __hip_atomic_fetch_add(p, v, __ATOMIC_RELAXED, __HIP_MEMORY_SCOPE_AGENT); }
__device__ __forceinline__ unsigned xb_xcc_id() { return (unsigned)__builtin_amdgcn_s_getreg((3 << 11) | 20) & 0xFu; }
#define XB_SPIN(cond, bar) do { unsigned _sp = 0; while (cond) { __builtin_amdgcn_s_sleep(1); \
    if ((++_sp & 255u) == 0u) { if (xb_ld(&(bar)[XB_TMO])) break; if (_sp > XB_SPIN_CAP) { atomicAdd(&(bar)[XB_TMO], 1u); break; } } } } while (0)
struct XcdBarrier { unsigned* bar; unsigned x; volatile LAS unsigned* st; };
__device__ __forceinline__ XcdBarrier xcd_barrier_post(unsigned* bar, volatile LAS unsigned* st) {
    XcdBarrier b; b.bar = bar; b.x = xb_xcc_id(); b.st = st;
    if (threadIdx.x == 0) (void)xb_add(&bar[XB_XCNT(b.x)], 1u);
    return b;
}
__device__ __forceinline__ void xcd_barrier_complete(unsigned* bar, unsigned x, unsigned& nloc, unsigned& nx) {
    const unsigned G = gridDim.x * gridDim.y * gridDim.z;
    unsigned sum, cnt, mine, sp = 0u;
    for (;;) {
        sum = 0u; cnt = 0u; mine = 0u;
#pragma unroll
        for (unsigned j = 0; j < 16; ++j) { const unsigned c = xb_ld(&bar[XB_XCNT(j)]); sum += c; cnt += (c > 0u) ? 1u : 0u; mine = (j == x) ? c : mine; }
        if (sum == G) break;
        __builtin_amdgcn_s_sleep(1);
        if ((++sp & 255u) == 0u) { if (xb_ld(&bar[XB_TMO])) break; if (sp > XB_SPIN_CAP) { atomicAdd(&bar[XB_TMO], 1u); break; } }
    }
    nloc = mine > 0u ? mine : 1u; nx = cnt > 0u ? cnt : 1u;
}
__device__ __forceinline__ void xcd_barrier(const XcdBarrier& b) {
    asm volatile("s_waitcnt vmcnt(0)" ::: "memory");
    __syncthreads();
    if (threadIdx.x == 0) {
        unsigned* bar = b.bar;
        __builtin_amdgcn_s_waitcnt(0);
        unsigned nloc = b.st[0], nx = b.st[1];
        if (nloc == 0u) { xcd_barrier_complete(bar, b.x, nloc, nx); b.st[0] = nloc; b.st[1] = nx; }
        const unsigned old = xb_add(&bar[XB_XSUB(b.x)], 1u);
        const unsigned gen = old / nloc;
        if (old + 1u == (gen + 1u) * nloc) {
            __builtin_amdgcn_fence(__ATOMIC_RELEASE, "agent");
            asm volatile("s_waitcnt vmcnt(0)" ::: "memory");
            const unsigned og = xb_add(&bar[XB_TOP], 1u);
            const unsigned tg = og / nx;
            if (og + 1u == (tg + 1u) * nx) xb_add(&bar[XB_TOPGEN], 1u);
            else XB_SPIN(xb_ld(&bar[XB_TOPGEN]) == tg, bar);
            __builtin_amdgcn_fence(__ATOMIC_ACQUIRE, "agent");
            xb_add(&bar[XB_XGEN(b.x)], 1u);
            asm volatile("s_waitcnt vmcnt(0)" ::: "memory");
        } else {
            XB_SPIN(xb_ld(&bar[XB_XGEN(b.x)]) == gen, bar);
            __builtin_amdgcn_fence(__ATOMIC_ACQUIRE, "agent");
            asm volatile("s_waitcnt vmcnt(0)" ::: "memory");
        }
    }
    __syncthreads();
}

struct Args { const float* in[33]; float* out; unsigned char* ws; int ph_lo, ph_hi, mode, pad; };
struct Frame {
    unsigned char* lds; LAS unsigned char* lds3; int tid, lane, wave, vcu, G, mode;
    const float *x, *meta, *norm_mix_g, *w_in, *a_re, *a_im, *log_dt, *b_re, *b_im, *c_re, *c_im, *ssm_d, *w_glu, *b_glu, *q_g, *k_g, *lq1, *lk1, *lq2, *lk2, *sub_g, *w_so, *w_ao, *w_o,
                *norm_ffn_g, *w_router, *b_router, *w_gate, *b_gate, *w_up, *b_up, *w_down, *b_down;
    float* out;
    bf16_t *XN, *Z, *YS, *YS2, *QKN, *YA, *MIX, *ACT, *Y2, *XN2, *ZM, *QKNM, *BBH, *CMT, *XN8, *Wt_in8, *H1B;
    bf16_t *Wt_in, *Wt_glu, *Wt_so, *Wt_ao, *Wt_o, *Wt_gu, *Wt_dn;
    float *BB, *AA, *E, *SIN, *LAM, *GATE; int *IDX, *POS, *CNT, *OFF, *ROWTOK, *ROWTK, *TEXP, *TCNT;
};
namespace pg8 {
#define PG8_LAS __attribute__((address_space(3)))
typedef unsigned short bf16_t;
typedef short bf16x8 __attribute__((ext_vector_type(8)));
typedef float f32x4 __attribute__((ext_vector_type(4)));
typedef unsigned u32x4 __attribute__((ext_vector_type(4)));
typedef int i32x8 __attribute__((ext_vector_type(8))); typedef int i32x4 __attribute__((ext_vector_type(4)));
__device__ __forceinline__ i32x8 cat8(bf16x8 a, bf16x8 b) { const i32x4 x = __builtin_bit_cast(i32x4, a), y = __builtin_bit_cast(i32x4, b); return (i32x8){x[0], x[1], x[2], x[3], y[0], y[1], y[2], y[3]}; }
constexpr int BM = 256, BK = 64, HALF = 128, HTB = HALF * BK * 2  , STAGE_BYTES = 8 * HTB, NXCD = 8, WGM = 8;

__host__ __device__ __forceinline__ int lds_byte(int r, int c) { const int st = (r >> 4) * 2 + (c >> 5), rr = r & 15, cc = c & 31, ob = rr * 64 + cc * 2; return st * 1024 + (ob ^ (((ob >> 9) & 1) << 5)); }
__host__ __device__ __forceinline__ void stage_rc(int b, int& R, int& C) { const int st = b / 1024, sb = b % 1024, swz = sb ^ (((sb >> 9) & 1) << 5); R = (st >> 1) * 16 + swz / 64; C = (st & 1) * 32 + (swz % 64) / 2; }
__host__ __device__ __forceinline__ int perm32(int rho) { const int n = rho >> 4, i = rho & 15; return 8 * (i >> 2) + 4 * n + (i & 3); }

struct Unit { int pm, pn; };
struct Gemm { const bf16_t* A; const bf16_t* Bt; int M, N, K; const PG8_LAS int* rowidx; };

struct StaticOrder {
    int nM, nN, nwg, G, c;
    __host__ __device__ void init(int M, int N, int G_, int c_) { nM = M / BM; nN = N / BM; nwg = nM * nN; G = G_; c = c_; }
    __host__ __device__ bool next(int i, Unit& u) const {
        const long L = (long)i * G + c; if (L >= nwg) return false;
        int wgid = (int)L; { const int q = nwg / NXCD, r = nwg % NXCD, xcd = wgid % NXCD, off = wgid / NXCD; wgid = (xcd < r ? xcd * (q + 1) : r * (q + 1) + (xcd - r) * q) + off; }
        const int nig = WGM * nN, gid = wgid / nig, fm = gid * WGM, gsz = (nM - fm) < WGM ? (nM - fm) : WGM;
        u.pm = fm + ((wgid % nig) % gsz); u.pn = (wgid % nig) / gsz; return true;
    }
    __device__ __forceinline__ void a_ready(const Unit&) const {}
    __device__ __forceinline__ void done(const Unit&) const {}
};

__device__ __forceinline__ unsigned cvt_pk_bf16(float lo, float hi) { unsigned r; asm volatile("v_cvt_pk_bf16_f32 %0, %1, %2" : "=v"(r) : "v"(lo), "v"(hi)); return r; }
typedef float f32x2 __attribute__((ext_vector_type(2)));
__device__ __forceinline__ f32x2 gelu_pk(f32x2 v) {
    const f32x2 av = __builtin_elementwise_abs(v), d = av * 0.2316418882f + 1.0f;
    f32x2 t; t.x = __builtin_amdgcn_rcpf(d.x); t.y = __builtin_amdgcn_rcpf(d.y);
    f32x2 q = t * 0.5307027145f + (-0.7265760135f); q = q * t + 0.7107068705f; q = q * t + (-0.142248368f); q = q * t + 0.127414796f; q = q * t;
    const f32x2 s = (v * v) * (-0.72134752044f);
    f32x2 e; e.x = __builtin_amdgcn_exp2f(s.x); e.y = __builtin_amdgcn_exp2f(s.y);
    const f32x2 m = v * (q * e), r = v - m;
    f32x2 o; o.x = v.x < 0.f ? m.x : r.x; o.y = v.y < 0.f ? m.y : r.y; return o;
}

template <int ACT  > struct EpiBf16 {
    static constexpr bool PERM = true, AFTER_DRAIN = false; static_assert(ACT == 0 || ACT == 1, "EpiBf16: ACT is 0 (none) or 1 (gelu_pk)");
    bf16_t* O; int ldc; const float* bias; int split_cols; size_t split_stride; float scale0; int nt_from;
    __device__ __forceinline__ void operator()(const f32x4 (&acc)[2][2][4][2], const Unit& u, int wr, int wc, int fr, int fq) const {
        const int row0 = u.pm * BM + wr * 64 + fr; int colt = u.pn * BM; bf16_t* base = O;
        float sc = 1.f; if (split_cols) { const int t = colt / split_cols; base += (size_t)t * split_stride; colt -= t * split_cols; if (t == 0) sc = scale0; }
        const int col0 = colt + wc * 32 + 8 * fq, bcol0 = u.pn * BM + wc * 32 + 8 * fq;
        f32x4 bv[2][2];
#pragma unroll
        for (int bj = 0; bj < 2; ++bj)
#pragma unroll
            for (int n = 0; n < 2; ++n) bv[bj][n] = bias ? *(const f32x4*)(bias + bcol0 + bj * HALF + 4 * n) : (f32x4){0.f, 0.f, 0.f, 0.f};
#pragma unroll
        for (int ai = 0; ai < 2; ++ai)
#pragma unroll
            for (int m = 0; m < 4; ++m) { bf16_t* rowp = base + (size_t)(row0 + ai * HALF + m * 16) * ldc + col0;
#pragma unroll
                for (int bj = 0; bj < 2; ++bj) { f32x4 v0 = acc[ai][bj][m][0] + bv[bj][0], v1 = acc[ai][bj][m][1] + bv[bj][1];
                    if (ACT == 1) { f32x2 a = gelu_pk((f32x2){v0[0], v0[1]}), b = gelu_pk((f32x2){v0[2], v0[3]}), c = gelu_pk((f32x2){v1[0], v1[1]}), d = gelu_pk((f32x2){v1[2], v1[3]});
                        v0 = (f32x4){a.x, a.y, b.x, b.y}; v1 = (f32x4){c.x, c.y, d.x, d.y}; }
                    v0 = v0 * sc; v1 = v1 * sc; u32x4 w; w.x = cvt_pk_bf16(v0[0], v0[1]); w.y = cvt_pk_bf16(v0[2], v0[3]); w.z = cvt_pk_bf16(v1[0], v1[1]); w.w = cvt_pk_bf16(v1[2], v1[3]);
                    if (nt_from && bcol0 >= nt_from) __builtin_nontemporal_store(w, (u32x4*)(rowp + bj * HALF)); else *(u32x4*)(rowp + bj * HALF) = w; } }
    }
};
__device__ __forceinline__ unsigned pk4_fp8(float a, float b, float c, float d) { int w = __builtin_amdgcn_cvt_pk_fp8_f32(a, b, 0, false); w = __builtin_amdgcn_cvt_pk_fp8_f32(c, d, w, true); return (unsigned)w; }
__device__ __forceinline__ float sigm(float x) { return __builtin_amdgcn_rcpf(1.f + __builtin_amdgcn_exp2f(-1.4426950408889634f * x)); }
__device__ __forceinline__ float bflo(unsigned w) { return __builtin_bit_cast(float, w << 16); }
__device__ __forceinline__ float bfhi(unsigned w) { return __builtin_bit_cast(float, w & 0xffff0000u); }
struct EpiGlu {
    static constexpr bool PERM = true, AFTER_DRAIN = false;
    const bf16_t* YS; bf16_t* O; const float* bias; int ldc, ldo;
    __device__ __forceinline__ void operator()(const f32x4 (&acc)[2][2][4][2], const Unit& u, int wr, int wc, int fr, int fq) const {
        const int row0 = u.pm * BM + wr * 64 + fr, col0 = u.pn * BM + wc * 32 + 8 * fq;
#pragma unroll
        for (int bj = 0; bj < 2; ++bj) {
            const f32x4 b0 = *(const f32x4*)(bias + col0 + bj * HALF), b1 = *(const f32x4*)(bias + col0 + bj * HALF + 4);
#pragma unroll
            for (int ai = 0; ai < 2; ++ai)
#pragma unroll
                for (int m = 0; m < 4; ++m) {
                    const size_t off = (size_t)(row0 + ai * HALF + m * 16) * ldc + col0 + bj * HALF;
                    const u32x4 y = *(const u32x4*)(YS + off);
                    const f32x4 v0 = acc[ai][bj][m][0] + b0, v1 = acc[ai][bj][m][1] + b1;
                    u32x4 w;
                    w.x = cvt_pk_bf16(bflo(y.x) * sigm(v0[0]), bfhi(y.x) * sigm(v0[1])); w.y = cvt_pk_bf16(bflo(y.y) * sigm(v0[2]), bfhi(y.y) * sigm(v0[3]));
                    w.z = cvt_pk_bf16(bflo(y.z) * sigm(v1[0]), bfhi(y.z) * sigm(v1[1])); w.w = cvt_pk_bf16(bflo(y.w) * sigm(v1[2]), bfhi(y.w) * sigm(v1[3]));
                    *(u32x4*)(O + (size_t)(row0 + ai * HALF + m * 16) * ldo + col0 + bj * HALF) = w;
                }
        }
    }
};
template <bool FIRST, bool OUT8 = false> struct EpiMix {
    static constexpr bool PERM = true, AFTER_DRAIN = false;
    const bf16_t* Zg; bf16_t* O; unsigned char* O8;
    __device__ __forceinline__ void operator()(const f32x4 (&acc)[2][2][4][2], const Unit& u, int wr, int wc, int fr, int fq) const {
        const int row0 = u.pm * BM + wr * 64 + fr, col0 = u.pn * BM + wc * 32 + 8 * fq;
#pragma unroll
        for (int ai = 0; ai < 2; ++ai)
#pragma unroll
            for (int m = 0; m < 4; ++m)
#pragma unroll
                for (int bj = 0; bj < 2; ++bj) {
                    const size_t row = (size_t)(row0 + ai * HALF + m * 16); const int col = col0 + bj * HALF;
                    const u32x4 z = *(const u32x4*)(Zg + row * 4096 + col);
                    const f32x4 a0 = acc[ai][bj][m][0], a1 = acc[ai][bj][m][1];
                    float v[8] = {sigm(bflo(z.x)) * a0[0], sigm(bfhi(z.x)) * a0[1], sigm(bflo(z.y)) * a0[2], sigm(bfhi(z.y)) * a0[3],
                                  sigm(bflo(z.z)) * a1[0], sigm(bfhi(z.z)) * a1[1], sigm(bflo(z.w)) * a1[2], sigm(bfhi(z.w)) * a1[3]};
                    if (!FIRST) { const u32x4 o = *(const u32x4*)(O + row * 1024 + col);
                        v[0] += bflo(o.x); v[1] += bfhi(o.x); v[2] += bflo(o.y); v[3] += bfhi(o.y); v[4] += bflo(o.z); v[5] += bfhi(o.z); v[6] += bflo(o.w); v[7] += bfhi(o.w); }
                    if constexpr (OUT8) { typedef unsigned u32x2 __attribute__((ext_vector_type(2))); *(u32x2*)(O8 + row * 1024 + col) = (u32x2){pk4_fp8(v[0], v[1], v[2], v[3]), pk4_fp8(v[4], v[5], v[6], v[7])}; }
                    else { u32x4 w; w.x = cvt_pk_bf16(v[0], v[1]); w.y = cvt_pk_bf16(v[2], v[3]); w.z = cvt_pk_bf16(v[4], v[5]); w.w = cvt_pk_bf16(v[6], v[7]);
                    *(u32x4*)(O + row * 1024 + col) = w; }
                }
    }
};
struct EpiMixCat {
    static constexpr bool PERM = true, AFTER_DRAIN = false;
    const bf16_t* Z; bf16_t* O;
    __device__ __forceinline__ void mid(f32x4 (&acc)[2][2][4][2], const Unit& u, int wr, int wc, int fr, int fq) const {
        int row0 = u.pm * BM + wr * 64 + fr, col0 = u.pn * BM + wc * 32 + 8 * fq;
        asm volatile("" : "+v"(row0), "+v"(col0));
#pragma unroll
        for (int ai = 0; ai < 2; ++ai)
#pragma unroll
            for (int m = 0; m < 4; ++m)
#pragma unroll
                for (int bj = 0; bj < 2; ++bj) {
                    const bf16_t* zp = Z + (size_t)(row0 + ai * HALF + m * 16) * 4096 + col0 + bj * HALF;
                    const u32x4 z0 = *(const u32x4*)(zp + 2048), z1 = *(const u32x4*)(zp + 3072);
                    const float a0[8] = {bflo(z0.x), bfhi(z0.x), bflo(z0.y), bfhi(z0.y), bflo(z0.z), bfhi(z0.z), bflo(z0.w), bfhi(z0.w)};
                    const float a1[8] = {bflo(z1.x), bfhi(z1.x), bflo(z1.y), bfhi(z1.y), bflo(z1.z), bfhi(z1.z), bflo(z1.w), bfhi(z1.w)};
#pragma unroll
                    for (int i = 0; i < 8; ++i) {
                        const float r = (1.f + __builtin_amdgcn_exp2f(-1.4426950408889634f * a0[i])) * __builtin_amdgcn_rcpf(1.f + __builtin_amdgcn_exp2f(-1.4426950408889634f * a1[i]));
                        acc[ai][bj][m][i >> 2][i & 3] *= r; }
                }
    }
    __device__ __forceinline__ void operator()(const f32x4 (&acc)[2][2][4][2], const Unit& u, int wr, int wc, int fr, int fq) const {
        const int row0 = u.pm * BM + wr * 64 + fr, col0 = u.pn * BM + wc * 32 + 8 * fq;
#pragma unroll
        for (int ai = 0; ai < 2; ++ai)
#pragma unroll
            for (int m = 0; m < 4; ++m)
#pragma unroll
                for (int bj = 0; bj < 2; ++bj) {
                    const size_t row = (size_t)(row0 + ai * HALF + m * 16); const int col = col0 + bj * HALF;
                    const u32x4 z = *(const u32x4*)(Z + row * 4096 + 2048 + col);
                    const f32x4 a0 = acc[ai][bj][m][0], a1 = acc[ai][bj][m][1];
                    u32x4 w; w.x = cvt_pk_bf16(sigm(bflo(z.x)) * a0[0], sigm(bfhi(z.x)) * a0[1]); w.y = cvt_pk_bf16(sigm(bflo(z.y)) * a0[2], sigm(bfhi(z.y)) * a0[3]);
                    w.z = cvt_pk_bf16(sigm(bflo(z.z)) * a1[0], sigm(bfhi(z.z)) * a1[1]); w.w = cvt_pk_bf16(sigm(bflo(z.w)) * a1[2], sigm(bfhi(z.w)) * a1[3]);
                    *(u32x4*)(O + row * 1024 + col) = w;
                }
    }
};
struct EpiWoB {
    static constexpr bool PERM = true, AFTER_DRAIN = false;
    const float* x; bf16_t* O;
    __device__ __forceinline__ void operator()(const f32x4 (&acc)[2][2][4][2], const Unit& u, int wr, int wc, int fr, int fq) const {
        const int row0 = u.pm * BM + wr * 64 + fr, col0 = u.pn * BM + wc * 32 + 8 * fq;
#pragma unroll
        for (int ai = 0; ai < 2; ++ai)
#pragma unroll
            for (int m = 0; m < 4; ++m)
#pragma unroll
                for (int bj = 0; bj < 2; ++bj) {
                    const size_t off = (size_t)(row0 + ai * HALF + m * 16) * 1024 + col0 + bj * HALF;
                    const f32x4 v0 = *(const f32x4*)(x + off) + acc[ai][bj][m][0], v1 = *(const f32x4*)(x + off + 4) + acc[ai][bj][m][1];
                    u32x4 w; w.x = cvt_pk_bf16(v0[0], v0[1]); w.y = cvt_pk_bf16(v0[2], v0[3]); w.z = cvt_pk_bf16(v1[0], v1[1]); w.w = cvt_pk_bf16(v1[2], v1[3]);
                    *(u32x4*)(O + off) = w;
                }
    }
};
struct EpiWo {
    static constexpr bool PERM = false, AFTER_DRAIN = false;
    const float* x; float* out; float sc;
    __device__ __forceinline__ void operator()(const f32x4 (&acc)[2][2][4][2], const Unit& u, int wr, int wc, int fr, int fq) const {
        const int row0 = u.pm * BM + wr * 64 + fr, col0 = u.pn * BM + wc * 32 + 4 * fq;
#pragma unroll
        for (int ai = 0; ai < 2; ++ai)
#pragma unroll
            for (int m = 0; m < 4; ++m)
#pragma unroll
                for (int bj = 0; bj < 2; ++bj)
#pragma unroll
                    for (int n = 0; n < 2; ++n) {
                        const size_t off = (size_t)(row0 + ai * HALF + m * 16) * 1024 + col0 + bj * HALF + n * 16;
                        *(f32x4*)(out + off) = *(const f32x4*)(x + off) + acc[ai][bj][m][n] * sc;
                    }
    }
};
struct EpiScaleBf16 {
    static constexpr bool PERM = true, AFTER_DRAIN = false;
    bf16_t* O; int ldc; float s;
    __device__ __forceinline__ void operator()(const f32x4 (&acc)[2][2][4][2], const Unit& u, int wr, int wc, int fr, int fq) const {
        const int row0 = u.pm * BM + wr * 64 + fr, col0 = u.pn * BM + wc * 32 + 8 * fq;
#pragma unroll
        for (int ai = 0; ai < 2; ++ai)
#pragma unroll
            for (int m = 0; m < 4; ++m)
#pragma unroll
                for (int bj = 0; bj < 2; ++bj) { const f32x4 v0 = acc[ai][bj][m][0] * s, v1 = acc[ai][bj][m][1] * s;
                    u32x4 w; w.x = cvt_pk_bf16(v0[0], v0[1]); w.y = cvt_pk_bf16(v0[2], v0[3]); w.z = cvt_pk_bf16(v1[0], v1[1]); w.w = cvt_pk_bf16(v1[2], v1[3]);
                    *(u32x4*)(O + (size_t)(row0 + ai * HALF + m * 16) * ldc + col0 + bj * HALF) = w; }
    }
};
struct MoeOrder {
    const int* texp; int ntiles, NT, G, v;
    __device__ __forceinline__ bool next(int i, Unit& u) const {
        const int L = i * G + v; if (L >= ntiles * NT) return false;
        const int mt = L / NT; u.pm = mt; u.pn = texp[mt] * NT + (L % NT); return true;
    }
    __device__ __forceinline__ void a_ready(const Unit&) const {}
    __device__ __forceinline__ void done(const Unit&) const {}
};
template <bool FP8> struct EpiMoe1 {
    static constexpr bool PERM = true, AFTER_DRAIN = false;
    bf16_t* ACT; const float* bg; const float* bu;
    __device__ __forceinline__ void operator()(const f32x4 (&acc)[2][2][4][2], const Unit& u, int wr, int wc, int fr, int fq) const {
        const int e = u.pn >> 3, pnl = u.pn & 7;
        const int row0 = u.pm * BM + wr * 64 + fr, oc = pnl * HALF + wc * 32 + 8 * fq;
        const f32x4 g0 = *(const f32x4*)(bg + e * 1024 + oc), g1 = *(const f32x4*)(bg + e * 1024 + oc + 4), u0 = *(const f32x4*)(bu + e * 1024 + oc), u1 = *(const f32x4*)(bu + e * 1024 + oc + 4);
#pragma unroll
        for (int ai = 0; ai < 2; ++ai)
#pragma unroll
            for (int m = 0; m < 4; ++m) {
                const float sc = FP8 ? 0.03125f : 1.f;
                const f32x4 ga = acc[ai][0][m][0] * sc + g0, gb = acc[ai][0][m][1] * sc + g1, ua = acc[ai][1][m][0] * sc + u0, ub = acc[ai][1][m][1] * sc + u1;
                float v[8];
#pragma unroll
                for (int i = 0; i < 4; ++i) { const float gg = fminf(ga[i], 7.f), uu = fminf(fmaxf(ua[i], -7.f), 7.f); v[i] = (uu + 1.f) * gg * sigm(1.702f * gg);
                                              const float g2 = fminf(gb[i], 7.f), u2 = fminf(fmaxf(ub[i], -7.f), 7.f); v[4 + i] = (u2 + 1.f) * g2 * sigm(1.702f * g2); }
                if constexpr (FP8) { typedef unsigned u32x2 __attribute__((ext_vector_type(2)));
                    *(u32x2*)((unsigned char*)ACT + (size_t)(row0 + ai * HALF + m * 16) * 1024 + oc) = (u32x2){pk4_fp8(v[0], v[1], v[2], v[3]), pk4_fp8(v[4], v[5], v[6], v[7])}; }
                else { u32x4 w; w.x = cvt_pk_bf16(v[0], v[1]); w.y = cvt_pk_bf16(v[2], v[3]); w.z = cvt_pk_bf16(v[4], v[5]); w.w = cvt_pk_bf16(v[6], v[7]);
                    *(u32x4*)(ACT + (size_t)(row0 + ai * HALF + m * 16) * 1024 + oc) = w; }
            }
    }
};
template <bool FP8> struct EpiMoe2 {
    static constexpr bool PERM = true, AFTER_DRAIN = false;
    bf16_t* Y2; const float* bd; const int* rowtk;
    __device__ __forceinline__ void operator()(const f32x4 (&acc)[2][2][4][2], const Unit& u, int wr, int wc, int fr, int fq) const {
        const int e = u.pn >> 2, pnl = u.pn & 3;
        const int row0 = u.pm * BM + wr * 64 + fr, col0 = pnl * BM + wc * 32 + 8 * fq;
        f32x4 bv[2][2];
#pragma unroll
        for (int bj = 0; bj < 2; ++bj)
#pragma unroll
            for (int n = 0; n < 2; ++n) bv[bj][n] = *(const f32x4*)(bd + e * 1024 + col0 + bj * HALF + 4 * n);
#pragma unroll
        for (int ai = 0; ai < 2; ++ai)
#pragma unroll
            for (int m = 0; m < 4; ++m) {
                const int tk = rowtk[row0 + ai * HALF + m * 16];
                if (tk >= 0) {
#pragma unroll
                    for (int bj = 0; bj < 2; ++bj) { const float sc = FP8 ? 0.03125f : 1.f; const f32x4 v0 = acc[ai][bj][m][0] * sc + bv[bj][0], v1 = acc[ai][bj][m][1] * sc + bv[bj][1];
                        if constexpr (FP8) { typedef unsigned u32x2 __attribute__((ext_vector_type(2)));
                            *(u32x2*)((unsigned char*)Y2 + (size_t)tk * 1024 + col0 + bj * HALF) = (u32x2){pk4_fp8(v0[0], v0[1], v0[2], v0[3]), pk4_fp8(v1[0], v1[1], v1[2], v1[3])}; }
                        else { u32x4 w; w.x = cvt_pk_bf16(v0[0], v0[1]); w.y = cvt_pk_bf16(v0[2], v0[3]); w.z = cvt_pk_bf16(v1[0], v1[1]); w.w = cvt_pk_bf16(v1[2], v1[3]);
                        *(u32x4*)(Y2 + (size_t)tk * 1024 + col0 + bj * HALF) = w; } }
                }
            }
    }
};
template <class Epi, class Sched, bool ALIGN_EPI = false, bool SP2 = false, bool GATHER = false, bool FP8 = false, bool MID = false>
__device__ __forceinline__ void gemm_phase(PG8_LAS unsigned char* lds, const Gemm g, const Sched& S, const Epi& E) {
    static_assert(!GATHER || SP2, "the gathered A operand is wired into the SP2 loop only");
    const int tid = threadIdx.x, wid = __builtin_amdgcn_readfirstlane(tid >> 6), lane = tid & 63, wr = wid >> 2, wc = wid & 3, fr = lane & 15, fq = lane >> 4;
    const int K = g.K, nt = K / BK;
    unsigned voffA[2], voffB[2];
#pragma unroll
    for (int i = 0; i < 2; ++i) { int R, C; stage_rc(tid * 16 + i * 8192, R, C); const int Rb = Epi::PERM ? ((R & ~31) + perm32(R & 31)) : R;
        voffA[i] = (unsigned)(R * K + C) * 2u; voffB[i] = (unsigned)(Rb * K + C) * 2u; }
    const size_t kstep = (size_t)(BK * 2);
    const size_t hstep = (size_t)HALF * K * 2;
    const size_t tstep = 2 * hstep;
    const unsigned ldsw = (unsigned)wid * 1024u;
    const int aoff = lds_byte(wr * 64 + fr, fq * 8), boff = lds_byte(wc * 32 + fr, fq * 8);
#define PG8_SA(b, h) (((b) * 2 + (h)) * HTB)
#define PG8_SB(b, h) ((4 + (b) * 2 + (h)) * HTB)
#define PG8_STAGE(bufoff, gbase, voff) do { _Pragma("unroll") for (int _i = 0; _i < 2; ++_i) \
        __builtin_amdgcn_global_load_lds((const unsigned*)((const char*)(gbase) + (voff)[_i]), (PG8_LAS unsigned*)(lds + (bufoff) + ldsw + _i * 8192), 16, 0, 0); } while (0)
#define PG8_STAGE_A(bufoff, nx, h, koff, dptr) do { if constexpr (GATHER) { _Pragma("unroll") for (int _i = 0; _i < 2; ++_i) \
        __builtin_amdgcn_global_load_lds((const unsigned*)((const char*)g.A + (koff) + ((nx) ? nga[h][_i] : cga[h][_i])), (PG8_LAS unsigned*)(lds + (bufoff) + ldsw + _i * 8192), 16, 0, 0); } \
    else { PG8_STAGE(bufoff, dptr, voffA); } } while (0)
#define PG8_GATH(ord, o) do { _Pragma("unroll") for (int _h = 0; _h < 2; ++_h) _Pragma("unroll") for (int _i = 0; _i < 2; ++_i) { int R_, C_, t_ = tid; asm volatile("" : "+v"(t_)); stage_rc(t_ * 16 + _i * 8192, R_, C_);   \
        o[_h][_i] = ((unsigned)g.rowidx[(ord) * 256 + _h * HALF + R_] * (unsigned)K + (unsigned)C_) * 2u; } } while (0)
#define PG8_LDA(dst, b, h) do { if constexpr (FP8) { _Pragma("unroll") for (int m = 0; m < 4; ++m) dst##8[m] = cat8(*(const PG8_LAS bf16x8*)(lds + PG8_SA(b, h) + aoff + m * 2048), *(const PG8_LAS bf16x8*)(lds + PG8_SA(b, h) + aoff + m * 2048 + 1024)); } \
    else { _Pragma("unroll") for (int m = 0; m < 4; ++m) _Pragma("unroll") for (int k = 0; k < 2; ++k) dst[m][k] = *(const PG8_LAS bf16x8*)(lds + PG8_SA(b, h) + aoff + m * 2048 + k * 1024); } } while (0)
#define PG8_LDB(dst, b, h) do { if constexpr (FP8) { _Pragma("unroll") for (int n = 0; n < 2; ++n) dst##8[n] = cat8(*(const PG8_LAS bf16x8*)(lds + PG8_SB(b, h) + boff + n * 2048), *(const PG8_LAS bf16x8*)(lds + PG8_SB(b, h) + boff + n * 2048 + 1024)); } \
    else { _Pragma("unroll") for (int n = 0; n < 2; ++n) _Pragma("unroll") for (int k = 0; k < 2; ++k) dst[n][k] = *(const PG8_LAS bf16x8*)(lds + PG8_SB(b, h) + boff + n * 2048 + k * 1024); } } while (0)
#define PG8_MMA(ai, bj, At, Bt) do { __builtin_amdgcn_s_setprio(1); if constexpr (FP8) { _Pragma("unroll") for (int m = 0; m < 4; ++m) _Pragma("unroll") for (int n = 0; n < 2; ++n) \
        asm volatile("v_mfma_f32_16x16x128_f8f6f4 %0, %1, %2, %0" : "+v"(acc[ai][bj][m][n]) : "v"(Bt##8[n]), "v"(At##8[m]));   } \
    else { _Pragma("unroll") for (int m = 0; m < 4; ++m) _Pragma("unroll") for (int n = 0; n < 2; ++n) _Pragma("unroll") for (int k = 0; k < 2; ++k) \
        acc[ai][bj][m][n] = __builtin_amdgcn_mfma_f32_16x16x32_bf16(Bt[n][k], At[m][k], acc[ai][bj][m][n], 0, 0, 0); } __builtin_amdgcn_s_setprio(0); } while (0)
#define PG8_WAIT_V(n) asm volatile("s_waitcnt vmcnt(" #n ")" ::: "memory")
#define PG8_WAIT_L(n) asm volatile("s_waitcnt lgkmcnt(" #n ")" ::: "memory")
#define PG8_BAR __builtin_amdgcn_s_barrier()
#define PG8_SCHED __builtin_amdgcn_sched_barrier(0)
    Unit cur, nxt; int ui = 0;
    if (!S.next(0, cur)) return;
    f32x4 acc[2][2][4][2];
#pragma unroll
    for (int a = 0; a < 2; ++a)
#pragma unroll
        for (int b = 0; b < 2; ++b)
#pragma unroll
            for (int m = 0; m < 4; ++m)
#pragma unroll
                for (int n = 0; n < 2; ++n) acc[a][b][m][n] = (f32x4){0.f, 0.f, 0.f, 0.f};
    bf16x8 At[4][2], B0[2][2], B1[2][2]; i32x8 At8[4], B08[2], B18[2];
    const char* cA = (const char*)g.A + (size_t)cur.pm * tstep; const char* cB = (const char*)g.Bt + (size_t)cur.pn * tstep;
    S.a_ready(cur);
    unsigned cga[2][2] = {{0u, 0u}, {0u, 0u}}, nga[2][2] = {{0u, 0u}, {0u, 0u}};
    if constexpr (GATHER) PG8_GATH(0, cga);
    if constexpr (SP2) {
        PG8_STAGE(PG8_SB(0, 0), cB, voffB); PG8_STAGE(PG8_SB(0, 1), cB + hstep, voffB); PG8_STAGE_A(PG8_SA(0, 0), false, 0, 0, cA); PG8_STAGE_A(PG8_SA(0, 1), false, 1, 0, cA + hstep);
        if (wr == 1) PG8_BAR;
        PG8_WAIT_V(2); PG8_BAR;
        PG8_STAGE(PG8_SB(1, 0), cB + kstep, voffB); PG8_STAGE_A(PG8_SA(1, 0), false, 0, kstep, cA + kstep); PG8_STAGE(PG8_SB(1, 1), cB + hstep + kstep, voffB);
        PG8_WAIT_V(6); PG8_BAR;
    } else {
        PG8_STAGE(PG8_SB(0, 0), cB, voffB); PG8_STAGE(PG8_SA(0, 0), cA, voffA); PG8_STAGE(PG8_SB(0, 1), cB + hstep, voffB); PG8_STAGE(PG8_SA(0, 1), cA + hstep, voffA);
        if (wr == 1) PG8_BAR;
        PG8_WAIT_V(4); PG8_BAR;
        PG8_STAGE(PG8_SB(1, 0), cB + kstep, voffB); PG8_STAGE(PG8_SA(1, 0), cA + kstep, voffA); PG8_STAGE(PG8_SB(1, 1), cB + hstep + kstep, voffB);
        PG8_WAIT_V(6); PG8_BAR;
    }
    for (;;) {
        const bool has_next = S.next(ui + 1, nxt);
        if constexpr (GATHER) { if (has_next) PG8_GATH(ui + 1, nga); else { nga[0][0] = cga[0][0]; nga[0][1] = cga[0][1]; nga[1][0] = cga[1][0]; nga[1][1] = cga[1][1]; } }
        const char* nA = has_next ? (const char*)g.A + (size_t)nxt.pm * tstep : cA; const char* nB = has_next ? (const char*)g.Bt + (size_t)nxt.pn * tstep : cB;
#pragma unroll 1
        for (int t = 0; t < nt; t += 2) {
            if constexpr (MID) { if (t == nt / 2) { PG8_SCHED; E.mid(acc, cur, wr, wc, fr, fq); PG8_SCHED; } }
            const bool last = (t == nt - 2);
            const char* a1 = cA + (size_t)(t + 1) * kstep;
            const char* a2 = last ? nA : cA + (size_t)(t + 2) * kstep; const char* b2 = last ? nB : cB + (size_t)(t + 2) * kstep;
            const char* a3 = a2 + kstep; const char* b3 = b2 + kstep;
            if (last && has_next) S.a_ready(nxt);
            const size_t k1 = (size_t)(t + 1) * kstep, k2 = last ? (size_t)0 : (size_t)(t + 2) * kstep, k3 = k2 + kstep; (void)k1; (void)k2; (void)k3;
            if constexpr (SP2) {
            PG8_LDB(B0, 0, 0); PG8_LDB(B1, 0, 1); PG8_SCHED; PG8_LDA(At, 0, 0); PG8_STAGE_A(PG8_SA(1, 1), false, 1, k1, a1 + hstep);
            PG8_WAIT_V(8); PG8_WAIT_L(0); PG8_BAR; PG8_MMA(0, 0, At, B0); PG8_MMA(0, 1, At, B1); PG8_BAR; PG8_SCHED;
            PG8_LDA(At, 0, 1); PG8_STAGE(PG8_SB(0, 0), b2, voffB); PG8_STAGE(PG8_SB(0, 1), b2 + hstep, voffB); PG8_STAGE_A(PG8_SA(0, 0), last, 0, k2, a2);
            PG8_WAIT_V(8); PG8_WAIT_L(0); PG8_BAR; PG8_MMA(1, 0, At, B0); PG8_MMA(1, 1, At, B1); PG8_BAR; PG8_SCHED;
            PG8_LDB(B0, 1, 0); PG8_LDB(B1, 1, 1); PG8_SCHED; PG8_LDA(At, 1, 0); PG8_STAGE_A(PG8_SA(0, 1), last, 1, k2, a2 + hstep);
            PG8_WAIT_V(8); PG8_WAIT_L(0); PG8_BAR; PG8_MMA(0, 0, At, B0); PG8_MMA(0, 1, At, B1); PG8_BAR; PG8_SCHED;
            PG8_LDA(At, 1, 1); PG8_STAGE(PG8_SB(1, 0), b3, voffB); PG8_STAGE(PG8_SB(1, 1), b3 + hstep, voffB); PG8_STAGE_A(PG8_SA(1, 0), last, 0, k3, a3);
            PG8_WAIT_V(8); PG8_WAIT_L(0); PG8_BAR; PG8_MMA(1, 0, At, B0); PG8_MMA(1, 1, At, B1); PG8_BAR; PG8_SCHED;
            } else {
            PG8_LDB(B0, 0, 0); PG8_SCHED; PG8_LDA(At, 0, 0); PG8_STAGE(PG8_SA(1, 1), a1 + hstep, voffA);
            PG8_WAIT_L(8); PG8_BAR; PG8_WAIT_L(0); PG8_MMA(0, 0, At, B0); PG8_BAR; PG8_SCHED;
            PG8_LDB(B1, 0, 1); PG8_STAGE(PG8_SB(0, 0), b2, voffB);
            PG8_BAR; PG8_WAIT_L(0); PG8_MMA(0, 1, At, B1); PG8_BAR;
            PG8_LDA(At, 0, 1); PG8_STAGE(PG8_SA(0, 0), a2, voffA);
            PG8_BAR; PG8_WAIT_L(0); PG8_MMA(1, 0, At, B0); PG8_BAR; PG8_SCHED;
            PG8_STAGE(PG8_SB(0, 1), b2 + hstep, voffB);
            PG8_WAIT_V(6); PG8_BAR; PG8_MMA(1, 1, At, B1); PG8_BAR;
            PG8_LDB(B0, 1, 0); PG8_SCHED; PG8_LDA(At, 1, 0); PG8_STAGE(PG8_SA(0, 1), a2 + hstep, voffA);
            PG8_WAIT_L(8); PG8_BAR; PG8_WAIT_L(0); PG8_MMA(0, 0, At, B0); PG8_BAR; PG8_SCHED;
            PG8_LDB(B1, 1, 1); PG8_STAGE(PG8_SB(1, 0), b3, voffB);
            PG8_BAR; PG8_WAIT_L(0); PG8_MMA(0, 1, At, B1); PG8_BAR;
            PG8_LDA(At, 1, 1); PG8_STAGE(PG8_SA(1, 0), a3, voffA);
            PG8_BAR; PG8_WAIT_L(0); PG8_MMA(1, 0, At, B0); PG8_BAR; PG8_SCHED;
            PG8_STAGE(PG8_SB(1, 1), b3 + hstep, voffB);
            PG8_WAIT_V(6); PG8_BAR; PG8_MMA(1, 1, At, B1); PG8_BAR;
            }
        }
        if constexpr (ALIGN_EPI) { if (wr == 0) PG8_BAR; }
        if constexpr (FP8) asm volatile("s_nop 15\n\ts_nop 15" ::: "memory");
        if constexpr (!Epi::AFTER_DRAIN) { E(acc, cur, wr, wc, fr, fq); S.done(cur); }
        if (!has_next) break;
#pragma unroll
        for (int a = 0; a < 2; ++a)
#pragma unroll
            for (int b = 0; b < 2; ++b)
#pragma unroll
                for (int m = 0; m < 4; ++m)
#pragma unroll
                    for (int n = 0; n < 2; ++n) acc[a][b][m][n] = (f32x4){0.f, 0.f, 0.f, 0.f};
        cur = nxt; cA = nA; cB = nB; ++ui;
        if constexpr (GATHER) { cga[0][0] = nga[0][0]; cga[0][1] = nga[0][1]; cga[1][0] = nga[1][0]; cga[1][1] = nga[1][1]; }
        if constexpr (ALIGN_EPI) { if (wr == 1) PG8_BAR; }
    }
    PG8_WAIT_V(0);
    if constexpr (!ALIGN_EPI) { if (wr == 0) PG8_BAR; }
    PG8_BAR;
    if constexpr (Epi::AFTER_DRAIN) { E.fused(acc, cur, wr, wc, fr, fq, lds, wid, lane); S.done(cur); }
#undef PG8_SA
#undef PG8_SB
#undef PG8_STAGE
#undef PG8_STAGE_A
#undef PG8_GATH
#undef PG8_LDA
#undef PG8_LDB
#undef PG8_MMA
#undef PG8_WAIT_V
#undef PG8_WAIT_L
#undef PG8_BAR
#undef PG8_SCHED
}
}
#include <hip/hip_bf16.h>
#include <cmath>
namespace attn_body {
using bf16=__hip_bfloat16;
using bf16x8=__attribute__((ext_vector_type(8)))short;
using s16x4=__attribute__((ext_vector_type(4)))short;
using f32x16=__attribute__((ext_vector_type(16)))float;
using u32x4=__attribute__((ext_vector_type(4)))unsigned;
constexpr int BATCH=2,NHEAD=16,SEQ=8192,D=64,DM=NHEAD*D,KVSEQ=SEQ+64;
constexpr int NW=8,QBLK=32,QB=QBLK*NW,KVBLK=64,NQB=SEQ/QB;
constexpr int ATTN_PITCH=DM, ATTN_UNIT_ROWS=QB;
__device__ __forceinline__ int crow(int r,int hi){return (r&3)+8*(r>>2)+4*hi;}
#define SBAR() __builtin_amdgcn_sched_barrier(0)
__device__ __forceinline__ void cmask(f32x16&p0,f32x16&p1,int jb,int qrel,int hi){
  const float NEG=-INFINITY; int kb=64*jb+4*hi;
  #pragma unroll
  for(int r=0;r<16;++r){int kv=kb+(r&3)+8*(r>>2); if(kv>qrel)p0[r]=NEG; if(kv+32>qrel)p1[r]=NEG;}
}

constexpr int NSLOT=3, SLOTB=8192;
constexpr int LDS_K=0, LDS_V=NSLOT*SLOTB, LDS_WS=2*NSLOT*SLOTB, LDS_OST=LDS_WS+NW*64*4, LDS_BYTES=LDS_OST+NW*4096;
constexpr float C2=0.125f*1.4426950408889634f;
__device__ __forceinline__ void glds16(const void*gsrc,unsigned lds_dst){unsigned keep;
  asm volatile("s_mov_b32 %0, m0\n\ts_mov_b32 m0, %2\n\ts_nop 0\n\tglobal_load_lds_dwordx4 %1, off\n\ts_mov_b32 m0, %0":"=&s"(keep):"v"(gsrc),"s"(lds_dst):"memory");}
__device__ __forceinline__ float max3f(float a,float b,float c){float r;asm("v_max3_f32 %0, %1, %2, %3":"=v"(r):"v"(a),"v"(b),"v"(c));return r;}
__device__ __forceinline__ float max2f(float a,float b){float r;asm("v_max_f32_e32 %0, %1, %2":"=v"(r):"v"(a),"v"(b));return r;}
__device__ __forceinline__ float fadd_s(float a,float b){float r;asm("v_add_f32_e32 %0, %1, %2":"=v"(r):"v"(a),"v"(b));return r;}
__device__ __forceinline__ float fsub_s(float a,float b){float r;asm("v_sub_f32_e32 %0, %1, %2":"=v"(r):"v"(a),"v"(b));return r;}
typedef float f32x2_t __attribute__((ext_vector_type(2))); typedef __bf16 bf16x2_t __attribute__((ext_vector_type(2)));
__device__ __forceinline__ unsigned cvtpk_s(float lo,float hi){f32x2_t v={lo,hi};bf16x2_t b=__builtin_convertvector(v,bf16x2_t);return __builtin_bit_cast(unsigned,b);}
#define WAIT_BAR(N) asm volatile("s_waitcnt vmcnt(" #N ") lgkmcnt(0)\n\ts_barrier":::"memory")

__device__ __forceinline__ void qkt(f32x16&p0,f32x16&p1,const char*Kslot,const bf16x8*qr,const f32x16&negm,int r32,int hi){
  const char*kb=Kslot+hi*1024+r32*16;
  #pragma unroll
  for(int d0=0;d0<4;++d0){
    const bf16x8 b0=*reinterpret_cast<const bf16x8*>(kb+d0*2048);
    const bf16x8 b1=*reinterpret_cast<const bf16x8*>(kb+d0*2048+512);
    if(d0==0){p0=__builtin_amdgcn_mfma_f32_32x32x16_bf16(b0,qr[0],negm,0,0,0);p1=__builtin_amdgcn_mfma_f32_32x32x16_bf16(b1,qr[0],negm,0,0,0);}
    else{p0=__builtin_amdgcn_mfma_f32_32x32x16_bf16(b0,qr[d0],p0,0,0,0);p1=__builtin_amdgcn_mfma_f32_32x32x16_bf16(b1,qr[d0],p1,0,0,0);}}
}
typedef __attribute__((address_space(3))) const char* lds_cptr;
typedef short v4i16_t __attribute__((ext_vector_type(4)));
__device__ __forceinline__ void kload8(bf16x8*kf,lds_cptr kp){
  kf[0]=*(const __attribute__((address_space(3))) bf16x8*)(kp);      kf[1]=*(const __attribute__((address_space(3))) bf16x8*)(kp+512);
  kf[2]=*(const __attribute__((address_space(3))) bf16x8*)(kp+2048); kf[3]=*(const __attribute__((address_space(3))) bf16x8*)(kp+2560);
  kf[4]=*(const __attribute__((address_space(3))) bf16x8*)(kp+4096); kf[5]=*(const __attribute__((address_space(3))) bf16x8*)(kp+4608);
  kf[6]=*(const __attribute__((address_space(3))) bf16x8*)(kp+6144); kf[7]=*(const __attribute__((address_space(3))) bf16x8*)(kp+6656);
}
__device__ __forceinline__ void kload2(bf16x8*kf,lds_cptr kp,int j){ kf[2*j]=*(const __attribute__((address_space(3))) bf16x8*)(kp+j*2048); kf[2*j+1]=*(const __attribute__((address_space(3))) bf16x8*)(kp+j*2048+512); }
__device__ __forceinline__ s16x4 vtr(lds_cptr p){ return __builtin_bit_cast(s16x4,__builtin_amdgcn_ds_read_tr16_b64_v4i16((__attribute__((address_space(3))) v4i16_t*)p)); }
__device__ __forceinline__ float rowmax(const f32x16&p0,const f32x16&p1){
  float a=max3f(p0[0],p0[1],p1[0]),b=max3f(p0[2],p0[3],p1[1]);a=max3f(a,p1[2],p1[3]);
  #pragma unroll
  for(int r=4;r<16;r+=4){a=max3f(a,p0[r],p0[r+1]);b=max3f(b,p0[r+2],p0[r+3]);a=max3f(a,p1[r],p1[r+1]);b=max3f(b,p1[r+2],p1[r+3]);}
  const float m=max2f(a,b);
  auto rr=__builtin_amdgcn_permlane32_swap(__float_as_uint(m),__float_as_uint(m),false,false);
  return max2f(__uint_as_float(rr[0]),__uint_as_float(rr[1]));
}
__device__ __forceinline__ void pv(f32x16*o,int vb,bf16x8 pa0,bf16x8 pa1,bf16x8 pa2,bf16x8 pa3){
  #pragma unroll
  for(int d0=0;d0<2;++d0){s16x4 lo[4],hi[4];
    #pragma unroll
    for(int ks=0;ks<4;++ks){
      asm volatile("ds_read_b64_tr_b16 %0,%1 offset:%c2":"=&v"(lo[ks]):"v"(vb),"i"(d0*4096+ks*1024):"memory");
      asm volatile("ds_read_b64_tr_b16 %0,%1 offset:%c2":"=&v"(hi[ks]):"v"(vb),"i"(d0*4096+ks*1024+512):"memory");}
    asm volatile("s_waitcnt lgkmcnt(0)":::"memory");SBAR();
    #define PK(k) (bf16x8){lo[k][0],lo[k][1],lo[k][2],lo[k][3],hi[k][0],hi[k][1],hi[k][2],hi[k][3]}
    o[d0]=__builtin_amdgcn_mfma_f32_32x32x16_bf16(pa0,PK(0),o[d0],0,0,0);
    o[d0]=__builtin_amdgcn_mfma_f32_32x32x16_bf16(pa1,PK(1),o[d0],0,0,0);
    o[d0]=__builtin_amdgcn_mfma_f32_32x32x16_bf16(pa2,PK(2),o[d0],0,0,0);
    o[d0]=__builtin_amdgcn_mfma_f32_32x32x16_bf16(pa3,PK(3),o[d0],0,0,0);
    #undef PK
  }
}

#ifndef ATTN_STORE16
#define ATTN_STORE16(p,v) (*(u32x4*)(p)=(v))
#endif
template<int THRL> __device__ __forceinline__ void attn_unit(int b,int h,int qb,const bf16*Q,const bf16*__restrict__ K,const bf16*__restrict__ V,bf16*O,char*shm){
  const int tid=threadIdx.x,lane=tid&63,r32=lane&31,hi=lane>>5; const int wid=__builtin_amdgcn_readfirstlane(tid>>6);
  const long rowbase=(long)b*SEQ; const int q0=qb*QB;
  const bf16*Qw=Q+(rowbase+q0+wid*QBLK)*DM+h*D;
  const bf16*Kh=K+(long)b*KVSEQ*DM+h*D,*Vh=V+(long)b*KVSEQ*DM+h*D;
  const unsigned lds0=(unsigned)(uintptr_t)shm;
  float*wsf=(float*)(shm+LDS_WS)+wid*64;
  const bf16*ksrc=Kh+(long)lane*DM+wid*8;
  const bf16*vsrc=Vh+(long)(16*(wid&3)+(lane>>2))*DM+(wid>>2)*32+(lane&3)*8;
  const unsigned kdst=lds0+LDS_K+wid*1024, vdst=lds0+LDS_V+wid*1024;
  #define DMA_K(t,slot) glds16(ksrc+(long)(t)*KVBLK*DM,(unsigned)__builtin_amdgcn_readfirstlane(kdst+(slot)))
  #define DMA_V(t,slot) glds16(vsrc+(long)(t)*KVBLK*DM,(unsigned)__builtin_amdgcn_readfirstlane(vdst+(slot)))
  const int vb0=(int)(lds0+LDS_V)+((lane>>4)&1)*32+(lane&3)*8+(4*hi+((lane&15)>>2))*64;
  const char*Kbase=shm+LDS_K; bf16x8 kf[8];
  const lds_cptr shm3=(lds_cptr)shm; const lds_cptr kp0=shm3+LDS_K+hi*1024+r32*16; const lds_cptr vp0=shm3+LDS_V+((lane>>4)&1)*32+(lane&3)*8+(4*hi+((lane&15)>>2))*64;
  const int NT=(q0+QB)/KVBLK+1;
  DMA_K(0,0);DMA_V(0,0);DMA_K(1,SLOTB);
  bf16x8 qr[4];
  #pragma unroll
  for(int d0=0;d0<4;++d0)qr[d0]=*reinterpret_cast<const bf16x8*>(&Qw[(long)r32*DM+d0*16+hi*8]);
  float mhat=0.f,l_reg=0.f;f32x16 o[2];o[0]=f32x16{};o[1]=f32x16{};f32x16 negm=f32x16{};asm volatile("":"+v"(negm));
  const int qrel=wid*QBLK+r32;
  #define CMASK(P0,P1,t) do{int jb_=(t)-(NT-4); if(jb_>=0)cmask(P0,P1,jb_,qrel,hi);}while(0)
  bool resc=false;
  #define START(P0,P1) do{ const float rm=rowmax(P0,P1); resc=false; \
    { const float dl=rm; mhat=fadd_s(mhat,dl); \
      _Pragma("unroll") for(int r=0;r<16;++r){P0[r]=fsub_s(P0[r],dl);P1[r]=fsub_s(P1[r],dl);} \
      _Pragma("unroll") for(int r=0;r<16;++r)negm[r]=-mhat; asm volatile("":"+v"(negm)); } \
    _Pragma("unroll") for(int r=0;r<16;++r)P0[r]=__builtin_amdgcn_exp2f(P0[r]); }while(0)
  #define RESC() do{ if(resc){ asm volatile("s_waitcnt lgkmcnt(0)":::"memory"); \
      _Pragma("unroll") for(int d_=0;d_<2;++d_) _Pragma("unroll") for(int r=0;r<16;++r)o[d_][r]*=wsf[crow(r,hi)]; } }while(0)
  f32x16 pA0,pA1,pB0,pB1;
  int sl_prev=0,sl_cur=0,sl_next=SLOTB;
  #define ROT() do{sl_prev=sl_cur;sl_cur=sl_next;sl_next=(sl_next==(NSLOT-1)*SLOTB)?0:sl_next+SLOTB;}while(0)
  DMA_K(2,2*SLOTB);
  WAIT_BAR(3);
  qkt(pA0,pA1,Kbase,qr,negm,r32,hi);asm volatile("s_nop 15\n\ts_nop 7":"+v"(pA0),"+v"(pA1));CMASK(pA0,pA1,0);
  _Pragma("unroll") for(int r=0;r<16;++r){ pA0[r]=-INFINITY; if(r<8)pA1[r]=-INFINITY; }
  START(pA0,pA1);
  _Pragma("unroll") for(int r=0;r<16;++r)pA1[r]=__builtin_amdgcn_exp2f(pA1[r]);
  WAIT_BAR(0);
  DMA_K(3,0);DMA_V(1,SLOTB);
  ROT();
  kload8(kf,kp0+sl_cur);
  WAIT_BAR(2);
  s16x4 vlo[8],vhi[8]; u32x4 pw0,pw1,pw2,pw3;
  #define PKW(P,B) cvtpk_s(P[B],P[B+1])
  #define PAF(k) __builtin_bit_cast(bf16x8,pw##k)
  #define VFR(i) (bf16x8){vlo[i][0],vlo[i][1],vlo[i][2],vlo[i][3],vhi[i][0],vhi[i][1],vhi[i][2],vhi[i][3]}
  #define PIN(x) asm volatile("":"+v"(x))
  #define MX3(a,b,c) __builtin_fmaxf(__builtin_fmaxf((a),(b)),(c))
  #define GAPA(MF,A0,A1,A2,A3,W0,W1,PW) do{ MF; sacc+=A0; sacc+=A1; sacc+=A2; sacc+=A3; PIN(sacc); W0; W1; PIN(PW); SBAR(); }while(0)
  #define EX(v) __builtin_amdgcn_exp2f(v)
  #define GAPB(MF,X,B) do{ MF; X[B]=EX(X[B]); X[B+1]=EX(X[B+1]); X[B+2]=EX(X[B+2]); X[B+3]=EX(X[B+3]); PIN(X); SBAR(); }while(0)
  #define VRD(i) do{ vlo[i]=vtr(vp_+(((i)>>2)*4096+((i)&3)*1024)); vhi[i]=vtr(vp_+(((i)>>2)*4096+((i)&3)*1024+512)); }while(0)
  #define KRD(G,j) do{ if(G){ kload2(kf,kp0+sl_next,j); SBAR(); } }while(0)
  #define STEP(C0,C1,P0,P1,t,GK,GV,GL) do{ SBAR(); \
    const lds_cptr vp_=vp0+sl_prev; \
    VRD(0); SBAR(); float sacc=(P0[0]+P0[1]); \
    GAPA(C0=__builtin_amdgcn_mfma_f32_32x32x16_bf16(kf[0],qr[0],negm,0,0,0), P0[2],P0[3],P0[4],P0[5],     pw0[0]=PKW(P0,0), pw0[1]=PKW(P0,2), pw0); \
    VRD(4); SBAR(); GAPA(C1=__builtin_amdgcn_mfma_f32_32x32x16_bf16(kf[1],qr[0],negm,0,0,0), P0[6],P0[7],P0[8],P0[9],     pw0[2]=PKW(P0,4), pw0[3]=PKW(P0,6), pw0); \
    VRD(1); SBAR(); GAPA(C0=__builtin_amdgcn_mfma_f32_32x32x16_bf16(kf[2],qr[1],C0,0,0,0),   P0[10],P0[11],P0[12],P0[13], pw1[0]=PKW(P0,8), pw1[1]=PKW(P0,10), pw1); \
    VRD(5); SBAR(); GAPA(C1=__builtin_amdgcn_mfma_f32_32x32x16_bf16(kf[3],qr[1],C1,0,0,0),   P0[14],P0[15],P1[0],P1[1],   pw1[2]=PKW(P0,12),pw1[3]=PKW(P0,14), pw1); \
    VRD(2); SBAR(); GAPA(C0=__builtin_amdgcn_mfma_f32_32x32x16_bf16(kf[4],qr[2],C0,0,0,0),   P1[2],P1[3],P1[4],P1[5],     pw2[0]=PKW(P1,0), pw2[1]=PKW(P1,2), pw2); \
    VRD(6); SBAR(); GAPA(C1=__builtin_amdgcn_mfma_f32_32x32x16_bf16(kf[5],qr[2],C1,0,0,0),   P1[6],P1[7],P1[8],P1[9],     pw2[2]=PKW(P1,4), pw2[3]=PKW(P1,6), pw2); \
    VRD(3); SBAR(); GAPA(C0=__builtin_amdgcn_mfma_f32_32x32x16_bf16(kf[6],qr[3],C0,0,0,0),   P1[10],P1[11],P1[12],P1[13], pw3[0]=PKW(P1,8), pw3[1]=PKW(P1,10), pw3); \
    VRD(7); SBAR(); GAPA(C1=__builtin_amdgcn_mfma_f32_32x32x16_bf16(kf[7],qr[3],C1,0,0,0),   P1[14],P1[15],0.f,0.f,       pw3[2]=PKW(P1,12),pw3[3]=PKW(P1,14), pw3); \
    l_reg+=sacc; \
    if(GK){DMA_K((t)+3,sl_cur);} if(GV){DMA_V((t)+1,sl_next);} \
    CMASK(C0,C1,t); \
    { float a=MX3(C0[0],C0[1],C1[0]),b=MX3(C0[2],C0[3],C1[1]); a=MX3(a,C1[2],C1[3]); \
      _Pragma("unroll") for(int r=4;r<16;r+=4){a=MX3(a,C0[r],C0[r+1]);b=MX3(b,C0[r+2],C0[r+3]);a=MX3(a,C1[r],C1[r+1]);b=MX3(b,C1[r+2],C1[r+3]);} \
      float rm=__builtin_fmaxf(a,b); { auto rr=__builtin_amdgcn_permlane32_swap(__float_as_uint(rm),__float_as_uint(rm),false,false); rm=__builtin_fmaxf(__uint_as_float(rr[0]),__uint_as_float(rr[1])); } \
      resc=false; \
      if(__builtin_expect(__any(rm>(float)THRL),0)){ const float dl=__builtin_fmaxf(rm,0.f); mhat+=dl; \
        _Pragma("unroll") for(int r=0;r<16;++r){C0[r]-=dl;C1[r]-=dl;} \
        _Pragma("unroll") for(int r=0;r<16;++r)negm[r]=-mhat; asm volatile("":"+v"(negm)); \
        const float f=__builtin_amdgcn_exp2f(-dl); l_reg*=f; if(hi==0)wsf[r32]=f; resc=true; } } \
    SBAR(); \
    GAPB(o[0]=__builtin_amdgcn_mfma_f32_32x32x16_bf16(PAF(0),VFR(0),o[0],0,0,0), C0,0); \
    GAPB(o[1]=__builtin_amdgcn_mfma_f32_32x32x16_bf16(PAF(0),VFR(4),o[1],0,0,0), C0,4); \
    KRD(GL,0); GAPB(o[0]=__builtin_amdgcn_mfma_f32_32x32x16_bf16(PAF(1),VFR(1),o[0],0,0,0), C0,8); \
    KRD(GL,1); GAPB(o[1]=__builtin_amdgcn_mfma_f32_32x32x16_bf16(PAF(1),VFR(5),o[1],0,0,0), C0,12); \
    KRD(GL,2); GAPB(o[0]=__builtin_amdgcn_mfma_f32_32x32x16_bf16(PAF(2),VFR(2),o[0],0,0,0), C1,0); \
    KRD(GL,3); GAPB(o[1]=__builtin_amdgcn_mfma_f32_32x32x16_bf16(PAF(2),VFR(6),o[1],0,0,0), C1,4); \
    GAPB(o[0]=__builtin_amdgcn_mfma_f32_32x32x16_bf16(PAF(3),VFR(3),o[0],0,0,0), C1,8); \
    GAPB(o[1]=__builtin_amdgcn_mfma_f32_32x32x16_bf16(PAF(3),VFR(7),o[1],0,0,0), C1,12); \
    }while(0)
  int t=1;
  #undef CMASK
  #define CMASK(P0,P1,t) do{}while(0)
  for(;t+5<NT;t+=2){
    STEP(pB0,pB1,pA0,pA1,t,true,true,true);     WAIT_BAR(2); RESC(); ROT();
    STEP(pA0,pA1,pB0,pB1,t+1,true,true,true);   WAIT_BAR(2); RESC(); ROT();
  }
  #undef CMASK
  #define CMASK(P0,P1,t) do{int jb_=(t)-(NT-4); if(jb_>=0)cmask(P0,P1,jb_,qrel,hi);}while(0)
  #define ENDW(tt) do{ if((tt)+3<NT){WAIT_BAR(2);} else if((tt)+2<NT){WAIT_BAR(1);} else {WAIT_BAR(0);} }while(0)
  for(;t+2<NT;t+=2){
    STEP(pB0,pB1,pA0,pA1,t,(t+3<NT),(t+1<NT),(t+1<NT));       ENDW(t);   RESC(); ROT();
    STEP(pA0,pA1,pB0,pB1,t+1,(t+4<NT),(t+2<NT),(t+2<NT));     ENDW(t+1); RESC(); ROT();
  }
  STEP(pB0,pB1,pA0,pA1,t,false,true,true); WAIT_BAR(0); RESC(); ROT();
  STEP(pA0,pA1,pB0,pB1,NT-1,false,false,false); RESC();
  { float sacc=pA0[0]+pA0[1]; _Pragma("unroll") for(int r=2;r<16;++r)sacc+=pA0[r]; _Pragma("unroll") for(int r=0;r<16;++r)sacc+=pA1[r]; l_reg+=sacc;
    pw0=(u32x4){PKW(pA0,0),PKW(pA0,2),PKW(pA0,4),PKW(pA0,6)};pw1=(u32x4){PKW(pA0,8),PKW(pA0,10),PKW(pA0,12),PKW(pA0,14)};pw2=(u32x4){PKW(pA1,0),PKW(pA1,2),PKW(pA1,4),PKW(pA1,6)};pw3=(u32x4){PKW(pA1,8),PKW(pA1,10),PKW(pA1,12),PKW(pA1,14)};
    SBAR(); pv(o,vb0+sl_cur,PAF(0),PAF(1),PAF(2),PAF(3)); }
  #undef PKW
  #undef PAF
  #undef VFR
  #undef PIN
  #undef MX3
  #undef GAPA
  #undef GAPB
  #undef EX
  #undef VRD
  #undef KRD
  #undef STEP
  #undef ENDW
  {auto rr=__builtin_amdgcn_permlane32_swap(__float_as_uint(l_reg),__float_as_uint(l_reg),false,false);l_reg=__uint_as_float(rr[0])+__uint_as_float(rr[1]);}
  if(hi==0)wsf[32+r32]=l_reg;asm volatile("s_waitcnt lgkmcnt(0)":::"memory");
  float rli[16];
  #pragma unroll
  for(int r=0;r<16;++r)rli[r]=__builtin_amdgcn_rcpf(wsf[32+crow(r,hi)]);
  bf16*Ow=O+(rowbase+q0+wid*QBLK)*DM+h*D;
  { bf16*stg=(bf16*)(shm+LDS_OST)+wid*2048;
    #pragma unroll
    for(int r=0;r<16;++r){const int orow=crow(r,hi);
      #pragma unroll
      for(int d0=0;d0<2;++d0)stg[orow*64+d0*32+r32]=__float2bfloat16(o[d0][r]*rli[r]);}
    asm volatile("s_waitcnt lgkmcnt(0)":::"memory");
    #pragma unroll
    for(int i=0;i<4;++i){const int row=i*8+(lane>>3),ch=lane&7; const u32x4 v=*(const u32x4*)(stg+row*64+ch*8); ATTN_STORE16(Ow+(long)row*DM+ch*8,v);} }
  asm volatile("s_waitcnt lgkmcnt(0)\n\ts_barrier":::"memory");
  #undef DMA_K
  #undef DMA_V
  #undef CMASK
  #undef START
  #undef RESC
  #undef ROT
}
constexpr int ATTN_LDS_BYTES=LDS_BYTES;
struct AttnTensors { const bf16* Q; const bf16* K; const bf16* V; bf16* O; };
struct AttnUnit { int bh; int qb; };
struct StaticOrder {
  int vcu;
  __device__ __forceinline__ explicit StaticOrder(int grid,int block):vcu((block%8)*(grid/8)+block/8){}
  __device__ __forceinline__ bool next(int i,AttnUnit&u)const{ if(i>=4)return false; const int s=vcu&7; u.bh=vcu>>3; u.qb=(i==0)?s:(i==1)?15-s:(i==2)?16+s:31-s; return true; }
  __device__ __forceinline__ void a_ready(const AttnUnit&)const{}
  __device__ __forceinline__ void done(const AttnUnit&)const{}
};
template<class Sched,int THRL=8> __device__ __forceinline__ void attn_phase(char*lds,const AttnTensors&T,const Sched&S){
  AttnUnit u;
  for(int i=0;S.next(i,u);++i){ S.a_ready(u); attn_unit<THRL>(u.bh/NHEAD,u.bh%NHEAD,u.qb,T.Q,T.K,T.V,T.O,lds); S.done(u); }
}
#undef SBAR
#undef WAIT_BAR
}
namespace attn2 {
using bf16=__hip_bfloat16;
using bf16x8=__attribute__((ext_vector_type(8)))short;
using s16x4=__attribute__((ext_vector_type(4)))short;
using f32x16=__attribute__((ext_vector_type(16)))float;
using u32x4=__attribute__((ext_vector_type(4)))unsigned;
constexpr int BATCH=2,NHEAD=8,SEQ=8192,D=64,DQK=NHEAD*D,DVP=512,DOP=1024,DM=DQK,KVSEQ=SEQ+64;
constexpr int NW=8,QBLK=32,QB=QBLK*NW,KVBLK=64,NQB=SEQ/QB;
constexpr int ATTN_PITCH=DM, ATTN_UNIT_ROWS=QB;
__device__ __forceinline__ int crow(int r,int hi){return (r&3)+8*(r>>2)+4*hi;}
#define SBAR() __builtin_amdgcn_sched_barrier(0)
__device__ __forceinline__ void cmask(f32x16&p0,f32x16&p1,int jb,int qrel,int hi){
  const float NEG=-INFINITY; int kb=64*jb+4*hi;
  #pragma unroll
  for(int r=0;r<16;++r){int kv=kb+(r&3)+8*(r>>2); if(kv>qrel)p0[r]=NEG; if(kv+32>qrel)p1[r]=NEG;}
}

constexpr int NSLOT=3, SLOTB=8192;
constexpr int LDS_K=0, LDS_V=NSLOT*SLOTB, LDS_WS=3*NSLOT*SLOTB, LDS_OST=LDS_WS+NW*64*4, LDS_BYTES=LDS_OST+NW*8192;
constexpr float C2=0.125f*1.4426950408889634f;
__device__ __forceinline__ void glds16(const void*gsrc,unsigned lds_dst){unsigned keep;
  asm volatile("s_mov_b32 %0, m0\n\ts_mov_b32 m0, %2\n\ts_nop 0\n\tglobal_load_lds_dwordx4 %1, off\n\ts_mov_b32 m0, %0":"=&s"(keep):"v"(gsrc),"s"(lds_dst):"memory");}
__device__ __forceinline__ float max3f(float a,float b,float c){float r;asm("v_max3_f32 %0, %1, %2, %3":"=v"(r):"v"(a),"v"(b),"v"(c));return r;}
__device__ __forceinline__ float max2f(float a,float b){float r;asm("v_max_f32_e32 %0, %1, %2":"=v"(r):"v"(a),"v"(b));return r;}
__device__ __forceinline__ float fadd_s(float a,float b){float r;asm("v_add_f32_e32 %0, %1, %2":"=v"(r):"v"(a),"v"(b));return r;}
__device__ __forceinline__ float fsub_s(float a,float b){float r;asm("v_sub_f32_e32 %0, %1, %2":"=v"(r):"v"(a),"v"(b));return r;}
typedef float f32x2_t __attribute__((ext_vector_type(2))); typedef __bf16 bf16x2_t __attribute__((ext_vector_type(2)));
__device__ __forceinline__ unsigned cvtpk_s(float lo,float hi){f32x2_t v={lo,hi};bf16x2_t b=__builtin_convertvector(v,bf16x2_t);return __builtin_bit_cast(unsigned,b);}
#define WAIT_BAR(N) asm volatile("s_waitcnt vmcnt(" #N ") lgkmcnt(0)\n\ts_barrier":::"memory")

__device__ __forceinline__ void qkt(f32x16&p0,f32x16&p1,const char*Kslot,const bf16x8*qr,const f32x16&negm,int r32,int hi){
  const char*kb=Kslot+hi*1024+r32*16;
  #pragma unroll
  for(int d0=0;d0<4;++d0){
    const bf16x8 b0=*reinterpret_cast<const bf16x8*>(kb+d0*2048);
    const bf16x8 b1=*reinterpret_cast<const bf16x8*>(kb+d0*2048+512);
    if(d0==0){p0=__builtin_amdgcn_mfma_f32_32x32x16_bf16(b0,qr[0],negm,0,0,0);p1=__builtin_amdgcn_mfma_f32_32x32x16_bf16(b1,qr[0],negm,0,0,0);}
    else{p0=__builtin_amdgcn_mfma_f32_32x32x16_bf16(b0,qr[d0],p0,0,0,0);p1=__builtin_amdgcn_mfma_f32_32x32x16_bf16(b1,qr[d0],p1,0,0,0);}}
}
typedef __attribute__((address_space(3))) const char* lds_cptr;
typedef short v4i16_t __attribute__((ext_vector_type(4)));
__device__ __forceinline__ void kload8(bf16x8*kf,lds_cptr kp){
  kf[0]=*(const __attribute__((address_space(3))) bf16x8*)(kp);      kf[1]=*(const __attribute__((address_space(3))) bf16x8*)(kp+512);
  kf[2]=*(const __attribute__((address_space(3))) bf16x8*)(kp+2048); kf[3]=*(const __attribute__((address_space(3))) bf16x8*)(kp+2560);
  kf[4]=*(const __attribute__((address_space(3))) bf16x8*)(kp+4096); kf[5]=*(const __attribute__((address_space(3))) bf16x8*)(kp+4608);
  kf[6]=*(const __attribute__((address_space(3))) bf16x8*)(kp+6144); kf[7]=*(const __attribute__((address_space(3))) bf16x8*)(kp+6656);
}
__device__ __forceinline__ void kload2(bf16x8*kf,lds_cptr kp,int j){ kf[2*j]=*(const __attribute__((address_space(3))) bf16x8*)(kp+j*2048); kf[2*j+1]=*(const __attribute__((address_space(3))) bf16x8*)(kp+j*2048+512); }
__device__ __forceinline__ s16x4 vtr(lds_cptr p){ return __builtin_bit_cast(s16x4,__builtin_amdgcn_ds_read_tr16_b64_v4i16((__attribute__((address_space(3))) v4i16_t*)p)); }
__device__ __forceinline__ float rowmax(const f32x16&p0,const f32x16&p1){
  float a=max3f(p0[0],p0[1],p1[0]),b=max3f(p0[2],p0[3],p1[1]);a=max3f(a,p1[2],p1[3]);
  #pragma unroll
  for(int r=4;r<16;r+=4){a=max3f(a,p0[r],p0[r+1]);b=max3f(b,p0[r+2],p0[r+3]);a=max3f(a,p1[r],p1[r+1]);b=max3f(b,p1[r+2],p1[r+3]);}
  const float m=max2f(a,b);
  auto rr=__builtin_amdgcn_permlane32_swap(__float_as_uint(m),__float_as_uint(m),false,false);
  return max2f(__uint_as_float(rr[0]),__uint_as_float(rr[1]));
}
__device__ __forceinline__ void pv(f32x16*o,int vb,bf16x8 pa0,bf16x8 pa1,bf16x8 pa2,bf16x8 pa3){
  #pragma unroll
  for(int d0=0;d0<4;++d0){s16x4 lo[4],hi[4];
    #pragma unroll
    for(int ks=0;ks<4;++ks){
      asm volatile("ds_read_b64_tr_b16 %0,%1 offset:%c2":"=&v"(lo[ks]):"v"(vb),"i"(d0*4096+ks*1024):"memory");
      asm volatile("ds_read_b64_tr_b16 %0,%1 offset:%c2":"=&v"(hi[ks]):"v"(vb),"i"(d0*4096+ks*1024+512):"memory");}
    asm volatile("s_waitcnt lgkmcnt(0)":::"memory");SBAR();
    #define PK(k) (bf16x8){lo[k][0],lo[k][1],lo[k][2],lo[k][3],hi[k][0],hi[k][1],hi[k][2],hi[k][3]}
    o[d0]=__builtin_amdgcn_mfma_f32_32x32x16_bf16(pa0,PK(0),o[d0],0,0,0);
    o[d0]=__builtin_amdgcn_mfma_f32_32x32x16_bf16(pa1,PK(1),o[d0],0,0,0);
    o[d0]=__builtin_amdgcn_mfma_f32_32x32x16_bf16(pa2,PK(2),o[d0],0,0,0);
    o[d0]=__builtin_amdgcn_mfma_f32_32x32x16_bf16(pa3,PK(3),o[d0],0,0,0);
    #undef PK
  }
}

#ifndef ATTN_STORE16
#define ATTN_STORE16(p,v) (*(u32x4*)(p)=(v))
#endif
template<int THRL> __device__ __forceinline__ void attn_unit(int b,int h,int qb,const bf16*Q,const bf16*__restrict__ K,const bf16*__restrict__ V,bf16*O,char*shm){
  int tid=threadIdx.x; asm volatile("":"+v"(tid));
  const int lane=tid&63,r32=lane&31,hi=lane>>5; const int wid=__builtin_amdgcn_readfirstlane(tid>>6);
  const long rowbase=(long)b*SEQ; const int q0=qb*QB;
  const bf16*Qw=Q+(rowbase+q0+wid*QBLK)*DQK+h*D;
  const bf16*Kh=K+(long)b*KVSEQ*DQK+h*D,*Vh=V+(long)b*KVSEQ*DVP+(h>>1)*128;
  const unsigned lds0=(unsigned)(uintptr_t)shm;
  float*wsf=(float*)(shm+LDS_WS)+wid*64;
  const bf16*ksrc=Kh+(long)lane*DQK+wid*8;
  const bf16*vsrc=Vh+(long)(16*(wid&3)+(lane>>2))*DVP+(wid>>2)*32+(lane&3)*8;
  const unsigned kdst=lds0+LDS_K+wid*1024, vdst=lds0+LDS_V+wid*1024;
  #define DMA_K(t,slot) glds16(ksrc+(long)(t)*KVBLK*DQK,(unsigned)__builtin_amdgcn_readfirstlane(kdst+(slot)))
  #define DMA_V(t,slot) do{ glds16(vsrc+(long)(t)*KVBLK*DVP,(unsigned)__builtin_amdgcn_readfirstlane(vdst+2*(slot))); glds16(vsrc+(long)(t)*KVBLK*DVP+64,(unsigned)__builtin_amdgcn_readfirstlane(vdst+2*(slot)+8192)); }while(0)
  const int vb0=(int)(lds0+LDS_V)+((lane>>4)&1)*32+(lane&3)*8+(4*hi+((lane&15)>>2))*64;
  const char*Kbase=shm+LDS_K; bf16x8 kf[8];
  const lds_cptr shm3=(lds_cptr)shm; const lds_cptr kp0=shm3+LDS_K+hi*1024+r32*16; const lds_cptr vp0=shm3+LDS_V+((lane>>4)&1)*32+(lane&3)*8+(4*hi+((lane&15)>>2))*64;
  const int NT=(q0+QB)/KVBLK+1;
  DMA_K(0,0);DMA_V(0,0);DMA_K(1,SLOTB);
  bf16x8 qr[4];
  #pragma unroll
  for(int d0=0;d0<4;++d0)qr[d0]=*reinterpret_cast<const bf16x8*>(&Qw[(long)r32*DQK+d0*16+hi*8]);
  float mhat=0.f,l_reg=0.f;f32x16 o[4];o[0]=f32x16{};o[1]=f32x16{};o[2]=f32x16{};o[3]=f32x16{};const f32x16 zero16=f32x16{};
  const int qrel=wid*QBLK+r32;
  #define CMASK(P0,P1,t) do{int jb_=(t)-(NT-4); if(jb_>=0)cmask(P0,P1,jb_,qrel,hi);}while(0)
  bool resc=false;
  #define START(P0,P1) do{ const float rm=rowmax(P0,P1); resc=false; \
    { const float dl=rm; mhat=fadd_s(mhat,dl); \
      _Pragma("unroll") for(int r=0;r<16;++r){P0[r]=fsub_s(P0[r],dl);P1[r]=fsub_s(P1[r],dl);} \
      } \
    _Pragma("unroll") for(int r=0;r<16;++r)P0[r]=__builtin_amdgcn_exp2f(P0[r]); }while(0)
  #define RESC() do{ if(resc){ asm volatile("s_waitcnt lgkmcnt(0)":::"memory"); \
      _Pragma("unroll") for(int d_=0;d_<4;++d_) _Pragma("unroll") for(int r=0;r<16;++r)o[d_][r]*=wsf[crow(r,hi)]; } }while(0)
  f32x16 pA0,pA1,pB0,pB1;
  int sl_prev=0,sl_cur=0,sl_next=SLOTB;
  #define ROT() do{sl_prev=sl_cur;sl_cur=sl_next;sl_next=(sl_next==(NSLOT-1)*SLOTB)?0:sl_next+SLOTB;}while(0)
  DMA_K(2,2*SLOTB);
  WAIT_BAR(4);
  qkt(pA0,pA1,Kbase,qr,zero16,r32,hi);asm volatile("s_nop 15\n\ts_nop 7":"+v"(pA0),"+v"(pA1));CMASK(pA0,pA1,0);
  _Pragma("unroll") for(int r=0;r<16;++r){ pA0[r]=-INFINITY; if(r<8)pA1[r]=-INFINITY; }
  _Pragma("unroll") for(int r=0;r<16;++r)pA0[r]=__builtin_amdgcn_exp2f(pA0[r]);
  _Pragma("unroll") for(int r=0;r<16;++r)pA1[r]=__builtin_amdgcn_exp2f(pA1[r]);
  WAIT_BAR(0);
  DMA_K(3,0);DMA_V(1,SLOTB);
  ROT();
  kload8(kf,kp0+sl_cur);
  WAIT_BAR(3);
  s16x4 vlo[4],vhi[4]; u32x4 pwa0,pwa1,pwa2,pwa3,pwb0,pwb1,pwb2,pwb3;
  #define PKW(P,B) cvtpk_s(P[B],P[B+1])
  #define PAFX(P,k) __builtin_bit_cast(bf16x8,P##k)
  #define VFR(i) (bf16x8){vlo[i][0],vlo[i][1],vlo[i][2],vlo[i][3],vhi[i][0],vhi[i][1],vhi[i][2],vhi[i][3]}
  #define PIN(x) asm volatile("":"+v"(x))
  #define MX3(a,b,c) __builtin_fmaxf(__builtin_fmaxf((a),(b)),(c))
  #define EX(v) __builtin_amdgcn_exp2f(v)
  #define VRD(s,i) do{ vlo[s]=vtr(vp_+(((i)>>2)*4096+((i)&3)*1024)); vhi[s]=vtr(vp_+(((i)>>2)*4096+((i)&3)*1024+512)); }while(0)
  #define KRD(G,j) do{ if(G){ kload2(kf,kp0+sl_next,j); SBAR(); } }while(0)
  #define GAPA(MF) do{ MF; SBAR(); }while(0)
  #define GAPB(MF,RD,X,B,PV_,W) do{ MF; RD; X[B]=EX(X[B]); X[B+1]=EX(X[B+1]); sacc+=X[B]; sacc+=X[B+1]; PIN(sacc); PV_[W]=cvtpk_s(X[B],X[B+1]); PIN(PV_); SBAR(); }while(0)
  #define STEP(C0,C1,PP,PC,t,GK,GV,GL) do{ SBAR(); \
    const lds_cptr vp_=vp0+2*sl_prev; \
    GAPA(C0=__builtin_amdgcn_mfma_f32_32x32x16_bf16(kf[0],qr[0],zero16,0,0,0)); GAPA(C1=__builtin_amdgcn_mfma_f32_32x32x16_bf16(kf[1],qr[0],zero16,0,0,0)); GAPA(C0=__builtin_amdgcn_mfma_f32_32x32x16_bf16(kf[2],qr[1],C0,0,0,0)); GAPA(C1=__builtin_amdgcn_mfma_f32_32x32x16_bf16(kf[3],qr[1],C1,0,0,0)); VRD(0,0); SBAR(); GAPA(C0=__builtin_amdgcn_mfma_f32_32x32x16_bf16(kf[4],qr[2],C0,0,0,0)); VRD(1,4); SBAR(); GAPA(C1=__builtin_amdgcn_mfma_f32_32x32x16_bf16(kf[5],qr[2],C1,0,0,0)); VRD(2,8); SBAR(); GAPA(C0=__builtin_amdgcn_mfma_f32_32x32x16_bf16(kf[6],qr[3],C0,0,0,0)); VRD(3,12); SBAR(); GAPA(C1=__builtin_amdgcn_mfma_f32_32x32x16_bf16(kf[7],qr[3],C1,0,0,0)); \
    if(GK){DMA_K((t)+3,sl_cur);} if(GV){DMA_V((t)+1,sl_next);} \
    CMASK(C0,C1,t); \
    SBAR(); float sacc=0.f; \
    GAPB(o[0]=__builtin_amdgcn_mfma_f32_32x32x16_bf16(PAFX(PP,0),VFR(0),o[0],0,0,0), VRD(0,1), C0,0, PC##0,0); \
    GAPB(o[1]=__builtin_amdgcn_mfma_f32_32x32x16_bf16(PAFX(PP,0),VFR(1),o[1],0,0,0), VRD(1,5), C0,2, PC##0,1); \
    GAPB(o[2]=__builtin_amdgcn_mfma_f32_32x32x16_bf16(PAFX(PP,0),VFR(2),o[2],0,0,0), VRD(2,9), C0,4, PC##0,2); \
    GAPB(o[3]=__builtin_amdgcn_mfma_f32_32x32x16_bf16(PAFX(PP,0),VFR(3),o[3],0,0,0), VRD(3,13), C0,6, PC##0,3); \
    GAPB(o[0]=__builtin_amdgcn_mfma_f32_32x32x16_bf16(PAFX(PP,1),VFR(0),o[0],0,0,0), VRD(0,2), C0,8, PC##1,0); \
    GAPB(o[1]=__builtin_amdgcn_mfma_f32_32x32x16_bf16(PAFX(PP,1),VFR(1),o[1],0,0,0), VRD(1,6), C0,10, PC##1,1); \
    GAPB(o[2]=__builtin_amdgcn_mfma_f32_32x32x16_bf16(PAFX(PP,1),VFR(2),o[2],0,0,0), VRD(2,10), C0,12, PC##1,2); \
    GAPB(o[3]=__builtin_amdgcn_mfma_f32_32x32x16_bf16(PAFX(PP,1),VFR(3),o[3],0,0,0), VRD(3,14), C0,14, PC##1,3); \
    GAPB(o[0]=__builtin_amdgcn_mfma_f32_32x32x16_bf16(PAFX(PP,2),VFR(0),o[0],0,0,0), VRD(0,3), C1,0, PC##2,0); \
    GAPB(o[1]=__builtin_amdgcn_mfma_f32_32x32x16_bf16(PAFX(PP,2),VFR(1),o[1],0,0,0), VRD(1,7), C1,2, PC##2,1); \
    GAPB(o[2]=__builtin_amdgcn_mfma_f32_32x32x16_bf16(PAFX(PP,2),VFR(2),o[2],0,0,0), VRD(2,11), C1,4, PC##2,2); \
    GAPB(o[3]=__builtin_amdgcn_mfma_f32_32x32x16_bf16(PAFX(PP,2),VFR(3),o[3],0,0,0), VRD(3,15), C1,6, PC##2,3); \
    KRD(GL,0); GAPB(o[0]=__builtin_amdgcn_mfma_f32_32x32x16_bf16(PAFX(PP,3),VFR(0),o[0],0,0,0), (void)0, C1,8, PC##3,0); \
    KRD(GL,1); GAPB(o[1]=__builtin_amdgcn_mfma_f32_32x32x16_bf16(PAFX(PP,3),VFR(1),o[1],0,0,0), (void)0, C1,10, PC##3,1); \
    KRD(GL,2); GAPB(o[2]=__builtin_amdgcn_mfma_f32_32x32x16_bf16(PAFX(PP,3),VFR(2),o[2],0,0,0), (void)0, C1,12, PC##3,2); \
    KRD(GL,3); GAPB(o[3]=__builtin_amdgcn_mfma_f32_32x32x16_bf16(PAFX(PP,3),VFR(3),o[3],0,0,0), (void)0, C1,14, PC##3,3); \
    l_reg+=sacc; \
    }while(0)
  { float sacc=pA0[0]+pA0[1]; _Pragma("unroll") for(int r=2;r<16;++r)sacc+=pA0[r]; _Pragma("unroll") for(int r=0;r<16;++r)sacc+=pA1[r]; l_reg+=sacc;
    pwa0=(u32x4){PKW(pA0,0),PKW(pA0,2),PKW(pA0,4),PKW(pA0,6)};pwa1=(u32x4){PKW(pA0,8),PKW(pA0,10),PKW(pA0,12),PKW(pA0,14)};pwa2=(u32x4){PKW(pA1,0),PKW(pA1,2),PKW(pA1,4),PKW(pA1,6)};pwa3=(u32x4){PKW(pA1,8),PKW(pA1,10),PKW(pA1,12),PKW(pA1,14)}; }
  pwb0=pwa0;pwb1=pwa1;pwb2=pwa2;pwb3=pwa3;
  int t=1;
  #undef CMASK
  #define CMASK(P0,P1,t) do{int jb_=(t)-(NT-4); if(jb_>=0)cmask(P0,P1,jb_,qrel,hi);}while(0)
  #define ENDW(tt) do{ if((tt)+3<NT){WAIT_BAR(3);} else if((tt)+2<NT){WAIT_BAR(2);} else {WAIT_BAR(0);} }while(0)
  for(;t+2<NT;t+=2){
    STEP(pA0,pA1,pwa,pwb,t,(t+3<NT),(t+1<NT),(t+1<NT));       ENDW(t);   ROT();
    STEP(pA0,pA1,pwb,pwa,t+1,(t+4<NT),(t+2<NT),(t+2<NT));     ENDW(t+1); ROT();
  }
  STEP(pA0,pA1,pwa,pwb,t,false,true,true); WAIT_BAR(0); ROT();
  STEP(pA0,pA1,pwb,pwa,NT-1,false,false,false);
  SBAR(); pv(o,vb0+2*sl_cur,PAFX(pwa,0),PAFX(pwa,1),PAFX(pwa,2),PAFX(pwa,3));
  #undef PAFX
  #undef PKW
  #undef VFR
  #undef PIN
  #undef MX3
  #undef GAPA
  #undef GAPB
  #undef EX
  #undef VRD
  #undef KRD
  #undef STEP
  #undef ENDW
  {auto rr=__builtin_amdgcn_permlane32_swap(__float_as_uint(l_reg),__float_as_uint(l_reg),false,false);l_reg=__uint_as_float(rr[0])+__uint_as_float(rr[1]);}
  if(hi==0)wsf[32+r32]=l_reg;asm volatile("s_waitcnt lgkmcnt(0)":::"memory");
  float rli[16];
  #pragma unroll
  for(int r=0;r<16;++r)rli[r]=__builtin_amdgcn_rcpf(wsf[32+crow(r,hi)]);
  bf16*Ow=O+(rowbase+q0+wid*QBLK)*DOP+h*128;
  { bf16*stg=(bf16*)(shm+LDS_OST)+wid*4096;
    #pragma unroll
    for(int r=0;r<16;++r){const int orow=crow(r,hi);
      #pragma unroll
      for(int d0=0;d0<4;++d0)stg[orow*128+d0*32+r32]=__float2bfloat16(o[d0][r]*rli[r]);}
    asm volatile("s_waitcnt lgkmcnt(0)":::"memory");
    #pragma unroll
    for(int i=0;i<8;++i){const int row=i*4+(lane>>4),ch=lane&15; const u32x4 v=*(const u32x4*)(stg+row*128+ch*8); ATTN_STORE16(Ow+(long)row*DOP+ch*8,v);} }
  asm volatile("s_waitcnt lgkmcnt(0)\n\ts_barrier":::"memory");
  #undef DMA_K
  #undef DMA_V
  #undef CMASK
  #undef START
  #undef RESC
  #undef ROT
}
constexpr int ATTN_LDS_BYTES=LDS_BYTES;
struct AttnTensors { const bf16* Q; const bf16* K; const bf16* V; bf16* O; };
struct AttnUnit { int bh; int qb; };
struct StaticOrder {
  int vcu;
  __device__ __forceinline__ explicit StaticOrder(int grid,int block):vcu((block%8)*(grid/8)+block/8){}
  __device__ __forceinline__ bool next(int i,AttnUnit&u)const{ if(i>=2)return false; const int s=vcu&15; u.bh=vcu>>4; u.qb=(i==0)?31-s:s; return true; }
  __device__ __forceinline__ void a_ready(const AttnUnit&)const{}
  __device__ __forceinline__ void done(const AttnUnit&)const{}
};
template<class Sched,int THRL=8> __device__ __forceinline__ void attn_phase(char*lds,const AttnTensors&T,const Sched&S){
  AttnUnit u;
  _Pragma("unroll 1") for(int i=0;S.next(i,u);++i){ S.a_ready(u); attn_unit<THRL>(u.bh/NHEAD,u.bh%NHEAD,u.qb,T.Q,T.K,T.V,T.O,lds); S.done(u); }
}
#undef SBAR
#undef WAIT_BAR
}
#define GAS __attribute__((address_space(1)))
typedef unsigned v4u __attribute__((ext_vector_type(4)));
#define LDS_WAIT() asm volatile("s_waitcnt lgkmcnt(0)" ::: "memory")

#ifndef T_GEMM_Z
#define T_GEMM_Z 1
#endif
#ifndef T_GEMM_GLU
#define T_GEMM_GLU 1
#endif
#ifndef T_GEMM_MIX
#define T_GEMM_MIX 1
#endif
#ifndef T_GEMM_WO
#define T_GEMM_WO 1
#endif
#ifndef T_MOE
#define T_MOE 1
#endif
#ifndef XN_UNR
#define XN_UNR 4
#endif
#ifndef T_S5
#define T_S5 1
#endif
#ifndef T_ATTN
#define T_ATTN 2
#endif
#ifndef T_ROUTER
#define T_ROUTER 1
#endif
#ifndef COOP_LAUNCH
#define COOP_LAUNCH 0
#endif
#ifndef T_GATE8
#define T_GATE8 0
#endif
#ifndef T_WO8
#define T_WO8 0
#endif
#ifndef T_MIXCAT
#define T_MIXCAT 1
#endif
#ifndef T_H1B
#define T_H1B 0
#endif
#ifndef DN_LATE
#define DN_LATE 16
#endif
#ifndef DN_MID
#define DN_MID 8
#endif
#ifndef T_FP8
#define T_FP8 1
#endif

template <bool GATHER>
__device__ __forceinline__ void gemm_core(f32x4 (&acc)[2][2], bool act, const bf16_t* __restrict__ A, int lda, const int* __restrict__ rowidx, int m0,
                                          const float* __restrict__ B, int ldb, int n0, int K, bf16_t* As, bf16_t* Bs) {
    const int tid = threadIdx.x & 255, lane = tid & 63, w = tid >> 6, wm = w >> 1, wn = w & 1;
    const int ar = tid >> 2, ak = (tid & 3) * 8, bk = tid >> 3, bn = (tid & 7) * 8;
    int arow = m0 + ar; if (GATHER) arow = act ? rowidx[m0 + ar] : -1;
#pragma unroll
    for (int i = 0; i < 2; ++i)
#pragma unroll
        for (int j = 0; j < 2; ++j) acc[i][j] = (f32x4){0.f, 0.f, 0.f, 0.f};
    for (int k0 = 0; k0 < K; k0 += 32) {
        uint4 av = make_uint4(0, 0, 0, 0); f32x4 b0 = (f32x4){0.f, 0.f, 0.f, 0.f}, b1 = b0;
        if (act) {
            if (arow >= 0) av = *(const uint4*)(A + (size_t)arow * lda + k0 + ak);
            b0 = *(const f32x4*)(B + (size_t)(k0 + bk) * ldb + n0 + bn); b1 = *(const f32x4*)(B + (size_t)(k0 + bk) * ldb + n0 + bn + 4);
        }
        __syncthreads();
        *(uint4*)(As + ar * 40 + ak) = av;
#pragma unroll
        for (int i = 0; i < 4; ++i) { Bs[(bn + i) * 40 + bk] = (bf16_t)f2bf(b0[i]); Bs[(bn + 4 + i) * 40 + bk] = (bf16_t)f2bf(b1[i]); }
        __syncthreads();
        bf16x8 a[2], b[2];
#pragma unroll
        for (int i = 0; i < 2; ++i) { a[i] = *(const bf16x8*)(As + (wm * 32 + i * 16 + (lane & 15)) * 40 + 8 * (lane >> 4)); b[i] = *(const bf16x8*)(Bs + (wn * 32 + i * 16 + (lane & 15)) * 40 + 8 * (lane >> 4)); }
#pragma unroll
        for (int i = 0; i < 2; ++i)
#pragma unroll
            for (int j = 0; j < 2; ++j) acc[i][j] = __builtin_amdgcn_mfma_f32_16x16x32_bf16(a[i], b[j], acc[i][j], 0, 0, 0);
    }
}
#define SG_LOOP(ntm, ntn) \
    bf16_t* As = (bf16_t*)(F.lds + (F.tid >> 8) * 16384); bf16_t* Bs = As + 64 * 40; \
    const int ntiles_ = (ntm) * (ntn), stride_ = 2 * F.G; \
    for (int it_ = 0; it_ * stride_ < ntiles_; ++it_) { \
        int t_ = it_ * stride_ + F.vcu * 2 + (F.tid >> 8); const bool act = t_ < ntiles_; if (!act) t_ = ntiles_ - 1; \
        const int m0 = (t_ / (ntn)) * 64, n0 = (t_ % (ntn)) * 64; (void)m0; (void)n0;
#define SG_END } __syncthreads();
#define EPI_LOOP(...) \
    if (act) { const int lane_ = threadIdx.x & 63, w_ = (threadIdx.x >> 6) & 3, wm_ = w_ >> 1, wn_ = w_ & 1; \
      _Pragma("unroll") for (int mi = 0; mi < 2; ++mi) _Pragma("unroll") for (int ni = 0; ni < 2; ++ni) _Pragma("unroll") for (int r = 0; r < 4; ++r) { \
        const int row = m0 + wm_ * 32 + mi * 16 + (lane_ >> 4) * 4 + r, col = n0 + wn_ * 32 + ni * 16 + (lane_ & 15); __VA_ARGS__ } }

struct CpItem { const float* src; bf16_t* dst; };
__device__ __forceinline__ void cp_load(const CpItem& c, int N, float (&wv)[32], int lane) {
#pragma unroll
    for (int i = 0; i < 32; ++i) wv[i] = __builtin_nontemporal_load(c.src + (size_t)(2 * i + (lane >> 5)) * N + (lane & 31));
}
__device__ __forceinline__ void cp_store(const CpItem& c, int K, const float (&wv)[32], LAS float* scr, int lane) {
#pragma unroll
    for (int i = 0; i < 32; ++i) scr[(2 * i + (lane >> 5)) * 33 + (lane & 31)] = wv[i];
    LDS_WAIT(); asm volatile("" ::: "memory");
    const int cc = lane & 7;
#pragma unroll
    for (int j = 0; j < 4; ++j) { const int n = (lane >> 3) + 8 * j; const LAS float* sp = scr + (8 * cc) * 33 + n;
        v4u o; o.x = pk2(sp[0 * 33], sp[1 * 33]); o.y = pk2(sp[2 * 33], sp[3 * 33]); o.z = pk2(sp[4 * 33], sp[5 * 33]); o.w = pk2(sp[6 * 33], sp[7 * 33]);
        *(GAS v4u*)(c.dst + (size_t)n * K + 8 * cc) = o; }
    LDS_WAIT(); asm volatile("" ::: "memory");
}
__device__ __forceinline__ void cp_store8(const CpItem& c, int K, const float (&wv)[32], LAS float* scr, int lane) {
#pragma unroll
    for (int i = 0; i < 32; ++i) scr[(2 * i + (lane >> 5)) * 33 + (lane & 31)] = wv[i] * 32.f;
    LDS_WAIT(); asm volatile("" ::: "memory");
    const int cc = lane & 3;
#pragma unroll
    for (int j = 0; j < 2; ++j) { const int n = (lane >> 2) + 16 * j; const LAS float* sp = scr + (16 * cc) * 33 + n;
        v4u o; o.x = pg8::pk4_fp8(sp[0 * 33], sp[1 * 33], sp[2 * 33], sp[3 * 33]); o.y = pg8::pk4_fp8(sp[4 * 33], sp[5 * 33], sp[6 * 33], sp[7 * 33]);
        o.z = pg8::pk4_fp8(sp[8 * 33], sp[9 * 33], sp[10 * 33], sp[11 * 33]); o.w = pg8::pk4_fp8(sp[12 * 33], sp[13 * 33], sp[14 * 33], sp[15 * 33]);
        __builtin_nontemporal_store(o, (GAS v4u*)((unsigned char*)c.dst + (size_t)n * K + 16 * cc)); }
    LDS_WAIT(); asm volatile("" ::: "memory");
}
template <int MODE, bool FP8 = false>
__device__ __forceinline__ void cp_set(Frame& F, const float* W, int K, int N, bf16_t* WT, int ne, int ncols = 0, int dpitch = 0, int koff = 0, int gwo = -1, int ngwo = 0) {
    const int gw = gwo >= 0 ? gwo : F.vcu * NWAVES + F.wave, NGW = gwo >= 0 ? ngwo : F.G * NWAVES, lane = F.lane;
    LAS float* scr = (LAS float*)(F.lds3 + F.wave * 16384);
    const int nbn = (ncols ? ncols : N) / 32, ipm = (K / 64) * nbn, nitems = ne * ipm;
    auto dec = [&](int it) { CpItem c; const int e = it / ipm, q = it % ipm, kb = q / nbn, n0 = 32 * (q % nbn);
        const size_t drow = MODE == 0 ? (size_t)e * N + n0 : (size_t)e * 2048 + 256 * (n0 / 128) + 128 * (MODE - 1) + (n0 % 128);
        c.src = W + (size_t)e * K * N + (size_t)(64 * kb) * N + n0; c.dst = FP8 ? (bf16_t*)((unsigned char*)WT + drow * K + 64 * kb) : WT + drow * (dpitch ? dpitch : K) + koff + 64 * kb; return c; };
    int it = gw; if (it >= nitems) return;
    CpItem c0 = dec(it); float wa[32], wb[32];
    cp_load(c0, N, wa, lane);
    for (;;) {
        const int itn = it + NGW; const bool hn = itn < nitems; CpItem c1 = c0;
        if (hn) { c1 = dec(itn); cp_load(c1, N, wb, lane); }
        if constexpr (FP8) cp_store8(c0, K, wa, scr, lane); else cp_store(c0, dpitch ? dpitch : K, wa, scr, lane);
        if (!hn) break;
#pragma unroll
        for (int i = 0; i < 32; ++i) wa[i] = wb[i];
        c0 = c1; it = itn;
    }
}
__device__ __forceinline__ void cp_all(Frame& F) {
    cp_set<0>(F, F.w_in, D, INW, F.Wt_in, 1); if (T_GATE8) cp_set<0, true>(F, F.w_in + 2048, D, INW, F.Wt_in8, 1, 2048); cp_set<0>(F, F.w_glu, SW, SW, F.Wt_glu, 1); if (T_MIXCAT) { cp_set<0>(F, F.w_ao, AW, D, F.Wt_so, 1, 0, 1024, 0); cp_set<0>(F, F.w_so, SW, D, F.Wt_so, 1, 0, 1024, 512); }
    else { cp_set<0>(F, F.w_so, SW, D, F.Wt_so, 1); cp_set<0>(F, F.w_ao, AW, D, F.Wt_ao, 1); } cp_set<0, T_WO8>(F, F.w_o, D, D, F.Wt_o, 1);
    if (T_MOE) { cp_set<1, T_FP8>(F, F.w_gate, D, D, F.Wt_gu, NE); cp_set<2, T_FP8>(F, F.w_up, D, D, F.Wt_gu, NE); cp_set<0, T_FP8>(F, F.w_down, D, D, F.Wt_dn, NE - (T_GEMM_GLU ? DN_LATE : 0) - DN_MID); }
}
__device__ __forceinline__ void p0_meta(Frame& F) {
    float* xm = (float*)F.lds;
    float* red = xm + 16 * 1025;
    for (int rr = 0; rr < 2; ++rr) {
        const int row = 2 * F.wave + rr; const float* src = F.meta + (size_t)row * D;
        f32x4 v[4]; float ss = 0.f;
#pragma unroll
        for (int j = 0; j < 4; ++j) { v[j] = *(const f32x4*)(src + 256 * j + 4 * F.lane); ss += v[j][0] * v[j][0] + v[j][1] * v[j][1] + v[j][2] * v[j][2] + v[j][3] * v[j][3]; }
        ss = wave_sum(ss);
        const float rs = rsqrtf(ss * (1.f / D) + EPS);
#pragma unroll
        for (int j = 0; j < 4; ++j) { const f32x4 gg = *(const f32x4*)(F.norm_mix_g + 256 * j + 4 * F.lane);
#pragma unroll
            for (int q = 0; q < 4; ++q) xm[row * 1025 + 256 * j + 4 * F.lane + q] = v[j][q] * rs * gg[q]; }
    }
    __syncthreads();
    const int c = F.tid & 15, kq = F.tid >> 4;
    for (int cgp = F.vcu; cgp < INW / 16; cgp += F.G) {
        const int col = 16 * cgp + c;
        float wv[32];
#pragma unroll
        for (int i = 0; i < 32; ++i) wv[i] = F.w_in[(size_t)(32 * kq + i) * INW + col];
        float acc[16];
#pragma unroll
        for (int r = 0; r < 16; ++r) acc[r] = 0.f;
#pragma unroll
        for (int i = 0; i < 32; ++i)
#pragma unroll
            for (int r = 0; r < 16; ++r) acc[r] += xm[r * 1025 + 32 * kq + i] * wv[i];
#pragma unroll
        for (int r = 0; r < 16; ++r) red[(kq * 16 + r) * 16 + c] = acc[r];
        __syncthreads();
        if (F.tid < 256) { float v = 0.f;
#pragma unroll
            for (int q = 0; q < 32; ++q) v += red[q * 256 + F.tid];
            F.ZM[(F.tid >> 4) * INW + 16 * cgp + (F.tid & 15)] = (bf16_t)f2bf(v); }
        __syncthreads();
    }
}
__device__ __forceinline__ void s_prologue(Frame& F) {
    if (!(F.mode & 4)) p0_meta(F);
    const int gw = F.vcu * NWAVES + F.wave, NGW = F.G * NWAVES, lane = F.lane;
    if (!(F.mode & 8)) cp_all(F);
    if (!(F.mode & 16)) {
      f32x4 gg[4];
#pragma unroll
      for (int j = 0; j < 4; ++j) gg[j] = *(const f32x4*)(F.norm_mix_g + 256 * j + 4 * lane);
      for (int row0 = gw; row0 < M; row0 += XN_UNR * NGW) {
        f32x4 v[XN_UNR][4];
#pragma unroll
        for (int u = 0; u < XN_UNR; ++u)
#pragma unroll
            for (int j = 0; j < 4; ++j) v[u][j] = __builtin_nontemporal_load((const f32x4*)(F.x + (size_t)(row0 + u * NGW) * D + 256 * j + 4 * lane));
#pragma unroll
        for (int u = 0; u < XN_UNR; ++u) { const int row = row0 + u * NGW; float ss = 0.f;
#pragma unroll
            for (int j = 0; j < 4; ++j) ss += v[u][j][0] * v[u][j][0] + v[u][j][1] * v[u][j][1] + v[u][j][2] * v[u][j][2] + v[u][j][3] * v[u][j][3];
            ss = wave_sum(ss);
            const float rs = rsqrtf(ss * (1.f / D) + EPS);
#pragma unroll
            for (int j = 0; j < 4; ++j) {
                *(uint2*)(F.XN + (size_t)row * D + 256 * j + 4 * lane) = make_uint2(pk2(v[u][j][0] * rs * gg[j][0], v[u][j][1] * rs * gg[j][1]), pk2(v[u][j][2] * rs * gg[j][2], v[u][j][3] * rs * gg[j][3]));
                if (T_GATE8) *(unsigned*)((unsigned char*)F.XN8 + (size_t)row * D + 256 * j + 4 * lane) = pg8::pk4_fp8(v[u][j][0] * rs * gg[j][0], v[u][j][1] * rs * gg[j][1], v[u][j][2] * rs * gg[j][2], v[u][j][3] * rs * gg[j][3]);
            } }
      }
    }
    const int gt = F.vcu * NTHR + F.tid, NGT = F.G * NTHR;
    for (int idx = gt; idx < NG * NP * NC; idx += NGT) {
        const int gp = idx / NC, c = idx % NC, g = gp / NP, p = gp % NP;
        const float lr = fminf(F.a_re[gp], -1e-4f), li = F.a_im[gp], dt = expf(F.log_dt[g]);
        const float mag = expf(lr * dt), ar = mag * cosf(li * dt), ai = mag * sinf(li * dt);
        const float den = lr * lr + li * li, fr = ((ar - 1.f) * lr + ai * li) / den, fi = (ai * lr - (ar - 1.f) * li) / den;
        const float br = F.b_re[gp * NC + c], bi = F.b_im[gp * NC + c]; const float bbr = fr * br - fi * bi, bbi = fr * bi + fi * br;
        F.BB[gp * 32 + c] = bbr; F.BB[gp * 32 + 16 + c] = bbi; F.BBH[gp * 32 + c] = (bf16_t)f2bf(bbr); F.BBH[gp * 32 + 16 + c] = (bf16_t)f2bf(bbi);
        F.CMT[(g * NC + c) * 128 + 2 * p] = (bf16_t)f2bf(F.c_re[(g * NC + c) * NP + p]); F.CMT[(g * NC + c) * 128 + 2 * p + 1] = (bf16_t)f2bf(-F.c_im[(g * NC + c) * NP + p]);
        if (c == 0) { float pr = ar, pi = ai;
            for (int i = 0; i < 6; ++i) { const float nr = pr * pr - pi * pi, ni = 2.f * pr * pi; pr = nr; pi = ni; }
            F.AA[gp * 4 + 0] = ar; F.AA[gp * 4 + 1] = ai; F.AA[gp * 4 + 2] = pr; F.AA[gp * 4 + 3] = pi; }
    }
    if (gt == 0) { float s1 = 0.f, s2 = 0.f; for (int i = 0; i < 64; ++i) { s1 += F.lq1[i] * F.lk1[i]; s2 += F.lq2[i] * F.lk2[i]; } F.LAM[0] = expf(s1) - expf(s2) + 0.2f; }
    for (int i = gt; i < MOE_ROWS; i += NGT) { F.ROWTOK[i] = 0; F.ROWTK[i] = -1; }
}
__device__ __forceinline__ void s_gemm_z(Frame& F) {
    SG_LOOP(M / 64, INW / 64)
        f32x4 acc[2][2];
        gemm_core<false>(acc, act, F.XN, D, nullptr, m0, F.w_in, INW, n0, D, As, Bs);
        EPI_LOOP({ F.Z[(size_t)row * INW + col] = (bf16_t)f2bf(acc[mi][ni][r]); })
    SG_END
}
template <bool FINAL>
__device__ __forceinline__ void s_s5_scan(Frame& F) {
    const int gw = F.vcu * NWAVES + F.wave, NGW = F.G * NWAVES, p = F.lane;
    for (int it = gw; it < BATCH * NCHUNK * NG; it += NGW) {
        const int bc = it / NG, g = it % NG, gp = g * NP + p;
        const int row0 = bc * 64;
        float bbr[16], bbi[16];
#pragma unroll
        for (int c = 0; c < 16; ++c) { bbr[c] = F.BB[gp * 32 + c]; bbi[c] = F.BB[gp * 32 + 16 + c]; }
        const float ar = F.AA[gp * 4], ai = F.AA[gp * 4 + 1];
        float sr = 0.f, si = 0.f;
        const size_t eidx = ((size_t)bc * NG + g) * NP + p;
        float cr[16], ci[16]; float dd = 0.f;
        if (FINAL) { sr = F.SIN[eidx * 2]; si = F.SIN[eidx * 2 + 1];
#pragma unroll
            for (int c = 0; c < 16; ++c) { cr[c] = F.c_re[(g * NC + c) * NP + p]; ci[c] = F.c_im[(g * NC + c) * NP + p]; }
            dd = F.ssm_d[g * NC + (p & 15)]; }
        for (int t = 0; t < 64; ++t) {
            const bf16_t* zr = F.Z + (size_t)(row0 + t) * INW + g * NC;
            const uint4 u0 = *(const uint4*)zr, u1 = *(const uint4*)(zr + 8);
            const unsigned uw[8] = {u0.x, u0.y, u0.z, u0.w, u1.x, u1.y, u1.z, u1.w};
            float bur = 0.f, bui = 0.f;
#pragma unroll
            for (int c = 0; c < 8; ++c) { const float ua = bf2f(uw[c] & 0xffffu), ub = bf2f(uw[c] >> 16); bur += bbr[2 * c] * ua + bbr[2 * c + 1] * ub; bui += bbi[2 * c] * ua + bbi[2 * c + 1] * ub; }
            const float nr = ar * sr - ai * si + bur, ni = ar * si + ai * sr + bui; sr = nr; si = ni;
            if (FINAL) {
                float ymine = 0.f;
#pragma unroll
                for (int c = 0; c < 16; ++c) { const float yc = wave_sum(cr[c] * sr - ci[c] * si); if ((p & 15) == c) ymine = yc; }
                if (p < 16) { const float uu = bf2f(F.Z[(size_t)(row0 + t) * INW + g * NC + p]); F.YS[(size_t)(row0 + t) * SW + g * NC + p] = (bf16_t)f2bf(gelu_tanh(ymine + dd * uu)); }
            }
        }
        if (!FINAL) { F.E[eidx * 2] = sr; F.E[eidx * 2 + 1] = si; }
    }
}
__device__ __forceinline__ void s_s5_carry(Frame& F) {
    const int gt = F.vcu * NTHR + F.tid;
    if (gt < BATCH * NG * NP) {
        const int b = gt / (NG * NP), gp = gt % (NG * NP), g = gp / NP;
        const float ar = F.AA[gp * 4], ai = F.AA[gp * 4 + 1], a64r = F.AA[gp * 4 + 2], a64i = F.AA[gp * 4 + 3];
        float sr = 0.f, si = 0.f;
        for (int t = 0; t < NMETA; ++t) {
            float bur = 0.f, bui = 0.f;
            for (int c = 0; c < NC; ++c) { const float u = bf2f(F.ZM[t * INW + g * NC + c]); bur += F.BB[gp * 32 + c] * u; bui += F.BB[gp * 32 + 16 + c] * u; }
            const float nr = ar * sr - ai * si + bur, ni = ar * si + ai * sr + bui; sr = nr; si = ni;
        }
        for (int c = 0; c < NCHUNK; ++c) {
            const size_t e = ((size_t)(b * NCHUNK + c) * NG * NP + gp) * 2;
            F.SIN[e] = sr; F.SIN[e + 1] = si;
            const float er = F.E[e], ei = F.E[e + 1];
            const float nr = a64r * sr - a64i * si + er, ni = a64r * si + a64i * sr + ei; sr = nr; si = ni;
        }
    }
}
__device__ __forceinline__ void s_qkn(Frame& F) {
    const int gw = F.vcu * NWAVES + F.wave, NGW = F.G * NWAVES, lane = F.lane;
    for (int row = gw; row < M + NMETA; row += NGW) {
        const bf16_t* zr = (row < M ? F.Z + (size_t)row * INW : F.ZM + (size_t)(row - M) * INW) + 512 + 16 * lane;
        const uint4 u0 = *(const uint4*)zr, u1 = *(const uint4*)(zr + 8);
        const unsigned uw[8] = {u0.x, u0.y, u0.z, u0.w, u1.x, u1.y, u1.z, u1.w};
        float v[16]; float ss = 0.f;
#pragma unroll
        for (int c = 0; c < 8; ++c) { v[2 * c] = bf2f(uw[c] & 0xffffu); v[2 * c + 1] = bf2f(uw[c] >> 16); ss += v[2 * c] * v[2 * c] + v[2 * c + 1] * v[2 * c + 1]; }
        ss += __shfl_xor(ss, 1); ss += __shfl_xor(ss, 2);
        const float rs = rsqrtf(ss * (1.f / 64.f) + EPS);
        const float* gg = (lane < 32 ? F.q_g : F.k_g) + 16 * (lane & 3);
        unsigned o[8];
#pragma unroll
        for (int c = 0; c < 8; ++c) o[c] = pk2(v[2 * c] * rs * gg[2 * c], v[2 * c + 1] * rs * gg[2 * c + 1]);
        bf16_t* qr = (row < M ? F.QKN + (size_t)row * D : F.QKNM + (size_t)(row - M) * D) + 16 * lane;
        *(uint4*)qr = make_uint4(o[0], o[1], o[2], o[3]); *(uint4*)(qr + 8) = make_uint4(o[4], o[5], o[6], o[7]);
    }
}
__device__ __forceinline__ void s_attn(Frame& F) {
    const int half = F.tid >> 8, tid = F.tid & 255, qrow = tid >> 2, part = tid & 3;
    float* Ks = (float*)(F.lds + half * 67584); float* Vs = Ks + 64 * 132;
    constexpr int NQB = SEQ / 64;
    for (int it = F.vcu; it < NQB * 2 * BATCH; it += F.G) {
        const int qb = NQB - 1 - it / (2 * BATCH), h = (it & 1) * 2 + half, b = (it >> 1) & 1;
        const int lq = qb * 64 + qrow + NMETA;
        const size_t tq = (size_t)b * SEQ + qb * 64 + qrow;
        float q0[16], q1[16];
        {
            const bf16_t* qp = F.QKN + tq * D + h * 128 + 16 * part;
#pragma unroll
            for (int d = 0; d < 16; ++d) { q0[d] = bf2f(qp[d]) * 0.125f; q1[d] = bf2f(qp[64 + d]) * 0.125f; }
        }
        float m0 = -1e30f, m1 = -1e30f, l0 = 0.f, l1 = 0.f, o0[32], o1[32];
#pragma unroll
        for (int d = 0; d < 32; ++d) { o0[d] = 0.f; o1[d] = 0.f; }
        for (int kt = 0; kt <= qb + 1; ++kt) {
            __syncthreads();
            for (int i = tid; i < 64 * 128; i += 256) {
                const int j = i >> 7, c = i & 127, lk = kt * 64 + j;
                float kv = 0.f, vv = 0.f;
                if (lk < NMETA) { kv = bf2f(F.QKNM[lk * D + 512 + h * 128 + c]); vv = bf2f(F.ZM[lk * INW + 1536 + h * 128 + c]); }
                else if (lk < NMETA + SEQ) { const size_t tk = (size_t)b * SEQ + lk - NMETA; kv = bf2f(F.QKN[tk * D + 512 + h * 128 + c]); vv = bf2f(F.Z[tk * INW + 1536 + h * 128 + c]); }
                Ks[j * 132 + c] = kv; Vs[j * 132 + c] = vv;
            }
            __syncthreads();
            for (int j = 0; j < 64; ++j) {
                const int lk = kt * 64 + j;
                float s0 = 0.f, s1 = 0.f;
#pragma unroll
                for (int d = 0; d < 16; ++d) { s0 += q0[d] * Ks[j * 132 + 16 * part + d]; s1 += q1[d] * Ks[j * 132 + 64 + 16 * part + d]; }
                s0 += __shfl_xor(s0, 1); s0 += __shfl_xor(s0, 2); s1 += __shfl_xor(s1, 1); s1 += __shfl_xor(s1, 2);
                if (lk <= lq) {
                    if (s0 > m0) { const float sc = __expf(m0 - s0); l0 *= sc;
#pragma unroll
                        for (int d = 0; d < 32; ++d) o0[d] *= sc; m0 = s0; }
                    if (s1 > m1) { const float sc = __expf(m1 - s1); l1 *= sc;
#pragma unroll
                        for (int d = 0; d < 32; ++d) o1[d] *= sc; m1 = s1; }
                    const float p0 = __expf(s0 - m0), p1 = __expf(s1 - m1); l0 += p0; l1 += p1;
#pragma unroll
                    for (int d = 0; d < 32; ++d) { const float v = Vs[j * 132 + 32 * part + d]; o0[d] += p0 * v; o1[d] += p1 * v; }
                }
            }
        }
        const float lam = F.LAM[0], i0 = 1.f / l0, i1 = lam / l1;
        float ss = 0.f;
#pragma unroll
        for (int d = 0; d < 32; ++d) { o0[d] = o0[d] * i0 - o1[d] * i1; ss += o0[d] * o0[d]; }
        ss += __shfl_xor(ss, 1); ss += __shfl_xor(ss, 2);
        const float rs = rsqrtf(ss * (1.f / 128.f) + EPS) * 0.8f;
        bf16_t* op = F.YA + tq * AW + h * 128 + 32 * part;
#pragma unroll
        for (int d = 0; d < 32; ++d) op[d] = (bf16_t)f2bf(o0[d] * rs * F.sub_g[32 * part + d]);
    }
    __syncthreads();
}
__device__ __forceinline__ void s_gemm_glu(Frame& F) {
    SG_LOOP(M / 64, SW / 64)
        f32x4 acc[2][2];
        gemm_core<false>(acc, act, F.YS, SW, nullptr, m0, F.w_glu, SW, n0, SW, As, Bs);
        EPI_LOOP({ const float ys = bf2f(F.YS[(size_t)row * SW + col]); F.YS2[(size_t)row * SW + col] = (bf16_t)f2bf(ys * sigmoidf_(acc[mi][ni][r] + F.b_glu[col])); })
    SG_END
}
__device__ __forceinline__ void s_gemm_mix(Frame& F) {
    SG_LOOP(M / 64, D / 64)
        f32x4 acc[2][2], acc2[2][2];
        gemm_core<false>(acc, act, F.YS2, SW, nullptr, m0, F.w_so, D, n0, SW, As, Bs);
        gemm_core<false>(acc2, act, F.YA, AW, nullptr, m0, F.w_ao, D, n0, AW, As, Bs);
        EPI_LOOP({ const float g0 = sigmoidf_(bf2f(F.Z[(size_t)row * INW + 2048 + col])), g1 = sigmoidf_(bf2f(F.Z[(size_t)row * INW + 3072 + col]));
                   F.MIX[(size_t)row * D + col] = (bf16_t)f2bf(g0 * acc[mi][ni][r] + g1 * acc2[mi][ni][r]); })
    SG_END
}
__device__ __forceinline__ void s_gemm_wo(Frame& F) {
    SG_LOOP(M / 64, D / 64)
        f32x4 acc[2][2];
        gemm_core<false>(acc, act, F.MIX, D, nullptr, m0, F.w_o, D, n0, D, As, Bs);
        EPI_LOOP({ const size_t o = (size_t)row * D + col; F.out[o] = F.x[o] + acc[mi][ni][r]; })
    SG_END
}
__device__ __forceinline__ void s_router(Frame& F) {
    const int gw = F.vcu * NWAVES + F.wave, NGW = F.G * NWAVES, lane = F.lane;
    for (int t = gw; t < M; t += NGW) {
        const float* hr = F.out + (size_t)t * D;
        float ss = 0.f;
#pragma unroll
        for (int j = 0; j < 4; ++j) { const f32x4 a = *(const f32x4*)(hr + 256 * j + 4 * lane); ss += a[0] * a[0] + a[1] * a[1] + a[2] * a[2] + a[3] * a[3]; }
        ss = wave_sum(ss);
        const float rs = rsqrtf(ss * (1.f / D) + EPS);
        float lg[NE];
#pragma unroll
        for (int e = 0; e < NE; ++e) lg[e] = 0.f;
#pragma unroll 1
        for (int j = 0; j < 4; ++j) {
            const f32x4 a = *(const f32x4*)(hr + 256 * j + 4 * lane), gg = *(const f32x4*)(F.norm_ffn_g + 256 * j + 4 * lane);
            const f32x4 v = a * rs * gg;
            *(uint2*)(F.XN2 + (size_t)t * D + 256 * j + 4 * lane) = make_uint2(pk2(v[0], v[1]), pk2(v[2], v[3]));
            const float* wr = F.w_router + (size_t)(256 * j + 4 * lane) * NE;
#pragma unroll
            for (int q = 0; q < 4; ++q)
#pragma unroll
                for (int e = 0; e < NE; e += 4) { const f32x4 w4 = *(const f32x4*)(wr + q * NE + e); lg[e] += v[q] * w4[0]; lg[e + 1] += v[q] * w4[1]; lg[e + 2] += v[q] * w4[2]; lg[e + 3] += v[q] * w4[3]; }
        }
#pragma unroll
        for (int e = 0; e < NE; ++e) lg[e] = wave_sum(lg[e]) + F.b_router[e];
        if (lane == 0) {
            int id[4]; float tv[4];
#pragma unroll
            for (int k = 0; k < 4; ++k) {
                float best = -3.4e38f; int bi = 0;
#pragma unroll
                for (int e = 0; e < NE; ++e) { const bool taken = (k > 0 && id[0] == e) || (k > 1 && id[1] == e) || (k > 2 && id[2] == e); if (!taken && lg[e] > best) { best = lg[e]; bi = e; } }
                id[k] = bi; tv[k] = best;
            }
            const float e0 = 1.f, e1 = __expf(tv[1] - tv[0]), e2 = __expf(tv[2] - tv[0]), e3 = __expf(tv[3] - tv[0]), inv = 1.f / (e0 + e1 + e2 + e3);
            const float gw4[4] = {e0 * inv, e1 * inv, e2 * inv, e3 * inv};
#pragma unroll
            for (int k = 0; k < 4; ++k) { F.IDX[t * 4 + k] = id[k]; F.GATE[t * 4 + k] = gw4[k]; F.POS[t * 4 + k] = atomicAdd(&F.CNT[id[k]], 1); }
        }
    }
}
__device__ __forceinline__ void s_scatter(Frame& F) {
    int* offs = (int*)F.lds;
    if (F.tid == 0) { int o = 0; for (int e = 0; e < NE; ++e) { offs[e] = o; o += (F.CNT[e] + 255) / 256 * 256; } offs[NE] = o; }
    __syncthreads();
    if (F.vcu == 0 && F.tid <= NE) F.OFF[F.tid] = offs[F.tid];
    if (F.vcu == 0) for (int mt = F.tid; mt < MOE_ROWS / 256; mt += NTHR) { int e = 0; while (e < NE - 1 && offs[e + 1] <= mt * 256) ++e; F.TEXP[mt] = e; }
    const int gt = F.vcu * NTHR + F.tid, NGT = F.G * NTHR;
    for (int a = gt; a < NASSIGN; a += NGT) { const int r = offs[F.IDX[a]] + F.POS[a]; F.ROWTOK[r] = a >> 2; F.ROWTK[r] = a; }
    __syncthreads();
}
__device__ __forceinline__ void t_scatter(Frame& F) {
    int* psum = (int*)F.lds;
    int* offs = psum + 512;
    int* base = offs + 64;
    { const int e = F.tid & 31, part = F.tid >> 5; int sacc = 0;
      for (int i = 0; i < 32; ++i) sacc += F.TCNT[(part * 32 + i) * NE + e];
      psum[part * 32 + e] = sacc; }
    __syncthreads();
    if (F.tid == 0) { int o = 0; for (int e = 0; e < NE; ++e) { int tot = 0; for (int p = 0; p < 16; ++p) tot += psum[p * 32 + e]; offs[e] = o; o += (tot + 255) / 256 * 256; } offs[NE] = o; }
    __syncthreads();
    if (F.vcu == 0 && F.tid <= NE) F.OFF[F.tid] = offs[F.tid];
    if (F.vcu == 0) for (int mt = F.tid; mt < MOE_ROWS / 256; mt += NTHR) { int e = 0; while (e < NE - 1 && offs[e + 1] <= mt * 256) ++e; F.TEXP[mt] = e; }
    for (int tile = F.vcu; tile < M / 32; tile += F.G) {
        if (F.tid < 32) { const int part = tile >> 5; int b = offs[F.tid];
            for (int p = 0; p < part; ++p) b += psum[p * 32 + F.tid];
            for (int t2 = part * 32; t2 < tile; ++t2) b += F.TCNT[t2 * NE + F.tid];
            base[F.tid] = b; }
        __syncthreads();
        if (F.tid < 128) { const int a = tile * 128 + F.tid, r = base[F.IDX[a]] + F.POS[a]; F.ROWTOK[r] = a >> 2; F.ROWTK[r] = a; }
        __syncthreads();
    }
}
__device__ __forceinline__ int tile_expert(const int* OFF, int m0) { int e = 0; while (e < NE - 1 && OFF[e + 1] <= m0) ++e; return e; }
__device__ __forceinline__ void s_moe1(Frame& F) {
    const int nrows = F.OFF[NE];
    SG_LOOP(nrows / 64, D / 64)
        const int e = tile_expert(F.OFF, m0);
        f32x4 acc[2][2], acc2[2][2];
        gemm_core<true>(acc, act, F.XN2, D, F.ROWTOK, m0, F.w_gate + (size_t)e * D * D, D, n0, D, As, Bs);
        gemm_core<true>(acc2, act, F.XN2, D, F.ROWTOK, m0, F.w_up + (size_t)e * D * D, D, n0, D, As, Bs);
        EPI_LOOP({ const float gg = fminf(acc[mi][ni][r] + F.b_gate[e * D + col], 7.f), uu = fminf(fmaxf(acc2[mi][ni][r] + F.b_up[e * D + col], -7.f), 7.f);
                   F.ACT[(size_t)row * D + col] = (bf16_t)f2bf((uu + 1.f) * (gg * sigmoidf_(1.702f * gg))); })
    SG_END
}
__device__ __forceinline__ void s_moe2(Frame& F) {
    const int nrows = F.OFF[NE];
    SG_LOOP(nrows / 64, D / 64)
        const int e = tile_expert(F.OFF, m0);
        f32x4 acc[2][2];
        gemm_core<false>(acc, act, F.ACT, D, nullptr, m0, F.w_down + (size_t)e * D * D, D, n0, D, As, Bs);
        EPI_LOOP({ const int tk = F.ROWTK[row]; if (tk >= 0) F.Y2[(size_t)tk * D + col] = (bf16_t)f2bf(acc[mi][ni][r] + F.b_down[e * D + col]); })
    SG_END
}
__device__ __forceinline__ void s_combine(Frame& F) {
    const int gw = F.vcu * NWAVES + F.wave, NGW = F.G * NWAVES, c = F.lane * 16;
    for (int t0 = gw * 2; t0 < M; t0 += NGW * 2) {
        f32x4 o[2][4]; uint4 y[2][4][2]; float gwt[2][4];
#pragma unroll
        for (int u = 0; u < 2; ++u) { const int t = t0 + u;
            if (T_H1B) { const uint4 h0 = *(const uint4*)(F.H1B + (size_t)t * D + c), h1 = *(const uint4*)(F.H1B + (size_t)t * D + c + 8);
                o[u][0] = (f32x4){bf2f(h0.x & 0xffffu), bf2f(h0.x >> 16), bf2f(h0.y & 0xffffu), bf2f(h0.y >> 16)}; o[u][1] = (f32x4){bf2f(h0.z & 0xffffu), bf2f(h0.z >> 16), bf2f(h0.w & 0xffffu), bf2f(h0.w >> 16)};
                o[u][2] = (f32x4){bf2f(h1.x & 0xffffu), bf2f(h1.x >> 16), bf2f(h1.y & 0xffffu), bf2f(h1.y >> 16)}; o[u][3] = (f32x4){bf2f(h1.z & 0xffffu), bf2f(h1.z >> 16), bf2f(h1.w & 0xffffu), bf2f(h1.w >> 16)}; }
            else
#pragma unroll
            for (int q = 0; q < 4; ++q) o[u][q] = *(const f32x4*)(F.out + (size_t)t * D + c + 4 * q);
#pragma unroll
            for (int k = 0; k < 4; ++k) { gwt[u][k] = F.GATE[t * 4 + k];
                if (T_FP8) { const v4u yv = __builtin_nontemporal_load((const v4u*)((const unsigned char*)F.Y2 + (size_t)(t * 4 + k) * D + c)); y[u][k][0] = make_uint4(yv[0], yv[1], yv[2], yv[3]); y[u][k][1] = y[u][k][0]; }
                else { y[u][k][0] = *(const uint4*)(F.Y2 + (size_t)(t * 4 + k) * D + c); y[u][k][1] = *(const uint4*)(F.Y2 + (size_t)(t * 4 + k) * D + c + 8); } } }
#pragma unroll
        for (int u = 0; u < 2; ++u) { const int t = t0 + u;
#pragma unroll
            for (int k = 0; k < 4; ++k) { const float gk = gwt[u][k];
                if (T_FP8) { const uint4 v = y[u][k][0]; const unsigned wv[4] = {v.x, v.y, v.z, v.w};
#pragma unroll
                    for (int q = 0; q < 4; ++q) { typedef float f32x2_ __attribute__((ext_vector_type(2)));
                        const f32x2_ lo = __builtin_amdgcn_cvt_pk_f32_fp8((int)wv[q], false), hi = __builtin_amdgcn_cvt_pk_f32_fp8((int)wv[q], true);
                        o[u][q][0] += gk * lo[0]; o[u][q][1] += gk * lo[1]; o[u][q][2] += gk * hi[0]; o[u][q][3] += gk * hi[1]; } }
                else {
#pragma unroll
                for (int hh = 0; hh < 2; ++hh) { const uint4 v = y[u][k][hh]; const unsigned wv[4] = {v.x, v.y, v.z, v.w};
#pragma unroll
                    for (int q = 0; q < 4; ++q) { o[u][2 * hh + (q >> 1)][2 * (q & 1)] += gk * bf2f(wv[q] & 0xffffu); o[u][2 * hh + (q >> 1)][2 * (q & 1) + 1] += gk * bf2f(wv[q] >> 16); } } } }
#pragma unroll
            for (int q = 0; q < 4; ++q) __builtin_nontemporal_store(o[u][q], (f32x4*)(F.out + (size_t)t * D + c + 4 * q)); }
    }
}

typedef float f32x16 __attribute__((ext_vector_type(16)));
__device__ __forceinline__ void cmul(float ar, float ai, float br, float bi, float& cr, float& ci) { cr = ar * br - ai * bi; ci = ar * bi + ai * br; }
template <bool FINAL>
__device__ __forceinline__ void t_s5_pass(Frame& F) {
    const int gw = F.vcu * NWAVES + F.wave, NGW = F.G * NWAVES, lane = F.lane, r32 = lane & 31, hi = lane >> 5;
    LAS unsigned char* sl = F.lds3 + F.wave * 17408;
    const int wpg = NGW / NG, g = gw / wpg, w0 = gw % wpg;
    if (g >= NG) return;
    bf16x8 bfr[4];
#pragma unroll
    for (int nt = 0; nt < 4; ++nt) bfr[nt] = *(const bf16x8*)(F.BBH + (size_t)(g * NP + 32 * (nt & 1) + r32) * 32 + 16 * (nt >> 1) + 8 * hi);
    float aar[2], aai[2];
#pragma unroll
    for (int set = 0; set < 2; ++set) { aar[set] = F.AA[(g * NP + 32 * set + r32) * 4]; aai[set] = F.AA[(g * NP + 32 * set + r32) * 4 + 1]; }
    bf16x8 afn[2];
    if (w0 < BATCH * NCHUNK) { afn[0] = *(const bf16x8*)(F.Z + ((size_t)w0 * 64 + r32) * INW + g * NC + 8 * hi); afn[1] = *(const bf16x8*)(F.Z + ((size_t)w0 * 64 + 32 + r32) * INW + g * NC + 8 * hi); }
    const int c16 = lane & 15, q = lane >> 4;
    bf16x8 cfr[4]; f32x4 dv = {};
    if (FINAL) {
#pragma unroll
        for (int ks = 0; ks < 4; ++ks) cfr[ks] = *(const bf16x8*)(F.CMT + (size_t)(g * NC + c16) * 128 + ks * 32 + 8 * q);
        dv = *(const f32x4*)(F.ssm_d + g * NC + 4 * q); }
    for (int bc = w0; bc < BATCH * NCHUNK; bc += wpg) {
        const size_t tok0 = (size_t)bc * 64;
        uint2 uu[4]; float sin0[2][2] = {{0.f, 0.f}, {0.f, 0.f}};
        if (FINAL) {
#pragma unroll
            for (int set = 0; set < 2; ++set) { const size_t e = ((size_t)bc * NG * NP + g * NP + 32 * set + r32) * 2; sin0[set][0] = F.SIN[e]; sin0[set][1] = F.SIN[e + 1]; }
#pragma unroll
            for (int t4 = 0; t4 < 4; ++t4) uu[t4] = *(const uint2*)(F.Z + (tok0 + 16 * t4 + c16) * INW + g * NC + 4 * q); }
        const bf16x8 afr0 = afn[0], afr1 = afn[1];
        if (bc + wpg < BATCH * NCHUNK) { const size_t tn = (size_t)(bc + wpg) * 64; afn[0] = *(const bf16x8*)(F.Z + (tn + r32) * INW + g * NC + 8 * hi); afn[1] = *(const bf16x8*)(F.Z + (tn + 32 + r32) * INW + g * NC + 8 * hi); }
        f32x16 bu[2][4];
#pragma unroll
        for (int nt = 0; nt < 4; ++nt) { f32x16 z = {}; bu[0][nt] = __builtin_amdgcn_mfma_f32_32x32x16_bf16(afr0, bfr[nt], z, 0, 0, 0); bu[1][nt] = __builtin_amdgcn_mfma_f32_32x32x16_bf16(afr1, bfr[nt], z, 0, 0, 0); }
        float ssr[2][2][16], ssi[2][2][16];
#pragma unroll
        for (int set = 0; set < 2; ++set) {
            const int p = 32 * set + r32, gp = g * NP + p;
            const float ar = aar[set], ai = aai[set];
            float a2r, a2i, a3r, a3i, a4r, a4i; cmul(ar, ai, ar, ai, a2r, a2i); cmul(a2r, a2i, ar, ai, a3r, a3i); cmul(a2r, a2i, a2r, a2i, a4r, a4i);
            float lr[8][4], li[8][4];
#pragma unroll
            for (int jj = 0; jj < 8; ++jj) {
                const int tt = jj >> 2, rb = jj & 3; float sr = 0.f, si = 0.f;
#pragma unroll
                for (int i = 0; i < 4; ++i) { const float br = bu[tt][set][4 * rb + i], bi = bu[tt][2 + set][4 * rb + i]; const float nr = ar * sr - ai * si + br, ni = ar * si + ai * sr + bi; sr = nr; si = ni; lr[jj][i] = sr; li[jj][i] = si; }
            }
            float cr = 0.f, ci = 0.f, sinr[8] = {0.f, 0.f, 0.f, 0.f, 0.f, 0.f, 0.f, 0.f}, sini[8] = {0.f, 0.f, 0.f, 0.f, 0.f, 0.f, 0.f, 0.f};
            if (FINAL) { cr = sin0[set][0]; ci = sin0[set][1]; }
#pragma unroll
            for (int j = 0; j < 16; ++j) {
                const int jj = j >> 1; const bool mine = (hi == (j & 1));
                sinr[jj] = mine ? cr : sinr[jj]; sini[jj] = mine ? ci : sini[jj];
                const float mr = a4r * cr - a4i * ci + lr[jj][3], mi = a4r * ci + a4i * cr + li[jj][3];
                const auto sr2 = __builtin_amdgcn_permlane32_swap(__float_as_uint(mr), __float_as_uint(mr), false, false), si2 = __builtin_amdgcn_permlane32_swap(__float_as_uint(mi), __float_as_uint(mi), false, false);
                cr = __uint_as_float(sr2[j & 1]); ci = __uint_as_float(si2[j & 1]);
            }
            if (!FINAL) { if (hi == 0) { const size_t e = (((size_t)(bc / NCHUNK) * NG * NP + gp) * NCHUNK + (bc % NCHUNK)) * 2; F.E[e] = cr; F.E[e + 1] = ci; } }
            else {
#pragma unroll
                for (int jj = 0; jj < 8; ++jj) {
                    const int tt = jj >> 2, rb = jj & 3;
                    const float pw_r[4] = {ar, a2r, a3r, a4r}, pw_i[4] = {ai, a2i, a3i, a4i};
#pragma unroll
                    for (int i = 0; i < 4; ++i) { ssr[set][tt][4 * rb + i] = lr[jj][i] + pw_r[i] * sinr[jj] - pw_i[i] * sini[jj]; ssi[set][tt][4 * rb + i] = li[jj][i] + pw_r[i] * sini[jj] + pw_i[i] * sinr[jj]; }
                }
            }
        }
        if (FINAL) {
#pragma unroll
            for (int set = 0; set < 2; ++set)
#pragma unroll
                for (int tt = 0; tt < 2; ++tt)
#pragma unroll
                    for (int r = 0; r < 16; ++r) { const int t = 32 * tt + 8 * (r >> 2) + 4 * hi + (r & 3);
                        *(LAS unsigned*)(sl + t * 272 + (32 * set + r32) * 4) = pk2(ssr[set][tt][r], ssi[set][tt][r]); }
            LDS_WAIT();
            f32x4 yacc[4];
#pragma unroll
            for (int t4 = 0; t4 < 4; ++t4) yacc[t4] = (f32x4){0.f, 0.f, 0.f, 0.f};
#pragma unroll
            for (int ks = 0; ks < 4; ++ks) {
                const bf16x8 cf = cfr[ks];
#pragma unroll
                for (int t4 = 0; t4 < 4; ++t4) { const bf16x8 sf = *(const LAS bf16x8*)(sl + (16 * t4 + c16) * 272 + (ks * 32 + 8 * q) * 2);
                    yacc[t4] = __builtin_amdgcn_mfma_f32_16x16x32_bf16(cf, sf, yacc[t4], 0, 0, 0); }
            }
            LDS_WAIT();
#pragma unroll
            for (int t4 = 0; t4 < 4; ++t4) {
                const size_t tok = tok0 + 16 * t4 + c16;
                const float y0 = gelu_tanh(yacc[t4][0] + dv[0] * bf2f(uu[t4].x & 0xffffu)), y1 = gelu_tanh(yacc[t4][1] + dv[1] * bf2f(uu[t4].x >> 16)),
                            y2 = gelu_tanh(yacc[t4][2] + dv[2] * bf2f(uu[t4].y & 0xffffu)), y3 = gelu_tanh(yacc[t4][3] + dv[3] * bf2f(uu[t4].y >> 16));
                *(uint2*)(F.YS + tok * SW + g * NC + 4 * q) = make_uint2(pk2(y0, y1), pk2(y2, y3));
            }
        }
    }
}
__device__ __forceinline__ void t_s5_carry(Frame& F) {
    const int gw = F.vcu * NWAVES + F.wave, NGW = F.G * NWAVES, lane = F.lane;
    for (int ch = gw; ch < BATCH * NG * NP; ch += NGW) {
        const int b = ch / (NG * NP), gp = ch % (NG * NP), g = gp / NP;
        const float ar = F.AA[gp * 4], ai = F.AA[gp * 4 + 1], Ar = F.AA[gp * 4 + 2], Ai = F.AA[gp * 4 + 3];
        float mr = 0.f, mi = 0.f;
        for (int t = 0; t < NMETA; ++t) {
            float bur = 0.f, bui = 0.f;
            for (int c = 0; c < NC; ++c) { const float u = bf2f(F.ZM[t * INW + g * NC + c]); bur += F.BB[gp * 32 + c] * u; bui += F.BB[gp * 32 + 16 + c] * u; }
            const float nr = ar * mr - ai * mi + bur, ni = ar * mi + ai * mr + bui; mr = nr; mi = ni;
        }
        const float* e = F.E + (size_t)ch * NCHUNK * 2;
        float v0r = e[2 * lane], v0i = e[2 * lane + 1], v1r = e[2 * (64 + lane)], v1i = e[2 * (64 + lane) + 1];
        float pr = Ar, pi = Ai;
#pragma unroll
        for (int d = 1; d < 64; d <<= 1) {
            const float u0r = __shfl_up(v0r, d), u0i = __shfl_up(v0i, d), u1r = __shfl_up(v1r, d), u1i = __shfl_up(v1i, d);
            if (lane >= d) { v0r += pr * u0r - pi * u0i; v0i += pr * u0i + pi * u0r; v1r += pr * u1r - pi * u1i; v1i += pr * u1i + pi * u1r; }
            const float nr = pr * pr - pi * pi, ni = 2.f * pr * pi; pr = nr; pi = ni;
        }
        float qr = 1.f, qi = 0.f, br_ = Ar, bi_ = Ai;
#pragma unroll
        for (int bit = 0; bit < 7; ++bit) { if (((lane + 1) >> bit) & 1) { const float nr = qr * br_ - qi * bi_, ni = qr * bi_ + qi * br_; qr = nr; qi = ni; } const float nr = br_ * br_ - bi_ * bi_, ni = 2.f * br_ * bi_; br_ = nr; bi_ = ni; }
        const float x0r = v0r + qr * mr - qi * mi, x0i = v0i + qr * mi + qi * mr;
        const float t0r = __shfl(x0r, 63), t0i = __shfl(x0i, 63);
        const float x1r = v1r + qr * t0r - qi * t0i, x1i = v1i + qr * t0i + qi * t0r;
        float* so = F.SIN + ((size_t)b * NCHUNK * NG * NP + gp) * 2;
        const size_t cs = (size_t)NG * NP * 2;
        if (lane == 0) { so[0] = mr; so[1] = mi; }
        so[(size_t)(lane + 1) * cs] = x0r; so[(size_t)(lane + 1) * cs + 1] = x0i;
        if (lane < 63) { so[(size_t)(lane + 65) * cs] = x1r; so[(size_t)(lane + 65) * cs + 1] = x1i; }
    }
}

__device__ __forceinline__ void rt_split(const f32x4& x0, const f32x4& x1, bf16x8& hi, bf16x8& lo) {
    unsigned hw[4], lw[4];
#pragma unroll
    for (int p = 0; p < 4; ++p) { const float a = p < 2 ? x0[2 * p] : x1[2 * p - 4], b = p < 2 ? x0[2 * p + 1] : x1[2 * p - 3];
        const unsigned ha = f2bf(a), hb = f2bf(b); hw[p] = ha | (hb << 16); lw[p] = pk2(a - bf2f(ha), b - bf2f(hb)); }
    hi = __builtin_bit_cast(bf16x8, (v4u){hw[0], hw[1], hw[2], hw[3]}); lo = __builtin_bit_cast(bf16x8, (v4u){lw[0], lw[1], lw[2], lw[3]});
}
#ifndef T_ROUTER2
#define T_ROUTER2 1
#endif
#ifndef T_ALT
#define T_ALT 1
#endif
#if T_ROUTER2
__device__ __forceinline__ void t_router(Frame& F) {
    const int lane = F.lane, w = F.wave, i32 = lane & 31, h = lane >> 5, kb = 128 * w + 64 * h;
    constexpr int TP = 1028;
    float* tileb = (float*)F.lds;
    float* part = tileb;
    float* lgs = tileb + 32 * TP;
    float* rsv = lgs + 2 * 32 * 33;
    int* cntl = (int*)(rsv + 64);
    bf16x8 bhi[8], blo[8];
#pragma unroll
    for (int s8 = 0; s8 < 8; ++s8) { f32x4 b0, b1;
#pragma unroll
        for (int q = 0; q < 4; ++q) { b0[q] = F.norm_ffn_g[kb + 8 * s8 + q] * F.w_router[(size_t)(kb + 8 * s8 + q) * NE + i32]; b1[q] = F.norm_ffn_g[kb + 8 * s8 + 4 + q] * F.w_router[(size_t)(kb + 8 * s8 + 4 + q) * NE + i32]; }
        rt_split(b0, b1, bhi[s8], blo[s8]); }
    f32x4 gg[4];
#pragma unroll
    for (int j = 0; j < 4; ++j) gg[j] = *(const f32x4*)(F.norm_ffn_g + 256 * j + 4 * lane);
    f32x4 R[16];
    auto ld = [&](int tile) {
#pragma unroll
        for (int r = 0; r < 4; ++r)
#pragma unroll
            for (int j = 0; j < 4; ++j) R[4 * r + j] = *(const f32x4*)(F.out + (size_t)(tile * 32 + 4 * w + r) * D + 256 * j + 4 * lane); };
    if (F.vcu < M / 32) ld(F.vcu);
    for (int t0 = F.vcu; t0 < M / 32; t0 += 2 * F.G) {
        const int t1 = t0 + F.G; const bool has1 = t1 < M / 32;
        if (F.tid < 64) cntl[F.tid] = 0;
        for (int tl = 0; tl < 2; ++tl) {
            if (tl == 1 && !has1) break;
            const int tile = tl ? t1 : t0;
#pragma unroll
            for (int r = 0; r < 4; ++r) { float ss = 0.f;
#pragma unroll
                for (int j = 0; j < 4; ++j) { const f32x4 v = R[4 * r + j]; ss += v[0] * v[0] + v[1] * v[1] + v[2] * v[2] + v[3] * v[3]; *(f32x4*)(tileb + (4 * w + r) * TP + 256 * j + 4 * lane) = v; }
                ss = wave_sum(ss);
                const float rs = rsqrtf(ss * (1.f / D) + EPS);
                if (lane == 0) rsv[tl * 32 + 4 * w + r] = rs;
                if (!(F.mode & 2)) { const size_t tok = (size_t)tile * 32 + 4 * w + r;
#pragma unroll
                    for (int j = 0; j < 4; ++j) { const f32x4 xv = R[4 * r + j] * rs * gg[j];
                        if (T_FP8) *(unsigned*)((unsigned char*)F.XN2 + tok * D + 256 * j + 4 * lane) = pg8::pk4_fp8(xv[0], xv[1], xv[2], xv[3]);
                        else *(uint2*)(F.XN2 + tok * D + 256 * j + 4 * lane) = make_uint2(pk2(xv[0], xv[1]), pk2(xv[2], xv[3])); } }
            }
            { const int nt = tl == 0 ? (has1 ? t1 : -1) : (t0 + 2 * F.G < M / 32 ? t0 + 2 * F.G : -1); if (nt >= 0) ld(nt); }
            __syncthreads();
            f32x16 acc = {};
#pragma unroll
            for (int s8 = 0; s8 < 8; ++s8) { const float* ap = tileb + i32 * TP + kb + 8 * s8; bf16x8 ahi, alo; rt_split(*(const f32x4*)ap, *(const f32x4*)(ap + 4), ahi, alo);
                acc = __builtin_amdgcn_mfma_f32_32x32x16_bf16(ahi, bhi[s8], acc, 0, 0, 0); acc = __builtin_amdgcn_mfma_f32_32x32x16_bf16(ahi, blo[s8], acc, 0, 0, 0); acc = __builtin_amdgcn_mfma_f32_32x32x16_bf16(alo, bhi[s8], acc, 0, 0, 0); }
            __syncthreads();
#pragma unroll
            for (int r = 0; r < 16; ++r) part[(w * 32 + (r & 3) + 8 * (r >> 2) + 4 * h) * 33 + i32] = acc[r];
            __syncthreads();
#pragma unroll
            for (int rep = 0; rep < 2; ++rep) { const int idx = F.tid + 512 * rep, ti = idx >> 5, tj = idx & 31; float v = 0.f;
#pragma unroll
                for (int ww = 0; ww < 8; ++ww) v += part[(ww * 32 + ti) * 33 + tj];
                lgs[(tl * 32 + ti) * 33 + tj] = v; }
            __syncthreads();
        }
        if (w == 0 && (h == 0 || has1) && !(F.mode & 1)) {
            const int tile = h ? t1 : t0, t = tile * 32 + i32; const float rs = rsv[lane];
            float lg[NE];
#pragma unroll
            for (int e = 0; e < NE; ++e) lg[e] = lgs[lane * 33 + e] * rs + F.b_router[e];
            int id[4]; float tv[4];
#pragma unroll
            for (int k = 0; k < 4; ++k) {
                float best = -3.4e38f; int bi = 0;
#pragma unroll
                for (int e = 0; e < NE; ++e) { const bool taken = (k > 0 && id[0] == e) || (k > 1 && id[1] == e) || (k > 2 && id[2] == e); if (!taken && lg[e] > best) { best = lg[e]; bi = e; } }
                id[k] = bi; tv[k] = best;
            }
            const float e0 = 1.f, e1 = __expf(tv[1] - tv[0]), e2 = __expf(tv[2] - tv[0]), e3 = __expf(tv[3] - tv[0]), inv = 1.f / (e0 + e1 + e2 + e3);
            const float gw4[4] = {e0 * inv, e1 * inv, e2 * inv, e3 * inv};
#pragma unroll
            for (int k = 0; k < 4; ++k) { F.IDX[t * 4 + k] = id[k]; F.GATE[t * 4 + k] = gw4[k]; F.POS[t * 4 + k] = atomicAdd(&cntl[32 * h + id[k]], 1); }
            F.TCNT[tile * NE + i32] = cntl[lane];
        }
        __syncthreads();
    }
}
#else
__device__ __forceinline__ void t_router(Frame& F) {
    const int lane = F.lane, w = F.wave, i32 = lane & 31, h = lane >> 5, kb = 128 * w + 64 * h;
    float* part = (float*)F.lds;
    float* ssp = part + 8 * 32 * 33;
    float* lgs = ssp + 8 * 64;
    float* rsv = lgs + 32 * 33;
    int* cntl = (int*)(rsv + 32);
    bf16x8 bhi[8], blo[8];
#pragma unroll
    for (int s8 = 0; s8 < 8; ++s8) { f32x4 b0, b1;
#pragma unroll
        for (int q = 0; q < 4; ++q) { b0[q] = F.norm_ffn_g[kb + 8 * s8 + q] * F.w_router[(size_t)(kb + 8 * s8 + q) * NE + i32]; b1[q] = F.norm_ffn_g[kb + 8 * s8 + 4 + q] * F.w_router[(size_t)(kb + 8 * s8 + 4 + q) * NE + i32]; }
        rt_split(b0, b1, bhi[s8], blo[s8]); }
    f32x4 a[16];
    for (int tile = F.vcu; tile < M / 32; tile += F.G) {
        const int tok0 = tile * 32;
        if (T_H1B) { const bf16_t* hb = F.H1B + (size_t)(tok0 + i32) * D + kb;
#pragma unroll
          for (int q = 0; q < 8; ++q) { const uint4 v = *(const uint4*)(hb + 8 * q);
              a[2 * q] = (f32x4){bf2f(v.x & 0xffffu), bf2f(v.x >> 16), bf2f(v.y & 0xffffu), bf2f(v.y >> 16)}; a[2 * q + 1] = (f32x4){bf2f(v.z & 0xffffu), bf2f(v.z >> 16), bf2f(v.w & 0xffffu), bf2f(v.w >> 16)}; } }
        else { const float* hr = F.out + (size_t)(tok0 + i32) * D + kb;
#pragma unroll
          for (int q = 0; q < 16; ++q) a[q] = *(const f32x4*)(hr + 4 * q); }
        float ss = 0.f;
#pragma unroll
        for (int q = 0; q < 16; ++q) ss += a[q][0] * a[q][0] + a[q][1] * a[q][1] + a[q][2] * a[q][2] + a[q][3] * a[q][3];
        f32x16 acc = {};
#pragma unroll
        for (int s8 = 0; s8 < 8; ++s8) { bf16x8 ahi, alo; rt_split(a[2 * s8], a[2 * s8 + 1], ahi, alo);
            acc = __builtin_amdgcn_mfma_f32_32x32x16_bf16(ahi, bhi[s8], acc, 0, 0, 0); acc = __builtin_amdgcn_mfma_f32_32x32x16_bf16(ahi, blo[s8], acc, 0, 0, 0); acc = __builtin_amdgcn_mfma_f32_32x32x16_bf16(alo, bhi[s8], acc, 0, 0, 0); }
#pragma unroll
        for (int r = 0; r < 16; ++r) part[(w * 32 + (r & 3) + 8 * (r >> 2) + 4 * h) * 33 + i32] = acc[r];
        ssp[w * 64 + lane] = ss;
        if (F.tid < 32) cntl[F.tid] = 0;
        __syncthreads();
#pragma unroll
        for (int rep = 0; rep < 2; ++rep) { const int idx = F.tid + 512 * rep, ti = idx >> 5, tj = idx & 31; float v = 0.f;
#pragma unroll
            for (int ww = 0; ww < 8; ++ww) v += part[(ww * 32 + ti) * 33 + tj];
            lgs[ti * 33 + tj] = v; }
        if (F.tid < 32) { float v = 0.f;
#pragma unroll
            for (int ww = 0; ww < 8; ++ww) v += ssp[ww * 64 + F.tid] + ssp[ww * 64 + 32 + F.tid];
            rsv[F.tid] = rsqrtf(v * (1.f / D) + EPS); }
        __syncthreads();
        const float rs = rsv[i32];
        if (w == 0 && lane < 32 && !(F.mode & 1)) {
            const int t = tok0 + lane;
            float lg[NE];
#pragma unroll
            for (int e = 0; e < NE; ++e) lg[e] = lgs[lane * 33 + e] * rs + F.b_router[e];
            int id[4]; float tv[4];
#pragma unroll
            for (int k = 0; k < 4; ++k) {
                float best = -3.4e38f; int bi = 0;
#pragma unroll
                for (int e = 0; e < NE; ++e) { const bool taken = (k > 0 && id[0] == e) || (k > 1 && id[1] == e) || (k > 2 && id[2] == e); if (!taken && lg[e] > best) { best = lg[e]; bi = e; } }
                id[k] = bi; tv[k] = best;
            }
            const float e0 = 1.f, e1 = __expf(tv[1] - tv[0]), e2 = __expf(tv[2] - tv[0]), e3 = __expf(tv[3] - tv[0]), inv = 1.f / (e0 + e1 + e2 + e3);
            const float gw4[4] = {e0 * inv, e1 * inv, e2 * inv, e3 * inv};
#pragma unroll
            for (int k = 0; k < 4; ++k) { F.IDX[t * 4 + k] = id[k]; F.GATE[t * 4 + k] = gw4[k]; F.POS[t * 4 + k] = atomicAdd(&cntl[id[k]], 1); }
            F.TCNT[tile * NE + lane] = cntl[lane];
        }
        if (!(F.mode & 2)) {
            bf16_t* xo = F.XN2 + (size_t)(tok0 + i32) * D + kb;
#pragma unroll
            for (int q = 0; q < 16; q += 4) { f32x4 xv[4];
#pragma unroll
                for (int u = 0; u < 4; ++u) xv[u] = a[q + u] * rs * *(const f32x4*)(F.norm_ffn_g + kb + 4 * (q + u));
                if (T_FP8) *(uint4*)((unsigned char*)F.XN2 + (size_t)(tok0 + i32) * D + kb + 4 * q) = make_uint4(pg8::pk4_fp8(xv[0][0], xv[0][1], xv[0][2], xv[0][3]), pg8::pk4_fp8(xv[1][0], xv[1][1], xv[1][2], xv[1][3]),
                                                                                                               pg8::pk4_fp8(xv[2][0], xv[2][1], xv[2][2], xv[2][3]), pg8::pk4_fp8(xv[3][0], xv[3][1], xv[3][2], xv[3][3]));
                else { *(uint4*)(xo + 4 * q) = make_uint4(pk2(xv[0][0], xv[0][1]), pk2(xv[0][2], xv[0][3]), pk2(xv[1][0], xv[1][1]), pk2(xv[1][2], xv[1][3]));
                       *(uint4*)(xo + 4 * q + 8) = make_uint4(pk2(xv[2][0], xv[2][1]), pk2(xv[2][2], xv[2][3]), pk2(xv[3][0], xv[3][1]), pk2(xv[3][2], xv[3][3])); } }
        }
        __syncthreads();
    }
}

#endif
__device__ __forceinline__ void t_qkv_prep(Frame& F) {
    const int gw = F.vcu * NWAVES + F.wave, NGW = F.G * NWAVES, lane = F.lane;
    bf16_t* Qd = F.QKN; bf16_t* Kd = F.YS; bf16_t* Vd = F.YS2;
    for (int row = gw; row < M + BATCH * 64; row += NGW) {
        const bf16_t* zr; bf16_t *qo = nullptr, *ko, *vo; bool zero = false;
        if (row < M) { const int b = row / SEQ, i = row % SEQ; zr = F.Z + (size_t)row * INW; qo = Qd + (size_t)row * D; ko = Kd + ((size_t)b * KVS + 64 + i) * D; vo = Vd + ((size_t)b * KVS + 64 + i) * D; }
        else { const int r = row - M, b = r / 64, l = r % 64; zero = l < 48; zr = F.ZM + (size_t)(zero ? 0 : l - 48) * INW; ko = Kd + ((size_t)b * KVS + l) * D; vo = Vd + ((size_t)b * KVS + l) * D; }
        {
            const uint4 u0 = *(const uint4*)(zr + 512 + 16 * lane), u1 = *(const uint4*)(zr + 512 + 16 * lane + 8);
            const unsigned uw[8] = {u0.x, u0.y, u0.z, u0.w, u1.x, u1.y, u1.z, u1.w};
            float v[16]; float ss = 0.f;
#pragma unroll
            for (int c = 0; c < 8; ++c) { v[2 * c] = bf2f(uw[c] & 0xffffu); v[2 * c + 1] = bf2f(uw[c] >> 16); ss += v[2 * c] * v[2 * c] + v[2 * c + 1] * v[2 * c + 1]; }
            ss += __shfl_xor(ss, 1); ss += __shfl_xor(ss, 2);
            float rs = rsqrtf(ss * (1.f / 64.f) + EPS); if (lane < 32) rs *= 0.125f * 1.4426950408889634f; if (zero) rs = 0.f;
            const float* gg = (lane < 32 ? F.q_g : F.k_g) + 16 * (lane & 3);
            unsigned o[8];
#pragma unroll
            for (int c = 0; c < 8; ++c) o[c] = pk2(v[2 * c] * rs * gg[2 * c], v[2 * c + 1] * rs * gg[2 * c + 1]);
            const int sh = (lane & 31) >> 2, h = sh >> 1, j = sh & 1;
            bf16_t* dst = (lane < 32) ? qo : ko;
            if (dst) {
#pragma unroll
                for (int vh = 0; vh < 2; ++vh) { bf16_t* d = dst + (4 * h + 2 * j + vh) * 64 + 16 * (lane & 3); *(uint4*)d = make_uint4(o[0], o[1], o[2], o[3]); *(uint4*)(d + 8) = make_uint4(o[4], o[5], o[6], o[7]); }
            }
        }
        {
            uint4 u = *(const uint4*)(zr + 1536 + 8 * lane); if (zero) u = make_uint4(0, 0, 0, 0);
            const int h = lane >> 4, dv = 8 * (lane & 15), vh = dv >> 6, d = dv & 63;
#pragma unroll
            for (int j = 0; j < 2; ++j) *(uint4*)(vo + (4 * h + 2 * j + vh) * 64 + d) = u;
        }
    }
}
#ifndef T_UNR
#define T_UNR 4
#endif
struct PrepRow { bf16_t *qo, *ko, *vo; bool zero; uint4 u0, u1, uv; };
__device__ __forceinline__ void t_qkv_prep2(Frame& F) {
    const int gw = F.vcu * NWAVES + F.wave, NGW = F.G * NWAVES, lane = F.lane;
    bf16_t* Q2 = F.YS; bf16_t* K2 = F.YS + (size_t)M * 512; bf16_t* V2 = F.YS2;
    constexpr int NR = M + BATCH * 64;
    const float* gg = (lane < 32 ? F.q_g : F.k_g) + 16 * (lane & 3);
    f32x4 gv[4];
#pragma unroll
    for (int c = 0; c < 4; ++c) gv[c] = *(const f32x4*)(gg + 4 * c);
    for (int row0 = gw; row0 < NR; row0 += T_UNR * NGW) {
        PrepRow p[T_UNR];
#pragma unroll
        for (int j = 0; j < T_UNR; ++j) { const int row = row0 + j * NGW; if (row >= NR) break;
            const bf16_t* zr; p[j].qo = nullptr; p[j].zero = false;
            if (row < M) { const int b = row / SEQ, i = row % SEQ; zr = F.Z + (size_t)row * INW; p[j].qo = Q2 + (size_t)row * 512; p[j].ko = K2 + ((size_t)b * KVS + 64 + i) * 512; p[j].vo = V2 + ((size_t)b * KVS + 64 + i) * 512; }
            else { const int r = row - M, b = r / 64, l = r % 64; p[j].zero = l < 48; zr = F.ZM + (size_t)(p[j].zero ? 0 : l - 48) * INW; p[j].ko = K2 + ((size_t)b * KVS + l) * 512; p[j].vo = V2 + ((size_t)b * KVS + l) * 512; }
            p[j].u0 = *(const uint4*)(zr + 512 + 16 * lane); p[j].u1 = *(const uint4*)(zr + 512 + 16 * lane + 8); p[j].uv = *(const uint4*)(zr + 1536 + 8 * lane); }
#pragma unroll
        for (int j = 0; j < T_UNR; ++j) { const int row = row0 + j * NGW; if (row >= NR) break;
            const unsigned uw[8] = {p[j].u0.x, p[j].u0.y, p[j].u0.z, p[j].u0.w, p[j].u1.x, p[j].u1.y, p[j].u1.z, p[j].u1.w};
            uint4 uv = p[j].uv;
            float v[16]; float ss = 0.f;
#pragma unroll
            for (int c = 0; c < 8; ++c) { v[2 * c] = bf2f(uw[c] & 0xffffu); v[2 * c + 1] = bf2f(uw[c] >> 16); ss += v[2 * c] * v[2 * c] + v[2 * c + 1] * v[2 * c + 1]; }
            ss += __shfl_xor(ss, 1); ss += __shfl_xor(ss, 2);
            float rs = rsqrtf(ss * (1.f / 64.f) + EPS); if (lane < 32) rs *= 0.125f * 1.4426950408889634f; if (p[j].zero) { rs = 0.f; uv = make_uint4(0, 0, 0, 0); }
            unsigned o[8];
#pragma unroll
            for (int c = 0; c < 8; ++c) o[c] = pk2(v[2 * c] * rs * gv[c >> 1][(2 * c) & 3], v[2 * c + 1] * rs * gv[c >> 1][(2 * c + 1) & 3]);
            bf16_t* dst = (lane < 32) ? p[j].qo : p[j].ko;
            if (dst) { bf16_t* d = dst + 16 * (lane & 31); *(uint4*)d = make_uint4(o[0], o[1], o[2], o[3]); *(uint4*)(d + 8) = make_uint4(o[4], o[5], o[6], o[7]); }
            *(uint4*)(p[j].vo + 8 * lane) = uv; }
    }
}
__device__ __forceinline__ void t_attn_post2(Frame& F) {
    const int gw = F.vcu * NWAVES + F.wave, NGW = F.G * NWAVES, lane = F.lane;
    const bf16_t* O = F.QKN; const float lam = F.LAM[0];
    const int h = lane >> 4, dv = 8 * (lane & 15);
    const f32x4 g0 = *(const f32x4*)(F.sub_g + dv), g1 = *(const f32x4*)(F.sub_g + dv + 4);
    for (int t0 = gw; t0 < M; t0 += T_UNR * NGW) {
        uint4 a[T_UNR], b[T_UNR];
#pragma unroll
        for (int j = 0; j < T_UNR; ++j) { const int t = t0 + j * NGW; if (t >= M) break; a[j] = *(const uint4*)(O + (size_t)t * D + 256 * h + dv); b[j] = *(const uint4*)(O + (size_t)t * D + 256 * h + 128 + dv); }
#pragma unroll
        for (int j = 0; j < T_UNR; ++j) { const int t = t0 + j * NGW; if (t >= M) break;
            const unsigned aw[4] = {a[j].x, a[j].y, a[j].z, a[j].w}, bw[4] = {b[j].x, b[j].y, b[j].z, b[j].w};
            float o[8]; float ss = 0.f;
#pragma unroll
            for (int c = 0; c < 4; ++c) { o[2 * c] = bf2f(aw[c] & 0xffffu) - lam * bf2f(bw[c] & 0xffffu); o[2 * c + 1] = bf2f(aw[c] >> 16) - lam * bf2f(bw[c] >> 16); ss += o[2 * c] * o[2 * c] + o[2 * c + 1] * o[2 * c + 1]; }
            ss += __shfl_xor(ss, 1); ss += __shfl_xor(ss, 2); ss += __shfl_xor(ss, 4); ss += __shfl_xor(ss, 8);
            const float rs = rsqrtf(ss * (1.f / 128.f) + EPS) * 0.8f;
            bf16_t* yo = T_MIXCAT ? F.YS2 + (size_t)t * 1024 + 128 * h + dv : F.YA + (size_t)t * AW + 128 * h + dv;
            *(uint4*)yo = make_uint4(pk2(o[0] * rs * g0[0], o[1] * rs * g0[1]), pk2(o[2] * rs * g0[2], o[3] * rs * g0[3]), pk2(o[4] * rs * g1[0], o[5] * rs * g1[1]), pk2(o[6] * rs * g1[2], o[7] * rs * g1[3])); }
    }
}
__device__ __forceinline__ void t_attn_post(Frame& F) {
    const int gw = F.vcu * NWAVES + F.wave, NGW = F.G * NWAVES, lane = F.lane;
    const bf16_t* O = F.QKN; const float lam = F.LAM[0];
    const int h = lane >> 4, dv = 8 * (lane & 15), vh = dv >> 6, d = dv & 63;
    const f32x4 g0 = *(const f32x4*)(F.sub_g + dv), g1 = *(const f32x4*)(F.sub_g + dv + 4);
    for (int t = gw; t < M; t += NGW) {
        const uint4 a = *(const uint4*)(O + (size_t)t * D + (4 * h + vh) * 64 + d), b = *(const uint4*)(O + (size_t)t * D + (4 * h + 2 + vh) * 64 + d);
        const unsigned aw[4] = {a.x, a.y, a.z, a.w}, bw[4] = {b.x, b.y, b.z, b.w};
        float o[8]; float ss = 0.f;
#pragma unroll
        for (int c = 0; c < 4; ++c) { o[2 * c] = bf2f(aw[c] & 0xffffu) - lam * bf2f(bw[c] & 0xffffu); o[2 * c + 1] = bf2f(aw[c] >> 16) - lam * bf2f(bw[c] >> 16); ss += o[2 * c] * o[2 * c] + o[2 * c + 1] * o[2 * c + 1]; }
        ss += __shfl_xor(ss, 1); ss += __shfl_xor(ss, 2); ss += __shfl_xor(ss, 4); ss += __shfl_xor(ss, 8);
        const float rs = rsqrtf(ss * (1.f / 128.f) + EPS) * 0.8f;
        *(uint4*)(F.YA + (size_t)t * AW + 128 * h + dv) = make_uint4(pk2(o[0] * rs * g0[0], o[1] * rs * g0[1]), pk2(o[2] * rs * g0[2], o[3] * rs * g0[3]), pk2(o[4] * rs * g1[0], o[5] * rs * g1[1]), pk2(o[6] * rs * g1[2], o[7] * rs * g1[3]));
    }
}

__device__ __forceinline__ void t_gemm_z(Frame& F) {
    if (T_GATE8) {
        { pg8::Gemm g{F.XN, F.Wt_in, M, 2048, D}; pg8::StaticOrder S; S.init(M, 2048, F.G, (int)blockIdx.x);
          pg8::EpiBf16<0> E{F.Z, INW, nullptr, 0, 0, 1.f, 0};
          pg8::gemm_phase<pg8::EpiBf16<0>, pg8::StaticOrder, true, true>(F.lds3, g, S, E); }
        { pg8::Gemm g{F.XN8, F.Wt_in8, M, 2048, D / 2}; pg8::StaticOrder S; S.init(M, 2048, F.G, (int)blockIdx.x);
          pg8::EpiScaleBf16 E{F.Z + 2048, INW, 0.03125f};
          pg8::gemm_phase<pg8::EpiScaleBf16, pg8::StaticOrder, true, true, false, true>(F.lds3, g, S, E); }
        return;
    }
    pg8::Gemm g{F.XN, F.Wt_in, M, INW, D}; pg8::StaticOrder S; S.init(M, INW, F.G, (int)blockIdx.x);
    pg8::EpiBf16<0> E{F.Z, INW, nullptr, 0, 0, 1.f, 0};
    pg8::gemm_phase<pg8::EpiBf16<0>, pg8::StaticOrder, true, true>(F.lds3, g, S, E);
}
__device__ __forceinline__ void t_gemm_glu(Frame& F) {
    pg8::Gemm g{F.YS, F.Wt_glu, M, SW, SW}; pg8::StaticOrder S; S.init(M, SW, F.G, (int)blockIdx.x);
    pg8::EpiGlu E{F.YS, T_MIXCAT ? F.YS2 + 512 : F.YS2, F.b_glu, SW, T_MIXCAT ? 1024 : SW};
    pg8::gemm_phase<pg8::EpiGlu, pg8::StaticOrder, true, true>(F.lds3, g, S, E);
    if (T_MOE && DN_LATE > 0) {
        const int nun = (M / 256) * (SW / 256), idle = F.G - nun;
        if (idle > 0 && (int)blockIdx.x >= nun) { const int j = (int)blockIdx.x - nun; const size_t eo = (size_t)(NE - DN_LATE);
            cp_set<0, T_FP8>(F, F.w_down + eo * D * D, D, D, T_FP8 ? (bf16_t*)((unsigned char*)F.Wt_dn + eo * D * D) : F.Wt_dn + eo * D * D, DN_LATE, 0, 0, 0, j * NWAVES + F.wave, idle * NWAVES); }
        else if (idle <= 0) cp_set<0, T_FP8>(F, F.w_down + (size_t)(NE - DN_LATE) * D * D, D, D, T_FP8 ? (bf16_t*)((unsigned char*)F.Wt_dn + (size_t)(NE - DN_LATE) * D * D) : F.Wt_dn + (size_t)(NE - DN_LATE) * D * D, DN_LATE);
    }
}
__device__ __forceinline__ void t_gemm_mix(Frame& F) {
    if (T_MIXCAT) { pg8::Gemm g{F.YS2, F.Wt_so, M, D, D}; pg8::StaticOrder S; S.init(M, D, F.G, (int)blockIdx.x);
        pg8::EpiMixCat E{F.Z, F.MIX};
        pg8::gemm_phase<pg8::EpiMixCat, pg8::StaticOrder, true, true, false, false, true>(F.lds3, g, S, E); return; }
    { pg8::Gemm g{F.YS2, F.Wt_so, M, D, SW}; pg8::StaticOrder S; S.init(M, D, F.G, (int)blockIdx.x);
      pg8::EpiMix<true> E{F.Z + 2048, F.MIX, nullptr};
      pg8::gemm_phase<pg8::EpiMix<true>, pg8::StaticOrder, true, true>(F.lds3, g, S, E); }
    asm volatile("s_waitcnt vmcnt(0)" ::: "memory"); __syncthreads();
    { pg8::Gemm g{F.YA, F.Wt_ao, M, D, AW}; pg8::StaticOrder S; S.init(M, D, F.G, (int)blockIdx.x);
      pg8::EpiMix<false, T_WO8> E{F.Z + 3072, F.MIX, (unsigned char*)F.YS2 + (size_t)M * SW * 2};
      pg8::gemm_phase<pg8::EpiMix<false, T_WO8>, pg8::StaticOrder, true, true>(F.lds3, g, S, E); }
}
__device__ __forceinline__ void t_gemm_wo(Frame& F) {
    if (T_H1B) { pg8::Gemm g{F.MIX, F.Wt_o, M, D, D}; pg8::StaticOrder S; S.init(M, D, F.G, (int)blockIdx.x);
        pg8::EpiWoB E{F.x, F.H1B};
        pg8::gemm_phase<pg8::EpiWoB, pg8::StaticOrder, true, true>(F.lds3, g, S, E); return; }
    pg8::Gemm g{T_WO8 ? (const bf16_t*)((unsigned char*)F.YS2 + (size_t)M * SW * 2) : F.MIX, F.Wt_o, M, D, T_WO8 ? D / 2 : D}; pg8::StaticOrder S; S.init(M, D, F.G, (int)blockIdx.x);
    pg8::EpiWo E{F.x, F.out, T_WO8 ? 0.03125f : 1.f};
    pg8::gemm_phase<pg8::EpiWo, pg8::StaticOrder, true, true, false, T_WO8>(F.lds3, g, S, E);
}

__device__ __forceinline__ void t_moe1(Frame& F) {
    const int ntiles = F.OFF[NE] / 256;
    pg8::MoeOrder S{F.TEXP, ntiles, 8, F.G, F.vcu};
    LAS int* idx = (LAS int*)(F.lds3 + 131072);
    { pg8::Unit u; for (int i = 0; i < 12 && S.next(i, u); ++i) if (F.tid < 256) idx[i * 256 + F.tid] = F.ROWTOK[u.pm * 256 + F.tid]; }
    __syncthreads();
    pg8::Gemm g{F.XN2, F.Wt_gu, MOE_ROWS, NE * 2048, T_FP8 ? D / 2 : D, idx};
    pg8::EpiMoe1<T_FP8> E{F.ACT, F.b_gate, F.b_up};
    pg8::gemm_phase<pg8::EpiMoe1<T_FP8>, pg8::MoeOrder, true, true, true, T_FP8>(F.lds3, g, S, E);
    if (DN_MID > 0) {
        const int nu = ntiles * 8, rem = nu % F.G, nidle = rem ? F.G - rem : F.G, j = rem ? F.vcu - rem : F.vcu;
        if (j >= 0) { const size_t eo = (size_t)(NE - (T_GEMM_GLU ? DN_LATE : 0) - DN_MID);
            cp_set<0, T_FP8>(F, F.w_down + eo * D * D, D, D, T_FP8 ? (bf16_t*)((unsigned char*)F.Wt_dn + eo * D * D) : F.Wt_dn + eo * D * D, DN_MID, 0, 0, 0, j * NWAVES + F.wave, nidle * NWAVES); }
    }
}
__device__ __forceinline__ void t_moe2(Frame& F) {
    const int ntiles = F.OFF[NE] / 256;
    pg8::MoeOrder S{F.TEXP, ntiles, 4, F.G, F.vcu};
    pg8::Gemm g{F.ACT, F.Wt_dn, MOE_ROWS, NE * 1024, T_FP8 ? D / 2 : D, nullptr};
    pg8::EpiMoe2<T_FP8> E{F.Y2, F.b_down, F.ROWTK};
    pg8::gemm_phase<pg8::EpiMoe2<T_FP8>, pg8::MoeOrder, true, true, false, T_FP8>(F.lds3, g, S, E);
}

constexpr int NPHASE = 13;
__global__ void __launch_bounds__(NTHR, 2) mk_fwd(Args args) {
    extern __shared__ __attribute__((aligned(16))) unsigned char lds[];
    Frame F;
    F.lds = lds; F.lds3 = (LAS unsigned char*)lds; F.tid = threadIdx.x; F.lane = F.tid & 63; F.wave = __builtin_amdgcn_readfirstlane(F.tid >> 6);
    F.mode = args.mode; F.G = gridDim.x; { const int bx = blockIdx.x; F.vcu = (F.G % 8 == 0) ? (bx % 8) * (F.G / 8) + bx / 8 : bx; }
    const float* const* in = args.in;
    F.x = in[0]; F.meta = in[1]; F.norm_mix_g = in[2]; F.w_in = in[3]; F.a_re = in[4]; F.a_im = in[5]; F.log_dt = in[6]; F.b_re = in[7]; F.b_im = in[8]; F.c_re = in[9]; F.c_im = in[10]; F.ssm_d = in[11];
    F.w_glu = in[12]; F.b_glu = in[13]; F.q_g = in[14]; F.k_g = in[15]; F.lq1 = in[16]; F.lk1 = in[17]; F.lq2 = in[18]; F.lk2 = in[19]; F.sub_g = in[20]; F.w_so = in[21]; F.w_ao = in[22]; F.w_o = in[23];
    F.norm_ffn_g = in[24]; F.w_router = in[25]; F.b_router = in[26]; F.w_gate = in[27]; F.b_gate = in[28]; F.w_up = in[29]; F.b_up = in[30]; F.w_down = in[31]; F.b_down = in[32];
    F.out = args.out;
    unsigned char* ws = args.ws;
    F.XN = (bf16_t*)(ws + WS_R0); F.QKN = (bf16_t*)(ws + WS_R0); F.MIX = (bf16_t*)(ws + WS_R0);
    F.YS = (bf16_t*)(ws + WS_R1); F.YA = (bf16_t*)(ws + WS_R1 + (size_t)M * SW * 2); F.XN2 = (bf16_t*)(ws + WS_R1);
    F.YS2 = (bf16_t*)(ws + WS_R2); F.Z = (bf16_t*)(ws + WS_R3); F.ACT = (bf16_t*)(ws + WS_R3); F.Y2 = (bf16_t*)(ws + WS_WGU);
    F.Wt_in = (bf16_t*)(ws + WS_WD + WD_IN); F.Wt_glu = (bf16_t*)(ws + WS_WD + WD_GLU); F.Wt_so = (bf16_t*)(ws + WS_WD + WD_SO); F.Wt_ao = (bf16_t*)(ws + WS_WD + WD_AO); F.Wt_o = (bf16_t*)(ws + WS_WD + WD_O);
    F.XN8 = (bf16_t*)(ws + WS_R2); F.H1B = (bf16_t*)(ws + WS_R2); F.Wt_in8 = (bf16_t*)(ws + WS_WGU + 64 * MiB);     F.Wt_gu = (bf16_t*)(ws + WS_WGU); F.Wt_dn = (bf16_t*)(ws + WS_WDN);
    unsigned char* sm = ws + WS_SM;
    F.BB = (float*)(sm + SM_BB); F.AA = (float*)(sm + SM_AA); F.E = (float*)(sm + SM_E); F.SIN = (float*)(sm + SM_SIN); F.LAM = (float*)(sm + SM_LAM); F.GATE = (float*)(sm + SM_GATE);
    F.IDX = (int*)(sm + SM_IDX); F.POS = (int*)(sm + SM_POS); F.OFF = (int*)(sm + SM_OFF); F.ROWTOK = (int*)(sm + SM_ROWTOK); F.ROWTK = (int*)(sm + SM_ROWTK); F.TEXP = (int*)(sm + SM_TEXP); F.TCNT = (int*)(sm + SM_TCNT);
    F.ZM = (bf16_t*)(sm + SM_ZM); F.QKNM = (bf16_t*)(sm + SM_QKNM); F.BBH = (bf16_t*)(sm + SM_BBH); F.CMT = (bf16_t*)(sm + SM_CMT);
    unsigned* ctl = (unsigned*)(ws + WS_CTL);
    F.CNT = (int*)(ctl + CW_CNT);
    volatile LAS unsigned* MISC = (volatile LAS unsigned*)((LAS unsigned char*)lds + MISC_OFF);
    for (int u = F.tid; u < 64; u += NTHR) MISC[u] = 0u;
    __syncthreads();
    XcdBarrier bar = xcd_barrier_post(ctl + CW_BAR, MISC + 8);
#if COOP_LAUNCH
    cg::grid_group grid = cg::this_grid();
#endif
    const int lo = args.ph_lo, hi = args.ph_hi;
    bool first_seam = true; (void)first_seam;
#if COOP_LAUNCH
#define SEAM(k) do { if ((k) + 1 < hi) { if (first_seam) { grid.sync(); first_seam = false; } else xcd_barrier(bar); } } while (0)
#else
#define SEAM(k) do { if ((k) + 1 < hi) xcd_barrier(bar); } while (0)
#endif
#define IN(k) (lo <= (k) && (k) < hi)
#ifdef PROBE_LO
    if (F.mode & 2048) { for (int i = 0; i < 20; ++i) xcd_barrier(bar); }
#endif
    if (IN(0)) { s_prologue(F); SEAM(0); }
    if (IN(1)) { if (T_GEMM_Z) t_gemm_z(F); else s_gemm_z(F); SEAM(1); }
#if T_S5 && T_ATTN == 2 && T_ALT
    if (IN(2)) { if (F.wave & 1) { t_qkv_prep2(F); t_s5_pass<false>(F); } else { t_s5_pass<false>(F); t_qkv_prep2(F); } SEAM(2); }
#else
    if (IN(2)) { if (T_S5) { if (!(F.mode & 32)) t_s5_pass<false>(F); } else s_s5_scan<false>(F); if (F.mode & 64) {} else if (T_ATTN == 2) t_qkv_prep2(F); else if (T_ATTN) t_qkv_prep(F); else s_qkn(F); SEAM(2); }
#endif
    if (IN(3)) { if (T_S5) t_s5_carry(F); else s_s5_carry(F);
        if (T_ATTN == 2) { const attn2::AttnTensors AT{(const attn2::bf16*)F.YS, (const attn2::bf16*)(F.YS + (size_t)M * 512), (const attn2::bf16*)F.YS2, (attn2::bf16*)F.QKN};
                      const attn2::StaticOrder S((int)F.G, (int)blockIdx.x);
#ifdef PROBE_LO
                      if (F.mode & 256) attn2::attn_phase<attn2::StaticOrder, 8, 1>((char*)lds, AT, S); else if (F.mode & 512) attn2::attn_phase<attn2::StaticOrder, 8, 2>((char*)lds, AT, S); else if (F.mode & 1024) attn2::attn_phase<attn2::StaticOrder, 8, 4>((char*)lds, AT, S); else if (F.mode & 4096) attn2::attn_phase<attn2::StaticOrder, 8, 8>((char*)lds, AT, S); else if (F.mode & 8192) attn2::attn_phase<attn2::StaticOrder, 8, 16>((char*)lds, AT, S); else if (F.mode & 16384) attn2::attn_phase<attn2::StaticOrder, 8, 32>((char*)lds, AT, S); else
#endif
                      attn2::attn_phase<attn2::StaticOrder>((char*)lds, AT, S); }
        else if (T_ATTN) { const attn_body::AttnTensors AT{(const attn_body::bf16*)F.QKN, (const attn_body::bf16*)F.YS, (const attn_body::bf16*)F.YS2, (attn_body::bf16*)F.QKN};
                      const attn_body::StaticOrder S((int)F.G, (int)blockIdx.x); attn_body::attn_phase<attn_body::StaticOrder>((char*)lds, AT, S); }
        else s_attn(F);
        SEAM(3); }
#if T_S5 && T_ATTN == 2 && T_ALT
    if (IN(4)) { if (F.wave & 1) { t_attn_post2(F); t_s5_pass<true>(F); } else { t_s5_pass<true>(F); t_attn_post2(F); } SEAM(4); }
#else
    if (IN(4)) { if (T_S5) { if (!(F.mode & 32)) t_s5_pass<true>(F); } else s_s5_scan<true>(F); if (F.mode & 64) {} else if (T_ATTN == 2) t_attn_post2(F); else if (T_ATTN) t_attn_post(F); SEAM(4); }
#endif
    if (IN(5)) { if (T_GEMM_GLU) t_gemm_glu(F); else s_gemm_glu(F); SEAM(5); }
    if (IN(6)) { if (T_GEMM_MIX) t_gemm_mix(F); else s_gemm_mix(F); SEAM(6); }
    if (IN(7)) { if (T_GEMM_WO) t_gemm_wo(F); else s_gemm_wo(F); SEAM(7); }
#if defined(PROBE_DUP) && PROBE_DUP == 8
    if (IN(8)) {
#pragma unroll 1
        for (int rep = 0; rep < 2; ++rep) { t_router(F); if (rep == 0) xcd_barrier(bar); }
        SEAM(8); }
#else
    if (IN(8)) { if (T_ROUTER) t_router(F); else s_router(F); SEAM(8); }
#endif
    if (IN(9)) { if (T_ROUTER) t_scatter(F); else s_scatter(F); SEAM(9); }
    if (IN(10)) { if (T_MOE) t_moe1(F); else s_moe1(F); SEAM(10); }
    if (IN(11)) { if (T_MOE) t_moe2(F); else s_moe2(F); SEAM(11); }
#if defined(PROBE_DUP) && PROBE_DUP == 11
    if (IN(11)) { t_moe2(F); xcd_barrier(bar); }
#endif
#if defined(PROBE_DUP) && PROBE_DUP == 10
    if (IN(10)) { t_moe1(F); xcd_barrier(bar); }
#endif
    if (IN(12)) { s_combine(F); }
#undef IN
#undef SEAM
}

extern "C" void kernel_launch(void* const* d_in, const int* in_sizes, int n_in, void* d_out, int out_size, void* d_ws, size_t ws_size, hipStream_t stream) {
    static int grid = 0;
    if (grid == 0) {
        if (n_in != 33 || ws_size < WS_END || out_size != M * D) { fprintf(stderr, "kernel_launch: need 33 inputs, out %d and %zu bytes of workspace (got %d, %d, %zu)\n", M * D, (size_t)WS_END, n_in, out_size, ws_size); grid = -1; return; }
        int dev = 0, cus = 0, per_cu = 0;
        if (hipGetDevice(&dev) != hipSuccess || hipDeviceGetAttribute(&cus, hipDeviceAttributeMultiprocessorCount, dev) != hipSuccess) { grid = -1; return; }
        if (hipFuncSetAttribute((const void*)mk_fwd, hipFuncAttributeMaxDynamicSharedMemorySize, LDS_BYTES) != hipSuccess) { fprintf(stderr, "kernel_launch: hipFuncSetAttribute failed\n"); grid = -1; return; }
        if (hipOccupancyMaxActiveBlocksPerMultiprocessor(&per_cu, (const void*)mk_fwd, NTHR, LDS_BYTES) != hipSuccess || per_cu < 1) { fprintf(stderr, "kernel_launch: occupancy query failed (%d)\n", per_cu); (void)hipGetLastError(); grid = -1; return; }
        grid = cus * (per_cu < 1 ? 1 : 1);
    }
    if (grid < 0) return;
    (void)hipMemsetAsync((char*)d_ws + WS_CTL, 0, CTL_ZERO_BYTES, stream);
    Args a{};
    for (int i = 0; i < 33; ++i) a.in[i] = (const float*)d_in[i];
    a.out = (float*)d_out; a.ws = (unsigned char*)d_ws; a.ph_lo = 0; a.ph_hi = NPHASE;
    void* kargs[] = {&a};
#if COOP_LAUNCH
    const hipError_t e = hipLaunchCooperativeKernel((const void*)mk_fwd, dim3(grid), dim3(NTHR), kargs, LDS_BYTES, stream);
#else
    (void)kargs; hipLaunchKernelGGL(mk_fwd, dim3(grid), dim3(NTHR), LDS_BYTES, stream, a);
    const hipError_t e = hipPeekAtLastError();
#endif
    if (e != hipSuccess) fprintf(stderr, "kernel_launch: launch failed: %s (grid %d)\n", hipGetErrorString(e), grid);
#ifdef PROBE_LO
    a.ph_lo = PROBE_LO; a.ph_hi = PROBE_HI; a.mode = PROBE_MODE;
    (void)hipMemsetAsync((char*)d_ws + WS_CTL + CW_BAR * 4, 0, XCD_BAR_WORDS * 4, stream);
#if COOP_LAUNCH
    (void)hipLaunchCooperativeKernel((const void*)mk_fwd, dim3(grid), dim3(NTHR), kargs, LDS_BYTES, stream);
#else
    hipLaunchKernelGGL(mk_fwd, dim3(grid), dim3(NTHR), LDS_BYTES, stream, a);
#endif
#endif
}
```

```cpp
#include <hip/hip_runtime.h>
#include <hip/hip_cooperative_groups.h>
#include <cstdio>
#include <cstdint>
namespace cg = cooperative_groups;

typedef unsigned short bf16_t;
typedef short bf16x8 __attribute__((ext_vector_type(8)));
typedef float f32x4 __attribute__((ext_vector_type(4)));
#define LAS __attribute__((address_space(3)))

constexpr int D = 1024, BATCH = 2, SEQ = 8192, NMETA = 16;
constexpr int M = BATCH * SEQ;
constexpr int INW = 4096;
constexpr int SW = 512;
constexpr int NG = 32, NP = 64, NC = 16;
constexpr int NCHUNK = SEQ / 64;
constexpr int AW = 512;
constexpr int NE = 32, TOPK = 4;
constexpr int NASSIGN = M * TOPK;
constexpr int MOE_ROWS = NASSIGN + NE * 256;
constexpr float EPS = 1e-6f;
constexpr int NWAVES = 8, NTHR = 512;
constexpr int KVS = 64 + SEQ;

constexpr size_t MiB = 1u << 20;
constexpr size_t al(size_t x) { return (x + 255) & ~(size_t)255; }
constexpr size_t WS_CTL = 0, CTL_ZERO_BYTES = 1 * MiB;
constexpr int CW_BAR = 4096;
constexpr int CW_CNT = 16384;
constexpr size_t WS_SM = 1 * MiB;
constexpr size_t SM_BB = 0;
constexpr size_t SM_AA = SM_BB + al((size_t)NG * NP * 32 * 4);
constexpr size_t SM_E = SM_AA + al((size_t)NG * NP * 4 * 4);
constexpr size_t SM_SIN = SM_E + al((size_t)BATCH * NCHUNK * NG * NP * 2 * 4);
constexpr size_t SM_LAM = SM_SIN + al((size_t)BATCH * NCHUNK * NG * NP * 2 * 4);
constexpr size_t SM_IDX = SM_LAM + 256;
constexpr size_t SM_GATE = SM_IDX + al((size_t)NASSIGN * 4);
constexpr size_t SM_POS = SM_GATE + al((size_t)NASSIGN * 4);
constexpr size_t SM_OFF = SM_POS + al((size_t)NASSIGN * 4);
constexpr size_t SM_ROWTOK = SM_OFF + 256;
constexpr size_t SM_ROWTK = SM_ROWTOK + al((size_t)MOE_ROWS * 4);
constexpr size_t SM_ZM = SM_ROWTK + al((size_t)MOE_ROWS * 4);
constexpr size_t SM_QKNM = SM_ZM + al((size_t)NMETA * INW * 2);
constexpr size_t SM_TEXP = SM_QKNM + al((size_t)NMETA * D * 2);
constexpr size_t SM_BBH = SM_TEXP + al((size_t)(MOE_ROWS / 256) * 4);
constexpr size_t SM_CMT = SM_BBH + al((size_t)NG * NP * 32 * 2);
constexpr size_t SM_TCNT = SM_CMT + al((size_t)NG * NC * 128 * 2);
constexpr size_t SM_END = SM_TCNT + al((size_t)(M / 32) * NE * 4);
static_assert(SM_END <= 13 * MiB, "small region");
constexpr size_t WS_WD = 14 * MiB;
constexpr size_t WD_IN = 0, WD_GLU = WD_IN + (size_t)INW * D * 2, WD_SO = WD_GLU + (size_t)SW * SW * 2, WD_AO = WD_SO + (size_t)D * SW * 2, WD_O = WD_AO + (size_t)D * AW * 2, WD_END = WD_O + (size_t)D * D * 2;
static_assert(WD_END <= 13 * MiB, "dense weight copies");
constexpr size_t WS_WGU = 27 * MiB;
constexpr size_t WS_WDN = WS_WGU + 128 * MiB;
constexpr size_t RSZ = 34078720;
constexpr size_t WS_R0 = WS_WDN + 64 * MiB;
constexpr size_t WS_R1 = WS_R0 + RSZ;
constexpr size_t WS_R2 = WS_R1 + RSZ;
constexpr size_t WS_R3 = WS_R2 + RSZ;
constexpr size_t WS_END = WS_R3 + al((size_t)MOE_ROWS * D * 2);
static_assert((size_t)M * INW * 2 <= (size_t)MOE_ROWS * D * 2 && (size_t)BATCH * KVS * D * 2 <= RSZ, "region sizes");

constexpr int LDS_BYTES = 147456;
constexpr int MISC_OFF = LDS_BYTES - 256;

__device__ __forceinline__ unsigned f2bf(float f) { unsigned u = __builtin_bit_cast(unsigned, f); return (u + 0x7fffu + ((u >> 16) & 1u)) >> 16; }
__device__ __forceinline__ float bf2f(unsigned h) { return __builtin_bit_cast(float, h << 16); }
__device__ __forceinline__ unsigned pk2(float lo, float hi) { return f2bf(lo) | (f2bf(hi) << 16); }
__device__ __forceinline__ float wave_sum(float v) {
#pragma unroll
    for (int o = 1; o < 64; o <<= 1) v += __shfl_xor(v, o);
    return v;
}
__device__ __forceinline__ float sigmoidf_(float x) { return 1.f / (1.f + __expf(-x)); }
__device__ __forceinline__ float gelu_tanh(float x) { const float t = 0.7978845608028654f * (x + 0.044715f * x * x * x); return 0.5f * x * (1.f + tanhf(t)); }

#define XB_TMO      128
#define XB_XCNT(j)  (256  + 64 * (j))
#define XB_XSUB(j)  (1280 + 64 * (j))
#define XB_XGEN(j)  (2304 + 64 * (j))
#define XB_TOP      3328
#define XB_TOPGEN   3392
#define XCD_BAR_WORDS 3456
#define XB_SPIN_CAP (1u << 22)
__device__ __forceinline__ unsigned xb_ld(unsigned* p)              { return __hip_atomic_load(p, __ATOMIC_RELAXED, __HIP_MEMORY_SCOPE_AGENT); }
__device__ __forceinline__ unsigned xb_add(unsigned* p, unsigned v) { return __hip_atomic_fetch_add(p, v, __ATOMIC_RELAXED, __HIP_MEMORY_SCOPE_AGENT); }
__device__ __forceinline__ unsigned xb_xcc_id() { return (unsigned)__builtin_amdgcn_s_getreg((3 << 11) | 20) & 0xFu; }
#define XB_SPIN(cond, bar) do { unsigned _sp = 0; while (cond) { __builtin_amdgcn_s_sleep(1); \
    if ((++_sp & 255u) == 0u) { if (xb_ld(&(bar)[XB_TMO])) break; if (_sp > XB_SPIN_CAP) { atomicAdd(&(bar)[XB_TMO], 1u); break; } } } } while (0)
struct XcdBarrier { unsigned* bar; unsigned x; volatile LAS unsigned* st; };
__device__ __forceinline__ XcdBarrier xcd_barrier_post(unsigned* bar, volatile LAS unsigned* st) {
    XcdBarrier b; b.bar = bar; b.x = xb_xcc_id(); b.st = st;
    if (threadIdx.x == 0) (void)xb_add(&bar[XB_XCNT(b.x)], 1u);
    return b;
}
__device__ __forceinline__ void xcd_barrier_complete(unsigned* bar, unsigned x, unsigned& nloc, unsigned& nx) {
    const unsigned G = gridDim.x * gridDim.y * gridDim.z;
    unsigned sum, cnt, mine, sp = 0u;
    for (;;) {
        sum = 0u; cnt = 0u; mine = 0u;
#pragma unroll
        for (unsigned j = 0; j < 16; ++j) { const unsigned c = xb_ld(&bar[XB_XCNT(j)]); sum += c; cnt += (c > 0u) ? 1u : 0u; mine = (j == x) ? c : mine; }
        if (sum == G) break;
        __builtin_amdgcn_s_sleep(1);
        if ((++sp & 255u) == 0u) { if (xb_ld(&bar[XB_TMO])) break; if (sp > XB_SPIN_CAP) { atomicAdd(&bar[XB_TMO], 1u); break; } }
    }
    nloc = mine > 0u ? mine : 1u; nx = cnt > 0u ? cnt : 1u;
}
__device__ __forceinline__ void xcd_barrier(const XcdBarrier& b) {
    asm volatile("s_waitcnt vmcnt(0)" ::: "memory");
    __syncthreads();
    if (threadIdx.x == 0) {
        unsigned* bar = b.bar;
        __builtin_amdgcn_s_waitcnt(0);
        unsigned nloc = b.st[0], nx = b.st[1];
        if (nloc == 0u) { xcd_barrier_complete(bar, b.x, nloc, nx); b.st[0] = nloc; b.st[1] = nx; }
        const unsigned old = xb_add(&bar[XB_XSUB(b.x)], 1u);
        const unsigned gen = old / nloc;
        if (old + 1u == (gen + 1u) * nloc) {
            __builtin_amdgcn_fence(__ATOMIC_RELEASE, "agent");
            asm volatile("s_waitcnt vmcnt(0)" ::: "memory");
            const unsigned og = xb_add(&bar[XB_TOP], 1u);
            const unsigned tg = og / nx;
            if (og + 1u == (tg + 1u) * nx) xb_add(&bar[XB_TOPGEN], 1u);
            else XB_SPIN(xb_ld(&bar[XB_TOPGEN]) == tg, bar);
            __builtin_amdgcn_fence(__ATOMIC_ACQUIRE, "agent");
            xb_add(&bar[XB_XGEN(b.x)], 1u);
            asm volatile("s_waitcnt vmcnt(0)" ::: "memory");
        } else {
            XB_SPIN(xb_ld(&bar[XB_XGEN(b.x)]) == gen, bar);
            __builtin_amdgcn_fence(__ATOMIC_ACQUIRE, "agent");
            asm volatile("s_waitcnt vmcnt(0)" ::: "memory");
        }
    }
    __syncthreads();
}

struct Args { const float* in[33]; float* out; unsigned char* ws; int ph_lo, ph_hi, mode, pad; };
struct Frame {
    unsigned char* lds; LAS unsigned char* lds3; int tid, lane, wave, vcu, G, mode;
    const float *x, *meta, *norm_mix_g, *w_in, *a_re, *a_im, *log_dt, *b_re, *b_im, *c_re, *c_im, *ssm_d, *w_glu, *b_glu, *q_g, *k_g, *lq1, *lk1, *lq2, *lk2, *sub_g, *w_so, *w_ao, *w_o,
                *norm_ffn_g, *w_router, *b_router, *w_gate, *b_gate, *w_up, *b_up, *w_down, *b_down;
    float* out;
    bf16_t *XN, *Z, *YS, *YS2, *QKN, *YA, *MIX, *ACT, *Y2, *XN2, *ZM, *QKNM, *BBH, *CMT, *XN8, *Wt_in8, *H1B;
    bf16_t *Wt_in, *Wt_glu, *Wt_so, *Wt_ao, *Wt_o, *Wt_gu, *Wt_dn;
    float *BB, *AA, *E, *SIN, *LAM, *GATE; int *IDX, *POS, *CNT, *OFF, *ROWTOK, *ROWTK, *TEXP, *TCNT;
};
namespace pg8 {
#define PG8_LAS __attribute__((address_space(3)))
typedef unsigned short bf16_t;
typedef short bf16x8 __attribute__((ext_vector_type(8)));
typedef float f32x4 __attribute__((ext_vector_type(4)));
typedef unsigned u32x4 __attribute__((ext_vector_type(4)));
typedef int i32x8 __attribute__((ext_vector_type(8))); typedef int i32x4 __attribute__((ext_vector_type(4)));
__device__ __forceinline__ i32x8 cat8(bf16x8 a, bf16x8 b) { const i32x4 x = __builtin_bit_cast(i32x4, a), y = __builtin_bit_cast(i32x4, b); return (i32x8){x[0], x[1], x[2], x[3], y[0], y[1], y[2], y[3]}; }
constexpr int BM = 256, BK = 64, HALF = 128, HTB = HALF * BK * 2  , STAGE_BYTES = 8 * HTB, NXCD = 8, WGM = 8;

__host__ __device__ __forceinline__ int lds_byte(int r, int c) { const int st = (r >> 4) * 2 + (c >> 5), rr = r & 15, cc = c & 31, ob = rr * 64 + cc * 2; return st * 1024 + (ob ^ (((ob >> 9) & 1) << 5)); }
__host__ __device__ __forceinline__ void stage_rc(int b, int& R, int& C) { const int st = b / 1024, sb = b % 1024, swz = sb ^ (((sb >> 9) & 1) << 5); R = (st >> 1) * 16 + swz / 64; C = (st & 1) * 32 + (swz % 64) / 2; }
__host__ __device__ __forceinline__ int perm32(int rho) { const int n = rho >> 4, i = rho & 15; return 8 * (i >> 2) + 4 * n + (i & 3); }

struct Unit { int pm, pn; };
struct Gemm { const bf16_t* A; const bf16_t* Bt; int M, N, K; const PG8_LAS int* rowidx; };

struct StaticOrder {
    int nM, nN, nwg, G, c;
    __host__ __device__ void init(int M, int N, int G_, int c_) { nM = M / BM; nN = N / BM; nwg = nM * nN; G = G_; c = c_; }
    __host__ __device__ bool next(int i, Unit& u) const {
        const long L = (long)i * G + c; if (L >= nwg) return false;
        int wgid = (int)L; { const int q = nwg / NXCD, r = nwg % NXCD, xcd = wgid % NXCD, off = wgid / NXCD; wgid = (xcd < r ? xcd * (q + 1) : r * (q + 1) + (xcd - r) * q) + off; }
        const int nig = WGM * nN, gid = wgid / nig, fm = gid * WGM, gsz = (nM - fm) < WGM ? (nM - fm) : WGM;
        u.pm = fm + ((wgid % nig) % gsz); u.pn = (wgid % nig) / gsz; return true;
    }
    __device__ __forceinline__ void a_ready(const Unit&) const {}
    __device__ __forceinline__ void done(const Unit&) const {}
};

__device__ __forceinline__ unsigned cvt_pk_bf16(float lo, float hi) { unsigned r; asm volatile("v_cvt_pk_bf16_f32 %0, %1, %2" : "=v"(r) : "v"(lo), "v"(hi)); return r; }
typedef float f32x2 __attribute__((ext_vector_type(2)));
__device__ __forceinline__ f32x2 gelu_pk(f32x2 v) {
    const f32x2 av = __builtin_elementwise_abs(v), d = av * 0.2316418882f + 1.0f;
    f32x2 t; t.x = __builtin_amdgcn_rcpf(d.x); t.y = __builtin_amdgcn_rcpf(d.y);
    f32x2 q = t * 0.5307027145f + (-0.7265760135f); q = q * t + 0.7107068705f; q = q * t + (-0.142248368f); q = q * t + 0.127414796f; q = q * t;
    const f32x2 s = (v * v) * (-0.72134752044f);
    f32x2 e; e.x = __builtin_amdgcn_exp2f(s.x); e.y = __builtin_amdgcn_exp2f(s.y);
    const f32x2 m = v * (q * e), r = v - m;
    f32x2 o; o.x = v.x < 0.f ? m.x : r.x; o.y = v.y < 0.f ? m.y : r.y; return o;
}

template <int ACT  > struct EpiBf16 {
    static constexpr bool PERM = true, AFTER_DRAIN = false; static_assert(ACT == 0 || ACT == 1, "EpiBf16: ACT is 0 (none) or 1 (gelu_pk)");
    bf16_t* O; int ldc; const float* bias; int split_cols; size_t split_stride; float scale0; int nt_from;
    __device__ __forceinline__ void operator()(const f32x4 (&acc)[2][2][4][2], const Unit& u, int wr, int wc, int fr, int fq) const {
        const int row0 = u.pm * BM + wr * 64 + fr; int colt = u.pn * BM; bf16_t* base = O;
        float sc = 1.f; if (split_cols) { const int t = colt / split_cols; base += (size_t)t * split_stride; colt -= t * split_cols; if (t == 0) sc = scale0; }
        const int col0 = colt + wc * 32 + 8 * fq, bcol0 = u.pn * BM + wc * 32 + 8 * fq;
        f32x4 bv[2][2];
#pragma unroll
        for (int bj = 0; bj < 2; ++bj)
#pragma unroll
            for (int n = 0; n < 2; ++n) bv[bj][n] = bias ? *(const f32x4*)(bias + bcol0 + bj * HALF + 4 * n) : (f32x4){0.f, 0.f, 0.f, 0.f};
#pragma unroll
        for (int ai = 0; ai < 2; ++ai)
#pragma unroll
            for (int m = 0; m < 4; ++m) { bf16_t* rowp = base + (size_t)(row0 + ai * HALF + m * 16) * ldc + col0;
#pragma unroll
                for (int bj = 0; bj < 2; ++bj) { f32x4 v0 = acc[ai][bj][m][0] + bv[bj][0], v1 = acc[ai][bj][m][1] + bv[bj][1];
                    if (ACT == 1) { f32x2 a = gelu_pk((f32x2){v0[0], v0[1]}), b = gelu_pk((f32x2){v0[2], v0[3]}), c = gelu_pk((f32x2){v1[0], v1[1]}), d = gelu_pk((f32x2){v1[2], v1[3]});
                        v0 = (f32x4){a.x, a.y, b.x, b.y}; v1 = (f32x4){c.x, c.y, d.x, d.y}; }
                    v0 = v0 * sc; v1 = v1 * sc; u32x4 w; w.x = cvt_pk_bf16(v0[0], v0[1]); w.y = cvt_pk_bf16(v0[2], v0[3]); w.z = cvt_pk_bf16(v1[0], v1[1]); w.w = cvt_pk_bf16(v1[2], v1[3]);
                    if (nt_from && bcol0 >= nt_from) __builtin_nontemporal_store(w, (u32x4*)(rowp + bj * HALF)); else *(u32x4*)(rowp + bj * HALF) = w; } }
    }
};
__device__ __forceinline__ unsigned pk4_fp8(float a, float b, float c, float d) { int w = __builtin_amdgcn_cvt_pk_fp8_f32(a, b, 0, false); w = __builtin_amdgcn_cvt_pk_fp8_f32(c, d, w, true); return (unsigned)w; }
__device__ __forceinline__ float sigm(float x) { return __builtin_amdgcn_rcpf(1.f + __builtin_amdgcn_exp2f(-1.4426950408889634f * x)); }
__device__ __forceinline__ float bflo(unsigned w) { return __builtin_bit_cast(float, w << 16); }
__device__ __forceinline__ float bfhi(unsigned w) { return __builtin_bit_cast(float, w & 0xffff0000u); }
struct EpiGlu {
    static constexpr bool PERM = true, AFTER_DRAIN = false;
    const bf16_t* YS; bf16_t* O; const float* bias; int ldc, ldo;
    __device__ __forceinline__ void operator()(const f32x4 (&acc)[2][2][4][2], const Unit& u, int wr, int wc, int fr, int fq) const {
        const int row0 = u.pm * BM + wr * 64 + fr, col0 = u.pn * BM + wc * 32 + 8 * fq;
#pragma unroll
        for (int bj = 0; bj < 2; ++bj) {
            const f32x4 b0 = *(const f32x4*)(bias + col0 + bj * HALF), b1 = *(const f32x4*)(bias + col0 + bj * HALF + 4);
#pragma unroll
            for (int ai = 0; ai < 2; ++ai)
#pragma unroll
                for (int m = 0; m < 4; ++m) {
                    const size_t off = (size_t)(row0 + ai * HALF + m * 16) * ldc + col0 + bj * HALF;
                    const u32x4 y = *(const u32x4*)(YS + off);
                    const f32x4 v0 = acc[ai][bj][m][0] + b0, v1 = acc[ai][bj][m][1] + b1;
                    u32x4 w;
                    w.x = cvt_pk_bf16(bflo(y.x) * sigm(v0[0]), bfhi(y.x) * sigm(v0[1])); w.y = cvt_pk_bf16(bflo(y.y) * sigm(v0[2]), bfhi(y.y) * sigm(v0[3]));
                    w.z = cvt_pk_bf16(bflo(y.z) * sigm(v1[0]), bfhi(y.z) * sigm(v1[1])); w.w = cvt_pk_bf16(bflo(y.w) * sigm(v1[2]), bfhi(y.w) * sigm(v1[3]));
                    *(u32x4*)(O + (size_t)(row0 + ai * HALF + m * 16) * ldo + col0 + bj * HALF) = w;
                }
        }
    }
};
template <bool FIRST, bool OUT8 = false> struct EpiMix {
    static constexpr bool PERM = true, AFTER_DRAIN = false;
    const bf16_t* Zg; bf16_t* O; unsigned char* O8;
    __device__ __forceinline__ void operator()(const f32x4 (&acc)[2][2][4][2], const Unit& u, int wr, int wc, int fr, int fq) const {
        const int row0 = u.pm * BM + wr * 64 + fr, col0 = u.pn * BM + wc * 32 + 8 * fq;
#pragma unroll
        for (int ai = 0; ai < 2; ++ai)
#pragma unroll
            for (int m = 0; m < 4; ++m)
#pragma unroll
                for (int bj = 0; bj < 2; ++bj) {
                    const size_t row = (size_t)(row0 + ai * HALF + m * 16); const int col = col0 + bj * HALF;
                    const u32x4 z = *(const u32x4*)(Zg + row * 4096 + col);
                    const f32x4 a0 = acc[ai][bj][m][0], a1 = acc[ai][bj][m][1];
                    float v[8] = {sigm(bflo(z.x)) * a0[0], sigm(bfhi(z.x)) * a0[1], sigm(bflo(z.y)) * a0[2], sigm(bfhi(z.y)) * a0[3],
                                  sigm(bflo(z.z)) * a1[0], sigm(bfhi(z.z)) * a1[1], sigm(bflo(z.w)) * a1[2], sigm(bfhi(z.w)) * a1[3]};
                    if (!FIRST) { const u32x4 o = *(const u32x4*)(O + row * 1024 + col);
                        v[0] += bflo(o.x); v[1] += bfhi(o.x); v[2] += bflo(o.y); v[3] += bfhi(o.y); v[4] += bflo(o.z); v[5] += bfhi(o.z); v[6] += bflo(o.w); v[7] += bfhi(o.w); }
                    if constexpr (OUT8) { typedef unsigned u32x2 __attribute__((ext_vector_type(2))); *(u32x2*)(O8 + row * 1024 + col) = (u32x2){pk4_fp8(v[0], v[1], v[2], v[3]), pk4_fp8(v[4], v[5], v[6], v[7])}; }
                    else { u32x4 w; w.x = cvt_pk_bf16(v[0], v[1]); w.y = cvt_pk_bf16(v[2], v[3]); w.z = cvt_pk_bf16(v[4], v[5]); w.w = cvt_pk_bf16(v[6], v[7]);
                    *(u32x4*)(O + row * 1024 + col) = w; }
                }
    }
};
struct EpiMixCat {
    static constexpr bool PERM = true, AFTER_DRAIN = false;
    const bf16_t* Z; bf16_t* O;
    __device__ __forceinline__ void mid(f32x4 (&acc)[2][2][4][2], const Unit& u, int wr, int wc, int fr, int fq) const {
        int row0 = u.pm * BM + wr * 64 + fr, col0 = u.pn * BM + wc * 32 + 8 * fq;
        asm volatile("" : "+v"(row0), "+v"(col0));
#pragma unroll
        for (int ai = 0; ai < 2; ++ai)
#pragma unroll
            for (int m = 0; m < 4; ++m)
#pragma unroll
                for (int bj = 0; bj < 2; ++bj) {
                    const bf16_t* zp = Z + (size_t)(row0 + ai * HALF + m * 16) * 4096 + col0 + bj * HALF;
                    const u32x4 z0 = *(const u32x4*)(zp + 2048), z1 = *(const u32x4*)(zp + 3072);
                    const float a0[8] = {bflo(z0.x), bfhi(z0.x), bflo(z0.y), bfhi(z0.y), bflo(z0.z), bfhi(z0.z), bflo(z0.w), bfhi(z0.w)};
                    const float a1[8] = {bflo(z1.x), bfhi(z1.x), bflo(z1.y), bfhi(z1.y), bflo(z1.z), bfhi(z1.z), bflo(z1.w), bfhi(z1.w)};
#pragma unroll
                    for (int i = 0; i < 8; ++i) {
                        const float r = (1.f + __builtin_amdgcn_exp2f(-1.4426950408889634f * a0[i])) * __builtin_amdgcn_rcpf(1.f + __builtin_amdgcn_exp2f(-1.4426950408889634f * a1[i]));
                        acc[ai][bj][m][i >> 2][i & 3] *= r; }
                }
    }
    __device__ __forceinline__ void operator()(const f32x4 (&acc)[2][2][4][2], const Unit& u, int wr, int wc, int fr, int fq) const {
        const int row0 = u.pm * BM + wr * 64 + fr, col0 = u.pn * BM + wc * 32 + 8 * fq;
#pragma unroll
        for (int ai = 0; ai < 2; ++ai)
#pragma unroll
            for (int m = 0; m < 4; ++m)
#pragma unroll
                for (int bj = 0; bj < 2; ++bj) {
                    const size_t row = (size_t)(row0 + ai * HALF + m * 16); const int col = col0 + bj * HALF;
                    const u32x4 z = *(const u32x4*)(Z + row * 4096 + 2048 + col);
                    const f32x4 a0 = acc[ai][bj][m][0], a1 = acc[ai][bj][m][1];
                    u32x4 w; w.x = cvt_pk_bf16(sigm(bflo(z.x)) * a0[0], sigm(bfhi(z.x)) * a0[1]); w.y = cvt_pk_bf16(sigm(bflo(z.y)) * a0[2], sigm(bfhi(z.y)) * a0[3]);
                    w.z = cvt_pk_bf16(sigm(bflo(z.z)) * a1[0], sigm(bfhi(z.z)) * a1[1]); w.w = cvt_pk_bf16(sigm(bflo(z.w)) * a1[2], sigm(bfhi(z.w)) * a1[3]);
                    *(u32x4*)(O + row * 1024 + col) = w;
                }
    }
};
struct EpiWoB {
    static constexpr bool PERM = true, AFTER_DRAIN = false;
    const float* x; bf16_t* O;
    __device__ __forceinline__ void operator()(const f32x4 (&acc)[2][2][4][2], const Unit& u, int wr, int wc, int fr, int fq) const {
        const int row0 = u.pm * BM + wr * 64 + fr, col0 = u.pn * BM + wc * 32 + 8 * fq;
#pragma unroll
        for (int ai = 0; ai < 2; ++ai)
#pragma unroll
            for (int m = 0; m < 4; ++m)
#pragma unroll
                for (int bj = 0; bj < 2; ++bj) {
                    const size_t off = (size_t)(row0 + ai * HALF + m * 16) * 1024 + col0 + bj * HALF;
                    const f32x4 v0 = *(const f32x4*)(x + off) + acc[ai][bj][m][0], v1 = *(const f32x4*)(x + off + 4) + acc[ai][bj][m][1];
                    u32x4 w; w.x = cvt_pk_bf16(v0[0], v0[1]); w.y = cvt_pk_bf16(v0[2], v0[3]); w.z = cvt_pk_bf16(v1[0], v1[1]); w.w = cvt_pk_bf16(v1[2], v1[3]);
                    *(u32x4*)(O + off) = w;
                }
    }
};
struct EpiWo {
    static constexpr bool PERM = false, AFTER_DRAIN = false;
    const float* x; float* out; float sc;
    __device__ __forceinline__ void operator()(const f32x4 (&acc)[2][2][4][2], const Unit& u, int wr, int wc, int fr, int fq) const {
        const int row0 = u.pm * BM + wr * 64 + fr, col0 = u.pn * BM + wc * 32 + 4 * fq;
#pragma unroll
        for (int ai = 0; ai < 2; ++ai)
#pragma unroll
            for (int m = 0; m < 4; ++m)
#pragma unroll
                for (int bj = 0; bj < 2; ++bj)
#pragma unroll
                    for (int n = 0; n < 2; ++n) {
                        const size_t off = (size_t)(row0 + ai * HALF + m * 16) * 1024 + col0 + bj * HALF + n * 16;
                        *(f32x4*)(out + off) = *(const f32x4*)(x + off) + acc[ai][bj][m][n] * sc;
                    }
    }
};
struct EpiScaleBf16 {
    static constexpr bool PERM = true, AFTER_DRAIN = false;
    bf16_t* O; int ldc; float s;
    __device__ __forceinline__ void operator()(const f32x4 (&acc)[2][2][4][2], const Unit& u, int wr, int wc, int fr, int fq) const {
        const int row0 = u.pm * BM + wr * 64 + fr, col0 = u.pn * BM + wc * 32 + 8 * fq;
#pragma unroll
        for (int ai = 0; ai < 2; ++ai)
#pragma unroll
            for (int m = 0; m < 4; ++m)
#pragma unroll
                for (int bj = 0; bj < 2; ++bj) { const f32x4 v0 = acc[ai][bj][m][0] * s, v1 = acc[ai][bj][m][1] * s;
                    u32x4 w; w.x = cvt_pk_bf16(v0[0], v0[1]); w.y = cvt_pk_bf16(v0[2], v0[3]); w.z = cvt_pk_bf16(v1[0], v1[1]); w.w = cvt_pk_bf16(v1[2], v1[3]);
                    *(u32x4*)(O + (size_t)(row0 + ai * HALF + m * 16) * ldc + col0 + bj * HALF) = w; }
    }
};
struct MoeOrder {
    const int* texp; int ntiles, NT, G, v;
    __device__ __forceinline__ bool next(int i, Unit& u) const {
        const int L = i * G + v; if (L >= ntiles * NT) return false;
        const int mt = L / NT; u.pm = mt; u.pn = texp[mt] * NT + (L % NT); return true;
    }
    __device__ __forceinline__ void a_ready(const Unit&) const {}
    __device__ __forceinline__ void done(const Unit&) const {}
};
template <bool FP8> struct EpiMoe1 {
    static constexpr bool PERM = true, AFTER_DRAIN = false;
    bf16_t* ACT; const float* bg; const float* bu;
    __device__ __forceinline__ void operator()(const f32x4 (&acc)[2][2][4][2], const Unit& u, int wr, int wc, int fr, int fq) const {
        const int e = u.pn >> 3, pnl = u.pn & 7;
        const int row0 = u.pm * BM + wr * 64 + fr, oc = pnl * HALF + wc * 32 + 8 * fq;
        const f32x4 g0 = *(const f32x4*)(bg + e * 1024 + oc), g1 = *(const f32x4*)(bg + e * 1024 + oc + 4), u0 = *(const f32x4*)(bu + e * 1024 + oc), u1 = *(const f32x4*)(bu + e * 1024 + oc + 4);
#pragma unroll
        for (int ai = 0; ai < 2; ++ai)
#pragma unroll
            for (int m = 0; m < 4; ++m) {
                const float sc = FP8 ? 0.03125f : 1.f;
                const f32x4 ga = acc[ai][0][m][0] * sc + g0, gb = acc[ai][0][m][1] * sc + g1, ua = acc[ai][1][m][0] * sc + u0, ub = acc[ai][1][m][1] * sc + u1;
                float v[8];
#pragma unroll
                for (int i = 0; i < 4; ++i) { const float gg = fminf(ga[i], 7.f), uu = fminf(fmaxf(ua[i], -7.f), 7.f); v[i] = (uu + 1.f) * gg * sigm(1.702f * gg);
                                              const float g2 = fminf(gb[i], 7.f), u2 = fminf(fmaxf(ub[i], -7.f), 7.f); v[4 + i] = (u2 + 1.f) * g2 * sigm(1.702f * g2); }
                if constexpr (FP8) { typedef unsigned u32x2 __attribute__((ext_vector_type(2)));
                    *(u32x2*)((unsigned char*)ACT + (size_t)(row0 + ai * HALF + m * 16) * 1024 + oc) = (u32x2){pk4_fp8(v[0], v[1], v[2], v[3]), pk4_fp8(v[4], v[5], v[6], v[7])}; }
                else { u32x4 w; w.x = cvt_pk_bf16(v[0], v[1]); w.y = cvt_pk_bf16(v[2], v[3]); w.z = cvt_pk_bf16(v[4], v[5]); w.w = cvt_pk_bf16(v[6], v[7]);
                    *(u32x4*)(ACT + (size_t)(row0 + ai * HALF + m * 16) * 1024 + oc) = w; }
            }
    }
};
template <bool FP8> struct EpiMoe2 {
    static constexpr bool PERM = true, AFTER_DRAIN = false;
    bf16_t* Y2; const float* bd; const int* rowtk;
    __device__ __forceinline__ void operator()(const f32x4 (&acc)[2][2][4][2], const Unit& u, int wr, int wc, int fr, int fq) const {
        const int e = u.pn >> 2, pnl = u.pn & 3;
        const int row0 = u.pm * BM + wr * 64 + fr, col0 = pnl * BM + wc * 32 + 8 * fq;
        f32x4 bv[2][2];
#pragma unroll
        for (int bj = 0; bj < 2; ++bj)
#pragma unroll
            for (int n = 0; n < 2; ++n) bv[bj][n] = *(const f32x4*)(bd + e * 1024 + col0 + bj * HALF + 4 * n);
#pragma unroll
        for (int ai = 0; ai < 2; ++ai)
#pragma unroll
            for (int m = 0; m < 4; ++m) {
                const int tk = rowtk[row0 + ai * HALF + m * 16];
                if (tk >= 0) {
#pragma unroll
                    for (int bj = 0; bj < 2; ++bj) { const float sc = FP8 ? 0.03125f : 1.f; const f32x4 v0 = acc[ai][bj][m][0] * sc + bv[bj][0], v1 = acc[ai][bj][m][1] * sc + bv[bj][1];
                        if constexpr (FP8) { typedef unsigned u32x2 __attribute__((ext_vector_type(2)));
                            *(u32x2*)((unsigned char*)Y2 + (size_t)tk * 1024 + col0 + bj * HALF) = (u32x2){pk4_fp8(v0[0], v0[1], v0[2], v0[3]), pk4_fp8(v1[0], v1[1], v1[2], v1[3])}; }
                        else { u32x4 w; w.x = cvt_pk_bf16(v0[0], v0[1]); w.y = cvt_pk_bf16(v0[2], v0[3]); w.z = cvt_pk_bf16(v1[0], v1[1]); w.w = cvt_pk_bf16(v1[2], v1[3]);
                        *(u32x4*)(Y2 + (size_t)tk * 1024 + col0 + bj * HALF) = w; } }
                }
            }
    }
};
template <class Epi, class Sched, bool ALIGN_EPI = false, bool SP2 = false, bool GATHER = false, bool FP8 = false, bool MID = false>
__device__ __forceinline__ void gemm_phase(PG8_LAS unsigned char* lds, const Gemm g, const Sched& S, const Epi& E) {
    static_assert(!GATHER || SP2, "the gathered A operand is wired into the SP2 loop only");
    const int tid = threadIdx.x, wid = __builtin_amdgcn_readfirstlane(tid >> 6), lane = tid & 63, wr = wid >> 2, wc = wid & 3, fr = lane & 15, fq = lane >> 4;
    const int K = g.K, nt = K / BK;
    unsigned voffA[2], voffB[2];
#pragma unroll
    for (int i = 0; i < 2; ++i) { int R, C; stage_rc(tid * 16 + i * 8192, R, C); const int Rb = Epi::PERM ? ((R & ~31) + perm32(R & 31)) : R;
        voffA[i] = (unsigned)(R * K + C) * 2u; voffB[i] = (unsigned)(Rb * K + C) * 2u; }
    const size_t kstep = (size_t)(BK * 2);
    const size_t hstep = (size_t)HALF * K * 2;
    const size_t tstep = 2 * hstep;
    const unsigned ldsw = (unsigned)wid * 1024u;
    const int aoff = lds_byte(wr * 64 + fr, fq * 8), boff = lds_byte(wc * 32 + fr, fq * 8);
#define PG8_SA(b, h) (((b) * 2 + (h)) * HTB)
#define PG8_SB(b, h) ((4 + (b) * 2 + (h)) * HTB)
#define PG8_STAGE(bufoff, gbase, voff) do { _Pragma("unroll") for (int _i = 0; _i < 2; ++_i) \
        __builtin_amdgcn_global_load_lds((const unsigned*)((const char*)(gbase) + (voff)[_i]), (PG8_LAS unsigned*)(lds + (bufoff) + ldsw + _i * 8192), 16, 0, 0); } while (0)
#define PG8_STAGE_A(bufoff, nx, h, koff, dptr) do { if constexpr (GATHER) { _Pragma("unroll") for (int _i = 0; _i < 2; ++_i) \
        __builtin_amdgcn_global_load_lds((const unsigned*)((const char*)g.A + (koff) + ((nx) ? nga[h][_i] : cga[h][_i])), (PG8_LAS unsigned*)(lds + (bufoff) + ldsw + _i * 8192), 16, 0, 0); } \
    else { PG8_STAGE(bufoff, dptr, voffA); } } while (0)
#define PG8_GATH(ord, o) do { _Pragma("unroll") for (int _h = 0; _h < 2; ++_h) _Pragma("unroll") for (int _i = 0; _i < 2; ++_i) { int R_, C_, t_ = tid; asm volatile("" : "+v"(t_)); stage_rc(t_ * 16 + _i * 8192, R_, C_);   \
        o[_h][_i] = ((unsigned)g.rowidx[(ord) * 256 + _h * HALF + R_] * (unsigned)K + (unsigned)C_) * 2u; } } while (0)
#define PG8_LDA(dst, b, h) do { if constexpr (FP8) { _Pragma("unroll") for (int m = 0; m < 4; ++m) dst##8[m] = cat8(*(const PG8_LAS bf16x8*)(lds + PG8_SA(b, h) + aoff + m * 2048), *(const PG8_LAS bf16x8*)(lds + PG8_SA(b, h) + aoff + m * 2048 + 1024)); } \
    else { _Pragma("unroll") for (int m = 0; m < 4; ++m) _Pragma("unroll") for (int k = 0; k < 2; ++k) dst[m][k] = *(const PG8_LAS bf16x8*)(lds + PG8_SA(b, h) + aoff + m * 2048 + k * 1024); } } while (0)
#define PG8_LDB(dst, b, h) do { if constexpr (FP8) { _Pragma("unroll") for (int n = 0; n < 2; ++n) dst##8[n] = cat8(*(const PG8_LAS bf16x8*)(lds + PG8_SB(b, h) + boff + n * 2048), *(const PG8_LAS bf16x8*)(lds + PG8_SB(b, h) + boff + n * 2048 + 1024)); } \
    else { _Pragma("unroll") for (int n = 0; n < 2; ++n) _Pragma("unroll") for (int k = 0; k < 2; ++k) dst[n][k] = *(const PG8_LAS bf16x8*)(lds + PG8_SB(b, h) + boff + n * 2048 + k * 1024); } } while (0)
#define PG8_MMA(ai, bj, At, Bt) do { __builtin_amdgcn_s_setprio(1); if constexpr (FP8) { _Pragma("unroll") for (int m = 0; m < 4; ++m) _Pragma("unroll") for (int n = 0; n < 2; ++n) \
        asm volatile("v_mfma_f32_16x16x128_f8f6f4 %0, %1, %2, %0" : "+v"(acc[ai][bj][m][n]) : "v"(Bt##8[n]), "v"(At##8[m]));   } \
    else { _Pragma("unroll") for (int m = 0; m < 4; ++m) _Pragma("unroll") for (int n = 0; n < 2; ++n) _Pragma("unroll") for (int k = 0; k < 2; ++k) \
        acc[ai][bj][m][n] = __builtin_amdgcn_mfma_f32_16x16x32_bf16(Bt[n][k], At[m][k], acc[ai][bj][m][n], 0, 0, 0); } __builtin_amdgcn_s_setprio(0); } while (0)
#define PG8_WAIT_V(n) asm volatile("s_waitcnt vmcnt(" #n ")" ::: "memory")
#define PG8_WAIT_L(n) asm volatile("s_waitcnt lgkmcnt(" #n ")" ::: "memory")
#define PG8_BAR __builtin_amdgcn_s_barrier()
#define PG8_SCHED __builtin_amdgcn_sched_barrier(0)
    Unit cur, nxt; int ui = 0;
    if (!S.next(0, cur)) return;
    f32x4 acc[2][2][4][2];
#pragma unroll
    for (int a = 0; a < 2; ++a)
#pragma unroll
        for (int b = 0; b < 2; ++b)
#pragma unroll
            for (int m = 0; m < 4; ++m)
#pragma unroll
                for (int n = 0; n < 2; ++n) acc[a][b][m][n] = (f32x4){0.f, 0.f, 0.f, 0.f};
    bf16x8 At[4][2], B0[2][2], B1[2][2]; i32x8 At8[4], B08[2], B18[2];
    const char* cA = (const char*)g.A + (size_t)cur.pm * tstep; const char* cB = (const char*)g.Bt + (size_t)cur.pn * tstep;
    S.a_ready(cur);
    unsigned cga[2][2] = {{0u, 0u}, {0u, 0u}}, nga[2][2] = {{0u, 0u}, {0u, 0u}};
    if constexpr (GATHER) PG8_GATH(0, cga);
    if constexpr (SP2) {
        PG8_STAGE(PG8_SB(0, 0), cB, voffB); PG8_STAGE(PG8_SB(0, 1), cB + hstep, voffB); PG8_STAGE_A(PG8_SA(0, 0), false, 0, 0, cA); PG8_STAGE_A(PG8_SA(0, 1), false, 1, 0, cA + hstep);
        if (wr == 1) PG8_BAR;
        PG8_WAIT_V(2); PG8_BAR;
        PG8_STAGE(PG8_SB(1, 0), cB + kstep, voffB); PG8_STAGE_A(PG8_SA(1, 0), false, 0, kstep, cA + kstep); PG8_STAGE(PG8_SB(1, 1), cB + hstep + kstep, voffB);
        PG8_WAIT_V(6); PG8_BAR;
    } else {
        PG8_STAGE(PG8_SB(0, 0), cB, voffB); PG8_STAGE(PG8_SA(0, 0), cA, voffA); PG8_STAGE(PG8_SB(0, 1), cB + hstep, voffB); PG8_STAGE(PG8_SA(0, 1), cA + hstep, voffA);
        if (wr == 1) PG8_BAR;
        PG8_WAIT_V(4); PG8_BAR;
        PG8_STAGE(PG8_SB(1, 0), cB + kstep, voffB); PG8_STAGE(PG8_SA(1, 0), cA + kstep, voffA); PG8_STAGE(PG8_SB(1, 1), cB + hstep + kstep, voffB);
        PG8_WAIT_V(6); PG8_BAR;
    }
    for (;;) {
        const bool has_next = S.next(ui + 1, nxt);
        if constexpr (GATHER) { if (has_next) PG8_GATH(ui + 1, nga); else { nga[0][0] = cga[0][0]; nga[0][1] = cga[0][1]; nga[1][0] = cga[1][0]; nga[1][1] = cga[1][1]; } }
        const char* nA = has_next ? (const char*)g.A + (size_t)nxt.pm * tstep : cA; const char* nB = has_next ? (const char*)g.Bt + (size_t)nxt.pn * tstep : cB;
#pragma unroll 1
        for (int t = 0; t < nt; t += 2) {
            if constexpr (MID) { if (t == nt / 2) { PG8_SCHED; E.mid(acc, cur, wr, wc, fr, fq); PG8_SCHED; } }
            const bool last = (t == nt - 2);
            const char* a1 = cA + (size_t)(t + 1) * kstep;
            const char* a2 = last ? nA : cA + (size_t)(t + 2) * kstep; const char* b2 = last ? nB : cB + (size_t)(t + 2) * kstep;
            const char* a3 = a2 + kstep; const char* b3 = b2 + kstep;
            if (last && has_next) S.a_ready(nxt);
            const size_t k1 = (size_t)(t + 1) * kstep, k2 = last ? (size_t)0 : (size_t)(t + 2) * kstep, k3 = k2 + kstep; (void)k1; (void)k2; (void)k3;
            if constexpr (SP2) {
            PG8_LDB(B0, 0, 0); PG8_LDB(B1, 0, 1); PG8_SCHED; PG8_LDA(At, 0, 0); PG8_STAGE_A(PG8_SA(1, 1), false, 1, k1, a1 + hstep);
            PG8_WAIT_V(8); PG8_WAIT_L(0); PG8_BAR; PG8_MMA(0, 0, At, B0); PG8_MMA(0, 1, At, B1); PG8_BAR; PG8_SCHED;
            PG8_LDA(At, 0, 1); PG8_STAGE(PG8_SB(0, 0), b2, voffB); PG8_STAGE(PG8_SB(0, 1), b2 + hstep, voffB); PG8_STAGE_A(PG8_SA(0, 0), last, 0, k2, a2);
            PG8_WAIT_V(8); PG8_WAIT_L(0); PG8_BAR; PG8_MMA(1, 0, At, B0); PG8_MMA(1, 1, At, B1); PG8_BAR; PG8_SCHED;
            PG8_LDB(B0, 1, 0); PG8_LDB(B1, 1, 1); PG8_SCHED; PG8_LDA(At, 1, 0); PG8_STAGE_A(PG8_SA(0, 1), last, 1, k2, a2 + hstep);
            PG8_WAIT_V(8); PG8_WAIT_L(0); PG8_BAR; PG8_MMA(0, 0, At, B0); PG8_MMA(0, 1, At, B1); PG8_BAR; PG8_SCHED;
            PG8_LDA(At, 1, 1); PG8_STAGE(PG8_SB(1, 0), b3, voffB); PG8_STAGE(PG8_SB(1, 1), b3 + hstep, voffB); PG8_STAGE_A(PG8_SA(1, 0), last, 0, k3, a3);
            PG8_WAIT_V(8); PG8_WAIT_L(0); PG8_BAR; PG8_MMA(1, 0, At, B0); PG8_MMA(1, 1, At, B1); PG8_BAR; PG8_SCHED;
            } else {
            PG8_LDB(B0, 0, 0); PG8_SCHED; PG8_LDA(At, 0, 0); PG8_STAGE(PG8_SA(1, 1), a1 + hstep, voffA);
            PG8_WAIT_L(8); PG8_BAR; PG8_WAIT_L(0); PG8_MMA(0, 0, At, B0); PG8_BAR; PG8_SCHED;
            PG8_LDB(B1, 0, 1); PG8_STAGE(PG8_SB(0, 0), b2, voffB);
            PG8_BAR; PG8_WAIT_L(0); PG8_MMA(0, 1, At, B1); PG8_BAR;
            PG8_LDA(At, 0, 1); PG8_STAGE(PG8_SA(0, 0), a2, voffA);
            PG8_BAR; PG8_WAIT_L(0); PG8_MMA(1, 0, At, B0); PG8_BAR; PG8_SCHED;
            PG8_STAGE(PG8_SB(0, 1), b2 + hstep, voffB);
            PG8_WAIT_V(6); PG8_BAR; PG8_MMA(1, 1, At, B1); PG8_BAR;
            PG8_LDB(B0, 1, 0); PG8_SCHED; PG8_LDA(At, 1, 0); PG8_STAGE(PG8_SA(0, 1), a2 + hstep, voffA);
            PG8_WAIT_L(8); PG8_BAR; PG8_WAIT_L(0); PG8_MMA(0, 0, At, B0); PG8_BAR; PG8_SCHED;
            PG8_LDB(B1, 1, 1); PG8_STAGE(PG8_SB(1, 0), b3, voffB);
            PG8_BAR; PG8_WAIT_L(0); PG8_MMA(0, 1, At, B1); PG8_BAR;
            PG8_LDA(At, 1, 1); PG8_STAGE(PG8_SA(1, 0), a3, voffA);
            PG8_BAR; PG8_WAIT_L(0); PG8_MMA(1, 0, At, B0); PG8_BAR; PG8_SCHED;
            PG8_STAGE(PG8_SB(1, 1), b3 + hstep, voffB);
            PG8_WAIT_V(6); PG8_BAR; PG8_MMA(1, 1, At, B1); PG8_BAR;
            }
        }
        if constexpr (ALIGN_EPI) { if (wr == 0) PG8_BAR; }
        if constexpr (FP8) asm volatile("s_nop 15\n\ts_nop 15" ::: "memory");
        if constexpr (!Epi::AFTER_DRAIN) { E(acc, cur, wr, wc, fr, fq); S.done(cur); }
        if (!has_next) break;
#pragma unroll
        for (int a = 0; a < 2; ++a)
#pragma unroll
            for (int b = 0; b < 2; ++b)
#pragma unroll
                for (int m = 0; m < 4; ++m)
#pragma unroll
                    for (int n = 0; n < 2; ++n) acc[a][b][m][n] = (f32x4){0.f, 0.f, 0.f, 0.f};
        cur = nxt; cA = nA; cB = nB; ++ui;
        if constexpr (GATHER) { cga[0][0] = nga[0][0]; cga[0][1] = nga[0][1]; cga[1][0] = nga[1][0]; cga[1][1] = nga[1][1]; }
        if constexpr (ALIGN_EPI) { if (wr == 1) PG8_BAR; }
    }
    PG8_WAIT_V(0);
    if constexpr (!ALIGN_EPI) { if (wr == 0) PG8_BAR; }
    PG8_BAR;
    if constexpr (Epi::AFTER_DRAIN) { E.fused(acc, cur, wr, wc, fr, fq, lds, wid, lane); S.done(cur); }
#undef PG8_SA
#undef PG8_SB
#undef PG8_STAGE
#undef PG8_STAGE_A
#undef PG8_GATH
#undef PG8_LDA
#undef PG8_LDB
#undef PG8_MMA
#undef PG8_WAIT_V
#undef PG8_WAIT_L
#undef PG8_BAR
#undef PG8_SCHED
}
}
#include <hip/hip_bf16.h>
#include <cmath>
namespace attn_body {
using bf16=__hip_bfloat16;
using bf16x8=__attribute__((ext_vector_type(8)))short;
using s16x4=__attribute__((ext_vector_type(4)))short;
using f32x16=__attribute__((ext_vector_type(16)))float;
using u32x4=__attribute__((ext_vector_type(4)))unsigned;
constexpr int BATCH=2,NHEAD=16,SEQ=8192,D=64,DM=NHEAD*D,KVSEQ=SEQ+64;
constexpr int NW=8,QBLK=32,QB=QBLK*NW,KVBLK=64,NQB=SEQ/QB;
constexpr int ATTN_PITCH=DM, ATTN_UNIT_ROWS=QB;
__device__ __forceinline__ int crow(int r,int hi){return (r&3)+8*(r>>2)+4*hi;}
#define SBAR() __builtin_amdgcn_sched_barrier(0)
__device__ __forceinline__ void cmask(f32x16&p0,f32x16&p1,int jb,int qrel,int hi){
  const float NEG=-INFINITY; int kb=64*jb+4*hi;
  #pragma unroll
  for(int r=0;r<16;++r){int kv=kb+(r&3)+8*(r>>2); if(kv>qrel)p0[r]=NEG; if(kv+32>qrel)p1[r]=NEG;}
}

constexpr int NSLOT=3, SLOTB=8192;
constexpr int LDS_K=0, LDS_V=NSLOT*SLOTB, LDS_WS=2*NSLOT*SLOTB, LDS_OST=LDS_WS+NW*64*4, LDS_BYTES=LDS_OST+NW*4096;
constexpr float C2=0.125f*1.4426950408889634f;
__device__ __forceinline__ void glds16(const void*gsrc,unsigned lds_dst){unsigned keep;
  asm volatile("s_mov_b32 %0, m0\n\ts_mov_b32 m0, %2\n\ts_nop 0\n\tglobal_load_lds_dwordx4 %1, off\n\ts_mov_b32 m0, %0":"=&s"(keep):"v"(gsrc),"s"(lds_dst):"memory");}
__device__ __forceinline__ float max3f(float a,float b,float c){float r;asm("v_max3_f32 %0, %1, %2, %3":"=v"(r):"v"(a),"v"(b),"v"(c));return r;}
__device__ __forceinline__ float max2f(float a,float b){float r;asm("v_max_f32_e32 %0, %1, %2":"=v"(r):"v"(a),"v"(b));return r;}
__device__ __forceinline__ float fadd_s(float a,float b){float r;asm("v_add_f32_e32 %0, %1, %2":"=v"(r):"v"(a),"v"(b));return r;}
__device__ __forceinline__ float fsub_s(float a,float b){float r;asm("v_sub_f32_e32 %0, %1, %2":"=v"(r):"v"(a),"v"(b));return r;}
typedef float f32x2_t __attribute__((ext_vector_type(2))); typedef __bf16 bf16x2_t __attribute__((ext_vector_type(2)));
__device__ __forceinline__ unsigned cvtpk_s(float lo,float hi){f32x2_t v={lo,hi};bf16x2_t b=__builtin_convertvector(v,bf16x2_t);return __builtin_bit_cast(unsigned,b);}
#define WAIT_BAR(N) asm volatile("s_waitcnt vmcnt(" #N ") lgkmcnt(0)\n\ts_barrier":::"memory")

__device__ __forceinline__ void qkt(f32x16&p0,f32x16&p1,const char*Kslot,const bf16x8*qr,const f32x16&negm,int r32,int hi){
  const char*kb=Kslot+hi*1024+r32*16;
  #pragma unroll
  for(int d0=0;d0<4;++d0){
    const bf16x8 b0=*reinterpret_cast<const bf16x8*>(kb+d0*2048);
    const bf16x8 b1=*reinterpret_cast<const bf16x8*>(kb+d0*2048+512);
    if(d0==0){p0=__builtin_amdgcn_mfma_f32_32x32x16_bf16(b0,qr[0],negm,0,0,0);p1=__builtin_amdgcn_mfma_f32_32x32x16_bf16(b1,qr[0],negm,0,0,0);}
    else{p0=__builtin_amdgcn_mfma_f32_32x32x16_bf16(b0,qr[d0],p0,0,0,0);p1=__builtin_amdgcn_mfma_f32_32x32x16_bf16(b1,qr[d0],p1,0,0,0);}}
}
typedef __attribute__((address_space(3))) const char* lds_cptr;
typedef short v4i16_t __attribute__((ext_vector_type(4)));
__device__ __forceinline__ void kload8(bf16x8*kf,lds_cptr kp){
  kf[0]=*(const __attribute__((address_space(3))) bf16x8*)(kp);      kf[1]=*(const __attribute__((address_space(3))) bf16x8*)(kp+512);
  kf[2]=*(const __attribute__((address_space(3))) bf16x8*)(kp+2048); kf[3]=*(const __attribute__((address_space(3))) bf16x8*)(kp+2560);
  kf[4]=*(const __attribute__((address_space(3))) bf16x8*)(kp+4096); kf[5]=*(const __attribute__((address_space(3))) bf16x8*)(kp+4608);
  kf[6]=*(const __attribute__((address_space(3))) bf16x8*)(kp+6144); kf[7]=*(const __attribute__((address_space(3))) bf16x8*)(kp+6656);
}
__device__ __forceinline__ void kload2(bf16x8*kf,lds_cptr kp,int j){ kf[2*j]=*(const __attribute__((address_space(3))) bf16x8*)(kp+j*2048); kf[2*j+1]=*(const __attribute__((address_space(3))) bf16x8*)(kp+j*2048+512); }
__device__ __forceinline__ s16x4 vtr(lds_cptr p){ return __builtin_bit_cast(s16x4,__builtin_amdgcn_ds_read_tr16_b64_v4i16((__attribute__((address_space(3))) v4i16_t*)p)); }
__device__ __forceinline__ float rowmax(const f32x16&p0,const f32x16&p1){
  float a=max3f(p0[0],p0[1],p1[0]),b=max3f(p0[2],p0[3],p1[1]);a=max3f(a,p1[2],p1[3]);
  #pragma unroll
  for(int r=4;r<16;r+=4){a=max3f(a,p0[r],p0[r+1]);b=max3f(b,p0[r+2],p0[r+3]);a=max3f(a,p1[r],p1[r+1]);b=max3f(b,p1[r+2],p1[r+3]);}
  const float m=max2f(a,b);
  auto rr=__builtin_amdgcn_permlane32_swap(__float_as_uint(m),__float_as_uint(m),false,false);
  return max2f(__uint_as_float(rr[0]),__uint_as_float(rr[1]));
}
__device__ __forceinline__ void pv(f32x16*o,int vb,bf16x8 pa0,bf16x8 pa1,bf16x8 pa2,bf16x8 pa3){
  #pragma unroll
  for(int d0=0;d0<2;++d0){s16x4 lo[4],hi[4];
    #pragma unroll
    for(int ks=0;ks<4;++ks){
      asm volatile("ds_read_b64_tr_b16 %0,%1 offset:%c2":"=&v"(lo[ks]):"v"(vb),"i"(d0*4096+ks*1024):"memory");
      asm volatile("ds_read_b64_tr_b16 %0,%1 offset:%c2":"=&v"(hi[ks]):"v"(vb),"i"(d0*4096+ks*1024+512):"memory");}
    asm volatile("s_waitcnt lgkmcnt(0)":::"memory");SBAR();
    #define PK(k) (bf16x8){lo[k][0],lo[k][1],lo[k][2],lo[k][3],hi[k][0],hi[k][1],hi[k][2],hi[k][3]}
    o[d0]=__builtin_amdgcn_mfma_f32_32x32x16_bf16(pa0,PK(0),o[d0],0,0,0);
    o[d0]=__builtin_amdgcn_mfma_f32_32x32x16_bf16(pa1,PK(1),o[d0],0,0,0);
    o[d0]=__builtin_amdgcn_mfma_f32_32x32x16_bf16(pa2,PK(2),o[d0],0,0,0);
    o[d0]=__builtin_amdgcn_mfma_f32_32x32x16_bf16(pa3,PK(3),o[d0],0,0,0);
    #undef PK
  }
}

#ifndef ATTN_STORE16
#define ATTN_STORE16(p,v) (*(u32x4*)(p)=(v))
#endif
template<int THRL> __device__ __forceinline__ void attn_unit(int b,int h,int qb,const bf16*Q,const bf16*__restrict__ K,const bf16*__restrict__ V,bf16*O,char*shm){
  const int tid=threadIdx.x,lane=tid&63,r32=lane&31,hi=lane>>5; const int wid=__builtin_amdgcn_readfirstlane(tid>>6);
  const long rowbase=(long)b*SEQ; const int q0=qb*QB;
  const bf16*Qw=Q+(rowbase+q0+wid*QBLK)*DM+h*D;
  const bf16*Kh=K+(long)b*KVSEQ*DM+h*D,*Vh=V+(long)b*KVSEQ*DM+h*D;
  const unsigned lds0=(unsigned)(uintptr_t)shm;
  float*wsf=(float*)(shm+LDS_WS)+wid*64;
  const bf16*ksrc=Kh+(long)lane*DM+wid*8;
  const bf16*vsrc=Vh+(long)(16*(wid&3)+(lane>>2))*DM+(wid>>2)*32+(lane&3)*8;
  const unsigned kdst=lds0+LDS_K+wid*1024, vdst=lds0+LDS_V+wid*1024;
  #define DMA_K(t,slot) glds16(ksrc+(long)(t)*KVBLK*DM,(unsigned)__builtin_amdgcn_readfirstlane(kdst+(slot)))
  #define DMA_V(t,slot) glds16(vsrc+(long)(t)*KVBLK*DM,(unsigned)__builtin_amdgcn_readfirstlane(vdst+(slot)))
  const int vb0=(int)(lds0+LDS_V)+((lane>>4)&1)*32+(lane&3)*8+(4*hi+((lane&15)>>2))*64;
  const char*Kbase=shm+LDS_K; bf16x8 kf[8];
  const lds_cptr shm3=(lds_cptr)shm; const lds_cptr kp0=shm3+LDS_K+hi*1024+r32*16; const lds_cptr vp0=shm3+LDS_V+((lane>>4)&1)*32+(lane&3)*8+(4*hi+((lane&15)>>2))*64;
  const int NT=(q0+QB)/KVBLK+1;
  DMA_K(0,0);DMA_V(0,0);DMA_K(1,SLOTB);
  bf16x8 qr[4];
  #pragma unroll
  for(int d0=0;d0<4;++d0)qr[d0]=*reinterpret_cast<const bf16x8*>(&Qw[(long)r32*DM+d0*16+hi*8]);
  float mhat=0.f,l_reg=0.f;f32x16 o[2];o[0]=f32x16{};o[1]=f32x16{};f32x16 negm=f32x16{};asm volatile("":"+v"(negm));
  const int qrel=wid*QBLK+r32;
  #define CMASK(P0,P1,t) do{int jb_=(t)-(NT-4); if(jb_>=0)cmask(P0,P1,jb_,qrel,hi);}while(0)
  bool resc=false;
  #define START(P0,P1) do{ const float rm=rowmax(P0,P1); resc=false; \
    { const float dl=rm; mhat=fadd_s(mhat,dl); \
      _Pragma("unroll") for(int r=0;r<16;++r){P0[r]=fsub_s(P0[r],dl);P1[r]=fsub_s(P1[r],dl);} \
      _Pragma("unroll") for(int r=0;r<16;++r)negm[r]=-mhat; asm volatile("":"+v"(negm)); } \
    _Pragma("unroll") for(int r=0;r<16;++r)P0[r]=__builtin_amdgcn_exp2f(P0[r]); }while(0)
  #define RESC() do{ if(resc){ asm volatile("s_waitcnt lgkmcnt(0)":::"memory"); \
      _Pragma("unroll") for(int d_=0;d_<2;++d_) _Pragma("unroll") for(int r=0;r<16;++r)o[d_][r]*=wsf[crow(r,hi)]; } }while(0)
  f32x16 pA0,pA1,pB0,pB1;
  int sl_prev=0,sl_cur=0,sl_next=SLOTB;
  #define ROT() do{sl_prev=sl_cur;sl_cur=sl_next;sl_next=(sl_next==(NSLOT-1)*SLOTB)?0:sl_next+SLOTB;}while(0)
  DMA_K(2,2*SLOTB);
  WAIT_BAR(3);
  qkt(pA0,pA1,Kbase,qr,negm,r32,hi);asm volatile("s_nop 15\n\ts_nop 7":"+v"(pA0),"+v"(pA1));CMASK(pA0,pA1,0);
  _Pragma("unroll") for(int r=0;r<16;++r){ pA0[r]=-INFINITY; if(r<8)pA1[r]=-INFINITY; }
  START(pA0,pA1);
  _Pragma("unroll") for(int r=0;r<16;++r)pA1[r]=__builtin_amdgcn_exp2f(pA1[r]);
  WAIT_BAR(0);
  DMA_K(3,0);DMA_V(1,SLOTB);
  ROT();
  kload8(kf,kp0+sl_cur);
  WAIT_BAR(2);
  s16x4 vlo[8],vhi[8]; u32x4 pw0,pw1,pw2,pw3;
  #define PKW(P,B) cvtpk_s(P[B],P[B+1])
  #define PAF(k) __builtin_bit_cast(bf16x8,pw##k)
  #define VFR(i) (bf16x8){vlo[i][0],vlo[i][1],vlo[i][2],vlo[i][3],vhi[i][0],vhi[i][1],vhi[i][2],vhi[i][3]}
  #define PIN(x) asm volatile("":"+v"(x))
  #define MX3(a,b,c) __builtin_fmaxf(__builtin_fmaxf((a),(b)),(c))
  #define GAPA(MF,A0,A1,A2,A3,W0,W1,PW) do{ MF; sacc+=A0; sacc+=A1; sacc+=A2; sacc+=A3; PIN(sacc); W0; W1; PIN(PW); SBAR(); }while(0)
  #define EX(v) __builtin_amdgcn_exp2f(v)
  #define GAPB(MF,X,B) do{ MF; X[B]=EX(X[B]); X[B+1]=EX(X[B+1]); X[B+2]=EX(X[B+2]); X[B+3]=EX(X[B+3]); PIN(X); SBAR(); }while(0)
  #define VRD(i) do{ vlo[i]=vtr(vp_+(((i)>>2)*4096+((i)&3)*1024)); vhi[i]=vtr(vp_+(((i)>>2)*4096+((i)&3)*1024+512)); }while(0)
  #define KRD(G,j) do{ if(G){ kload2(kf,kp0+sl_next,j); SBAR(); } }while(0)
  #define STEP(C0,C1,P0,P1,t,GK,GV,GL) do{ SBAR(); \
    const lds_cptr vp_=vp0+sl_prev; \
    VRD(0); SBAR(); float sacc=(P0[0]+P0[1]); \
    GAPA(C0=__builtin_amdgcn_mfma_f32_32x32x16_bf16(kf[0],qr[0],negm,0,0,0), P0[2],P0[3],P0[4],P0[5],     pw0[0]=PKW(P0,0), pw0[1]=PKW(P0,2), pw0); \
    VRD(4); SBAR(); GAPA(C1=__builtin_amdgcn_mfma_f32_32x32x16_bf16(kf[1],qr[0],negm,0,0,0), P0[6],P0[7],P0[8],P0[9],     pw0[2]=PKW(P0,4), pw0[3]=PKW(P0,6), pw0); \
    VRD(1); SBAR(); GAPA(C0=__builtin_amdgcn_mfma_f32_32x32x16_bf16(kf[2],qr[1],C0,0,0,0),   P0[10],P0[11],P0[12],P0[13], pw1[0]=PKW(P0,8), pw1[1]=PKW(P0,10), pw1); \
    VRD(5); SBAR(); GAPA(C1=__builtin_amdgcn_mfma_f32_32x32x16_bf16(kf[3],qr[1],C1,0,0,0),   P0[14],P0[15],P1[0],P1[1],   pw1[2]=PKW(P0,12),pw1[3]=PKW(P0,14), pw1); \
    VRD(2); SBAR(); GAPA(C0=__builtin_amdgcn_mfma_f32_32x32x16_bf16(kf[4],qr[2],C0,0,0,0),   P1[2],P1[3],P1[4],P1[5],     pw2[0]=PKW(P1,0), pw2[1]=PKW(P1,2), pw2); \
    VRD(6); SBAR(); GAPA(C1=__builtin_amdgcn_mfma_f32_32x32x16_bf16(kf[5],qr[2],C1,0,0,0),   P1[6],P1[7],P1[8],P1[9],     pw2[2]=PKW(P1,4), pw2[3]=PKW(P1,6), pw2); \
    VRD(3); SBAR(); GAPA(C0=__builtin_amdgcn_mfma_f32_32x32x16_bf16(kf[6],qr[3],C0,0,0,0),   P1[10],P1[11],P1[12],P1[13], pw3[0]=PKW(P1,8), pw3[1]=PKW(P1,10), pw3); \
    VRD(7); SBAR(); GAPA(C1=__builtin_amdgcn_mfma_f32_32x32x16_bf16(kf[7],qr[3],C1,0,0,0),   P1[14],P1[15],0.f,0.f,       pw3[2]=PKW(P1,12),pw3[3]=PKW(P1,14), pw3); \
    l_reg+=sacc; \
    if(GK){DMA_K((t)+3,sl_cur);} if(GV){DMA_V((t)+1,sl_next);} \
    CMASK(C0,C1,t); \
    { float a=MX3(C0[0],C0[1],C1[0]),b=MX3(C0[2],C0[3],C1[1]); a=MX3(a,C1[2],C1[3]); \
      _Pragma("unroll") for(int r=4;r<16;r+=4){a=MX3(a,C0[r],C0[r+1]);b=MX3(b,C0[r+2],C0[r+3]);a=MX3(a,C1[r],C1[r+1]);b=MX3(b,C1[r+2],C1[r+3]);} \
      float rm=__builtin_fmaxf(a,b); { auto rr=__builtin_amdgcn_permlane32_swap(__float_as_uint(rm),__float_as_uint(rm),false,false); rm=__builtin_fmaxf(__uint_as_float(rr[0]),__uint_as_float(rr[1])); } \
      resc=false; \
      if(__builtin_expect(__any(rm>(float)THRL),0)){ const float dl=__builtin_fmaxf(rm,0.f); mhat+=dl; \
        _Pragma("unroll") for(int r=0;r<16;++r){C0[r]-=dl;C1[r]-=dl;} \
        _Pragma("unroll") for(int r=0;r<16;++r)negm[r]=-mhat; asm volatile("":"+v"(negm)); \
        const float f=__builtin_amdgcn_exp2f(-dl); l_reg*=f; if(hi==0)wsf[r32]=f; resc=true; } } \
    SBAR(); \
    GAPB(o[0]=__builtin_amdgcn_mfma_f32_32x32x16_bf16(PAF(0),VFR(0),o[0],0,0,0), C0,0); \
    GAPB(o[1]=__builtin_amdgcn_mfma_f32_32x32x16_bf16(PAF(0),VFR(4),o[1],0,0,0), C0,4); \
    KRD(GL,0); GAPB(o[0]=__builtin_amdgcn_mfma_f32_32x32x16_bf16(PAF(1),VFR(1),o[0],0,0,0), C0,8); \
    KRD(GL,1); GAPB(o[1]=__builtin_amdgcn_mfma_f32_32x32x16_bf16(PAF(1),VFR(5),o[1],0,0,0), C0,12); \
    KRD(GL,2); GAPB(o[0]=__builtin_amdgcn_mfma_f32_32x32x16_bf16(PAF(2),VFR(2),o[0],0,0,0), C1,0); \
    KRD(GL,3); GAPB(o[1]=__builtin_amdgcn_mfma_f32_32x32x16_bf16(PAF(2),VFR(6),o[1],0,0,0), C1,4); \
    GAPB(o[0]=__builtin_amdgcn_mfma_f32_32x32x16_bf16(PAF(3),VFR(3),o[0],0,0,0), C1,8); \
    GAPB(o[1]=__builtin_amdgcn_mfma_f32_32x32x16_bf16(PAF(3),VFR(7),o[1],0,0,0), C1,12); \
    }while(0)
  int t=1;
  #undef CMASK
  #define CMASK(P0,P1,t) do{}while(0)
  for(;t+5<NT;t+=2){
    STEP(pB0,pB1,pA0,pA1,t,true,true,true);     WAIT_BAR(2); RESC(); ROT();
    STEP(pA0,pA1,pB0,pB1,t+1,true,true,true);   WAIT_BAR(2); RESC(); ROT();
  }
  #undef CMASK
  #define CMASK(P0,P1,t) do{int jb_=(t)-(NT-4); if(jb_>=0)cmask(P0,P1,jb_,qrel,hi);}while(0)
  #define ENDW(tt) do{ if((tt)+3<NT){WAIT_BAR(2);} else if((tt)+2<NT){WAIT_BAR(1);} else {WAIT_BAR(0);} }while(0)
  for(;t+2<NT;t+=2){
    STEP(pB0,pB1,pA0,pA1,t,(t+3<NT),(t+1<NT),(t+1<NT));       ENDW(t);   RESC(); ROT();
    STEP(pA0,pA1,pB0,pB1,t+1,(t+4<NT),(t+2<NT),(t+2<NT));     ENDW(t+1); RESC(); ROT();
  }
  STEP(pB0,pB1,pA0,pA1,t,false,true,true); WAIT_BAR(0); RESC(); ROT();
  STEP(pA0,pA1,pB0,pB1,NT-1,false,false,false); RESC();
  { float sacc=pA0[0]+pA0[1]; _Pragma("unroll") for(int r=2;r<16;++r)sacc+=pA0[r]; _Pragma("unroll") for(int r=0;r<16;++r)sacc+=pA1[r]; l_reg+=sacc;
    pw0=(u32x4){PKW(pA0,0),PKW(pA0,2),PKW(pA0,4),PKW(pA0,6)};pw1=(u32x4){PKW(pA0,8),PKW(pA0,10),PKW(pA0,12),PKW(pA0,14)};pw2=(u32x4){PKW(pA1,0),PKW(pA1,2),PKW(pA1,4),PKW(pA1,6)};pw3=(u32x4){PKW(pA1,8),PKW(pA1,10),PKW(pA1,12),PKW(pA1,14)};
    SBAR(); pv(o,vb0+sl_cur,PAF(0),PAF(1),PAF(2),PAF(3)); }
  #undef PKW
  #undef PAF
  #undef VFR
  #undef PIN
  #undef MX3
  #undef GAPA
  #undef GAPB
  #undef EX
  #undef VRD
  #undef KRD
  #undef STEP
  #undef ENDW
  {auto rr=__builtin_amdgcn_permlane32_swap(__float_as_uint(l_reg),__float_as_uint(l_reg),false,false);l_reg=__uint_as_float(rr[0])+__uint_as_float(rr[1]);}
  if(hi==0)wsf[32+r32]=l_reg;asm volatile("s_waitcnt lgkmcnt(0)":::"memory");
  float rli[16];
  #pragma unroll
  for(int r=0;r<16;++r)rli[r]=__builtin_amdgcn_rcpf(wsf[32+crow(r,hi)]);
  bf16*Ow=O+(rowbase+q0+wid*QBLK)*DM+h*D;
  { bf16*stg=(bf16*)(shm+LDS_OST)+wid*2048;
    #pragma unroll
    for(int r=0;r<16;++r){const int orow=crow(r,hi);
      #pragma unroll
      for(int d0=0;d0<2;++d0)stg[orow*64+d0*32+r32]=__float2bfloat16(o[d0][r]*rli[r]);}
    asm volatile("s_waitcnt lgkmcnt(0)":::"memory");
    #pragma unroll
    for(int i=0;i<4;++i){const int row=i*8+(lane>>3),ch=lane&7; const u32x4 v=*(const u32x4*)(stg+row*64+ch*8); ATTN_STORE16(Ow+(long)row*DM+ch*8,v);} }
  asm volatile("s_waitcnt lgkmcnt(0)\n\ts_barrier":::"memory");
  #undef DMA_K
  #undef DMA_V
  #undef CMASK
  #undef START
  #undef RESC
  #undef ROT
}
constexpr int ATTN_LDS_BYTES=LDS_BYTES;
struct AttnTensors { const bf16* Q; const bf16* K; const bf16* V; bf16* O; };
struct AttnUnit { int bh; int qb; };
struct StaticOrder {
  int vcu;
  __device__ __forceinline__ explicit StaticOrder(int grid,int block):vcu((block%8)*(grid/8)+block/8){}
  __device__ __forceinline__ bool next(int i,AttnUnit&u)const{ if(i>=4)return false; const int s=vcu&7; u.bh=vcu>>3; u.qb=(i==0)?s:(i==1)?15-s:(i==2)?16+s:31-s; return true; }
  __device__ __forceinline__ void a_ready(const AttnUnit&)const{}
  __device__ __forceinline__ void done(const AttnUnit&)const{}
};
template<class Sched,int THRL=8> __device__ __forceinline__ void attn_phase(char*lds,const AttnTensors&T,const Sched&S){
  AttnUnit u;
  for(int i=0;S.next(i,u);++i){ S.a_ready(u); attn_unit<THRL>(u.bh/NHEAD,u.bh%NHEAD,u.qb,T.Q,T.K,T.V,T.O,lds); S.done(u); }
}
#undef SBAR
#undef WAIT_BAR
}
namespace attn2 {
using bf16=__hip_bfloat16;
using bf16x8=__attribute__((ext_vector_type(8)))short;
using s16x4=__attribute__((ext_vector_type(4)))short;
using f32x16=__attribute__((ext_vector_type(16)))float;
using u32x4=__attribute__((ext_vector_type(4)))unsigned;
constexpr int BATCH=2,NHEAD=8,SEQ=8192,D=64,DQK=NHEAD*D,DVP=512,DOP=1024,DM=DQK,KVSEQ=SEQ+64;
constexpr int NW=8,QBLK=32,QB=QBLK*NW,KVBLK=64,NQB=SEQ/QB;
constexpr int ATTN_PITCH=DM, ATTN_UNIT_ROWS=QB;
__device__ __forceinline__ int crow(int r,int hi){return (r&3)+8*(r>>2)+4*hi;}
#define SBAR() __builtin_amdgcn_sched_barrier(0)
__device__ __forceinline__ void cmask(f32x16&p0,f32x16&p1,int jb,int qrel,int hi){
  const float NEG=-INFINITY; int kb=64*jb+4*hi;
  #pragma unroll
  for(int r=0;r<16;++r){int kv=kb+(r&3)+8*(r>>2); if(kv>qrel)p0[r]=NEG; if(kv+32>qrel)p1[r]=NEG;}
}

constexpr int NSLOT=3, SLOTB=8192;
constexpr int LDS_K=0, LDS_V=NSLOT*SLOTB, LDS_WS=3*NSLOT*SLOTB, LDS_OST=LDS_WS+NW*64*4, LDS_BYTES=LDS_OST+NW*8192;
constexpr float C2=0.125f*1.4426950408889634f;
__device__ __forceinline__ void glds16(const void*gsrc,unsigned lds_dst){unsigned keep;
  asm volatile("s_mov_b32 %0, m0\n\ts_mov_b32 m0, %2\n\ts_nop 0\n\tglobal_load_lds_dwordx4 %1, off\n\ts_mov_b32 m0, %0":"=&s"(keep):"v"(gsrc),"s"(lds_dst):"memory");}
__device__ __forceinline__ float max3f(float a,float b,float c){float r;asm("v_max3_f32 %0, %1, %2, %3":"=v"(r):"v"(a),"v"(b),"v"(c));return r;}
__device__ __forceinline__ float max2f(float a,float b){float r;asm("v_max_f32_e32 %0, %1, %2":"=v"(r):"v"(a),"v"(b));return r;}
__device__ __forceinline__ float fadd_s(float a,float b){float r;asm("v_add_f32_e32 %0, %1, %2":"=v"(r):"v"(a),"v"(b));return r;}
__device__ __forceinline__ float fsub_s(float a,float b){float r;asm("v_sub_f32_e32 %0, %1, %2":"=v"(r):"v"(a),"v"(b));return r;}
typedef float f32x2_t __attribute__((ext_vector_type(2))); typedef __bf16 bf16x2_t __attribute__((ext_vector_type(2)));
__device__ __forceinline__ unsigned cvtpk_s(float lo,float hi){f32x2_t v={lo,hi};bf16x2_t b=__builtin_convertvector(v,bf16x2_t);return __builtin_bit_cast(unsigned,b);}
#define WAIT_BAR(N) asm volatile("s_waitcnt vmcnt(" #N ") lgkmcnt(0)\n\ts_barrier":::"memory")

__device__ __forceinline__ void qkt(f32x16&p0,f32x16&p1,const char*Kslot,const bf16x8*qr,const f32x16&negm,int r32,int hi){
  const char*kb=Kslot+hi*1024+r32*16;
  #pragma unroll
  for(int d0=0;d0<4;++d0){
    const bf16x8 b0=*reinterpret_cast<const bf16x8*>(kb+d0*2048);
    const bf16x8 b1=*reinterpret_cast<const bf16x8*>(kb+d0*2048+512);
    if(d0==0){p0=__builtin_amdgcn_mfma_f32_32x32x16_bf16(b0,qr[0],negm,0,0,0);p1=__builtin_amdgcn_mfma_f32_32x32x16_bf16(b1,qr[0],negm,0,0,0);}
    else{p0=__builtin_amdgcn_mfma_f32_32x32x16_bf16(b0,qr[d0],p0,0,0,0);p1=__builtin_amdgcn_mfma_f32_32x32x16_bf16(b1,qr[d0],p1,0,0,0);}}
}
typedef __attribute__((address_space(3))) const char* lds_cptr;
typedef short v4i16_t __attribute__((ext_vector_type(4)));
__device__ __forceinline__ void kload8(bf16x8*kf,lds_cptr kp){
  kf[0]=*(const __attribute__((address_space(3))) bf16x8*)(kp);      kf[1]=*(const __attribute__((address_space(3))) bf16x8*)(kp+512);
  kf[2]=*(const __attribute__((address_space(3))) bf16x8*)(kp+2048); kf[3]=*(const __attribute__((address_space(3))) bf16x8*)(kp+2560);
  kf[4]=*(const __attribute__((address_space(3))) bf16x8*)(kp+4096); kf[5]=*(const __attribute__((address_space(3))) bf16x8*)(kp+4608);
  kf[6]=*(const __attribute__((address_space(3))) bf16x8*)(kp+6144); kf[7]=*(const __attribute__((address_space(3))) bf16x8*)(kp+6656);
}
__device__ __forceinline__ void kload2(bf16x8*kf,lds_cptr kp,int j){ kf[2*j]=*(const __attribute__((address_space(3))) bf16x8*)(kp+j*2048); kf[2*j+1]=*(const __attribute__((address_space(3))) bf16x8*)(kp+j*2048+512); }
__device__ __forceinline__ s16x4 vtr(lds_cptr p){ return __builtin_bit_cast(s16x4,__builtin_amdgcn_ds_read_tr16_b64_v4i16((__attribute__((address_space(3))) v4i16_t*)p)); }
__device__ __forceinline__ float rowmax(const f32x16&p0,const f32x16&p1){
  float a=max3f(p0[0],p0[1],p1[0]),b=max3f(p0[2],p0[3],p1[1]);a=max3f(a,p1[2],p1[3]);
  #pragma unroll
  for(int r=4;r<16;r+=4){a=max3f(a,p0[r],p0[r+1]);b=max3f(b,p0[r+2],p0[r+3]);a=max3f(a,p1[r],p1[r+1]);b=max3f(b,p1[r+2],p1[r+3]);}
  const float m=max2f(a,b);
  auto rr=__builtin_amdgcn_permlane32_swap(__float_as_uint(m),__float_as_uint(m),false,false);
  return max2f(__uint_as_float(rr[0]),__uint_as_float(rr[1]));
}
__device__ __forceinline__ void pv(f32x16*o,int vb,bf16x8 pa0,bf16x8 pa1,bf16x8 pa2,bf16x8 pa3){
  #pragma unroll
  for(int d0=0;d0<4;++d0){s16x4 lo[4],hi[4];
    #pragma unroll
    for(int ks=0;ks<4;++ks){
      asm volatile("ds_read_b64_tr_b16 %0,%1 offset:%c2":"=&v"(lo[ks]):"v"(vb),"i"(d0*4096+ks*1024):"memory");
      asm volatile("ds_read_b64_tr_b16 %0,%1 offset:%c2":"=&v"(hi[ks]):"v"(vb),"i"(d0*4096+ks*1024+512):"memory");}
    asm volatile("s_waitcnt lgkmcnt(0)":::"memory");SBAR();
    #define PK(k) (bf16x8){lo[k][0],lo[k][1],lo[k][2],lo[k][3],hi[k][0],hi[k][1],hi[k][2],hi[k][3]}
    o[d0]=__builtin_amdgcn_mfma_f32_32x32x16_bf16(pa0,PK(0),o[d0],0,0,0);
    o[d0]=__builtin_amdgcn_mfma_f32_32x32x16_bf16(pa1,PK(1),o[d0],0,0,0);
    o[d0]=__builtin_amdgcn_mfma_f32_32x32x16_bf16(pa2,PK(2),o[d0],0,0,0);
    o[d0]=__builtin_amdgcn_mfma_f32_32x32x16_bf16(pa3,PK(3),o[d0],0,0,0);
    #undef PK
  }
}

#ifndef ATTN_STORE16
#define ATTN_STORE16(p,v) (*(u32x4*)(p)=(v))
#endif
template<int THRL> __device__ __forceinline__ void attn_unit(int b,int h,int qb,const bf16*Q,const bf16*__restrict__ K,const bf16*__restrict__ V,bf16*O,char*shm){
  int tid=threadIdx.x; asm volatile("":"+v"(tid));
  const int lane=tid&63,r32=lane&31,hi=lane>>5; const int wid=__builtin_amdgcn_readfirstlane(tid>>6);
  const long rowbase=(long)b*SEQ; const int q0=qb*QB;
  const bf16*Qw=Q+(rowbase+q0+wid*QBLK)*DQK+h*D;
  const bf16*Kh=K+(long)b*KVSEQ*DQK+h*D,*Vh=V+(long)b*KVSEQ*DVP+(h>>1)*128;
  const unsigned lds0=(unsigned)(uintptr_t)shm;
  float*wsf=(float*)(shm+LDS_WS)+wid*64;
  const bf16*ksrc=Kh+(long)lane*DQK+wid*8;
  const bf16*vsrc=Vh+(long)(16*(wid&3)+(lane>>2))*DVP+(wid>>2)*32+(lane&3)*8;
  const unsigned kdst=lds0+LDS_K+wid*1024, vdst=lds0+LDS_V+wid*1024;
  #define DMA_K(t,slot) glds16(ksrc+(long)(t)*KVBLK*DQK,(unsigned)__builtin_amdgcn_readfirstlane(kdst+(slot)))
  #define DMA_V(t,slot) do{ glds16(vsrc+(long)(t)*KVBLK*DVP,(unsigned)__builtin_amdgcn_readfirstlane(vdst+2*(slot))); glds16(vsrc+(long)(t)*KVBLK*DVP+64,(unsigned)__builtin_amdgcn_readfirstlane(vdst+2*(slot)+8192)); }while(0)
  const int vb0=(int)(lds0+LDS_V)+((lane>>4)&1)*32+(lane&3)*8+(4*hi+((lane&15)>>2))*64;
  const char*Kbase=shm+LDS_K; bf16x8 kf[8];
  const lds_cptr shm3=(lds_cptr)shm; const lds_cptr kp0=shm3+LDS_K+hi*1024+r32*16; const lds_cptr vp0=shm3+LDS_V+((lane>>4)&1)*32+(lane&3)*8+(4*hi+((lane&15)>>2))*64;
  const int NT=(q0+QB)/KVBLK+1;
  DMA_K(0,0);DMA_V(0,0);DMA_K(1,SLOTB);
  bf16x8 qr[4];
  #pragma unroll
  for(int d0=0;d0<4;++d0)qr[d0]=*reinterpret_cast<const bf16x8*>(&Qw[(long)r32*DQK+d0*16+hi*8]);
  float mhat=0.f,l_reg=0.f;f32x16 o[4];o[0]=f32x16{};o[1]=f32x16{};o[2]=f32x16{};o[3]=f32x16{};const f32x16 zero16=f32x16{};
  const int qrel=wid*QBLK+r32;
  #define CMASK(P0,P1,t) do{int jb_=(t)-(NT-4); if(jb_>=0)cmask(P0,P1,jb_,qrel,hi);}while(0)
  bool resc=false;
  #define START(P0,P1) do{ const float rm=rowmax(P0,P1); resc=false; \
    { const float dl=rm; mhat=fadd_s(mhat,dl); \
      _Pragma("unroll") for(int r=0;r<16;++r){P0[r]=fsub_s(P0[r],dl);P1[r]=fsub_s(P1[r],dl);} \
      } \
    _Pragma("unroll") for(int r=0;r<16;++r)P0[r]=__builtin_amdgcn_exp2f(P0[r]); }while(0)
  #define RESC() do{ if(resc){ asm volatile("s_waitcnt lgkmcnt(0)":::"memory"); \
      _Pragma("unroll") for(int d_=0;d_<4;++d_) _Pragma("unroll") for(int r=0;r<16;++r)o[d_][r]*=wsf[crow(r,hi)]; } }while(0)
  f32x16 pA0,pA1,pB0,pB1;
  int sl_prev=0,sl_cur=0,sl_next=SLOTB;
  #define ROT() do{sl_prev=sl_cur;sl_cur=sl_next;sl_next=(sl_next==(NSLOT-1)*SLOTB)?0:sl_next+SLOTB;}while(0)
  DMA_K(2,2*SLOTB);
  WAIT_BAR(4);
  qkt(pA0,pA1,Kbase,qr,zero16,r32,hi);asm volatile("s_nop 15\n\ts_nop 7":"+v"(pA0),"+v"(pA1));CMASK(pA0,pA1,0);
  _Pragma("unroll") for(int r=0;r<16;++r){ pA0[r]=-INFINITY; if(r<8)pA1[r]=-INFINITY; }
  _Pragma("unroll") for(int r=0;r<16;++r)pA0[r]=__builtin_amdgcn_exp2f(pA0[r]);
  _Pragma("unroll") for(int r=0;r<16;++r)pA1[r]=__builtin_amdgcn_exp2f(pA1[r]);
  WAIT_BAR(0);
  DMA_K(3,0);DMA_V(1,SLOTB);
  ROT();
  kload8(kf,kp0+sl_cur);
  WAIT_BAR(3);
  s16x4 vlo[4],vhi[4]; u32x4 pwa0,pwa1,pwa2,pwa3,pwb0,pwb1,pwb2,pwb3;
  #define PKW(P,B) cvtpk_s(P[B],P[B+1])
  #define PAFX(P,k) __builtin_bit_cast(bf16x8,P##k)
  #define VFR(i) (bf16x8){vlo[i][0],vlo[i][1],vlo[i][2],vlo[i][3],vhi[i][0],vhi[i][1],vhi[i][2],vhi[i][3]}
  #define PIN(x) asm volatile("":"+v"(x))
  #define MX3(a,b,c) __builtin_fmaxf(__builtin_fmaxf((a),(b)),(c))
  #define EX(v) __builtin_amdgcn_exp2f(v)
  #define VRD(s,i) do{ vlo[s]=vtr(vp_+(((i)>>2)*4096+((i)&3)*1024)); vhi[s]=vtr(vp_+(((i)>>2)*4096+((i)&3)*1024+512)); }while(0)
  #define KRD(G,j) do{ if(G){ kload2(kf,kp0+sl_next,j); SBAR(); } }while(0)
  #define GAPA(MF) do{ MF; SBAR(); }while(0)
  #define GAPB(MF,RD,X,B,PV_,W) do{ MF; RD; X[B]=EX(X[B]); X[B+1]=EX(X[B+1]); sacc+=X[B]; sacc+=X[B+1]; PIN(sacc); PV_[W]=cvtpk_s(X[B],X[B+1]); PIN(PV_); SBAR(); }while(0)
  #define STEP(C0,C1,PP,PC,t,GK,GV,GL) do{ SBAR(); \
    const lds_cptr vp_=vp0+2*sl_prev; \
    GAPA(C0=__builtin_amdgcn_mfma_f32_32x32x16_bf16(kf[0],qr[0],zero16,0,0,0)); GAPA(C1=__builtin_amdgcn_mfma_f32_32x32x16_bf16(kf[1],qr[0],zero16,0,0,0)); GAPA(C0=__builtin_amdgcn_mfma_f32_32x32x16_bf16(kf[2],qr[1],C0,0,0,0)); GAPA(C1=__builtin_amdgcn_mfma_f32_32x32x16_bf16(kf[3],qr[1],C1,0,0,0)); VRD(0,0); SBAR(); GAPA(C0=__builtin_amdgcn_mfma_f32_32x32x16_bf16(kf[4],qr[2],C0,0,0,0)); VRD(1,4); SBAR(); GAPA(C1=__builtin_amdgcn_mfma_f32_32x32x16_bf16(kf[5],qr[2],C1,0,0,0)); VRD(2,8); SBAR(); GAPA(C0=__builtin_amdgcn_mfma_f32_32x32x16_bf16(kf[6],qr[3],C0,0,0,0)); VRD(3,12); SBAR(); GAPA(C1=__builtin_amdgcn_mfma_f32_32x32x16_bf16(kf[7],qr[3],C1,0,0,0)); \
    if(GK){DMA_K((t)+3,sl_cur);} if(GV){DMA_V((t)+1,sl_next);} \
    CMASK(C0,C1,t); \
    SBAR(); float sacc=0.f; \
    GAPB(o[0]=__builtin_amdgcn_mfma_f32_32x32x16_bf16(PAFX(PP,0),VFR(0),o[0],0,0,0), VRD(0,1), C0,0, PC##0,0); \
    GAPB(o[1]=__builtin_amdgcn_mfma_f32_32x32x16_bf16(PAFX(PP,0),VFR(1),o[1],0,0,0), VRD(1,5), C0,2, PC##0,1); \
    GAPB(o[2]=__builtin_amdgcn_mfma_f32_32x32x16_bf16(PAFX(PP,0),VFR(2),o[2],0,0,0), VRD(2,9), C0,4, PC##0,2); \
    GAPB(o[3]=__builtin_amdgcn_mfma_f32_32x32x16_bf16(PAFX(PP,0),VFR(3),o[3],0,0,0), VRD(3,13), C0,6, PC##0,3); \
    GAPB(o[0]=__builtin_amdgcn_mfma_f32_32x32x16_bf16(PAFX(PP,1),VFR(0),o[0],0,0,0), VRD(0,2), C0,8, PC##1,0); \
    GAPB(o[1]=__builtin_amdgcn_mfma_f32_32x32x16_bf16(PAFX(PP,1),VFR(1),o[1],0,0,0), VRD(1,6), C0,10, PC##1,1); \
    GAPB(o[2]=__builtin_amdgcn_mfma_f32_32x32x16_bf16(PAFX(PP,1),VFR(2),o[2],0,0,0), VRD(2,10), C0,12, PC##1,2); \
    GAPB(o[3]=__builtin_amdgcn_mfma_f32_32x32x16_bf16(PAFX(PP,1),VFR(3),o[3],0,0,0), VRD(3,14), C0,14, PC##1,3); \
    GAPB(o[0]=__builtin_amdgcn_mfma_f32_32x32x16_bf16(PAFX(PP,2),VFR(0),o[0],0,0,0), VRD(0,3), C1,0, PC##2,0); \
    GAPB(o[1]=__builtin_amdgcn_mfma_f32_32x32x16_bf16(PAFX(PP,2),VFR(1),o[1],0,0,0), VRD(1,7), C1,2, PC##2,1); \
    GAPB(o[2]=__builtin_amdgcn_mfma_f32_32x32x16_bf16(PAFX(PP,2),VFR(2),o[2],0,0,0), VRD(2,11), C1,4, PC##2,2); \
    GAPB(o[3]=__builtin_amdgcn_mfma_f32_32x32x16_bf16(PAFX(PP,2),VFR(3),o[3],0,0,0), VRD(3,15), C1,6, PC##2,3); \
    KRD(GL,0); GAPB(o[0]=__builtin_amdgcn_mfma_f32_32x32x16_bf16(PAFX(PP,3),VFR(0),o[0],0,0,0), (void)0, C1,8, PC##3,0); \
    KRD(GL,1); GAPB(o[1]=__builtin_amdgcn_mfma_f32_32x32x16_bf16(PAFX(PP,3),VFR(1),o[1],0,0,0), (void)0, C1,10, PC##3,1); \
    KRD(GL,2); GAPB(o[2]=__builtin_amdgcn_mfma_f32_32x32x16_bf16(PAFX(PP,3),VFR(2),o[2],0,0,0), (void)0, C1,12, PC##3,2); \
    KRD(GL,3); GAPB(o[3]=__builtin_amdgcn_mfma_f32_32x32x16_bf16(PAFX(PP,3),VFR(3),o[3],0,0,0), (void)0, C1,14, PC##3,3); \
    l_reg+=sacc; \
    }while(0)
  { float sacc=pA0[0]+pA0[1]; _Pragma("unroll") for(int r=2;r<16;++r)sacc+=pA0[r]; _Pragma("unroll") for(int r=0;r<16;++r)sacc+=pA1[r]; l_reg+=sacc;
    pwa0=(u32x4){PKW(pA0,0),PKW(pA0,2),PKW(pA0,4),PKW(pA0,6)};pwa1=(u32x4){PKW(pA0,8),PKW(pA0,10),PKW(pA0,12),PKW(pA0,14)};pwa2=(u32x4){PKW(pA1,0),PKW(pA1,2),PKW(pA1,4),PKW(pA1,6)};pwa3=(u32x4){PKW(pA1,8),PKW(pA1,10),PKW(pA1,12),PKW(pA1,14)}; }
  pwb0=pwa0;pwb1=pwa1;pwb2=pwa2;pwb3=pwa3;
  int t=1;
  #undef CMASK
  #define CMASK(P0,P1,t) do{int jb_=(t)-(NT-4); if(jb_>=0)cmask(P0,P1,jb_,qrel,hi);}while(0)
  #define ENDW(tt) do{ if((tt)+3<NT){WAIT_BAR(3);} else if((tt)+2<NT){WAIT_BAR(2);} else {WAIT_BAR(0);} }while(0)
  for(;t+2<NT;t+=2){
    STEP(pA0,pA1,pwa,pwb,t,(t+3<NT),(t+1<NT),(t+1<NT));       ENDW(t);   ROT();
    STEP(pA0,pA1,pwb,pwa,t+1,(t+4<NT),(t+2<NT),(t+2<NT));     ENDW(t+1); ROT();
  }
  STEP(pA0,pA1,pwa,pwb,t,false,true,true); WAIT_BAR(0); ROT();
  STEP(pA0,pA1,pwb,pwa,NT-1,false,false,false);
  SBAR(); pv(o,vb0+2*sl_cur,PAFX(pwa,0),PAFX(pwa,1),PAFX(pwa,2),PAFX(pwa,3));
  #undef PAFX
  #undef PKW
  #undef VFR
  #undef PIN
  #undef MX3
  #undef GAPA
  #undef GAPB
  #undef EX
  #undef VRD
  #undef KRD
  #undef STEP
  #undef ENDW
  {auto rr=__builtin_amdgcn_permlane32_swap(__float_as_uint(l_reg),__float_as_uint(l_reg),false,false);l_reg=__uint_as_float(rr[0])+__uint_as_float(rr[1]);}
  if(hi==0)wsf[32+r32]=l_reg;asm volatile("s_waitcnt lgkmcnt(0)":::"memory");
  float rli[16];
  #pragma unroll
  for(int r=0;r<16;++r)rli[r]=__builtin_amdgcn_rcpf(wsf[32+crow(r,hi)]);
  bf16*Ow=O+(rowbase+q0+wid*QBLK)*DOP+h*128;
  { bf16*stg=(bf16*)(shm+LDS_OST)+wid*4096;
    #pragma unroll
    for(int r=0;r<16;++r){const int orow=crow(r,hi);
      #pragma unroll
      for(int d0=0;d0<4;++d0)stg[orow*128+d0*32+r32]=__float2bfloat16(o[d0][r]*rli[r]);}
    asm volatile("s_waitcnt lgkmcnt(0)":::"memory");
    #pragma unroll
    for(int i=0;i<8;++i){const int row=i*4+(lane>>4),ch=lane&15; const u32x4 v=*(const u32x4*)(stg+row*128+ch*8); ATTN_STORE16(Ow+(long)row*DOP+ch*8,v);} }
  asm volatile("s_waitcnt lgkmcnt(0)\n\ts_barrier":::"memory");
  #undef DMA_K
  #undef DMA_V
  #undef CMASK
  #undef START
  #undef RESC
  #undef ROT
}
constexpr int ATTN_LDS_BYTES=LDS_BYTES;
struct AttnTensors { const bf16* Q; const bf16* K; const bf16* V; bf16* O; };
struct AttnUnit { int bh; int qb; };
struct StaticOrder {
  int vcu;
  __device__ __forceinline__ explicit StaticOrder(int grid,int block):vcu((block%8)*(grid/8)+block/8){}
  __device__ __forceinline__ bool next(int i,AttnUnit&u)const{ if(i>=2)return false; const int s=vcu&15; u.bh=vcu>>4; u.qb=(i==0)?31-s:s; return true; }
  __device__ __forceinline__ void a_ready(const AttnUnit&)const{}
  __device__ __forceinline__ void done(const AttnUnit&)const{}
};
template<class Sched,int THRL=8> __device__ __forceinline__ void attn_phase(char*lds,const AttnTensors&T,const Sched&S){
  AttnUnit u;
  _Pragma("unroll 1") for(int i=0;S.next(i,u);++i){ S.a_ready(u); attn_unit<THRL>(u.bh/NHEAD,u.bh%NHEAD,u.qb,T.Q,T.K,T.V,T.O,lds); S.done(u); }
}
#undef SBAR
#undef WAIT_BAR
}
#define GAS __attribute__((address_space(1)))
typedef unsigned v4u __attribute__((ext_vector_type(4)));
#define LDS_WAIT() asm volatile("s_waitcnt lgkmcnt(0)" ::: "memory")

#ifndef T_GEMM_Z
#define T_GEMM_Z 1
#endif
#ifndef T_GEMM_GLU
#define T_GEMM_GLU 1
#endif
#ifndef T_GEMM_MIX
#define T_GEMM_MIX 1
#endif
#ifndef T_GEMM_WO
#define T_GEMM_WO 1
#endif
#ifndef T_MOE
#define T_MOE 1
#endif
#ifndef CB_UNR
#define CB_UNR 4
#endif
#ifndef XN_UNR
#define XN_UNR 4
#endif
#ifndef T_S5
#define T_S5 1
#endif
#ifndef T_ATTN
#define T_ATTN 2
#endif
#ifndef T_ROUTER
#define T_ROUTER 1
#endif
#ifndef COOP_LAUNCH
#define COOP_LAUNCH 0
#endif
#ifndef T_GATE8
#define T_GATE8 0
#endif
#ifndef T_WO8
#define T_WO8 0
#endif
#ifndef T_MIXCAT
#define T_MIXCAT 1
#endif
#ifndef T_H1B
#define T_H1B 0
#endif
#ifndef DN_LATE
#define DN_LATE 16
#endif
#ifndef DN_MID
#define DN_MID 8
#endif
#ifndef T_FP8
#define T_FP8 1
#endif

template <bool GATHER>
__device__ __forceinline__ void gemm_core(f32x4 (&acc)[2][2], bool act, const bf16_t* __restrict__ A, int lda, const int* __restrict__ rowidx, int m0,
                                          const float* __restrict__ B, int ldb, int n0, int K, bf16_t* As, bf16_t* Bs) {
    const int tid = threadIdx.x & 255, lane = tid & 63, w = tid >> 6, wm = w >> 1, wn = w & 1;
    const int ar = tid >> 2, ak = (tid & 3) * 8, bk = tid >> 3, bn = (tid & 7) * 8;
    int arow = m0 + ar; if (GATHER) arow = act ? rowidx[m0 + ar] : -1;
#pragma unroll
    for (int i = 0; i < 2; ++i)
#pragma unroll
        for (int j = 0; j < 2; ++j) acc[i][j] = (f32x4){0.f, 0.f, 0.f, 0.f};
    for (int k0 = 0; k0 < K; k0 += 32) {
        uint4 av = make_uint4(0, 0, 0, 0); f32x4 b0 = (f32x4){0.f, 0.f, 0.f, 0.f}, b1 = b0;
        if (act) {
            if (arow >= 0) av = *(const uint4*)(A + (size_t)arow * lda + k0 + ak);
            b0 = *(const f32x4*)(B + (size_t)(k0 + bk) * ldb + n0 + bn); b1 = *(const f32x4*)(B + (size_t)(k0 + bk) * ldb + n0 + bn + 4);
        }
        __syncthreads();
        *(uint4*)(As + ar * 40 + ak) = av;
#pragma unroll
        for (int i = 0; i < 4; ++i) { Bs[(bn + i) * 40 + bk] = (bf16_t)f2bf(b0[i]); Bs[(bn + 4 + i) * 40 + bk] = (bf16_t)f2bf(b1[i]); }
        __syncthreads();
        bf16x8 a[2], b[2];
#pragma unroll
        for (int i = 0; i < 2; ++i) { a[i] = *(const bf16x8*)(As + (wm * 32 + i * 16 + (lane & 15)) * 40 + 8 * (lane >> 4)); b[i] = *(const bf16x8*)(Bs + (wn * 32 + i * 16 + (lane & 15)) * 40 + 8 * (lane >> 4)); }
#pragma unroll
        for (int i = 0; i < 2; ++i)
#pragma unroll
            for (int j = 0; j < 2; ++j) acc[i][j] = __builtin_amdgcn_mfma_f32_16x16x32_bf16(a[i], b[j], acc[i][j], 0, 0, 0);
    }
}
#define SG_LOOP(ntm, ntn) \
    bf16_t* As = (bf16_t*)(F.lds + (F.tid >> 8) * 16384); bf16_t* Bs = As + 64 * 40; \
    const int ntiles_ = (ntm) * (ntn), stride_ = 2 * F.G; \
    for (int it_ = 0; it_ * stride_ < ntiles_; ++it_) { \
        int t_ = it_ * stride_ + F.vcu * 2 + (F.tid >> 8); const bool act = t_ < ntiles_; if (!act) t_ = ntiles_ - 1; \
        const int m0 = (t_ / (ntn)) * 64, n0 = (t_ % (ntn)) * 64; (void)m0; (void)n0;
#define SG_END } __syncthreads();
#define EPI_LOOP(...) \
    if (act) { const int lane_ = threadIdx.x & 63, w_ = (threadIdx.x >> 6) & 3, wm_ = w_ >> 1, wn_ = w_ & 1; \
      _Pragma("unroll") for (int mi = 0; mi < 2; ++mi) _Pragma("unroll") for (int ni = 0; ni < 2; ++ni) _Pragma("unroll") for (int r = 0; r < 4; ++r) { \
        const int row = m0 + wm_ * 32 + mi * 16 + (lane_ >> 4) * 4 + r, col = n0 + wn_ * 32 + ni * 16 + (lane_ & 15); __VA_ARGS__ } }

struct CpItem { const float* src; bf16_t* dst; };
__device__ __forceinline__ void cp_load(const CpItem& c, int N, float (&wv)[32], int lane) {
#pragma unroll
    for (int i = 0; i < 32; ++i) wv[i] = __builtin_nontemporal_load(c.src + (size_t)(2 * i + (lane >> 5)) * N + (lane & 31));
}
__device__ __forceinline__ void cp_store(const CpItem& c, int K, const float (&wv)[32], LAS float* scr, int lane) {
#pragma unroll
    for (int i = 0; i < 32; ++i) scr[(2 * i + (lane >> 5)) * 33 + (lane & 31)] = wv[i];
    LDS_WAIT(); asm volatile("" ::: "memory");
    const int cc = lane & 7;
#pragma unroll
    for (int j = 0; j < 4; ++j) { const int n = (lane >> 3) + 8 * j; const LAS float* sp = scr + (8 * cc) * 33 + n;
        v4u o; o.x = pk2(sp[0 * 33], sp[1 * 33]); o.y = pk2(sp[2 * 33], sp[3 * 33]); o.z = pk2(sp[4 * 33], sp[5 * 33]); o.w = pk2(sp[6 * 33], sp[7 * 33]);
        *(GAS v4u*)(c.dst + (size_t)n * K + 8 * cc) = o; }
    LDS_WAIT(); asm volatile("" ::: "memory");
}
__device__ __forceinline__ void cp_store8(const CpItem& c, int K, const float (&wv)[32], LAS float* scr, int lane) {
#pragma unroll
    for (int i = 0; i < 32; ++i) scr[(2 * i + (lane >> 5)) * 33 + (lane & 31)] = wv[i] * 32.f;
    LDS_WAIT(); asm volatile("" ::: "memory");
    const int cc = lane & 3;
#pragma unroll
    for (int j = 0; j < 2; ++j) { const int n = (lane >> 2) + 16 * j; const LAS float* sp = scr + (16 * cc) * 33 + n;
        v4u o; o.x = pg8::pk4_fp8(sp[0 * 33], sp[1 * 33], sp[2 * 33], sp[3 * 33]); o.y = pg8::pk4_fp8(sp[4 * 33], sp[5 * 33], sp[6 * 33], sp[7 * 33]);
        o.z = pg8::pk4_fp8(sp[8 * 33], sp[9 * 33], sp[10 * 33], sp[11 * 33]); o.w = pg8::pk4_fp8(sp[12 * 33], sp[13 * 33], sp[14 * 33], sp[15 * 33]);
        __builtin_nontemporal_store(o, (GAS v4u*)((unsigned char*)c.dst + (size_t)n * K + 16 * cc)); }
    LDS_WAIT(); asm volatile("" ::: "memory");
}
template <int MODE, bool FP8 = false>
__device__ __forceinline__ void cp_set(Frame& F, const float* W, int K, int N, bf16_t* WT, int ne, int ncols = 0, int dpitch = 0, int koff = 0, int gwo = -1, int ngwo = 0) {
    const int gw = gwo >= 0 ? gwo : F.vcu * NWAVES + F.wave, NGW = gwo >= 0 ? ngwo : F.G * NWAVES, lane = F.lane;
    LAS float* scr = (LAS float*)(F.lds3 + F.wave * 16384);
    const int nbn = (ncols ? ncols : N) / 32, ipm = (K / 64) * nbn, nitems = ne * ipm;
    auto dec = [&](int it) { CpItem c; const int e = it / ipm, q = it % ipm, kb = q / nbn, n0 = 32 * (q % nbn);
        const size_t drow = MODE == 0 ? (size_t)e * N + n0 : (size_t)e * 2048 + 256 * (n0 / 128) + 128 * (MODE - 1) + (n0 % 128);
        c.src = W + (size_t)e * K * N + (size_t)(64 * kb) * N + n0; c.dst = FP8 ? (bf16_t*)((unsigned char*)WT + drow * K + 64 * kb) : WT + drow * (dpitch ? dpitch : K) + koff + 64 * kb; return c; };
    int it = gw; if (it >= nitems) return;
    CpItem c0 = dec(it); float wa[32], wb[32];
    cp_load(c0, N, wa, lane);
    for (;;) {
        const int itn = it + NGW; const bool hn = itn < nitems; CpItem c1 = c0;
        if (hn) { c1 = dec(itn); cp_load(c1, N, wb, lane); }
        if constexpr (FP8) cp_store8(c0, K, wa, scr, lane); else cp_store(c0, dpitch ? dpitch : K, wa, scr, lane);
        if (!hn) break;
#pragma unroll
        for (int i = 0; i < 32; ++i) wa[i] = wb[i];
        c0 = c1; it = itn;
    }
}
__device__ __forceinline__ void cp_all(Frame& F) {
    cp_set<0>(F, F.w_in, D, INW, F.Wt_in, 1); if (T_GATE8) cp_set<0, true>(F, F.w_in + 2048, D, INW, F.Wt_in8, 1, 2048); cp_set<0>(F, F.w_glu, SW, SW, F.Wt_glu, 1); if (T_MIXCAT) { cp_set<0>(F, F.w_ao, AW, D, F.Wt_so, 1, 0, 1024, 0); cp_set<0>(F, F.w_so, SW, D, F.Wt_so, 1, 0, 1024, 512); }
    else { cp_set<0>(F, F.w_so, SW, D, F.Wt_so, 1); cp_set<0>(F, F.w_ao, AW, D, F.Wt_ao, 1); } cp_set<0, T_WO8>(F, F.w_o, D, D, F.Wt_o, 1);
    if (T_MOE) { cp_set<1, T_FP8>(F, F.w_gate, D, D, F.Wt_gu, NE); cp_set<2, T_FP8>(F, F.w_up, D, D, F.Wt_gu, NE); cp_set<0, T_FP8>(F, F.w_down, D, D, F.Wt_dn, NE - (T_GEMM_GLU ? DN_LATE : 0) - DN_MID); }
}
__device__ __forceinline__ void p0_meta(Frame& F) {
    float* xm = (float*)F.lds;
    float* red = xm + 16 * 1025;
    for (int rr = 0; rr < 2; ++rr) {
        const int row = 2 * F.wave + rr; const float* src = F.meta + (size_t)row * D;
        f32x4 v[4]; float ss = 0.f;
#pragma unroll
        for (int j = 0; j < 4; ++j) { v[j] = *(const f32x4*)(src + 256 * j + 4 * F.lane); ss += v[j][0] * v[j][0] + v[j][1] * v[j][1] + v[j][2] * v[j][2] + v[j][3] * v[j][3]; }
        ss = wave_sum(ss);
        const float rs = rsqrtf(ss * (1.f / D) + EPS);
#pragma unroll
        for (int j = 0; j < 4; ++j) { const f32x4 gg = *(const f32x4*)(F.norm_mix_g + 256 * j + 4 * F.lane);
#pragma unroll
            for (int q = 0; q < 4; ++q) xm[row * 1025 + 256 * j + 4 * F.lane + q] = v[j][q] * rs * gg[q]; }
    }
    __syncthreads();
    const int c = F.tid & 15, kq = F.tid >> 4;
    for (int cgp = F.vcu; cgp < INW / 16; cgp += F.G) {
        const int col = 16 * cgp + c;
        float wv[32];
#pragma unroll
        for (int i = 0; i < 32; ++i) wv[i] = F.w_in[(size_t)(32 * kq + i) * INW + col];
        float acc[16];
#pragma unroll
        for (int r = 0; r < 16; ++r) acc[r] = 0.f;
#pragma unroll
        for (int i = 0; i < 32; ++i)
#pragma unroll
            for (int r = 0; r < 16; ++r) acc[r] += xm[r * 1025 + 32 * kq + i] * wv[i];
#pragma unroll
        for (int r = 0; r < 16; ++r) red[(kq * 16 + r) * 16 + c] = acc[r];
        __syncthreads();
        if (F.tid < 256) { float v = 0.f;
#pragma unroll
            for (int q = 0; q < 32; ++q) v += red[q * 256 + F.tid];
            F.ZM[(F.tid >> 4) * INW + 16 * cgp + (F.tid & 15)] = (bf16_t)f2bf(v); }
        __syncthreads();
    }
}
__device__ __forceinline__ void s_prologue(Frame& F) {
    if (!(F.mode & 4)) p0_meta(F);
    const int gw = F.vcu * NWAVES + F.wave, NGW = F.G * NWAVES, lane = F.lane;
    if (!(F.mode & 8)) cp_all(F);
    if (!(F.mode & 16)) {
      f32x4 gg[4];
#pragma unroll
      for (int j = 0; j < 4; ++j) gg[j] = *(const f32x4*)(F.norm_mix_g + 256 * j + 4 * lane);
      for (int row0 = gw; row0 < M; row0 += XN_UNR * NGW) {
        f32x4 v[XN_UNR][4];
#pragma unroll
        for (int u = 0; u < XN_UNR; ++u)
#pragma unroll
            for (int j = 0; j < 4; ++j) v[u][j] = __builtin_nontemporal_load((const f32x4*)(F.x + (size_t)(row0 + u * NGW) * D + 256 * j + 4 * lane));
#pragma unroll
        for (int u = 0; u < XN_UNR; ++u) { const int row = row0 + u * NGW; float ss = 0.f;
#pragma unroll
            for (int j = 0; j < 4; ++j) ss += v[u][j][0] * v[u][j][0] + v[u][j][1] * v[u][j][1] + v[u][j][2] * v[u][j][2] + v[u][j][3] * v[u][j][3];
            ss = wave_sum(ss);
            const float rs = rsqrtf(ss * (1.f / D) + EPS);
#pragma unroll
            for (int j = 0; j < 4; ++j) {
                *(uint2*)(F.XN + (size_t)row * D + 256 * j + 4 * lane) = make_uint2(pk2(v[u][j][0] * rs * gg[j][0], v[u][j][1] * rs * gg[j][1]), pk2(v[u][j][2] * rs * gg[j][2], v[u][j][3] * rs * gg[j][3]));
                if (T_GATE8) *(unsigned*)((unsigned char*)F.XN8 + (size_t)row * D + 256 * j + 4 * lane) = pg8::pk4_fp8(v[u][j][0] * rs * gg[j][0], v[u][j][1] * rs * gg[j][1], v[u][j][2] * rs * gg[j][2], v[u][j][3] * rs * gg[j][3]);
            } }
      }
    }
    const int gt = F.vcu * NTHR + F.tid, NGT = F.G * NTHR;
    for (int idx = gt; idx < NG * NP * NC; idx += NGT) {
        const int gp = idx / NC, c = idx % NC, g = gp / NP, p = gp % NP;
        const float lr = fminf(F.a_re[gp], -1e-4f), li = F.a_im[gp], dt = expf(F.log_dt[g]);
        const float mag = expf(lr * dt), ar = mag * cosf(li * dt), ai = mag * sinf(li * dt);
        const float den = lr * lr + li * li, fr = ((ar - 1.f) * lr + ai * li) / den, fi = (ai * lr - (ar - 1.f) * li) / den;
        const float br = F.b_re[gp * NC + c], bi = F.b_im[gp * NC + c]; const float bbr = fr * br - fi * bi, bbi = fr * bi + fi * br;
        F.BB[gp * 32 + c] = bbr; F.BB[gp * 32 + 16 + c] = bbi; F.BBH[gp * 32 + c] = (bf16_t)f2bf(bbr); F.BBH[gp * 32 + 16 + c] = (bf16_t)f2bf(bbi);
        F.CMT[(g * NC + c) * 128 + 2 * p] = (bf16_t)f2bf(F.c_re[(g * NC + c) * NP + p]); F.CMT[(g * NC + c) * 128 + 2 * p + 1] = (bf16_t)f2bf(-F.c_im[(g * NC + c) * NP + p]);
        if (c == 0) { float pr = ar, pi = ai;
            for (int i = 0; i < 6; ++i) { const float nr = pr * pr - pi * pi, ni = 2.f * pr * pi; pr = nr; pi = ni; }
            F.AA[gp * 4 + 0] = ar; F.AA[gp * 4 + 1] = ai; F.AA[gp * 4 + 2] = pr; F.AA[gp * 4 + 3] = pi; }
    }
    if (gt == 0) { float s1 = 0.f, s2 = 0.f; for (int i = 0; i < 64; ++i) { s1 += F.lq1[i] * F.lk1[i]; s2 += F.lq2[i] * F.lk2[i]; } F.LAM[0] = expf(s1) - expf(s2) + 0.2f; }
    for (int i = gt; i < MOE_ROWS; i += NGT) { F.ROWTOK[i] = 0; F.ROWTK[i] = -1; }
}
__device__ __forceinline__ void s_gemm_z(Frame& F) {
    SG_LOOP(M / 64, INW / 64)
        f32x4 acc[2][2];
        gemm_core<false>(acc, act, F.XN, D, nullptr, m0, F.w_in, INW, n0, D, As, Bs);
        EPI_LOOP({ F.Z[(size_t)row * INW + col] = (bf16_t)f2bf(acc[mi][ni][r]); })
    SG_END
}
template <bool FINAL>
__device__ __forceinline__ void s_s5_scan(Frame& F) {
    const int gw = F.vcu * NWAVES + F.wave, NGW = F.G * NWAVES, p = F.lane;
    for (int it = gw; it < BATCH * NCHUNK * NG; it += NGW) {
        const int bc = it / NG, g = it % NG, gp = g * NP + p;
        const int row0 = bc * 64;
        float bbr[16], bbi[16];
#pragma unroll
        for (int c = 0; c < 16; ++c) { bbr[c] = F.BB[gp * 32 + c]; bbi[c] = F.BB[gp * 32 + 16 + c]; }
        const float ar = F.AA[gp * 4], ai = F.AA[gp * 4 + 1];
        float sr = 0.f, si = 0.f;
        const size_t eidx = ((size_t)bc * NG + g) * NP + p;
        float cr[16], ci[16]; float dd = 0.f;
        if (FINAL) { sr = F.SIN[eidx * 2]; si = F.SIN[eidx * 2 + 1];
#pragma unroll
            for (int c = 0; c < 16; ++c) { cr[c] = F.c_re[(g * NC + c) * NP + p]; ci[c] = F.c_im[(g * NC + c) * NP + p]; }
            dd = F.ssm_d[g * NC + (p & 15)]; }
        for (int t = 0; t < 64; ++t) {
            const bf16_t* zr = F.Z + (size_t)(row0 + t) * INW + g * NC;
            const uint4 u0 = *(const uint4*)zr, u1 = *(const uint4*)(zr + 8);
            const unsigned uw[8] = {u0.x, u0.y, u0.z, u0.w, u1.x, u1.y, u1.z, u1.w};
            float bur = 0.f, bui = 0.f;
#pragma unroll
            for (int c = 0; c < 8; ++c) { const float ua = bf2f(uw[c] & 0xffffu), ub = bf2f(uw[c] >> 16); bur += bbr[2 * c] * ua + bbr[2 * c + 1] * ub; bui += bbi[2 * c] * ua + bbi[2 * c + 1] * ub; }
            const float nr = ar * sr - ai * si + bur, ni = ar * si + ai * sr + bui; sr = nr; si = ni;
            if (FINAL) {
                float ymine = 0.f;
#pragma unroll
                for (int c = 0; c < 16; ++c) { const float yc = wave_sum(cr[c] * sr - ci[c] * si); if ((p & 15) == c) ymine = yc; }
                if (p < 16) { const float uu = bf2f(F.Z[(size_t)(row0 + t) * INW + g * NC + p]); F.YS[(size_t)(row0 + t) * SW + g * NC + p] = (bf16_t)f2bf(gelu_tanh(ymine + dd * uu)); }
            }
        }
        if (!FINAL) { F.E[eidx * 2] = sr; F.E[eidx * 2 + 1] = si; }
    }
}
__device__ __forceinline__ void s_s5_carry(Frame& F) {
    const int gt = F.vcu * NTHR + F.tid;
    if (gt < BATCH * NG * NP) {
        const int b = gt / (NG * NP), gp = gt % (NG * NP), g = gp / NP;
        const float ar = F.AA[gp * 4], ai = F.AA[gp * 4 + 1], a64r = F.AA[gp * 4 + 2], a64i = F.AA[gp * 4 + 3];
        float sr = 0.f, si = 0.f;
        for (int t = 0; t < NMETA; ++t) {
            float bur = 0.f, bui = 0.f;
            for (int c = 0; c < NC; ++c) { const float u = bf2f(F.ZM[t * INW + g * NC + c]); bur += F.BB[gp * 32 + c] * u; bui += F.BB[gp * 32 + 16 + c] * u; }
            const float nr = ar * sr - ai * si + bur, ni = ar * si + ai * sr + bui; sr = nr; si = ni;
        }
        for (int c = 0; c < NCHUNK; ++c) {
            const size_t e = ((size_t)(b * NCHUNK + c) * NG * NP + gp) * 2;
            F.SIN[e] = sr; F.SIN[e + 1] = si;
            const float er = F.E[e], ei = F.E[e + 1];
            const float nr = a64r * sr - a64i * si + er, ni = a64r * si + a64i * sr + ei; sr = nr; si = ni;
        }
    }
}
__device__ __forceinline__ void s_qkn(Frame& F) {
    const int gw = F.vcu * NWAVES + F.wave, NGW = F.G * NWAVES, lane = F.lane;
    for (int row = gw; row < M + NMETA; row += NGW) {
        const bf16_t* zr = (row < M ? F.Z + (size_t)row * INW : F.ZM + (size_t)(row - M) * INW) + 512 + 16 * lane;
        const uint4 u0 = *(const uint4*)zr, u1 = *(const uint4*)(zr + 8);
        const unsigned uw[8] = {u0.x, u0.y, u0.z, u0.w, u1.x, u1.y, u1.z, u1.w};
        float v[16]; float ss = 0.f;
#pragma unroll
        for (int c = 0; c < 8; ++c) { v[2 * c] = bf2f(uw[c] & 0xffffu); v[2 * c + 1] = bf2f(uw[c] >> 16); ss += v[2 * c] * v[2 * c] + v[2 * c + 1] * v[2 * c + 1]; }
        ss += __shfl_xor(ss, 1); ss += __shfl_xor(ss, 2);
        const float rs = rsqrtf(ss * (1.f / 64.f) + EPS);
        const float* gg = (lane < 32 ? F.q_g : F.k_g) + 16 * (lane & 3);
        unsigned o[8];
#pragma unroll
        for (int c = 0; c < 8; ++c) o[c] = pk2(v[2 * c] * rs * gg[2 * c], v[2 * c + 1] * rs * gg[2 * c + 1]);
        bf16_t* qr = (row < M ? F.QKN + (size_t)row * D : F.QKNM + (size_t)(row - M) * D) + 16 * lane;
        *(uint4*)qr = make_uint4(o[0], o[1], o[2], o[3]); *(uint4*)(qr + 8) = make_uint4(o[4], o[5], o[6], o[7]);
    }
}
__device__ __forceinline__ void s_attn(Frame& F) {
    const int half = F.tid >> 8, tid = F.tid & 255, qrow = tid >> 2, part = tid & 3;
    float* Ks = (float*)(F.lds + half * 67584); float* Vs = Ks + 64 * 132;
    constexpr int NQB = SEQ / 64;
    for (int it = F.vcu; it < NQB * 2 * BATCH; it += F.G) {
        const int qb = NQB - 1 - it / (2 * BATCH), h = (it & 1) * 2 + half, b = (it >> 1) & 1;
        const int lq = qb * 64 + qrow + NMETA;
        const size_t tq = (size_t)b * SEQ + qb * 64 + qrow;
        float q0[16], q1[16];
        {
            const bf16_t* qp = F.QKN + tq * D + h * 128 + 16 * part;
#pragma unroll
            for (int d = 0; d < 16; ++d) { q0[d] = bf2f(qp[d]) * 0.125f; q1[d] = bf2f(qp[64 + d]) * 0.125f; }
        }
        float m0 = -1e30f, m1 = -1e30f, l0 = 0.f, l1 = 0.f, o0[32], o1[32];
#pragma unroll
        for (int d = 0; d < 32; ++d) { o0[d] = 0.f; o1[d] = 0.f; }
        for (int kt = 0; kt <= qb + 1; ++kt) {
            __syncthreads();
            for (int i = tid; i < 64 * 128; i += 256) {
                const int j = i >> 7, c = i & 127, lk = kt * 64 + j;
                float kv = 0.f, vv = 0.f;
                if (lk < NMETA) { kv = bf2f(F.QKNM[lk * D + 512 + h * 128 + c]); vv = bf2f(F.ZM[lk * INW + 1536 + h * 128 + c]); }
                else if (lk < NMETA + SEQ) { const size_t tk = (size_t)b * SEQ + lk - NMETA; kv = bf2f(F.QKN[tk * D + 512 + h * 128 + c]); vv = bf2f(F.Z[tk * INW + 1536 + h * 128 + c]); }
                Ks[j * 132 + c] = kv; Vs[j * 132 + c] = vv;
            }
            __syncthreads();
            for (int j = 0; j < 64; ++j) {
                const int lk = kt * 64 + j;
                float s0 = 0.f, s1 = 0.f;
#pragma unroll
                for (int d = 0; d < 16; ++d) { s0 += q0[d] * Ks[j * 132 + 16 * part + d]; s1 += q1[d] * Ks[j * 132 + 64 + 16 * part + d]; }
                s0 += __shfl_xor(s0, 1); s0 += __shfl_xor(s0, 2); s1 += __shfl_xor(s1, 1); s1 += __shfl_xor(s1, 2);
                if (lk <= lq) {
                    if (s0 > m0) { const float sc = __expf(m0 - s0); l0 *= sc;
#pragma unroll
                        for (int d = 0; d < 32; ++d) o0[d] *= sc; m0 = s0; }
                    if (s1 > m1) { const float sc = __expf(m1 - s1); l1 *= sc;
#pragma unroll
                        for (int d = 0; d < 32; ++d) o1[d] *= sc; m1 = s1; }
                    const float p0 = __expf(s0 - m0), p1 = __expf(s1 - m1); l0 += p0; l1 += p1;
#pragma unroll
                    for (int d = 0; d < 32; ++d) { const float v = Vs[j * 132 + 32 * part + d]; o0[d] += p0 * v; o1[d] += p1 * v; }
                }
            }
        }
        const float lam = F.LAM[0], i0 = 1.f / l0, i1 = lam / l1;
        float ss = 0.f;
#pragma unroll
        for (int d = 0; d < 32; ++d) { o0[d] = o0[d] * i0 - o1[d] * i1; ss += o0[d] * o0[d]; }
        ss += __shfl_xor(ss, 1); ss += __shfl_xor(ss, 2);
        const float rs = rsqrtf(ss * (1.f / 128.f) + EPS) * 0.8f;
        bf16_t* op = F.YA + tq * AW + h * 128 + 32 * part;
#pragma unroll
        for (int d = 0; d < 32; ++d) op[d] = (bf16_t)f2bf(o0[d] * rs * F.sub_g[32 * part + d]);
    }
    __syncthreads();
}
__device__ __forceinline__ void s_gemm_glu(Frame& F) {
    SG_LOOP(M / 64, SW / 64)
        f32x4 acc[2][2];
        gemm_core<false>(acc, act, F.YS, SW, nullptr, m0, F.w_glu, SW, n0, SW, As, Bs);
        EPI_LOOP({ const float ys = bf2f(F.YS[(size_t)row * SW + col]); F.YS2[(size_t)row * SW + col] = (bf16_t)f2bf(ys * sigmoidf_(acc[mi][ni][r] + F.b_glu[col])); })
    SG_END
}
__device__ __forceinline__ void s_gemm_mix(Frame& F) {
    SG_LOOP(M / 64, D / 64)
        f32x4 acc[2][2], acc2[2][2];
        gemm_core<false>(acc, act, F.YS2, SW, nullptr, m0, F.w_so, D, n0, SW, As, Bs);
        gemm_core<false>(acc2, act, F.YA, AW, nullptr, m0, F.w_ao, D, n0, AW, As, Bs);
        EPI_LOOP({ const float g0 = sigmoidf_(bf2f(F.Z[(size_t)row * INW + 2048 + col])), g1 = sigmoidf_(bf2f(F.Z[(size_t)row * INW + 3072 + col]));
                   F.MIX[(size_t)row * D + col] = (bf16_t)f2bf(g0 * acc[mi][ni][r] + g1 * acc2[mi][ni][r]); })
    SG_END
}
__device__ __forceinline__ void s_gemm_wo(Frame& F) {
    SG_LOOP(M / 64, D / 64)
        f32x4 acc[2][2];
        gemm_core<false>(acc, act, F.MIX, D, nullptr, m0, F.w_o, D, n0, D, As, Bs);
        EPI_LOOP({ const size_t o = (size_t)row * D + col; F.out[o] = F.x[o] + acc[mi][ni][r]; })
    SG_END
}
__device__ __forceinline__ void s_router(Frame& F) {
    const int gw = F.vcu * NWAVES + F.wave, NGW = F.G * NWAVES, lane = F.lane;
    for (int t = gw; t < M; t += NGW) {
        const float* hr = F.out + (size_t)t * D;
        float ss = 0.f;
#pragma unroll
        for (int j = 0; j < 4; ++j) { const f32x4 a = *(const f32x4*)(hr + 256 * j + 4 * lane); ss += a[0] * a[0] + a[1] * a[1] + a[2] * a[2] + a[3] * a[3]; }
        ss = wave_sum(ss);
        const float rs = rsqrtf(ss * (1.f / D) + EPS);
        float lg[NE];
#pragma unroll
        for (int e = 0; e < NE; ++e) lg[e] = 0.f;
#pragma unroll 1
        for (int j = 0; j < 4; ++j) {
            const f32x4 a = *(const f32x4*)(hr + 256 * j + 4 * lane), gg = *(const f32x4*)(F.norm_ffn_g + 256 * j + 4 * lane);
            const f32x4 v = a * rs * gg;
            *(uint2*)(F.XN2 + (size_t)t * D + 256 * j + 4 * lane) = make_uint2(pk2(v[0], v[1]), pk2(v[2], v[3]));
            const float* wr = F.w_router + (size_t)(256 * j + 4 * lane) * NE;
#pragma unroll
            for (int q = 0; q < 4; ++q)
#pragma unroll
                for (int e = 0; e < NE; e += 4) { const f32x4 w4 = *(const f32x4*)(wr + q * NE + e); lg[e] += v[q] * w4[0]; lg[e + 1] += v[q] * w4[1]; lg[e + 2] += v[q] * w4[2]; lg[e + 3] += v[q] * w4[3]; }
        }
#pragma unroll
        for (int e = 0; e < NE; ++e) lg[e] = wave_sum(lg[e]) + F.b_router[e];
        if (lane == 0) {
            int id[4]; float tv[4];
#pragma unroll
            for (int k = 0; k < 4; ++k) {
                float best = -3.4e38f; int bi = 0;
#pragma unroll
                for (int e = 0; e < NE; ++e) { const bool taken = (k > 0 && id[0] == e) || (k > 1 && id[1] == e) || (k > 2 && id[2] == e); if (!taken && lg[e] > best) { best = lg[e]; bi = e; } }
                id[k] = bi; tv[k] = best;
            }
            const float e0 = 1.f, e1 = __expf(tv[1] - tv[0]), e2 = __expf(tv[2] - tv[0]), e3 = __expf(tv[3] - tv[0]), inv = 1.f / (e0 + e1 + e2 + e3);
            const float gw4[4] = {e0 * inv, e1 * inv, e2 * inv, e3 * inv};
#pragma unroll
            for (int k = 0; k < 4; ++k) { F.IDX[t * 4 + k] = id[k]; F.GATE[t * 4 + k] = gw4[k]; F.POS[t * 4 + k] = atomicAdd(&F.CNT[id[k]], 1); }
        }
    }
}
__device__ __forceinline__ void s_scatter(Frame& F) {
    int* offs = (int*)F.lds;
    if (F.tid == 0) { int o = 0; for (int e = 0; e < NE; ++e) { offs[e] = o; o += (F.CNT[e] + 255) / 256 * 256; } offs[NE] = o; }
    __syncthreads();
    if (F.vcu == 0 && F.tid <= NE) F.OFF[F.tid] = offs[F.tid];
    if (F.vcu == 0) for (int mt = F.tid; mt < MOE_ROWS / 256; mt += NTHR) { int e = 0; while (e < NE - 1 && offs[e + 1] <= mt * 256) ++e; F.TEXP[mt] = e; }
    const int gt = F.vcu * NTHR + F.tid, NGT = F.G * NTHR;
    for (int a = gt; a < NASSIGN; a += NGT) { const int r = offs[F.IDX[a]] + F.POS[a]; F.ROWTOK[r] = a >> 2; F.ROWTK[r] = a; }
    __syncthreads();
}
__device__ __forceinline__ void t_scatter(Frame& F) {
    int* psum = (int*)F.lds;
    int* offs = psum + 512;
    int* base = offs + 64;
    { const int e = F.tid & 31, part = F.tid >> 5; int sacc = 0;
      for (int i = 0; i < 32; ++i) sacc += F.TCNT[(part * 32 + i) * NE + e];
      psum[part * 32 + e] = sacc; }
    __syncthreads();
    if (F.tid == 0) { int o = 0; for (int e = 0; e < NE; ++e) { int tot = 0; for (int p = 0; p < 16; ++p) tot += psum[p * 32 + e]; offs[e] = o; o += (tot + 255) / 256 * 256; } offs[NE] = o; }
    __syncthreads();
    if (F.vcu == 0 && F.tid <= NE) F.OFF[F.tid] = offs[F.tid];
    if (F.vcu == 0) for (int mt = F.tid; mt < MOE_ROWS / 256; mt += NTHR) { int e = 0; while (e < NE - 1 && offs[e + 1] <= mt * 256) ++e; F.TEXP[mt] = e; }
    for (int tile = F.vcu; tile < M / 32; tile += F.G) {
        if (F.tid < 32) { const int part = tile >> 5; int b = offs[F.tid];
            for (int p = 0; p < part; ++p) b += psum[p * 32 + F.tid];
            for (int t2 = part * 32; t2 < tile; ++t2) b += F.TCNT[t2 * NE + F.tid];
            base[F.tid] = b; }
        __syncthreads();
        if (F.tid < 128) { const int a = tile * 128 + F.tid, r = base[F.IDX[a]] + F.POS[a]; F.ROWTOK[r] = a >> 2; F.ROWTK[r] = a; }
        __syncthreads();
    }
}
__device__ __forceinline__ int tile_expert(const int* OFF, int m0) { int e = 0; while (e < NE - 1 && OFF[e + 1] <= m0) ++e; return e; }
__device__ __forceinline__ void s_moe1(Frame& F) {
    const int nrows = F.OFF[NE];
    SG_LOOP(nrows / 64, D / 64)
        const int e = tile_expert(F.OFF, m0);
        f32x4 acc[2][2], acc2[2][2];
        gemm_core<true>(acc, act, F.XN2, D, F.ROWTOK, m0, F.w_gate + (size_t)e * D * D, D, n0, D, As, Bs);
        gemm_core<true>(acc2, act, F.XN2, D, F.ROWTOK, m0, F.w_up + (size_t)e * D * D, D, n0, D, As, Bs);
        EPI_LOOP({ const float gg = fminf(acc[mi][ni][r] + F.b_gate[e * D + col], 7.f), uu = fminf(fmaxf(acc2[mi][ni][r] + F.b_up[e * D + col], -7.f), 7.f);
                   F.ACT[(size_t)row * D + col] = (bf16_t)f2bf((uu + 1.f) * (gg * sigmoidf_(1.702f * gg))); })
    SG_END
}
__device__ __forceinline__ void s_moe2(Frame& F) {
    const int nrows = F.OFF[NE];
    SG_LOOP(nrows / 64, D / 64)
        const int e = tile_expert(F.OFF, m0);
        f32x4 acc[2][2];
        gemm_core<false>(acc, act, F.ACT, D, nullptr, m0, F.w_down + (size_t)e * D * D, D, n0, D, As, Bs);
        EPI_LOOP({ const int tk = F.ROWTK[row]; if (tk >= 0) F.Y2[(size_t)tk * D + col] = (bf16_t)f2bf(acc[mi][ni][r] + F.b_down[e * D + col]); })
    SG_END
}
__device__ __forceinline__ void s_combine(Frame& F) {
    const int gw = F.vcu * NWAVES + F.wave, NGW = F.G * NWAVES, c = F.lane * 16;
    for (int t0 = gw * CB_UNR; t0 < M; t0 += NGW * CB_UNR) {
        f32x4 o[CB_UNR][4]; uint4 y[CB_UNR][4][2]; float gwt[CB_UNR][4];
#pragma unroll
        for (int u = 0; u < CB_UNR; ++u) { const int t = t0 + u;
            if (T_H1B) { const uint4 h0 = *(const uint4*)(F.H1B + (size_t)t * D + c), h1 = *(const uint4*)(F.H1B + (size_t)t * D + c + 8);
                o[u][0] = (f32x4){bf2f(h0.x & 0xffffu), bf2f(h0.x >> 16), bf2f(h0.y & 0xffffu), bf2f(h0.y >> 16)}; o[u][1] = (f32x4){bf2f(h0.z & 0xffffu), bf2f(h0.z >> 16), bf2f(h0.w & 0xffffu), bf2f(h0.w >> 16)};
                o[u][2] = (f32x4){bf2f(h1.x & 0xffffu), bf2f(h1.x >> 16), bf2f(h1.y & 0xffffu), bf2f(h1.y >> 16)}; o[u][3] = (f32x4){bf2f(h1.z & 0xffffu), bf2f(h1.z >> 16), bf2f(h1.w & 0xffffu), bf2f(h1.w >> 16)}; }
            else
#pragma unroll
            for (int q = 0; q < 4; ++q) o[u][q] = *(const f32x4*)(F.out + (size_t)t * D + c + 4 * q);
#pragma unroll
            for (int k = 0; k < 4; ++k) { gwt[u][k] = F.GATE[t * 4 + k];
                if (T_FP8) { const v4u yv = __builtin_nontemporal_load((const v4u*)((const unsigned char*)F.Y2 + (size_t)(t * 4 + k) * D + c)); y[u][k][0] = make_uint4(yv[0], yv[1], yv[2], yv[3]); y[u][k][1] = y[u][k][0]; }
                else { y[u][k][0] = *(const uint4*)(F.Y2 + (size_t)(t * 4 + k) * D + c); y[u][k][1] = *(const uint4*)(F.Y2 + (size_t)(t * 4 + k) * D + c + 8); } } }
#pragma unroll
        for (int u = 0; u < CB_UNR; ++u) { const int t = t0 + u;
#pragma unroll
            for (int k = 0; k < 4; ++k) { const float gk = gwt[u][k];
                if (T_FP8) { const uint4 v = y[u][k][0]; const unsigned wv[4] = {v.x, v.y, v.z, v.w};
#pragma unroll
                    for (int q = 0; q < 4; ++q) { typedef float f32x2_ __attribute__((ext_vector_type(2)));
                        const f32x2_ lo = __builtin_amdgcn_cvt_pk_f32_fp8((int)wv[q], false), hi = __builtin_amdgcn_cvt_pk_f32_fp8((int)wv[q], true);
                        o[u][q][0] += gk * lo[0]; o[u][q][1] += gk * lo[1]; o[u][q][2] += gk * hi[0]; o[u][q][3] += gk * hi[1]; } }
                else {
#pragma unroll
                for (int hh = 0; hh < 2; ++hh) { const uint4 v = y[u][k][hh]; const unsigned wv[4] = {v.x, v.y, v.z, v.w};
#pragma unroll
                    for (int q = 0; q < 4; ++q) { o[u][2 * hh + (q >> 1)][2 * (q & 1)] += gk * bf2f(wv[q] & 0xffffu); o[u][2 * hh + (q >> 1)][2 * (q & 1) + 1] += gk * bf2f(wv[q] >> 16); } } } }
#pragma unroll
            for (int q = 0; q < 4; ++q) __builtin_nontemporal_store(o[u][q], (f32x4*)(F.out + (size_t)t * D + c + 4 * q)); }
    }
}

typedef float f32x16 __attribute__((ext_vector_type(16)));
__device__ __forceinline__ void cmul(float ar, float ai, float br, float bi, float& cr, float& ci) { cr = ar * br - ai * bi; ci = ar * bi + ai * br; }
template <bool FINAL>
__device__ __forceinline__ void t_s5_pass(Frame& F) {
    const int gw = F.vcu * NWAVES + F.wave, NGW = F.G * NWAVES, lane = F.lane, r32 = lane & 31, hi = lane >> 5;
    LAS unsigned char* sl = F.lds3 + F.wave * 17408;
    const int wpg = NGW / NG, g = gw / wpg, w0 = gw % wpg;
    if (g >= NG) return;
    bf16x8 bfr[4];
#pragma unroll
    for (int nt = 0; nt < 4; ++nt) bfr[nt] = *(const bf16x8*)(F.BBH + (size_t)(g * NP + 32 * (nt & 1) + r32) * 32 + 16 * (nt >> 1) + 8 * hi);
    float aar[2], aai[2];
#pragma unroll
    for (int set = 0; set < 2; ++set) { aar[set] = F.AA[(g * NP + 32 * set + r32) * 4]; aai[set] = F.AA[(g * NP + 32 * set + r32) * 4 + 1]; }
    bf16x8 afn[2];
    if (w0 < BATCH * NCHUNK) { afn[0] = *(const bf16x8*)(F.Z + ((size_t)w0 * 64 + r32) * INW + g * NC + 8 * hi); afn[1] = *(const bf16x8*)(F.Z + ((size_t)w0 * 64 + 32 + r32) * INW + g * NC + 8 * hi); }
    const int c16 = lane & 15, q = lane >> 4;
    bf16x8 cfr[4]; f32x4 dv = {};
    if (FINAL) {
#pragma unroll
        for (int ks = 0; ks < 4; ++ks) cfr[ks] = *(const bf16x8*)(F.CMT + (size_t)(g * NC + c16) * 128 + ks * 32 + 8 * q);
        dv = *(const f32x4*)(F.ssm_d + g * NC + 4 * q); }
    for (int bc = w0; bc < BATCH * NCHUNK; bc += wpg) {
        const size_t tok0 = (size_t)bc * 64;
        uint2 uu[4]; float sin0[2][2] = {{0.f, 0.f}, {0.f, 0.f}};
        if (FINAL) {
#pragma unroll
            for (int set = 0; set < 2; ++set) { const size_t e = ((size_t)bc * NG * NP + g * NP + 32 * set + r32) * 2; sin0[set][0] = F.SIN[e]; sin0[set][1] = F.SIN[e + 1]; }
#pragma unroll
            for (int t4 = 0; t4 < 4; ++t4) uu[t4] = *(const uint2*)(F.Z + (tok0 + 16 * t4 + c16) * INW + g * NC + 4 * q); }
        const bf16x8 afr0 = afn[0], afr1 = afn[1];
        if (bc + wpg < BATCH * NCHUNK) { const size_t tn = (size_t)(bc + wpg) * 64; afn[0] = *(const bf16x8*)(F.Z + (tn + r32) * INW + g * NC + 8 * hi); afn[1] = *(const bf16x8*)(F.Z + (tn + 32 + r32) * INW + g * NC + 8 * hi); }
        f32x16 bu[2][4];
#pragma unroll
        for (int nt = 0; nt < 4; ++nt) { f32x16 z = {}; bu[0][nt] = __builtin_amdgcn_mfma_f32_32x32x16_bf16(afr0, bfr[nt], z, 0, 0, 0); bu[1][nt] = __builtin_amdgcn_mfma_f32_32x32x16_bf16(afr1, bfr[nt], z, 0, 0, 0); }
        float ssr[2][2][16], ssi[2][2][16];
#pragma unroll
        for (int set = 0; set < 2; ++set) {
            const int p = 32 * set + r32, gp = g * NP + p;
            const float ar = aar[set], ai = aai[set];
            float a2r, a2i, a3r, a3i, a4r, a4i; cmul(ar, ai, ar, ai, a2r, a2i); cmul(a2r, a2i, ar, ai, a3r, a3i); cmul(a2r, a2i, a2r, a2i, a4r, a4i);
            float lr[8][4], li[8][4];
#pragma unroll
            for (int jj = 0; jj < 8; ++jj) {
                const int tt = jj >> 2, rb = jj & 3; float sr = 0.f, si = 0.f;
#pragma unroll
                for (int i = 0; i < 4; ++i) { const float br = bu[tt][set][4 * rb + i], bi = bu[tt][2 + set][4 * rb + i]; const float nr = ar * sr - ai * si + br, ni = ar * si + ai * sr + bi; sr = nr; si = ni; lr[jj][i] = sr; li[jj][i] = si; }
            }
            float cr = 0.f, ci = 0.f, sinr[8] = {0.f, 0.f, 0.f, 0.f, 0.f, 0.f, 0.f, 0.f}, sini[8] = {0.f, 0.f, 0.f, 0.f, 0.f, 0.f, 0.f, 0.f};
            if (FINAL) { cr = sin0[set][0]; ci = sin0[set][1]; }
#pragma unroll
            for (int j = 0; j < 16; ++j) {
                const int jj = j >> 1; const bool mine = (hi == (j & 1));
                sinr[jj] = mine ? cr : sinr[jj]; sini[jj] = mine ? ci : sini[jj];
                const float mr = a4r * cr - a4i * ci + lr[jj][3], mi = a4r * ci + a4i * cr + li[jj][3];
                const auto sr2 = __builtin_amdgcn_permlane32_swap(__float_as_uint(mr), __float_as_uint(mr), false, false), si2 = __builtin_amdgcn_permlane32_swap(__float_as_uint(mi), __float_as_uint(mi), false, false);
                cr = __uint_as_float(sr2[j & 1]); ci = __uint_as_float(si2[j & 1]);
            }
            if (!FINAL) { if (hi == 0) { const size_t e = (((size_t)(bc / NCHUNK) * NG * NP + gp) * NCHUNK + (bc % NCHUNK)) * 2; F.E[e] = cr; F.E[e + 1] = ci; } }
            else {
#pragma unroll
                for (int jj = 0; jj < 8; ++jj) {
                    const int tt = jj >> 2, rb = jj & 3;
                    const float pw_r[4] = {ar, a2r, a3r, a4r}, pw_i[4] = {ai, a2i, a3i, a4i};
#pragma unroll
                    for (int i = 0; i < 4; ++i) { ssr[set][tt][4 * rb + i] = lr[jj][i] + pw_r[i] * sinr[jj] - pw_i[i] * sini[jj]; ssi[set][tt][4 * rb + i] = li[jj][i] + pw_r[i] * sini[jj] + pw_i[i] * sinr[jj]; }
                }
            }
        }
        if (FINAL) {
#pragma unroll
            for (int set = 0; set < 2; ++set)
#pragma unroll
                for (int tt = 0; tt < 2; ++tt)
#pragma unroll
                    for (int r = 0; r < 16; ++r) { const int t = 32 * tt + 8 * (r >> 2) + 4 * hi + (r & 3);
                        *(LAS unsigned*)(sl + t * 272 + (32 * set + r32) * 4) = pk2(ssr[set][tt][r], ssi[set][tt][r]); }
            LDS_WAIT();
            f32x4 yacc[4];
#pragma unroll
            for (int t4 = 0; t4 < 4; ++t4) yacc[t4] = (f32x4){0.f, 0.f, 0.f, 0.f};
#pragma unroll
            for (int ks = 0; ks < 4; ++ks) {
                const bf16x8 cf = cfr[ks];
#pragma unroll
                for (int t4 = 0; t4 < 4; ++t4) { const bf16x8 sf = *(const LAS bf16x8*)(sl + (16 * t4 + c16) * 272 + (ks * 32 + 8 * q) * 2);
                    yacc[t4] = __builtin_amdgcn_mfma_f32_16x16x32_bf16(cf, sf, yacc[t4], 0, 0, 0); }
            }
            LDS_WAIT();
#pragma unroll
            for (int t4 = 0; t4 < 4; ++t4) {
                const size_t tok = tok0 + 16 * t4 + c16;
                const float y0 = gelu_tanh(yacc[t4][0] + dv[0] * bf2f(uu[t4].x & 0xffffu)), y1 = gelu_tanh(yacc[t4][1] + dv[1] * bf2f(uu[t4].x >> 16)),
                            y2 = gelu_tanh(yacc[t4][2] + dv[2] * bf2f(uu[t4].y & 0xffffu)), y3 = gelu_tanh(yacc[t4][3] + dv[3] * bf2f(uu[t4].y >> 16));
                *(uint2*)(F.YS + tok * SW + g * NC + 4 * q) = make_uint2(pk2(y0, y1), pk2(y2, y3));
            }
        }
    }
}
__device__ __forceinline__ void t_s5_carry(Frame& F) {
    const int gw = F.vcu * NWAVES + F.wave, NGW = F.G * NWAVES, lane = F.lane;
    for (int ch = gw; ch < BATCH * NG * NP; ch += NGW) {
        const int b = ch / (NG * NP), gp = ch % (NG * NP), g = gp / NP;
        const float ar = F.AA[gp * 4], ai = F.AA[gp * 4 + 1], Ar = F.AA[gp * 4 + 2], Ai = F.AA[gp * 4 + 3];
        const float* e = F.E + (size_t)ch * NCHUNK * 2;
        float v0r = e[2 * lane], v0i = e[2 * lane + 1], v1r = e[2 * (64 + lane)], v1i = e[2 * (64 + lane) + 1];
        float mr, mi;
        { const int tm = lane >> 2, cq = lane & 3;
          const uint2 zz = *(const uint2*)(F.ZM + (size_t)tm * INW + g * NC + 4 * cq);
          const f32x4 bbr = *(const f32x4*)(F.BB + gp * 32 + 4 * cq), bbi = *(const f32x4*)(F.BB + gp * 32 + 16 + 4 * cq);
          const float u0 = bf2f(zz.x & 0xffffu), u1 = bf2f(zz.x >> 16), u2 = bf2f(zz.y & 0xffffu), u3 = bf2f(zz.y >> 16);
          float bur = bbr[0] * u0 + bbr[1] * u1 + bbr[2] * u2 + bbr[3] * u3, bui = bbi[0] * u0 + bbi[1] * u1 + bbi[2] * u2 + bbi[3] * u3;
          bur += __shfl_xor(bur, 1); bui += __shfl_xor(bui, 1); bur += __shfl_xor(bur, 2); bui += __shfl_xor(bui, 2);
          float wr = 1.f, wi = 0.f, xr = ar, xi = ai;
#pragma unroll
          for (int bit = 0; bit < 4; ++bit) { if (((NMETA - 1 - tm) >> bit) & 1) { const float nr = wr * xr - wi * xi, ni = wr * xi + wi * xr; wr = nr; wi = ni; } const float nr = xr * xr - xi * xi, ni = 2.f * xr * xi; xr = nr; xi = ni; }
          float cr_ = cq ? 0.f : wr * bur - wi * bui, ci_ = cq ? 0.f : wr * bui + wi * bur;
          mr = wave_sum(cr_); mi = wave_sum(ci_); }
        float pr = Ar, pi = Ai;
#pragma unroll
        for (int d = 1; d < 64; d <<= 1) {
            const float u0r = __shfl_up(v0r, d), u0i = __shfl_up(v0i, d), u1r = __shfl_up(v1r, d), u1i = __shfl_up(v1i, d);
            if (lane >= d) { v0r += pr * u0r - pi * u0i; v0i += pr * u0i + pi * u0r; v1r += pr * u1r - pi * u1i; v1i += pr * u1i + pi * u1r; }
            const float nr = pr * pr - pi * pi, ni = 2.f * pr * pi; pr = nr; pi = ni;
        }
        float qr = 1.f, qi = 0.f, br_ = Ar, bi_ = Ai;
#pragma unroll
        for (int bit = 0; bit < 7; ++bit) { if (((lane + 1) >> bit) & 1) { const float nr = qr * br_ - qi * bi_, ni = qr * bi_ + qi * br_; qr = nr; qi = ni; } const float nr = br_ * br_ - bi_ * bi_, ni = 2.f * br_ * bi_; br_ = nr; bi_ = ni; }
        const float x0r = v0r + qr * mr - qi * mi, x0i = v0i + qr * mi + qi * mr;
        const float t0r = __shfl(x0r, 63), t0i = __shfl(x0i, 63);
        const float x1r = v1r + qr * t0r - qi * t0i, x1i = v1i + qr * t0i + qi * t0r;
        float* so = F.SIN + ((size_t)b * NCHUNK * NG * NP + gp) * 2;
        const size_t cs = (size_t)NG * NP * 2;
        if (lane == 0) { so[0] = mr; so[1] = mi; }
        so[(size_t)(lane + 1) * cs] = x0r; so[(size_t)(lane + 1) * cs + 1] = x0i;
        if (lane < 63) { so[(size_t)(lane + 65) * cs] = x1r; so[(size_t)(lane + 65) * cs + 1] = x1i; }
    }
}

__device__ __forceinline__ void rt_split(const f32x4& x0, const f32x4& x1, bf16x8& hi, bf16x8& lo) {
    unsigned hw[4], lw[4];
#pragma unroll
    for (int p = 0; p < 4; ++p) { const float a = p < 2 ? x0[2 * p] : x1[2 * p - 4], b = p < 2 ? x0[2 * p + 1] : x1[2 * p - 3];
        const unsigned ha = f2bf(a), hb = f2bf(b); hw[p] = ha | (hb << 16); lw[p] = pk2(a - bf2f(ha), b - bf2f(hb)); }
    hi = __builtin_bit_cast(bf16x8, (v4u){hw[0], hw[1], hw[2], hw[3]}); lo = __builtin_bit_cast(bf16x8, (v4u){lw[0], lw[1], lw[2], lw[3]});
}
#ifndef T_ROUTER2
#define T_ROUTER2 1
#endif
#ifndef T_ALT
#define T_ALT 1
#endif
#if T_ROUTER2
__device__ __forceinline__ void t_router(Frame& F) {
    const int lane = F.lane, w = F.wave, i32 = lane & 31, h = lane >> 5, kb = 128 * w + 64 * h;
    constexpr int TP = 1028;
    float* tileb = (float*)F.lds;
    float* part = tileb;
    float* lgs = tileb + 32 * TP;
    float* rsv = lgs + 2 * 32 * 33;
    int* cntl = (int*)(rsv + 64);
    bf16x8 bhi[8], blo[8];
#pragma unroll
    for (int s8 = 0; s8 < 8; ++s8) { f32x4 b0, b1;
#pragma unroll
        for (int q = 0; q < 4; ++q) { b0[q] = F.norm_ffn_g[kb + 8 * s8 + q] * F.w_router[(size_t)(kb + 8 * s8 + q) * NE + i32]; b1[q] = F.norm_ffn_g[kb + 8 * s8 + 4 + q] * F.w_router[(size_t)(kb + 8 * s8 + 4 + q) * NE + i32]; }
        rt_split(b0, b1, bhi[s8], blo[s8]); }
    f32x4 gg[4];
#pragma unroll
    for (int j = 0; j < 4; ++j) gg[j] = *(const f32x4*)(F.norm_ffn_g + 256 * j + 4 * lane);
    f32x4 R[16];
    auto ld = [&](int tile) {
#pragma unroll
        for (int r = 0; r < 4; ++r)
#pragma unroll
            for (int j = 0; j < 4; ++j) R[4 * r + j] = *(const f32x4*)(F.out + (size_t)(tile * 32 + 4 * w + r) * D + 256 * j + 4 * lane); };
    if (F.vcu < M / 32) ld(F.vcu);
    for (int t0 = F.vcu; t0 < M / 32; t0 += 2 * F.G) {
        const int t1 = t0 + F.G; const bool has1 = t1 < M / 32;
        if (F.tid < 64) cntl[F.tid] = 0;
        for (int tl = 0; tl < 2; ++tl) {
            if (tl == 1 && !has1) break;
            const int tile = tl ? t1 : t0;
#pragma unroll
            for (int r = 0; r < 4; ++r) { float ss = 0.f;
#pragma unroll
                for (int j = 0; j < 4; ++j) { const f32x4 v = R[4 * r + j]; ss += v[0] * v[0] + v[1] * v[1] + v[2] * v[2] + v[3] * v[3]; *(f32x4*)(tileb + (4 * w + r) * TP + 256 * j + 4 * lane) = v; }
                ss = wave_sum(ss);
                const float rs = rsqrtf(ss * (1.f / D) + EPS);
                if (lane == 0) rsv[tl * 32 + 4 * w + r] = rs;
                if (!(F.mode & 2)) { const size_t tok = (size_t)tile * 32 + 4 * w + r;
#pragma unroll
                    for (int j = 0; j < 4; ++j) { const f32x4 xv = R[4 * r + j] * rs * gg[j];
                        if (T_FP8) *(unsigned*)((unsigned char*)F.XN2 + tok * D + 256 * j + 4 * lane) = pg8::pk4_fp8(xv[0], xv[1], xv[2], xv[3]);
                        else *(uint2*)(F.XN2 + tok * D + 256 * j + 4 * lane) = make_uint2(pk2(xv[0], xv[1]), pk2(xv[2], xv[3])); } }
            }
            { const int nt = tl == 0 ? (has1 ? t1 : -1) : (t0 + 2 * F.G < M / 32 ? t0 + 2 * F.G : -1); if (nt >= 0) ld(nt); }
            __syncthreads();
            f32x16 acc = {};
#pragma unroll
            for (int s8 = 0; s8 < 8; ++s8) { const float* ap = tileb + i32 * TP + kb + 8 * s8; bf16x8 ahi, alo; rt_split(*(const f32x4*)ap, *(const f32x4*)(ap + 4), ahi, alo);
                acc = __builtin_amdgcn_mfma_f32_32x32x16_bf16(ahi, bhi[s8], acc, 0, 0, 0); acc = __builtin_amdgcn_mfma_f32_32x32x16_bf16(ahi, blo[s8], acc, 0, 0, 0); acc = __builtin_amdgcn_mfma_f32_32x32x16_bf16(alo, bhi[s8], acc, 0, 0, 0); }
            __syncthreads();
#pragma unroll
            for (int r = 0; r < 16; ++r) part[(w * 32 + (r & 3) + 8 * (r >> 2) + 4 * h) * 33 + i32] = acc[r];
            __syncthreads();
#pragma unroll
            for (int rep = 0; rep < 2; ++rep) { const int idx = F.tid + 512 * rep, ti = idx >> 5, tj = idx & 31; float v = 0.f;
#pragma unroll
                for (int ww = 0; ww < 8; ++ww) v += part[(ww * 32 + ti) * 33 + tj];
                lgs[(tl * 32 + ti) * 33 + tj] = v; }
            __syncthreads();
        }
        if (w == 0 && (h == 0 || has1) && !(F.mode & 1)) {
            const int tile = h ? t1 : t0, t = tile * 32 + i32; const float rs = rsv[lane];
            float lg[NE];
#pragma unroll
            for (int e = 0; e < NE; ++e) lg[e] = lgs[lane * 33 + e] * rs + F.b_router[e];
            int id[4]; float tv[4];
#pragma unroll
            for (int k = 0; k < 4; ++k) {
                float best = -3.4e38f; int bi = 0;
#pragma unroll
                for (int e = 0; e < NE; ++e) { const bool taken = (k > 0 && id[0] == e) || (k > 1 && id[1] == e) || (k > 2 && id[2] == e); if (!taken && lg[e] > best) { best = lg[e]; bi = e; } }
                id[k] = bi; tv[k] = best;
            }
            const float e0 = 1.f, e1 = __expf(tv[1] - tv[0]), e2 = __expf(tv[2] - tv[0]), e3 = __expf(tv[3] - tv[0]), inv = 1.f / (e0 + e1 + e2 + e3);
            const float gw4[4] = {e0 * inv, e1 * inv, e2 * inv, e3 * inv};
#pragma unroll
            for (int k = 0; k < 4; ++k) { F.IDX[t * 4 + k] = id[k]; F.GATE[t * 4 + k] = gw4[k]; F.POS[t * 4 + k] = atomicAdd(&cntl[32 * h + id[k]], 1); }
            F.TCNT[tile * NE + i32] = cntl[lane];
        }
        __syncthreads();
    }
}
#else
__device__ __forceinline__ void t_router(Frame& F) {
    const int lane = F.lane, w = F.wave, i32 = lane & 31, h = lane >> 5, kb = 128 * w + 64 * h;
    float* part = (float*)F.lds;
    float* ssp = part + 8 * 32 * 33;
    float* lgs = ssp + 8 * 64;
    float* rsv = lgs + 32 * 33;
    int* cntl = (int*)(rsv + 32);
    bf16x8 bhi[8], blo[8];
#pragma unroll
    for (int s8 = 0; s8 < 8; ++s8) { f32x4 b0, b1;
#pragma unroll
        for (int q = 0; q < 4; ++q) { b0[q] = F.norm_ffn_g[kb + 8 * s8 + q] * F.w_router[(size_t)(kb + 8 * s8 + q) * NE + i32]; b1[q] = F.norm_ffn_g[kb + 8 * s8 + 4 + q] * F.w_router[(size_t)(kb + 8 * s8 + 4 + q) * NE + i32]; }
        rt_split(b0, b1, bhi[s8], blo[s8]); }
    f32x4 a[16];
    for (int tile = F.vcu; tile < M / 32; tile += F.G) {
        const int tok0 = tile * 32;
        if (T_H1B) { const bf16_t* hb = F.H1B + (size_t)(tok0 + i32) * D + kb;
#pragma unroll
          for (int q = 0; q < 8; ++q) { const uint4 v = *(const uint4*)(hb + 8 * q);
              a[2 * q] = (f32x4){bf2f(v.x & 0xffffu), bf2f(v.x >> 16), bf2f(v.y & 0xffffu), bf2f(v.y >> 16)}; a[2 * q + 1] = (f32x4){bf2f(v.z & 0xffffu), bf2f(v.z >> 16), bf2f(v.w & 0xffffu), bf2f(v.w >> 16)}; } }
        else { const float* hr = F.out + (size_t)(tok0 + i32) * D + kb;
#pragma unroll
          for (int q = 0; q < 16; ++q) a[q] = *(const f32x4*)(hr + 4 * q); }
        float ss = 0.f;
#pragma unroll
        for (int q = 0; q < 16; ++q) ss += a[q][0] * a[q][0] + a[q][1] * a[q][1] + a[q][2] * a[q][2] + a[q][3] * a[q][3];
        f32x16 acc = {};
#pragma unroll
        for (int s8 = 0; s8 < 8; ++s8) { bf16x8 ahi, alo; rt_split(a[2 * s8], a[2 * s8 + 1], ahi, alo);
            acc = __builtin_amdgcn_mfma_f32_32x32x16_bf16(ahi, bhi[s8], acc, 0, 0, 0); acc = __builtin_amdgcn_mfma_f32_32x32x16_bf16(ahi, blo[s8], acc, 0, 0, 0); acc = __builtin_amdgcn_mfma_f32_32x32x16_bf16(alo, bhi[s8], acc, 0, 0, 0); }
#pragma unroll
        for (int r = 0; r < 16; ++r) part[(w * 32 + (r & 3) + 8 * (r >> 2) + 4 * h) * 33 + i32] = acc[r];
        ssp[w * 64 + lane] = ss;
        if (F.tid < 32) cntl[F.tid] = 0;
        __syncthreads();
#pragma unroll
        for (int rep = 0; rep < 2; ++rep) { const int idx = F.tid + 512 * rep, ti = idx >> 5, tj = idx & 31; float v = 0.f;
#pragma unroll
            for (int ww = 0; ww < 8; ++ww) v += part[(ww * 32 + ti) * 33 + tj];
            lgs[ti * 33 + tj] = v; }
        if (F.tid < 32) { float v = 0.f;
#pragma unroll
            for (int ww = 0; ww < 8; ++ww) v += ssp[ww * 64 + F.tid] + ssp[ww * 64 + 32 + F.tid];
            rsv[F.tid] = rsqrtf(v * (1.f / D) + EPS); }
        __syncthreads();
        const float rs = rsv[i32];
        if (w == 0 && lane < 32 && !(F.mode & 1)) {
            const int t = tok0 + lane;
            float lg[NE];
#pragma unroll
            for (int e = 0; e < NE; ++e) lg[e] = lgs[lane * 33 + e] * rs + F.b_router[e];
            int id[4]; float tv[4];
#pragma unroll
            for (int k = 0; k < 4; ++k) {
                float best = -3.4e38f; int bi = 0;
#pragma unroll
                for (int e = 0; e < NE; ++e) { const bool taken = (k > 0 && id[0] == e) || (k > 1 && id[1] == e) || (k > 2 && id[2] == e); if (!taken && lg[e] > best) { best = lg[e]; bi = e; } }
                id[k] = bi; tv[k] = best;
            }
            const float e0 = 1.f, e1 = __expf(tv[1] - tv[0]), e2 = __expf(tv[2] - tv[0]), e3 = __expf(tv[3] - tv[0]), inv = 1.f / (e0 + e1 + e2 + e3);
            const float gw4[4] = {e0 * inv, e1 * inv, e2 * inv, e3 * inv};
#pragma unroll
            for (int k = 0; k < 4; ++k) { F.IDX[t * 4 + k] = id[k]; F.GATE[t * 4 + k] = gw4[k]; F.POS[t * 4 + k] = atomicAdd(&cntl[id[k]], 1); }
            F.TCNT[tile * NE + lane] = cntl[lane];
        }
        if (!(F.mode & 2)) {
            bf16_t* xo = F.XN2 + (size_t)(tok0 + i32) * D + kb;
#pragma unroll
            for (int q = 0; q < 16; q += 4) { f32x4 xv[4];
#pragma unroll
                for (int u = 0; u < 4; ++u) xv[u] = a[q + u] * rs * *(const f32x4*)(F.norm_ffn_g + kb + 4 * (q + u));
                if (T_FP8) *(uint4*)((unsigned char*)F.XN2 + (size_t)(tok0 + i32) * D + kb + 4 * q) = make_uint4(pg8::pk4_fp8(xv[0][0], xv[0][1], xv[0][2], xv[0][3]), pg8::pk4_fp8(xv[1][0], xv[1][1], xv[1][2], xv[1][3]),
                                                                                                               pg8::pk4_fp8(xv[2][0], xv[2][1], xv[2][2], xv[2][3]), pg8::pk4_fp8(xv[3][0], xv[3][1], xv[3][2], xv[3][3]));
                else { *(uint4*)(xo + 4 * q) = make_uint4(pk2(xv[0][0], xv[0][1]), pk2(xv[0][2], xv[0][3]), pk2(xv[1][0], xv[1][1]), pk2(xv[1][2], xv[1][3]));
                       *(uint4*)(xo + 4 * q + 8) = make_uint4(pk2(xv[2][0], xv[2][1]), pk2(xv[2][2], xv[2][3]), pk2(xv[3][0], xv[3][1]), pk2(xv[3][2], xv[3][3])); } }
        }
        __syncthreads();
    }
}

#endif
__device__ __forceinline__ void t_qkv_prep(Frame& F) {
    const int gw = F.vcu * NWAVES + F.wave, NGW = F.G * NWAVES, lane = F.lane;
    bf16_t* Qd = F.QKN; bf16_t* Kd = F.YS; bf16_t* Vd = F.YS2;
    for (int row = gw; row < M + BATCH * 64; row += NGW) {
        const bf16_t* zr; bf16_t *qo = nullptr, *ko, *vo; bool zero = false;
        if (row < M) { const int b = row / SEQ, i = row % SEQ; zr = F.Z + (size_t)row * INW; qo = Qd + (size_t)row * D; ko = Kd + ((size_t)b * KVS + 64 + i) * D; vo = Vd + ((size_t)b * KVS + 64 + i) * D; }
        else { const int r = row - M, b = r / 64, l = r % 64; zero = l < 48; zr = F.ZM + (size_t)(zero ? 0 : l - 48) * INW; ko = Kd + ((size_t)b * KVS + l) * D; vo = Vd + ((size_t)b * KVS + l) * D; }
        {
            const uint4 u0 = *(const uint4*)(zr + 512 + 16 * lane), u1 = *(const uint4*)(zr + 512 + 16 * lane + 8);
            const unsigned uw[8] = {u0.x, u0.y, u0.z, u0.w, u1.x, u1.y, u1.z, u1.w};
            float v[16]; float ss = 0.f;
#pragma unroll
            for (int c = 0; c < 8; ++c) { v[2 * c] = bf2f(uw[c] & 0xffffu); v[2 * c + 1] = bf2f(uw[c] >> 16); ss += v[2 * c] * v[2 * c] + v[2 * c + 1] * v[2 * c + 1]; }
            ss += __shfl_xor(ss, 1); ss += __shfl_xor(ss, 2);
            float rs = rsqrtf(ss * (1.f / 64.f) + EPS); if (lane < 32) rs *= 0.125f * 1.4426950408889634f; if (zero) rs = 0.f;
            const float* gg = (lane < 32 ? F.q_g : F.k_g) + 16 * (lane & 3);
            unsigned o[8];
#pragma unroll
            for (int c = 0; c < 8; ++c) o[c] = pk2(v[2 * c] * rs * gg[2 * c], v[2 * c + 1] * rs * gg[2 * c + 1]);
            const int sh = (lane & 31) >> 2, h = sh >> 1, j = sh & 1;
            bf16_t* dst = (lane < 32) ? qo : ko;
            if (dst) {
#pragma unroll
                for (int vh = 0; vh < 2; ++vh) { bf16_t* d = dst + (4 * h + 2 * j + vh) * 64 + 16 * (lane & 3); *(uint4*)d = make_uint4(o[0], o[1], o[2], o[3]); *(uint4*)(d + 8) = make_uint4(o[4], o[5], o[6], o[7]); }
            }
        }
        {
            uint4 u = *(const uint4*)(zr + 1536 + 8 * lane); if (zero) u = make_uint4(0, 0, 0, 0);
            const int h = lane >> 4, dv = 8 * (lane & 15), vh = dv >> 6, d = dv & 63;
#pragma unroll
            for (int j = 0; j < 2; ++j) *(uint4*)(vo + (4 * h + 2 * j + vh) * 64 + d) = u;
        }
    }
}
#ifndef T_UNR
#define T_UNR 4
#endif
struct PrepRow { bf16_t *qo, *ko, *vo; bool zero; uint4 u0, u1, uv; };
__device__ __forceinline__ void t_qkv_prep2(Frame& F) {
    const int gw = F.vcu * NWAVES + F.wave, NGW = F.G * NWAVES, lane = F.lane;
    bf16_t* Q2 = F.YS; bf16_t* K2 = F.YS + (size_t)M * 512; bf16_t* V2 = F.YS2;
    constexpr int NR = M + BATCH * 64;
    const float* gg = (lane < 32 ? F.q_g : F.k_g) + 16 * (lane & 3);
    f32x4 gv[4];
#pragma unroll
    for (int c = 0; c < 4; ++c) gv[c] = *(const f32x4*)(gg + 4 * c);
    for (int row0 = gw; row0 < NR; row0 += T_UNR * NGW) {
        PrepRow p[T_UNR];
#pragma unroll
        for (int j = 0; j < T_UNR; ++j) { const int row = row0 + j * NGW; if (row >= NR) break;
            const bf16_t* zr; p[j].qo = nullptr; p[j].zero = false;
            if (row < M) { const int b = row / SEQ, i = row % SEQ; zr = F.Z + (size_t)row * INW; p[j].qo = Q2 + (size_t)row * 512; p[j].ko = K2 + ((size_t)b * KVS + 64 + i) * 512; p[j].vo = V2 + ((size_t)b * KVS + 64 + i) * 512; }
            else { const int r = row - M, b = r / 64, l = r % 64; p[j].zero = l < 48; zr = F.ZM + (size_t)(p[j].zero ? 0 : l - 48) * INW; p[j].ko = K2 + ((size_t)b * KVS + l) * 512; p[j].vo = V2 + ((size_t)b * KVS + l) * 512; }
            p[j].u0 = *(const uint4*)(zr + 512 + 16 * lane); p[j].u1 = *(const uint4*)(zr + 512 + 16 * lane + 8); p[j].uv = *(const uint4*)(zr + 1536 + 8 * lane); }
#pragma unroll
        for (int j = 0; j < T_UNR; ++j) { const int row = row0 + j * NGW; if (row >= NR) break;
            const unsigned uw[8] = {p[j].u0.x, p[j].u0.y, p[j].u0.z, p[j].u0.w, p[j].u1.x, p[j].u1.y, p[j].u1.z, p[j].u1.w};
            uint4 uv = p[j].uv;
            float v[16]; float ss = 0.f;
#pragma unroll
            for (int c = 0; c < 8; ++c) { v[2 * c] = bf2f(uw[c] & 0xffffu); v[2 * c + 1] = bf2f(uw[c] >> 16); ss += v[2 * c] * v[2 * c] + v[2 * c + 1] * v[2 * c + 1]; }
            ss += __shfl_xor(ss, 1); ss += __shfl_xor(ss, 2);
            float rs = rsqrtf(ss * (1.f / 64.f) + EPS); if (lane < 32) rs *= 0.125f * 1.4426950408889634f; if (p[j].zero) { rs = 0.f; uv = make_uint4(0, 0, 0, 0); }
            unsigned o[8];
#pragma unroll
            for (int c = 0; c < 8; ++c) o[c] = pk2(v[2 * c] * rs * gv[c >> 1][(2 * c) & 3], v[2 * c + 1] * rs * gv[c >> 1][(2 * c + 1) & 3]);
            bf16_t* dst = (lane < 32) ? p[j].qo : p[j].ko;
            if (dst) { bf16_t* d = dst + 16 * (lane & 31); *(uint4*)d = make_uint4(o[0], o[1], o[2], o[3]); *(uint4*)(d + 8) = make_uint4(o[4], o[5], o[6], o[7]); }
            *(uint4*)(p[j].vo + 8 * lane) = uv; }
    }
}
__device__ __forceinline__ void t_attn_post2(Frame& F) {
    const int gw = F.vcu * NWAVES + F.wave, NGW = F.G * NWAVES, lane = F.lane;
    const bf16_t* O = F.QKN; const float lam = F.LAM[0];
    const int h = lane >> 4, dv = 8 * (lane & 15);
    const f32x4 g0 = *(const f32x4*)(F.sub_g + dv), g1 = *(const f32x4*)(F.sub_g + dv + 4);
    for (int t0 = gw; t0 < M; t0 += T_UNR * NGW) {
        uint4 a[T_UNR], b[T_UNR];
#pragma unroll
        for (int j = 0; j < T_UNR; ++j) { const int t = t0 + j * NGW; if (t >= M) break; a[j] = *(const uint4*)(O + (size_t)t * D + 256 * h + dv); b[j] = *(const uint4*)(O + (size_t)t * D + 256 * h + 128 + dv); }
#pragma unroll
        for (int j = 0; j < T_UNR; ++j) { const int t = t0 + j * NGW; if (t >= M) break;
            const unsigned aw[4] = {a[j].x, a[j].y, a[j].z, a[j].w}, bw[4] = {b[j].x, b[j].y, b[j].z, b[j].w};
            float o[8]; float ss = 0.f;
#pragma unroll
            for (int c = 0; c < 4; ++c) { o[2 * c] = bf2f(aw[c] & 0xffffu) - lam * bf2f(bw[c] & 0xffffu); o[2 * c + 1] = bf2f(aw[c] >> 16) - lam * bf2f(bw[c] >> 16); ss += o[2 * c] * o[2 * c] + o[2 * c + 1] * o[2 * c + 1]; }
            ss += __shfl_xor(ss, 1); ss += __shfl_xor(ss, 2); ss += __shfl_xor(ss, 4); ss += __shfl_xor(ss, 8);
            const float rs = rsqrtf(ss * (1.f / 128.f) + EPS) * 0.8f;
            bf16_t* yo = T_MIXCAT ? F.YS2 + (size_t)t * 1024 + 128 * h + dv : F.YA + (size_t)t * AW + 128 * h + dv;
            *(uint4*)yo = make_uint4(pk2(o[0] * rs * g0[0], o[1] * rs * g0[1]), pk2(o[2] * rs * g0[2], o[3] * rs * g0[3]), pk2(o[4] * rs * g1[0], o[5] * rs * g1[1]), pk2(o[6] * rs * g1[2], o[7] * rs * g1[3])); }
    }
}
__device__ __forceinline__ void t_attn_post(Frame& F) {
    const int gw = F.vcu * NWAVES + F.wave, NGW = F.G * NWAVES, lane = F.lane;
    const bf16_t* O = F.QKN; const float lam = F.LAM[0];
    const int h = lane >> 4, dv = 8 * (lane & 15), vh = dv >> 6, d = dv & 63;
    const f32x4 g0 = *(const f32x4*)(F.sub_g + dv), g1 = *(const f32x4*)(F.sub_g + dv + 4);
    for (int t = gw; t < M; t += NGW) {
        const uint4 a = *(const uint4*)(O + (size_t)t * D + (4 * h + vh) * 64 + d), b = *(const uint4*)(O + (size_t)t * D + (4 * h + 2 + vh) * 64 + d);
        const unsigned aw[4] = {a.x, a.y, a.z, a.w}, bw[4] = {b.x, b.y, b.z, b.w};
        float o[8]; float ss = 0.f;
#pragma unroll
        for (int c = 0; c < 4; ++c) { o[2 * c] = bf2f(aw[c] & 0xffffu) - lam * bf2f(bw[c] & 0xffffu); o[2 * c + 1] = bf2f(aw[c] >> 16) - lam * bf2f(bw[c] >> 16); ss += o[2 * c] * o[2 * c] + o[2 * c + 1] * o[2 * c + 1]; }
        ss += __shfl_xor(ss, 1); ss += __shfl_xor(ss, 2); ss += __shfl_xor(ss, 4); ss += __shfl_xor(ss, 8);
        const float rs = rsqrtf(ss * (1.f / 128.f) + EPS) * 0.8f;
        *(uint4*)(F.YA + (size_t)t * AW + 128 * h + dv) = make_uint4(pk2(o[0] * rs * g0[0], o[1] * rs * g0[1]), pk2(o[2] * rs * g0[2], o[3] * rs * g0[3]), pk2(o[4] * rs * g1[0], o[5] * rs * g1[1]), pk2(o[6] * rs * g1[2], o[7] * rs * g1[3]));
    }
}

__device__ __forceinline__ void t_gemm_z(Frame& F) {
    if (T_GATE8) {
        { pg8::Gemm g{F.XN, F.Wt_in, M, 2048, D}; pg8::StaticOrder S; S.init(M, 2048, F.G, (int)blockIdx.x);
          pg8::EpiBf16<0> E{F.Z, INW, nullptr, 0, 0, 1.f, 0};
          pg8::gemm_phase<pg8::EpiBf16<0>, pg8::StaticOrder, true, true>(F.lds3, g, S, E); }
        { pg8::Gemm g{F.XN8, F.Wt_in8, M, 2048, D / 2}; pg8::StaticOrder S; S.init(M, 2048, F.G, (int)blockIdx.x);
          pg8::EpiScaleBf16 E{F.Z + 2048, INW, 0.03125f};
          pg8::gemm_phase<pg8::EpiScaleBf16, pg8::StaticOrder, true, true, false, true>(F.lds3, g, S, E); }
        return;
    }
    pg8::Gemm g{F.XN, F.Wt_in, M, INW, D}; pg8::StaticOrder S; S.init(M, INW, F.G, (int)blockIdx.x);
    pg8::EpiBf16<0> E{F.Z, INW, nullptr, 0, 0, 1.f, 0};
    pg8::gemm_phase<pg8::EpiBf16<0>, pg8::StaticOrder, true, true>(F.lds3, g, S, E);
}
__device__ __forceinline__ void t_gemm_glu(Frame& F) {
    pg8::Gemm g{F.YS, F.Wt_glu, M, SW, SW}; pg8::StaticOrder S; S.init(M, SW, F.G, (int)blockIdx.x);
    pg8::EpiGlu E{F.YS, T_MIXCAT ? F.YS2 + 512 : F.YS2, F.b_glu, SW, T_MIXCAT ? 1024 : SW};
    pg8::gemm_phase<pg8::EpiGlu, pg8::StaticOrder, true, true>(F.lds3, g, S, E);
    if (T_MOE && DN_LATE > 0) {
        const int nun = (M / 256) * (SW / 256), idle = F.G - nun;
        if (idle > 0 && (int)blockIdx.x >= nun) { const int j = (int)blockIdx.x - nun; const size_t eo = (size_t)(NE - DN_LATE);
            cp_set<0, T_FP8>(F, F.w_down + eo * D * D, D, D, T_FP8 ? (bf16_t*)((unsigned char*)F.Wt_dn + eo * D * D) : F.Wt_dn + eo * D * D, DN_LATE, 0, 0, 0, j * NWAVES + F.wave, idle * NWAVES); }
        else if (idle <= 0) cp_set<0, T_FP8>(F, F.w_down + (size_t)(NE - DN_LATE) * D * D, D, D, T_FP8 ? (bf16_t*)((unsigned char*)F.Wt_dn + (size_t)(NE - DN_LATE) * D * D) : F.Wt_dn + (size_t)(NE - DN_LATE) * D * D, DN_LATE);
    }
}
__device__ __forceinline__ void t_gemm_mix(Frame& F) {
    if (T_MIXCAT) { pg8::Gemm g{F.YS2, F.Wt_so, M, D, D}; pg8::StaticOrder S; S.init(M, D, F.G, (int)blockIdx.x);
        pg8::EpiMixCat E{F.Z, F.MIX};
        pg8::gemm_phase<pg8::EpiMixCat, pg8::StaticOrder, true, true, false, false, true>(F.lds3, g, S, E); return; }
    { pg8::Gemm g{F.YS2, F.Wt_so, M, D, SW}; pg8::StaticOrder S; S.init(M, D, F.G, (int)blockIdx.x);
      pg8::EpiMix<true> E{F.Z + 2048, F.MIX, nullptr};
      pg8::gemm_phase<pg8::EpiMix<true>, pg8::StaticOrder, true, true>(F.lds3, g, S, E); }
    asm volatile("s_waitcnt vmcnt(0)" ::: "memory"); __syncthreads();
    { pg8::Gemm g{F.YA, F.Wt_ao, M, D, AW}; pg8::StaticOrder S; S.init(M, D, F.G, (int)blockIdx.x);
      pg8::EpiMix<false, T_WO8> E{F.Z + 3072, F.MIX, (unsigned char*)F.YS2 + (size_t)M * SW * 2};
      pg8::gemm_phase<pg8::EpiMix<false, T_WO8>, pg8::StaticOrder, true, true>(F.lds3, g, S, E); }
}
__device__ __forceinline__ void t_gemm_wo(Frame& F) {
    if (T_H1B) { pg8::Gemm g{F.MIX, F.Wt_o, M, D, D}; pg8::StaticOrder S; S.init(M, D, F.G, (int)blockIdx.x);
        pg8::EpiWoB E{F.x, F.H1B};
        pg8::gemm_phase<pg8::EpiWoB, pg8::StaticOrder, true, true>(F.lds3, g, S, E); return; }
    pg8::Gemm g{T_WO8 ? (const bf16_t*)((unsigned char*)F.YS2 + (size_t)M * SW * 2) : F.MIX, F.Wt_o, M, D, T_WO8 ? D / 2 : D}; pg8::StaticOrder S; S.init(M, D, F.G, (int)blockIdx.x);
    pg8::EpiWo E{F.x, F.out, T_WO8 ? 0.03125f : 1.f};
    pg8::gemm_phase<pg8::EpiWo, pg8::StaticOrder, true, true, false, T_WO8>(F.lds3, g, S, E);
}

__device__ __forceinline__ void t_moe1(Frame& F) {
    const int ntiles = F.OFF[NE] / 256;
    pg8::MoeOrder S{F.TEXP, ntiles, 8, F.G, F.vcu};
    LAS int* idx = (LAS int*)(F.lds3 + 131072);
    { pg8::Unit u; for (int i = 0; i < 12 && S.next(i, u); ++i) if (F.tid < 256) idx[i * 256 + F.tid] = F.ROWTOK[u.pm * 256 + F.tid]; }
    __syncthreads();
    pg8::Gemm g{F.XN2, F.Wt_gu, MOE_ROWS, NE * 2048, T_FP8 ? D / 2 : D, idx};
    pg8::EpiMoe1<T_FP8> E{F.ACT, F.b_gate, F.b_up};
    pg8::gemm_phase<pg8::EpiMoe1<T_FP8>, pg8::MoeOrder, true, true, true, T_FP8>(F.lds3, g, S, E);
    if (DN_MID > 0) {
        const int nu = ntiles * 8, rem = nu % F.G, nidle = rem ? F.G - rem : F.G, j = rem ? F.vcu - rem : F.vcu;
        if (j >= 0) { const size_t eo = (size_t)(NE - (T_GEMM_GLU ? DN_LATE : 0) - DN_MID);
            cp_set<0, T_FP8>(F, F.w_down + eo * D * D, D, D, T_FP8 ? (bf16_t*)((unsigned char*)F.Wt_dn + eo * D * D) : F.Wt_dn + eo * D * D, DN_MID, 0, 0, 0, j * NWAVES + F.wave, nidle * NWAVES); }
    }
}
__device__ __forceinline__ void t_moe2(Frame& F) {
    const int ntiles = F.OFF[NE] / 256;
    pg8::MoeOrder S{F.TEXP, ntiles, 4, F.G, F.vcu};
    pg8::Gemm g{F.ACT, F.Wt_dn, MOE_ROWS, NE * 1024, T_FP8 ? D / 2 : D, nullptr};
    pg8::EpiMoe2<T_FP8> E{F.Y2, F.b_down, F.ROWTK};
    pg8::gemm_phase<pg8::EpiMoe2<T_FP8>, pg8::MoeOrder, true, true, false, T_FP8>(F.lds3, g, S, E);
}

constexpr int NPHASE = 13;
__global__ void __launch_bounds__(NTHR, 2) mk_fwd(Args args) {
    extern __shared__ __attribute__((aligned(16))) unsigned char lds[];
    Frame F;
    F.lds = lds; F.lds3 = (LAS unsigned char*)lds; F.tid = threadIdx.x; F.lane = F.tid & 63; F.wave = __builtin_amdgcn_readfirstlane(F.tid >> 6);
    F.mode = args.mode; F.G = gridDim.x; { const int bx = blockIdx.x; F.vcu = (F.G % 8 == 0) ? (bx % 8) * (F.G / 8) + bx / 8 : bx; }
    const float* const* in = args.in;
    F.x = in[0]; F.meta = in[1]; F.norm_mix_g = in[2]; F.w_in = in[3]; F.a_re = in[4]; F.a_im = in[5]; F.log_dt = in[6]; F.b_re = in[7]; F.b_im = in[8]; F.c_re = in[9]; F.c_im = in[10]; F.ssm_d = in[11];
    F.w_glu = in[12]; F.b_glu = in[13]; F.q_g = in[14]; F.k_g = in[15]; F.lq1 = in[16]; F.lk1 = in[17]; F.lq2 = in[18]; F.lk2 = in[19]; F.sub_g = in[20]; F.w_so = in[21]; F.w_ao = in[22]; F.w_o = in[23];
    F.norm_ffn_g = in[24]; F.w_router = in[25]; F.b_router = in[26]; F.w_gate = in[27]; F.b_gate = in[28]; F.w_up = in[29]; F.b_up = in[30]; F.w_down = in[31]; F.b_down = in[32];
    F.out = args.out;
    unsigned char* ws = args.ws;
    F.XN = (bf16_t*)(ws + WS_R0); F.QKN = (bf16_t*)(ws + WS_R0); F.MIX = (bf16_t*)(ws + WS_R0);
    F.YS = (bf16_t*)(ws + WS_R1); F.YA = (bf16_t*)(ws + WS_R1 + (size_t)M * SW * 2); F.XN2 = (bf16_t*)(ws + WS_R1);
    F.YS2 = (bf16_t*)(ws + WS_R2); F.Z = (bf16_t*)(ws + WS_R3); F.ACT = (bf16_t*)(ws + WS_R3); F.Y2 = (bf16_t*)(ws + WS_WGU);
    F.Wt_in = (bf16_t*)(ws + WS_WD + WD_IN); F.Wt_glu = (bf16_t*)(ws + WS_WD + WD_GLU); F.Wt_so = (bf16_t*)(ws + WS_WD + WD_SO); F.Wt_ao = (bf16_t*)(ws + WS_WD + WD_AO); F.Wt_o = (bf16_t*)(ws + WS_WD + WD_O);
    F.XN8 = (bf16_t*)(ws + WS_R2); F.H1B = (bf16_t*)(ws + WS_R2); F.Wt_in8 = (bf16_t*)(ws + WS_WGU + 64 * MiB);     F.Wt_gu = (bf16_t*)(ws + WS_WGU); F.Wt_dn = (bf16_t*)(ws + WS_WDN);
    unsigned char* sm = ws + WS_SM;
    F.BB = (float*)(sm + SM_BB); F.AA = (float*)(sm + SM_AA); F.E = (float*)(sm + SM_E); F.SIN = (float*)(sm + SM_SIN); F.LAM = (float*)(sm + SM_LAM); F.GATE = (float*)(sm + SM_GATE);
    F.IDX = (int*)(sm + SM_IDX); F.POS = (int*)(sm + SM_POS); F.OFF = (int*)(sm + SM_OFF); F.ROWTOK = (int*)(sm + SM_ROWTOK); F.ROWTK = (int*)(sm + SM_ROWTK); F.TEXP = (int*)(sm + SM_TEXP); F.TCNT = (int*)(sm + SM_TCNT);
    F.ZM = (bf16_t*)(sm + SM_ZM); F.QKNM = (bf16_t*)(sm + SM_QKNM); F.BBH = (bf16_t*)(sm + SM_BBH); F.CMT = (bf16_t*)(sm + SM_CMT);
    unsigned* ctl = (unsigned*)(ws + WS_CTL);
    F.CNT = (int*)(ctl + CW_CNT);
    volatile LAS unsigned* MISC = (volatile LAS unsigned*)((LAS unsigned char*)lds + MISC_OFF);
    for (int u = F.tid; u < 64; u += NTHR) MISC[u] = 0u;
    __syncthreads();
    XcdBarrier bar = xcd_barrier_post(ctl + CW_BAR, MISC + 8);
#if COOP_LAUNCH
    cg::grid_group grid = cg::this_grid();
#endif
    const int lo = args.ph_lo, hi = args.ph_hi;
    bool first_seam = true; (void)first_seam;
#if COOP_LAUNCH
#define SEAM(k) do { if ((k) + 1 < hi) { if (first_seam) { grid.sync(); first_seam = false; } else xcd_barrier(bar); } } while (0)
#else
#define SEAM(k) do { if ((k) + 1 < hi) xcd_barrier(bar); } while (0)
#endif
#define IN(k) (lo <= (k) && (k) < hi)
#ifdef PROBE_LO
    if (F.mode & 2048) { for (int i = 0; i < 20; ++i) xcd_barrier(bar); }
#endif
    if (IN(0)) { s_prologue(F); SEAM(0); }
    if (IN(1)) { if (T_GEMM_Z) t_gemm_z(F); else s_gemm_z(F); SEAM(1); }
#if T_S5 && T_ATTN == 2 && T_ALT
    if (IN(2)) { if (F.wave & 1) { t_qkv_prep2(F); t_s5_pass<false>(F); } else { t_s5_pass<false>(F); t_qkv_prep2(F); } SEAM(2); }
#else
    if (IN(2)) { if (T_S5) { if (!(F.mode & 32)) t_s5_pass<false>(F); } else s_s5_scan<false>(F); if (F.mode & 64) {} else if (T_ATTN == 2) t_qkv_prep2(F); else if (T_ATTN) t_qkv_prep(F); else s_qkn(F); SEAM(2); }
#endif
    if (IN(3)) { if (T_S5) t_s5_carry(F); else s_s5_carry(F);
        if (T_ATTN == 2) { const attn2::AttnTensors AT{(const attn2::bf16*)F.YS, (const attn2::bf16*)(F.YS + (size_t)M * 512), (const attn2::bf16*)F.YS2, (attn2::bf16*)F.QKN};
                      const attn2::StaticOrder S((int)F.G, (int)blockIdx.x);
#ifdef PROBE_LO
                      if (F.mode & 256) attn2::attn_phase<attn2::StaticOrder, 8, 1>((char*)lds, AT, S); else if (F.mode & 512) attn2::attn_phase<attn2::StaticOrder, 8, 2>((char*)lds, AT, S); else if (F.mode & 1024) attn2::attn_phase<attn2::StaticOrder, 8, 4>((char*)lds, AT, S); else if (F.mode & 4096) attn2::attn_phase<attn2::StaticOrder, 8, 8>((char*)lds, AT, S); else if (F.mode & 8192) attn2::attn_phase<attn2::StaticOrder, 8, 16>((char*)lds, AT, S); else if (F.mode & 16384) attn2::attn_phase<attn2::StaticOrder, 8, 32>((char*)lds, AT, S); else
#endif
                      attn2::attn_phase<attn2::StaticOrder>((char*)lds, AT, S); }
        else if (T_ATTN) { const attn_body::AttnTensors AT{(const attn_body::bf16*)F.QKN, (const attn_body::bf16*)F.YS, (const attn_body::bf16*)F.YS2, (attn_body::bf16*)F.QKN};
                      const attn_body::StaticOrder S((int)F.G, (int)blockIdx.x); attn_body::attn_phase<attn_body::StaticOrder>((char*)lds, AT, S); }
        else s_attn(F);
        SEAM(3); }
#if T_S5 && T_ATTN == 2 && T_ALT
    if (IN(4)) { if (F.wave & 1) { t_attn_post2(F); t_s5_pass<true>(F); } else { t_s5_pass<true>(F); t_attn_post2(F); } SEAM(4); }
#else
    if (IN(4)) { if (T_S5) { if (!(F.mode & 32)) t_s5_pass<true>(F); } else s_s5_scan<true>(F); if (F.mode & 64) {} else if (T_ATTN == 2) t_attn_post2(F); else if (T_ATTN) t_attn_post(F); SEAM(4); }
#endif
    if (IN(5)) { if (T_GEMM_GLU) t_gemm_glu(F); else s_gemm_glu(F); SEAM(5); }
    if (IN(6)) { if (T_GEMM_MIX) t_gemm_mix(F); else s_gemm_mix(F); SEAM(6); }
    if (IN(7)) { if (T_GEMM_WO) t_gemm_wo(F); else s_gemm_wo(F); SEAM(7); }
#if defined(PROBE_DUP) && PROBE_DUP == 8
    if (IN(8)) {
#pragma unroll 1
        for (int rep = 0; rep < 2; ++rep) { t_router(F); if (rep == 0) xcd_barrier(bar); }
        SEAM(8); }
#else
    if (IN(8)) { if (T_ROUTER) t_router(F); else s_router(F); SEAM(8); }
#endif
    if (IN(9)) { if (T_ROUTER) t_scatter(F); else s_scatter(F); SEAM(9); }
    if (IN(10)) { if (T_MOE) t_moe1(F); else s_moe1(F); SEAM(10); }
    if (IN(11)) { if (T_MOE) t_moe2(F); else s_moe2(F); SEAM(11); }
#if defined(PROBE_DUP) && PROBE_DUP == 11
    if (IN(11)) { t_moe2(F); xcd_barrier(bar); }
#endif
#if defined(PROBE_DUP) && PROBE_DUP == 10
    if (IN(10)) { t_moe1(F); xcd_barrier(bar); }
#endif
    if (IN(12)) { s_combine(F); }
#undef IN
#undef SEAM
}

extern "C" void kernel_launch(void* const* d_in, const int* in_sizes, int n_in, void* d_out, int out_size, void* d_ws, size_t ws_size, hipStream_t stream) {
    static int grid = 0;
    if (grid == 0) {
        if (n_in != 33 || ws_size < WS_END || out_size != M * D) { fprintf(stderr, "kernel_launch: need 33 inputs, out %d and %zu bytes of workspace (got %d, %d, %zu)\n", M * D, (size_t)WS_END, n_in, out_size, ws_size); grid = -1; return; }
        int dev = 0, cus = 0, per_cu = 0;
        if (hipGetDevice(&dev) != hipSuccess || hipDeviceGetAttribute(&cus, hipDeviceAttributeMultiprocessorCount, dev) != hipSuccess) { grid = -1; return; }
        if (hipFuncSetAttribute((const void*)mk_fwd, hipFuncAttributeMaxDynamicSharedMemorySize, LDS_BYTES) != hipSuccess) { fprintf(stderr, "kernel_launch: hipFuncSetAttribute failed\n"); grid = -1; return; }
        if (hipOccupancyMaxActiveBlocksPerMultiprocessor(&per_cu, (const void*)mk_fwd, NTHR, LDS_BYTES) != hipSuccess || per_cu < 1) { fprintf(stderr, "kernel_launch: occupancy query failed (%d)\n", per_cu); (void)hipGetLastError(); grid = -1; return; }
        grid = cus * (per_cu < 1 ? 1 : 1);
    }
    if (grid < 0) return;
    (void)hipMemsetAsync((char*)d_ws + WS_CTL, 0, CTL_ZERO_BYTES, stream);
    Args a{};
    for (int i = 0; i < 33; ++i) a.in[i] = (const float*)d_in[i];
    a.out = (float*)d_out; a.ws = (unsigned char*)d_ws; a.ph_lo = 0; a.ph_hi = NPHASE;
    void* kargs[] = {&a};
#if COOP_LAUNCH
    const hipError_t e = hipLaunchCooperativeKernel((const void*)mk_fwd, dim3(grid), dim3(NTHR), kargs, LDS_BYTES, stream);
#else
    (void)kargs; hipLaunchKernelGGL(mk_fwd, dim3(grid), dim3(NTHR), LDS_BYTES, stream, a);
    const hipError_t e = hipPeekAtLastError();
#endif
    if (e != hipSuccess) fprintf(stderr, "kernel_launch: launch failed: %s (grid %d)\n", hipGetErrorString(e), grid);
#ifdef PROBE_LO
    a.ph_lo = PROBE_LO; a.ph_hi = PROBE_HI; a.mode = PROBE_MODE;
    (void)hipMemsetAsync((char*)d_ws + WS_CTL + CW_BAR * 4, 0, XCD_BAR_WORDS * 4, stream);
#if COOP_LAUNCH
    (void)hipLaunchCooperativeKernel((const void*)mk_fwd, dim3(grid), dim3(NTHR), kargs, LDS_BYTES, stream);
#else
    hipLaunchKernelGGL(mk_fwd, dim3(grid), dim3(NTHR), LDS_BYTES, stream, a);
#endif
#endif
}
```

```cpp
#include <hip/hip_runtime.h>
#include <hip/hip_cooperative_groups.h>
#include <cstdio>
#include <cstdint>
namespace cg = cooperative_groups;

typedef unsigned short bf16_t;
typedef short bf16x8 __attribute__((ext_vector_type(8)));
typedef float f32x4 __attribute__((ext_vector_type(4)));
#define LAS __attribute__((address_space(3)))

constexpr int D = 1024, BATCH = 2, SEQ = 8192, NMETA = 16;
constexpr int M = BATCH * SEQ;
constexpr int INW = 4096;
constexpr int SW = 512;
constexpr int NG = 32, NP = 64, NC = 16;
constexpr int NCHUNK = SEQ / 64;
constexpr int AW = 512;
constexpr int NE = 32, TOPK = 4;
constexpr int NASSIGN = M * TOPK;
constexpr int MOE_ROWS = NASSIGN + NE * 256;
constexpr float EPS = 1e-6f;
constexpr int NWAVES = 8, NTHR = 512;
constexpr int KVS = 64 + SEQ;

constexpr size_t MiB = 1u << 20;
constexpr size_t al(size_t x) { return (x + 255) & ~(size_t)255; }
constexpr size_t WS_CTL = 0, CTL_ZERO_BYTES = 1 * MiB;
constexpr int CW_BAR = 4096;
constexpr int CW_CNT = 16384;
constexpr size_t WS_SM = 1 * MiB;
constexpr size_t SM_BB = 0;
constexpr size_t SM_AA = SM_BB + al((size_t)NG * NP * 32 * 4);
constexpr size_t SM_E = SM_AA + al((size_t)NG * NP * 4 * 4);
constexpr size_t SM_SIN = SM_E + al((size_t)BATCH * NCHUNK * NG * NP * 2 * 4);
constexpr size_t SM_LAM = SM_SIN + al((size_t)BATCH * NCHUNK * NG * NP * 2 * 4);
constexpr size_t SM_IDX = SM_LAM + 256;
constexpr size_t SM_GATE = SM_IDX + al((size_t)NASSIGN * 4);
constexpr size_t SM_POS = SM_GATE + al((size_t)NASSIGN * 4);
constexpr size_t SM_OFF = SM_POS + al((size_t)NASSIGN * 4);
constexpr size_t SM_ROWTOK = SM_OFF + 256;
constexpr size_t SM_ROWTK = SM_ROWTOK + al((size_t)MOE_ROWS * 4);
constexpr size_t SM_ZM = SM_ROWTK + al((size_t)MOE_ROWS * 4);
constexpr size_t SM_QKNM = SM_ZM + al((size_t)NMETA * INW * 2);
constexpr size_t SM_TEXP = SM_QKNM + al((size_t)NMETA * D * 2);
constexpr size_t SM_BBH = SM_TEXP + al((size_t)(MOE_ROWS / 256) * 4);
constexpr size_t SM_CMT = SM_BBH + al((size_t)NG * NP * 32 * 2);
constexpr size_t SM_TCNT = SM_CMT + al((size_t)NG * NC * 128 * 2);
constexpr size_t SM_END = SM_TCNT + al((size_t)(M / 32) * NE * 4);
static_assert(SM_END <= 13 * MiB, "small region");
constexpr size_t WS_WD = 14 * MiB;
constexpr size_t WD_IN = 0, WD_GLU = WD_IN + (size_t)INW * D * 2, WD_SO = WD_GLU + (size_t)SW * SW * 2, WD_AO = WD_SO + (size_t)D * SW * 2, WD_O = WD_AO + (size_t)D * AW * 2, WD_END = WD_O + (size_t)D * D * 2;
static_assert(WD_END <= 13 * MiB, "dense weight copies");
constexpr size_t WS_WGU = 27 * MiB;
constexpr size_t WS_WDN = WS_WGU + 128 * MiB;
constexpr size_t RSZ = 34078720;
constexpr size_t WS_R0 = WS_WDN + 64 * MiB;
constexpr size_t WS_R1 = WS_R0 + RSZ;
constexpr size_t WS_R2 = WS_R1 + RSZ;
constexpr size_t WS_R3 = WS_R2 + RSZ;
constexpr size_t WS_END = WS_R3 + al((size_t)MOE_ROWS * D * 2);
static_assert((size_t)M * INW * 2 <= (size_t)MOE_ROWS * D * 2 && (size_t)BATCH * KVS * D * 2 <= RSZ, "region sizes");

constexpr int LDS_BYTES = 163840;
constexpr int MISC_OFF = LDS_BYTES - 256;

__device__ __forceinline__ unsigned f2bf(float f) { unsigned u = __builtin_bit_cast(unsigned, f); return (u + 0x7fffu + ((u >> 16) & 1u)) >> 16; }
__device__ __forceinline__ float bf2f(unsigned h) { return __builtin_bit_cast(float, h << 16); }
__device__ __forceinline__ unsigned pk2(float lo, float hi) { return f2bf(lo) | (f2bf(hi) << 16); }
__device__ __forceinline__ float wave_sum(float v) {
#pragma unroll
    for (int o = 1; o < 64; o <<= 1) v += __shfl_xor(v, o);
    return v;
}
__device__ __forceinline__ float sigmoidf_(float x) { return 1.f / (1.f + __expf(-x)); }
__device__ __forceinline__ float gelu_tanh(float x) { const float t = 0.7978845608028654f * (x + 0.044715f * x * x * x); return 0.5f * x * (1.f + tanhf(t)); }

#define XB_TMO      128
#define XB_XCNT(j)  (256  + 64 * (j))
#define XB_XSUB(j)  (1280 + 64 * (j))
#define XB_XGEN(j)  (2304 + 64 * (j))
#define XB_TOP      3328
#define XB_TOPGEN   3392
#define XCD_BAR_WORDS 3456
#define XB_SPIN_CAP (1u << 22)
__device__ __forceinline__ unsigned xb_ld(unsigned* p)              { return __hip_atomic_load(p, __ATOMIC_RELAXED, __HIP_MEMORY_SCOPE_AGENT); }
__device__ __forceinline__ unsigned xb_add(unsigned* p, unsigned v) { return __hip_atomic_fetch_add(p, v, __ATOMIC_RELAXED, __HIP_MEMORY_SCOPE_AGENT); }
__device__ __forceinline__ unsigned xb_xcc_id() { return (unsigned)__builtin_amdgcn_s_getreg((3 << 11) | 20) & 0xFu; }
#define XB_SPIN(cond, bar) do { unsigned _sp = 0; while (cond) { __builtin_amdgcn_s_sleep(1); \
    if ((++_sp & 255u) == 0u) { if (xb_ld(&(bar)[XB_TMO])) break; if (_sp > XB_SPIN_CAP) { atomicAdd(&(bar)[XB_TMO], 1u); break; } } } } while (0)
struct XcdBarrier { unsigned* bar; unsigned x; volatile LAS unsigned* st; };
__device__ __forceinline__ XcdBarrier xcd_barrier_post(unsigned* bar, volatile LAS unsigned* st) {
    XcdBarrier b; b.bar = bar; b.x = xb_xcc_id(); b.st = st;
    if (threadIdx.x == 0) (void)xb_add(&bar[XB_XCNT(b.x)], 1u);
    return b;
}
__device__ __forceinline__ void xcd_barrier_complete(unsigned* bar, unsigned x, unsigned& nloc, unsigned& nx) {
    const unsigned G = gridDim.x * gridDim.y * gridDim.z;
    unsigned sum, cnt, mine, sp = 0u;
    for (;;) {
        sum = 0u; cnt = 0u; mine = 0u;
#pragma unroll
        for (unsigned j = 0; j < 16; ++j) { const unsigned c = xb_ld(&bar[XB_XCNT(j)]); sum += c; cnt += (c > 0u) ? 1u : 0u; mine = (j == x) ? c : mine; }
        if (sum == G) break;
        __builtin_amdgcn_s_sleep(1);
        if ((++sp & 255u) == 0u) { if (xb_ld(&bar[XB_TMO])) break; if (sp > XB_SPIN_CAP) { atomicAdd(&bar[XB_TMO], 1u); break; } }
    }
    nloc = mine > 0u ? mine : 1u; nx = cnt > 0u ? cnt : 1u;
}
__device__ __forceinline__ void xcd_barrier(const XcdBarrier& b) {
    asm volatile("s_waitcnt vmcnt(0)" ::: "memory");
    __syncthreads();
    if (threadIdx.x == 0) {
        unsigned* bar = b.bar;
        __builtin_amdgcn_s_waitcnt(0);
        unsigned nloc = b.st[0], nx = b.st[1];
        if (nloc == 0u) { xcd_barrier_complete(bar, b.x, nloc, nx); b.st[0] = nloc; b.st[1] = nx; }
        const unsigned old = xb_add(&bar[XB_XSUB(b.x)], 1u);
        const unsigned gen = old / nloc;
        if (old + 1u == (gen + 1u) * nloc) {
            __builtin_amdgcn_fence(__ATOMIC_RELEASE, "agent");
            asm volatile("s_waitcnt vmcnt(0)" ::: "memory");
            const unsigned og = xb_add(&bar[XB_TOP], 1u);
            const unsigned tg = og / nx;
            if (og + 1u == (tg + 1u) * nx) xb_add(&bar[XB_TOPGEN], 1u);
            else XB_SPIN(xb_ld(&bar[XB_TOPGEN]) == tg, bar);
            __builtin_amdgcn_fence(__ATOMIC_ACQUIRE, "agent");
            xb_add(&bar[XB_XGEN(b.x)], 1u);
            asm volatile("s_waitcnt vmcnt(0)" ::: "memory");
        } else {
            XB_SPIN(xb_ld(&bar[XB_XGEN(b.x)]) == gen, bar);
            __builtin_amdgcn_fence(__ATOMIC_ACQUIRE, "agent");
            asm volatile("s_waitcnt vmcnt(0)" ::: "memory");
        }
    }
    __syncthreads();
}

struct Args { const float* in[33]; float* out; unsigned char* ws; int ph_lo, ph_hi, mode, pad; };
struct Frame {
    unsigned char* lds; LAS unsigned char* lds3; int tid, lane, wave, vcu, G, mode;
    const float *x, *meta, *norm_mix_g, *w_in, *a_re, *a_im, *log_dt, *b_re, *b_im, *c_re, *c_im, *ssm_d, *w_glu, *b_glu, *q_g, *k_g, *lq1, *lk1, *lq2, *lk2, *sub_g, *w_so, *w_ao, *w_o,
                *norm_ffn_g, *w_router, *b_router, *w_gate, *b_gate, *w_up, *b_up, *w_down, *b_down;
    float* out;
    bf16_t *XN, *Z, *YS, *YS2, *QKN, *YA, *MIX, *ACT, *Y2, *XN2, *ZM, *QKNM, *BBH, *CMT, *XN8, *Wt_in8, *H1B;
    bf16_t *Wt_in, *Wt_glu, *Wt_so, *Wt_ao, *Wt_o, *Wt_gu, *Wt_dn;
    float *BB, *AA, *E, *SIN, *LAM, *GATE; int *IDX, *POS, *CNT, *OFF, *ROWTOK, *ROWTK, *TEXP, *TCNT;
};
namespace pg8 {
#define PG8_LAS __attribute__((address_space(3)))
typedef unsigned short bf16_t;
typedef short bf16x8 __attribute__((ext_vector_type(8)));
typedef float f32x4 __attribute__((ext_vector_type(4)));
typedef unsigned u32x4 __attribute__((ext_vector_type(4)));
typedef int i32x8 __attribute__((ext_vector_type(8))); typedef int i32x4 __attribute__((ext_vector_type(4)));
__device__ __forceinline__ i32x8 cat8(bf16x8 a, bf16x8 b) { const i32x4 x = __builtin_bit_cast(i32x4, a), y = __builtin_bit_cast(i32x4, b); return (i32x8){x[0], x[1], x[2], x[3], y[0], y[1], y[2], y[3]}; }
constexpr int BM = 256, BK = 64, HALF = 128, HTB = HALF * BK * 2  , STAGE_BYTES = 8 * HTB, NXCD = 8, WGM = 8;

__host__ __device__ __forceinline__ int lds_byte(int r, int c) { const int st = (r >> 4) * 2 + (c >> 5), rr = r & 15, cc = c & 31, ob = rr * 64 + cc * 2; return st * 1024 + (ob ^ (((ob >> 9) & 1) << 5)); }
__host__ __device__ __forceinline__ void stage_rc(int b, int& R, int& C) { const int st = b / 1024, sb = b % 1024, swz = sb ^ (((sb >> 9) & 1) << 5); R = (st >> 1) * 16 + swz / 64; C = (st & 1) * 32 + (swz % 64) / 2; }
__host__ __device__ __forceinline__ int perm32(int rho) { const int n = rho >> 4, i = rho & 15; return 8 * (i >> 2) + 4 * n + (i & 3); }

struct Unit { int pm, pn; };
struct Gemm { const bf16_t* A; const bf16_t* Bt; int M, N, K; const PG8_LAS int* rowidx; };

struct StaticOrder {
    int nM, nN, nwg, G, c;
    __host__ __device__ void init(int M, int N, int G_, int c_) { nM = M / BM; nN = N / BM; nwg = nM * nN; G = G_; c = c_; }
    __host__ __device__ bool next(int i, Unit& u) const {
        const long L = (long)i * G + c; if (L >= nwg) return false;
        int wgid = (int)L; { const int q = nwg / NXCD, r = nwg % NXCD, xcd = wgid % NXCD, off = wgid / NXCD; wgid = (xcd < r ? xcd * (q + 1) : r * (q + 1) + (xcd - r) * q) + off; }
        const int nig = WGM * nN, gid = wgid / nig, fm = gid * WGM, gsz = (nM - fm) < WGM ? (nM - fm) : WGM;
        u.pm = fm + ((wgid % nig) % gsz); u.pn = (wgid % nig) / gsz; return true;
    }
    __device__ __forceinline__ void a_ready(const Unit&) const {}
    __device__ __forceinline__ void done(const Unit&) const {}
};

__device__ __forceinline__ unsigned cvt_pk_bf16(float lo, float hi) { unsigned r; asm volatile("v_cvt_pk_bf16_f32 %0, %1, %2" : "=v"(r) : "v"(lo), "v"(hi)); return r; }
typedef float f32x2 __attribute__((ext_vector_type(2)));
__device__ __forceinline__ f32x2 gelu_pk(f32x2 v) {
    const f32x2 av = __builtin_elementwise_abs(v), d = av * 0.2316418882f + 1.0f;
    f32x2 t; t.x = __builtin_amdgcn_rcpf(d.x); t.y = __builtin_amdgcn_rcpf(d.y);
    f32x2 q = t * 0.5307027145f + (-0.7265760135f); q = q * t + 0.7107068705f; q = q * t + (-0.142248368f); q = q * t + 0.127414796f; q = q * t;
    const f32x2 s = (v * v) * (-0.72134752044f);
    f32x2 e; e.x = __builtin_amdgcn_exp2f(s.x); e.y = __builtin_amdgcn_exp2f(s.y);
    const f32x2 m = v * (q * e), r = v - m;
    f32x2 o; o.x = v.x < 0.f ? m.x : r.x; o.y = v.y < 0.f ? m.y : r.y; return o;
}

template <int ACT  > struct EpiBf16 {
    static constexpr bool PERM = true, AFTER_DRAIN = false; static_assert(ACT == 0 || ACT == 1, "EpiBf16: ACT is 0 (none) or 1 (gelu_pk)");
    bf16_t* O; int ldc; const float* bias; int split_cols; size_t split_stride; float scale0; int nt_from;
    __device__ __forceinline__ void operator()(const f32x4 (&acc)[2][2][4][2], const Unit& u, int wr, int wc, int fr, int fq) const {
        const int row0 = u.pm * BM + wr * 64 + fr; int colt = u.pn * BM; bf16_t* base = O;
        float sc = 1.f; if (split_cols) { const int t = colt / split_cols; base += (size_t)t * split_stride; colt -= t * split_cols; if (t == 0) sc = scale0; }
        const int col0 = colt + wc * 32 + 8 * fq, bcol0 = u.pn * BM + wc * 32 + 8 * fq;
        f32x4 bv[2][2];
#pragma unroll
        for (int bj = 0; bj < 2; ++bj)
#pragma unroll
            for (int n = 0; n < 2; ++n) bv[bj][n] = bias ? *(const f32x4*)(bias + bcol0 + bj * HALF + 4 * n) : (f32x4){0.f, 0.f, 0.f, 0.f};
#pragma unroll
        for (int ai = 0; ai < 2; ++ai)
#pragma unroll
            for (int m = 0; m < 4; ++m) { bf16_t* rowp = base + (size_t)(row0 + ai * HALF + m * 16) * ldc + col0;
#pragma unroll
                for (int bj = 0; bj < 2; ++bj) { f32x4 v0 = acc[ai][bj][m][0] + bv[bj][0], v1 = acc[ai][bj][m][1] + bv[bj][1];
                    if (ACT == 1) { f32x2 a = gelu_pk((f32x2){v0[0], v0[1]}), b = gelu_pk((f32x2){v0[2], v0[3]}), c = gelu_pk((f32x2){v1[0], v1[1]}), d = gelu_pk((f32x2){v1[2], v1[3]});
                        v0 = (f32x4){a.x, a.y, b.x, b.y}; v1 = (f32x4){c.x, c.y, d.x, d.y}; }
                    v0 = v0 * sc; v1 = v1 * sc; u32x4 w; w.x = cvt_pk_bf16(v0[0], v0[1]); w.y = cvt_pk_bf16(v0[2], v0[3]); w.z = cvt_pk_bf16(v1[0], v1[1]); w.w = cvt_pk_bf16(v1[2], v1[3]);
                    if (nt_from && bcol0 >= nt_from) __builtin_nontemporal_store(w, (u32x4*)(rowp + bj * HALF)); else *(u32x4*)(rowp + bj * HALF) = w; } }
    }
};
__device__ __forceinline__ unsigned pk4_fp8(float a, float b, float c, float d) { int w = __builtin_amdgcn_cvt_pk_fp8_f32(a, b, 0, false); w = __builtin_amdgcn_cvt_pk_fp8_f32(c, d, w, true); return (unsigned)w; }
__device__ __forceinline__ float sigm(float x) { return __builtin_amdgcn_rcpf(1.f + __builtin_amdgcn_exp2f(-1.4426950408889634f * x)); }
__device__ __forceinline__ float bflo(unsigned w) { return __builtin_bit_cast(float, w << 16); }
__device__ __forceinline__ float bfhi(unsigned w) { return __builtin_bit_cast(float, w & 0xffff0000u); }
struct EpiGlu {
    static constexpr bool PERM = true, AFTER_DRAIN = false;
    const bf16_t* YS; bf16_t* O; const float* bias; int ldc, ldo;
    __device__ __forceinline__ void operator()(const f32x4 (&acc)[2][2][4][2], const Unit& u, int wr, int wc, int fr, int fq) const {
        const int row0 = u.pm * BM + wr * 64 + fr, col0 = u.pn * BM + wc * 32 + 8 * fq;
#pragma unroll
        for (int bj = 0; bj < 2; ++bj) {
            const f32x4 b0 = *(const f32x4*)(bias + col0 + bj * HALF), b1 = *(const f32x4*)(bias + col0 + bj * HALF + 4);
#pragma unroll
            for (int ai = 0; ai < 2; ++ai)
#pragma unroll
                for (int m = 0; m < 4; ++m) {
                    const size_t off = (size_t)(row0 + ai * HALF + m * 16) * ldc + col0 + bj * HALF;
                    const u32x4 y = *(const u32x4*)(YS + off);
                    const f32x4 v0 = acc[ai][bj][m][0] + b0, v1 = acc[ai][bj][m][1] + b1;
                    u32x4 w;
                    w.x = cvt_pk_bf16(bflo(y.x) * sigm(v0[0]), bfhi(y.x) * sigm(v0[1])); w.y = cvt_pk_bf16(bflo(y.y) * sigm(v0[2]), bfhi(y.y) * sigm(v0[3]));
                    w.z = cvt_pk_bf16(bflo(y.z) * sigm(v1[0]), bfhi(y.z) * sigm(v1[1])); w.w = cvt_pk_bf16(bflo(y.w) * sigm(v1[2]), bfhi(y.w) * sigm(v1[3]));
                    *(u32x4*)(O + (size_t)(row0 + ai * HALF + m * 16) * ldo + col0 + bj * HALF) = w;
                }
        }
    }
};
template <bool FIRST, bool OUT8 = false> struct EpiMix {
    static constexpr bool PERM = true, AFTER_DRAIN = false;
    const bf16_t* Zg; bf16_t* O; unsigned char* O8;
    __device__ __forceinline__ void operator()(const f32x4 (&acc)[2][2][4][2], const Unit& u, int wr, int wc, int fr, int fq) const {
        const int row0 = u.pm * BM + wr * 64 + fr, col0 = u.pn * BM + wc * 32 + 8 * fq;
#pragma unroll
        for (int ai = 0; ai < 2; ++ai)
#pragma unroll
            for (int m = 0; m < 4; ++m)
#pragma unroll
                for (int bj = 0; bj < 2; ++bj) {
                    const size_t row = (size_t)(row0 + ai * HALF + m * 16); const int col = col0 + bj * HALF;
                    const u32x4 z = *(const u32x4*)(Zg + row * 4096 + col);
                    const f32x4 a0 = acc[ai][bj][m][0], a1 = acc[ai][bj][m][1];
                    float v[8] = {sigm(bflo(z.x)) * a0[0], sigm(bfhi(z.x)) * a0[1], sigm(bflo(z.y)) * a0[2], sigm(bfhi(z.y)) * a0[3],
                                  sigm(bflo(z.z)) * a1[0], sigm(bfhi(z.z)) * a1[1], sigm(bflo(z.w)) * a1[2], sigm(bfhi(z.w)) * a1[3]};
                    if (!FIRST) { const u32x4 o = *(const u32x4*)(O + row * 1024 + col);
                        v[0] += bflo(o.x); v[1] += bfhi(o.x); v[2] += bflo(o.y); v[3] += bfhi(o.y); v[4] += bflo(o.z); v[5] += bfhi(o.z); v[6] += bflo(o.w); v[7] += bfhi(o.w); }
                    if constexpr (OUT8) { typedef unsigned u32x2 __attribute__((ext_vector_type(2))); *(u32x2*)(O8 + row * 1024 + col) = (u32x2){pk4_fp8(v[0], v[1], v[2], v[3]), pk4_fp8(v[4], v[5], v[6], v[7])}; }
                    else { u32x4 w; w.x = cvt_pk_bf16(v[0], v[1]); w.y = cvt_pk_bf16(v[2], v[3]); w.z = cvt_pk_bf16(v[4], v[5]); w.w = cvt_pk_bf16(v[6], v[7]);
                    *(u32x4*)(O + row * 1024 + col) = w; }
                }
    }
};
struct EpiMixCat {
    static constexpr bool PERM = true, AFTER_DRAIN = false;
    const bf16_t* Z; bf16_t* O;
    __device__ __forceinline__ void mid(f32x4 (&acc)[2][2][4][2], const Unit& u, int wr, int wc, int fr, int fq) const {
        int row0 = u.pm * BM + wr * 64 + fr, col0 = u.pn * BM + wc * 32 + 8 * fq;
        asm volatile("" : "+v"(row0), "+v"(col0));
#pragma unroll
        for (int ai = 0; ai < 2; ++ai)
#pragma unroll
            for (int m = 0; m < 4; ++m)
#pragma unroll
                for (int bj = 0; bj < 2; ++bj) {
                    const bf16_t* zp = Z + (size_t)(row0 + ai * HALF + m * 16) * 4096 + col0 + bj * HALF;
                    const u32x4 z0 = *(const u32x4*)(zp + 2048), z1 = *(const u32x4*)(zp + 3072);
                    const float a0[8] = {bflo(z0.x), bfhi(z0.x), bflo(z0.y), bfhi(z0.y), bflo(z0.z), bfhi(z0.z), bflo(z0.w), bfhi(z0.w)};
                    const float a1[8] = {bflo(z1.x), bfhi(z1.x), bflo(z1.y), bfhi(z1.y), bflo(z1.z), bfhi(z1.z), bflo(z1.w), bfhi(z1.w)};
#pragma unroll
                    for (int i = 0; i < 8; ++i) {
                        const float r = (1.f + __builtin_amdgcn_exp2f(-1.4426950408889634f * a0[i])) * __builtin_amdgcn_rcpf(1.f + __builtin_amdgcn_exp2f(-1.4426950408889634f * a1[i]));
                        acc[ai][bj][m][i >> 2][i & 3] *= r; }
                }
    }
    __device__ __forceinline__ void operator()(const f32x4 (&acc)[2][2][4][2], const Unit& u, int wr, int wc, int fr, int fq) const {
        const int row0 = u.pm * BM + wr * 64 + fr, col0 = u.pn * BM + wc * 32 + 8 * fq;
#pragma unroll
        for (int ai = 0; ai < 2; ++ai)
#pragma unroll
            for (int m = 0; m < 4; ++m)
#pragma unroll
                for (int bj = 0; bj < 2; ++bj) {
                    const size_t row = (size_t)(row0 + ai * HALF + m * 16); const int col = col0 + bj * HALF;
                    const u32x4 z = *(const u32x4*)(Z + row * 4096 + 2048 + col);
                    const f32x4 a0 = acc[ai][bj][m][0], a1 = acc[ai][bj][m][1];
                    u32x4 w; w.x = cvt_pk_bf16(sigm(bflo(z.x)) * a0[0], sigm(bfhi(z.x)) * a0[1]); w.y = cvt_pk_bf16(sigm(bflo(z.y)) * a0[2], sigm(bfhi(z.y)) * a0[3]);
                    w.z = cvt_pk_bf16(sigm(bflo(z.z)) * a1[0], sigm(bfhi(z.z)) * a1[1]); w.w = cvt_pk_bf16(sigm(bflo(z.w)) * a1[2], sigm(bfhi(z.w)) * a1[3]);
                    *(u32x4*)(O + row * 1024 + col) = w;
                }
    }
};
struct EpiWoB {
    static constexpr bool PERM = true, AFTER_DRAIN = false;
    const float* x; bf16_t* O;
    __device__ __forceinline__ void operator()(const f32x4 (&acc)[2][2][4][2], const Unit& u, int wr, int wc, int fr, int fq) const {
        const int row0 = u.pm * BM + wr * 64 + fr, col0 = u.pn * BM + wc * 32 + 8 * fq;
#pragma unroll
        for (int ai = 0; ai < 2; ++ai)
#pragma unroll
            for (int m = 0; m < 4; ++m)
#pragma unroll
                for (int bj = 0; bj < 2; ++bj) {
                    const size_t off = (size_t)(row0 + ai * HALF + m * 16) * 1024 + col0 + bj * HALF;
                    const f32x4 v0 = *(const f32x4*)(x + off) + acc[ai][bj][m][0], v1 = *(const f32x4*)(x + off + 4) + acc[ai][bj][m][1];
                    u32x4 w; w.x = cvt_pk_bf16(v0[0], v0[1]); w.y = cvt_pk_bf16(v0[2], v0[3]); w.z = cvt_pk_bf16(v1[0], v1[1]); w.w = cvt_pk_bf16(v1[2], v1[3]);
                    *(u32x4*)(O + off) = w;
                }
    }
};
struct EpiWo {
    static constexpr bool PERM = false, AFTER_DRAIN = false;
    const float* x; float* out; float sc; int flags;
    __device__ __forceinline__ void operator()(const f32x4 (&acc)[2][2][4][2], const Unit& u, int wr, int wc, int fr, int fq) const {
        const int row0 = u.pm * BM + wr * 64 + fr, col0 = u.pn * BM + wc * 32 + 4 * fq;
#ifdef PROBE_LO
        if (flags) {
#pragma unroll
          for (int ai = 0; ai < 2; ++ai)
#pragma unroll
            for (int m = 0; m < 4; ++m)
#pragma unroll
                for (int bj = 0; bj < 2; ++bj)
#pragma unroll
                    for (int n = 0; n < 2; ++n) {
                        const size_t off = (size_t)(row0 + ai * HALF + m * 16) * 1024 + col0 + bj * HALF + n * 16;
                        f32x4 v = acc[ai][bj][m][n] * sc; if (!(flags & 1)) v += *(const f32x4*)(x + off);
                        if (!(flags & 2) || v[0] == 1234.5678f) *(f32x4*)(out + off) = v;
                    }
          return; }
#endif
#pragma unroll
        for (int ai = 0; ai < 2; ++ai)
#pragma unroll
            for (int m = 0; m < 4; ++m)
#pragma unroll
                for (int bj = 0; bj < 2; ++bj)
#pragma unroll
                    for (int n = 0; n < 2; ++n) {
                        const size_t off = (size_t)(row0 + ai * HALF + m * 16) * 1024 + col0 + bj * HALF + n * 16;
                        *(f32x4*)(out + off) = *(const f32x4*)(x + off) + acc[ai][bj][m][n] * sc;
                    }
    }
};
struct EpiWoK {
    static constexpr bool PERM = false, AFTER_DRAIN = false;
    const float* x; float* out;
    __device__ __forceinline__ const float* xaddr(const Unit& u, int j, int wr, int wc, int fr, int fq) const {
        const int ai = (j >> 4) & 1, bj = (j >> 3) & 1, m = (j >> 1) & 3, n = j & 1;
        return x + (size_t)(u.pm * BM + wr * 64 + fr + ai * HALF + m * 16) * 1024 + u.pn * BM + wc * 32 + 4 * fq + bj * HALF + n * 16;
    }
    __device__ __forceinline__ void operator()(const f32x4 (&acc)[2][2][4][2], const Unit& u, int wr, int wc, int fr, int fq) const {
        const int row0 = u.pm * BM + wr * 64 + fr, col0 = u.pn * BM + wc * 32 + 4 * fq;
#pragma unroll
        for (int ai = 0; ai < 2; ++ai)
#pragma unroll
            for (int m = 0; m < 4; ++m)
#pragma unroll
                for (int bj = 0; bj < 2; ++bj)
#pragma unroll
                    for (int n = 0; n < 2; ++n) *(f32x4*)(out + (size_t)(row0 + ai * HALF + m * 16) * 1024 + col0 + bj * HALF + n * 16) = acc[ai][bj][m][n];
    }
};
struct EpiScaleBf16 {
    static constexpr bool PERM = true, AFTER_DRAIN = false;
    bf16_t* O; int ldc; float s;
    __device__ __forceinline__ void operator()(const f32x4 (&acc)[2][2][4][2], const Unit& u, int wr, int wc, int fr, int fq) const {
        const int row0 = u.pm * BM + wr * 64 + fr, col0 = u.pn * BM + wc * 32 + 8 * fq;
#pragma unroll
        for (int ai = 0; ai < 2; ++ai)
#pragma unroll
            for (int m = 0; m < 4; ++m)
#pragma unroll
                for (int bj = 0; bj < 2; ++bj) { const f32x4 v0 = acc[ai][bj][m][0] * s, v1 = acc[ai][bj][m][1] * s;
                    u32x4 w; w.x = cvt_pk_bf16(v0[0], v0[1]); w.y = cvt_pk_bf16(v0[2], v0[3]); w.z = cvt_pk_bf16(v1[0], v1[1]); w.w = cvt_pk_bf16(v1[2], v1[3]);
                    *(u32x4*)(O + (size_t)(row0 + ai * HALF + m * 16) * ldc + col0 + bj * HALF) = w; }
    }
};
struct MoeOrder {
    const int* texp; int ntiles, NT, G, v;
    __device__ __forceinline__ bool next(int i, Unit& u) const {
        const int L = i * G + v; if (L >= ntiles * NT) return false;
        const int mt = L / NT; u.pm = mt; u.pn = texp[mt] * NT + (L % NT); return true;
    }
    __device__ __forceinline__ void a_ready(const Unit&) const {}
    __device__ __forceinline__ void done(const Unit&) const {}
};
template <bool FP8> struct EpiMoe1 {
    static constexpr bool PERM = true, AFTER_DRAIN = false;
    bf16_t* ACT; const float* bg; const float* bu;
    __device__ __forceinline__ void operator()(const f32x4 (&acc)[2][2][4][2], const Unit& u, int wr, int wc, int fr, int fq) const {
        const int e = u.pn >> 3, pnl = u.pn & 7;
        const int row0 = u.pm * BM + wr * 64 + fr, oc = pnl * HALF + wc * 32 + 8 * fq;
        const f32x4 g0 = *(const f32x4*)(bg + e * 1024 + oc), g1 = *(const f32x4*)(bg + e * 1024 + oc + 4), u0 = *(const f32x4*)(bu + e * 1024 + oc), u1 = *(const f32x4*)(bu + e * 1024 + oc + 4);
#pragma unroll
        for (int ai = 0; ai < 2; ++ai)
#pragma unroll
            for (int m = 0; m < 4; ++m) {
                const float sc = FP8 ? 0.03125f : 1.f;
                const f32x4 ga = acc[ai][0][m][0] * sc + g0, gb = acc[ai][0][m][1] * sc + g1, ua = acc[ai][1][m][0] * sc + u0, ub = acc[ai][1][m][1] * sc + u1;
                float v[8];
#pragma unroll
                for (int i = 0; i < 4; ++i) { const float gg = fminf(ga[i], 7.f), uu = fminf(fmaxf(ua[i], -7.f), 7.f); v[i] = (uu + 1.f) * gg * sigm(1.702f * gg);
                                              const float g2 = fminf(gb[i], 7.f), u2 = fminf(fmaxf(ub[i], -7.f), 7.f); v[4 + i] = (u2 + 1.f) * g2 * sigm(1.702f * g2); }
                if constexpr (FP8) { typedef unsigned u32x2 __attribute__((ext_vector_type(2)));
                    *(u32x2*)((unsigned char*)ACT + (size_t)(row0 + ai * HALF + m * 16) * 1024 + oc) = (u32x2){pk4_fp8(v[0], v[1], v[2], v[3]), pk4_fp8(v[4], v[5], v[6], v[7])}; }
                else { u32x4 w; w.x = cvt_pk_bf16(v[0], v[1]); w.y = cvt_pk_bf16(v[2], v[3]); w.z = cvt_pk_bf16(v[4], v[5]); w.w = cvt_pk_bf16(v[6], v[7]);
                    *(u32x4*)(ACT + (size_t)(row0 + ai * HALF + m * 16) * 1024 + oc) = w; }
            }
    }
};
template <bool FP8> struct EpiMoe2 {
    static constexpr bool PERM = true, AFTER_DRAIN = false;
    bf16_t* Y2; const float* bd; const int* rowtk;
    __device__ __forceinline__ void operator()(const f32x4 (&acc)[2][2][4][2], const Unit& u, int wr, int wc, int fr, int fq) const {
        const int e = u.pn >> 2, pnl = u.pn & 3;
        const int row0 = u.pm * BM + wr * 64 + fr, col0 = pnl * BM + wc * 32 + 8 * fq;
        f32x4 bv[2][2];
#pragma unroll
        for (int bj = 0; bj < 2; ++bj)
#pragma unroll
            for (int n = 0; n < 2; ++n) bv[bj][n] = *(const f32x4*)(bd + e * 1024 + col0 + bj * HALF + 4 * n);
#pragma unroll
        for (int ai = 0; ai < 2; ++ai)
#pragma unroll
            for (int m = 0; m < 4; ++m) {
                const int tk = rowtk[row0 + ai * HALF + m * 16];
                if (tk >= 0) {
#pragma unroll
                    for (int bj = 0; bj < 2; ++bj) { const float sc = FP8 ? 0.03125f : 1.f; const f32x4 v0 = acc[ai][bj][m][0] * sc + bv[bj][0], v1 = acc[ai][bj][m][1] * sc + bv[bj][1];
                        if constexpr (FP8) { typedef unsigned u32x2 __attribute__((ext_vector_type(2)));
                            *(u32x2*)((unsigned char*)Y2 + (size_t)tk * 1024 + col0 + bj * HALF) = (u32x2){pk4_fp8(v0[0], v0[1], v0[2], v0[3]), pk4_fp8(v1[0], v1[1], v1[2], v1[3])}; }
                        else { u32x4 w; w.x = cvt_pk_bf16(v0[0], v0[1]); w.y = cvt_pk_bf16(v0[2], v0[3]); w.z = cvt_pk_bf16(v1[0], v1[1]); w.w = cvt_pk_bf16(v1[2], v1[3]);
                        *(u32x4*)(Y2 + (size_t)tk * 1024 + col0 + bj * HALF) = w; } }
                }
            }
    }
};
template <class Epi, class Sched, bool ALIGN_EPI = false, bool SP2 = false, bool GATHER = false, bool FP8 = false, bool MID = false, bool KHOOK = false>
__device__ __forceinline__ void gemm_phase(PG8_LAS unsigned char* lds, const Gemm g, const Sched& S, const Epi& E) {
    static_assert(!GATHER || SP2, "the gathered A operand is wired into the SP2 loop only"); static_assert(!KHOOK || (SP2 && !FP8), "the K-loop addend hook is wired into the bf16 SP2 loop only");
    const int tid = threadIdx.x, wid = __builtin_amdgcn_readfirstlane(tid >> 6), lane = tid & 63, wr = wid >> 2, wc = wid & 3, fr = lane & 15, fq = lane >> 4;
    const int K = g.K, nt = K / BK;
    unsigned voffA[2], voffB[2];
#pragma unroll
    for (int i = 0; i < 2; ++i) { int R, C; stage_rc(tid * 16 + i * 8192, R, C); const int Rb = Epi::PERM ? ((R & ~31) + perm32(R & 31)) : R;
        voffA[i] = (unsigned)(R * K + C) * 2u; voffB[i] = (unsigned)(Rb * K + C) * 2u; }
    const size_t kstep = (size_t)(BK * 2);
    const size_t hstep = (size_t)HALF * K * 2;
    const size_t tstep = 2 * hstep;
    const unsigned ldsw = (unsigned)wid * 1024u;
    const int aoff = lds_byte(wr * 64 + fr, fq * 8), boff = lds_byte(wc * 32 + fr, fq * 8);
#define PG8_SA(b, h) (((b) * 2 + (h)) * HTB)
#define PG8_SB(b, h) ((4 + (b) * 2 + (h)) * HTB)
#define PG8_STAGE(bufoff, gbase, voff) do { _Pragma("unroll") for (int _i = 0; _i < 2; ++_i) \
        __builtin_amdgcn_global_load_lds((const unsigned*)((const char*)(gbase) + (voff)[_i]), (PG8_LAS unsigned*)(lds + (bufoff) + ldsw + _i * 8192), 16, 0, 0); } while (0)
#define PG8_STAGE_A(bufoff, nx, h, koff, dptr) do { if constexpr (GATHER) { _Pragma("unroll") for (int _i = 0; _i < 2; ++_i) \
        __builtin_amdgcn_global_load_lds((const unsigned*)((const char*)g.A + (koff) + ((nx) ? nga[h][_i] : cga[h][_i])), (PG8_LAS unsigned*)(lds + (bufoff) + ldsw + _i * 8192), 16, 0, 0); } \
    else { PG8_STAGE(bufoff, dptr, voffA); } } while (0)
#define PG8_GATH(ord, o) do { _Pragma("unroll") for (int _h = 0; _h < 2; ++_h) _Pragma("unroll") for (int _i = 0; _i < 2; ++_i) { int R_, C_, t_ = tid; asm volatile("" : "+v"(t_)); stage_rc(t_ * 16 + _i * 8192, R_, C_);   \
        o[_h][_i] = ((unsigned)g.rowidx[(ord) * 256 + _h * HALF + R_] * (unsigned)K + (unsigned)C_) * 2u; } } while (0)
#define PG8_LDA(dst, b, h) do { if constexpr (FP8) { _Pragma("unroll") for (int m = 0; m < 4; ++m) dst##8[m] = cat8(*(const PG8_LAS bf16x8*)(lds + PG8_SA(b, h) + aoff + m * 2048), *(const PG8_LAS bf16x8*)(lds + PG8_SA(b, h) + aoff + m * 2048 + 1024)); } \
    else { _Pragma("unroll") for (int m = 0; m < 4; ++m) _Pragma("unroll") for (int k = 0; k < 2; ++k) dst[m][k] = *(const PG8_LAS bf16x8*)(lds + PG8_SA(b, h) + aoff + m * 2048 + k * 1024); } } while (0)
#define PG8_LDB(dst, b, h) do { if constexpr (FP8) { _Pragma("unroll") for (int n = 0; n < 2; ++n) dst##8[n] = cat8(*(const PG8_LAS bf16x8*)(lds + PG8_SB(b, h) + boff + n * 2048), *(const PG8_LAS bf16x8*)(lds + PG8_SB(b, h) + boff + n * 2048 + 1024)); } \
    else { _Pragma("unroll") for (int n = 0; n < 2; ++n) _Pragma("unroll") for (int k = 0; k < 2; ++k) dst[n][k] = *(const PG8_LAS bf16x8*)(lds + PG8_SB(b, h) + boff + n * 2048 + k * 1024); } } while (0)
#define PG8_MMA(ai, bj, At, Bt) do { __builtin_amdgcn_s_setprio(1); if constexpr (FP8) { _Pragma("unroll") for (int m = 0; m < 4; ++m) _Pragma("unroll") for (int n = 0; n < 2; ++n) \
        asm volatile("v_mfma_f32_16x16x128_f8f6f4 %0, %1, %2, %0" : "+v"(acc[ai][bj][m][n]) : "v"(Bt##8[n]), "v"(At##8[m]));   } \
    else { _Pragma("unroll") for (int m = 0; m < 4; ++m) _Pragma("unroll") for (int n = 0; n < 2; ++n) _Pragma("unroll") for (int k = 0; k < 2; ++k) \
        acc[ai][bj][m][n] = __builtin_amdgcn_mfma_f32_16x16x32_bf16(Bt[n][k], At[m][k], acc[ai][bj][m][n], 0, 0, 0); } __builtin_amdgcn_s_setprio(0); } while (0)
#define PG8_WAIT_V(n) asm volatile("s_waitcnt vmcnt(" #n ")" ::: "memory")
#define PG8_WAIT_L(n) asm volatile("s_waitcnt lgkmcnt(" #n ")" ::: "memory")
#define PG8_BAR __builtin_amdgcn_s_barrier()
#define PG8_SCHED __builtin_amdgcn_sched_barrier(0)
#define PG8_XR 131072
#define PG8_ACCJ(j) acc[((j) >> 4) & 1][((j) >> 3) & 1][((j) >> 1) & 3][(j) & 1]
#define PG8_XISSUE(q) do { if constexpr (KHOOK) { const int s_ = 2 * t + (q); \
        __builtin_amdgcn_global_load_lds((const unsigned*)(E.xaddr(cur, s_, wr, wc, fr, fq)), (PG8_LAS unsigned*)(lds + PG8_XR + (s_ % 3) * 8192 + ldsw), 16, 0, 0); } } while (0)
#define PG8_XCASE(tt, q) case tt: if constexpr (2 * (tt) + (q) - 2 >= 0) PG8_ACCJ((2 * (tt) + (q) - 2) & 31) += xv_; break;
#define PG8_XADD(q) do { if constexpr (KHOOK) { const int c_ = 2 * t + (q) - 2; if (c_ >= 0) { \
        const f32x4 xv_ = *(const PG8_LAS f32x4*)(lds + PG8_XR + (c_ % 3) * 8192 + ldsw + lane * 16); \
        switch (t) { PG8_XCASE(0, q) PG8_XCASE(2, q) PG8_XCASE(4, q) PG8_XCASE(6, q) PG8_XCASE(8, q) PG8_XCASE(10, q) PG8_XCASE(12, q) PG8_XCASE(14, q) default: break; } } } } while (0)
#define PG8_WAIT_VK() do { if constexpr (KHOOK) PG8_WAIT_V(10); else PG8_WAIT_V(8); } while (0)
    Unit cur, nxt; int ui = 0;
    if (!S.next(0, cur)) return;
    f32x4 acc[2][2][4][2];
#pragma unroll
    for (int a = 0; a < 2; ++a)
#pragma unroll
        for (int b = 0; b < 2; ++b)
#pragma unroll
            for (int m = 0; m < 4; ++m)
#pragma unroll
                for (int n = 0; n < 2; ++n) acc[a][b][m][n] = (f32x4){0.f, 0.f, 0.f, 0.f};
    bf16x8 At[4][2], B0[2][2], B1[2][2]; i32x8 At8[4], B08[2], B18[2];
    const char* cA = (const char*)g.A + (size_t)cur.pm * tstep; const char* cB = (const char*)g.Bt + (size_t)cur.pn * tstep;
    S.a_ready(cur);
    unsigned cga[2][2] = {{0u, 0u}, {0u, 0u}}, nga[2][2] = {{0u, 0u}, {0u, 0u}};
    if constexpr (GATHER) PG8_GATH(0, cga);
    if constexpr (SP2) {
        PG8_STAGE(PG8_SB(0, 0), cB, voffB); PG8_STAGE(PG8_SB(0, 1), cB + hstep, voffB); PG8_STAGE_A(PG8_SA(0, 0), false, 0, 0, cA); PG8_STAGE_A(PG8_SA(0, 1), false, 1, 0, cA + hstep);
        if (wr == 1) PG8_BAR;
        PG8_WAIT_V(2); PG8_BAR;
        PG8_STAGE(PG8_SB(1, 0), cB + kstep, voffB); PG8_STAGE_A(PG8_SA(1, 0), false, 0, kstep, cA + kstep); PG8_STAGE(PG8_SB(1, 1), cB + hstep + kstep, voffB);
        PG8_WAIT_V(6); PG8_BAR;
    } else {
        PG8_STAGE(PG8_SB(0, 0), cB, voffB); PG8_STAGE(PG8_SA(0, 0), cA, voffA); PG8_STAGE(PG8_SB(0, 1), cB + hstep, voffB); PG8_STAGE(PG8_SA(0, 1), cA + hstep, voffA);
        if (wr == 1) PG8_BAR;
        PG8_WAIT_V(4); PG8_BAR;
        PG8_STAGE(PG8_SB(1, 0), cB + kstep, voffB); PG8_STAGE(PG8_SA(1, 0), cA + kstep, voffA); PG8_STAGE(PG8_SB(1, 1), cB + hstep + kstep, voffB);
        PG8_WAIT_V(6); PG8_BAR;
    }
    for (;;) {
        const bool has_next = S.next(ui + 1, nxt);
        if constexpr (GATHER) { if (has_next) PG8_GATH(ui + 1, nga); else { nga[0][0] = cga[0][0]; nga[0][1] = cga[0][1]; nga[1][0] = cga[1][0]; nga[1][1] = cga[1][1]; } }
        const char* nA = has_next ? (const char*)g.A + (size_t)nxt.pm * tstep : cA; const char* nB = has_next ? (const char*)g.Bt + (size_t)nxt.pn * tstep : cB;
#pragma unroll 1
        for (int t = 0; t < nt; t += 2) {
            if constexpr (MID) { if (t == nt / 2) { PG8_SCHED; E.mid(acc, cur, wr, wc, fr, fq); PG8_SCHED; } }
            const bool last = (t == nt - 2);
            const char* a1 = cA + (size_t)(t + 1) * kstep;
            const char* a2 = last ? nA : cA + (size_t)(t + 2) * kstep; const char* b2 = last ? nB : cB + (size_t)(t + 2) * kstep;
            const char* a3 = a2 + kstep; const char* b3 = b2 + kstep;
            if (last && has_next) S.a_ready(nxt);
            const size_t k1 = (size_t)(t + 1) * kstep, k2 = last ? (size_t)0 : (size_t)(t + 2) * kstep, k3 = k2 + kstep; (void)k1; (void)k2; (void)k3;
            if constexpr (SP2) {
            PG8_LDB(B0, 0, 0); PG8_LDB(B1, 0, 1); PG8_SCHED; PG8_LDA(At, 0, 0); PG8_STAGE_A(PG8_SA(1, 1), false, 1, k1, a1 + hstep); PG8_XISSUE(0);
            PG8_WAIT_VK(); PG8_WAIT_L(0); PG8_BAR; PG8_XADD(0); PG8_MMA(0, 0, At, B0); PG8_MMA(0, 1, At, B1); PG8_BAR; PG8_SCHED;
            PG8_LDA(At, 0, 1); PG8_STAGE(PG8_SB(0, 0), b2, voffB); PG8_STAGE(PG8_SB(0, 1), b2 + hstep, voffB); PG8_STAGE_A(PG8_SA(0, 0), last, 0, k2, a2); PG8_XISSUE(1);
            PG8_WAIT_VK(); PG8_WAIT_L(0); PG8_BAR; PG8_XADD(1); PG8_MMA(1, 0, At, B0); PG8_MMA(1, 1, At, B1); PG8_BAR; PG8_SCHED;
            PG8_LDB(B0, 1, 0); PG8_LDB(B1, 1, 1); PG8_SCHED; PG8_LDA(At, 1, 0); PG8_STAGE_A(PG8_SA(0, 1), last, 1, k2, a2 + hstep); PG8_XISSUE(2);
            PG8_WAIT_VK(); PG8_WAIT_L(0); PG8_BAR; PG8_XADD(2); PG8_MMA(0, 0, At, B0); PG8_MMA(0, 1, At, B1); PG8_BAR; PG8_SCHED;
            PG8_LDA(At, 1, 1); PG8_STAGE(PG8_SB(1, 0), b3, voffB); PG8_STAGE(PG8_SB(1, 1), b3 + hstep, voffB); PG8_STAGE_A(PG8_SA(1, 0), last, 0, k3, a3); PG8_XISSUE(3);
            PG8_WAIT_VK(); PG8_WAIT_L(0); PG8_BAR; PG8_XADD(3); PG8_MMA(1, 0, At, B0); PG8_MMA(1, 1, At, B1); PG8_BAR; PG8_SCHED;
            } else {
            PG8_LDB(B0, 0, 0); PG8_SCHED; PG8_LDA(At, 0, 0); PG8_STAGE(PG8_SA(1, 1), a1 + hstep, voffA);
            PG8_WAIT_L(8); PG8_BAR; PG8_WAIT_L(0); PG8_MMA(0, 0, At, B0); PG8_BAR; PG8_SCHED;
            PG8_LDB(B1, 0, 1); PG8_STAGE(PG8_SB(0, 0), b2, voffB);
            PG8_BAR; PG8_WAIT_L(0); PG8_MMA(0, 1, At, B1); PG8_BAR;
            PG8_LDA(At, 0, 1); PG8_STAGE(PG8_SA(0, 0), a2, voffA);
            PG8_BAR; PG8_WAIT_L(0); PG8_MMA(1, 0, At, B0); PG8_BAR; PG8_SCHED;
            PG8_STAGE(PG8_SB(0, 1), b2 + hstep, voffB);
            PG8_WAIT_V(6); PG8_BAR; PG8_MMA(1, 1, At, B1); PG8_BAR;
            PG8_LDB(B0, 1, 0); PG8_SCHED; PG8_LDA(At, 1, 0); PG8_STAGE(PG8_SA(0, 1), a2 + hstep, voffA);
            PG8_WAIT_L(8); PG8_BAR; PG8_WAIT_L(0); PG8_MMA(0, 0, At, B0); PG8_BAR; PG8_SCHED;
            PG8_LDB(B1, 1, 1); PG8_STAGE(PG8_SB(1, 0), b3, voffB);
            PG8_BAR; PG8_WAIT_L(0); PG8_MMA(0, 1, At, B1); PG8_BAR;
            PG8_LDA(At, 1, 1); PG8_STAGE(PG8_SA(1, 0), a3, voffA);
            PG8_BAR; PG8_WAIT_L(0); PG8_MMA(1, 0, At, B0); PG8_BAR; PG8_SCHED;
            PG8_STAGE(PG8_SB(1, 1), b3 + hstep, voffB);
            PG8_WAIT_V(6); PG8_BAR; PG8_MMA(1, 1, At, B1); PG8_BAR;
            }
        }
        if constexpr (ALIGN_EPI) { if (wr == 0) PG8_BAR; }
        if constexpr (KHOOK) { PG8_WAIT_V(0);
            PG8_ACCJ(30) += *(const PG8_LAS f32x4*)(lds + PG8_XR + (30 % 3) * 8192 + ldsw + lane * 16); PG8_ACCJ(31) += *(const PG8_LAS f32x4*)(lds + PG8_XR + (31 % 3) * 8192 + ldsw + lane * 16); PG8_WAIT_L(0); }
        if constexpr (FP8) asm volatile("s_nop 15\n\ts_nop 15" ::: "memory");
        if constexpr (!Epi::AFTER_DRAIN) { E(acc, cur, wr, wc, fr, fq); S.done(cur); }
        if (!has_next) break;
#pragma unroll
        for (int a = 0; a < 2; ++a)
#pragma unroll
            for (int b = 0; b < 2; ++b)
#pragma unroll
                for (int m = 0; m < 4; ++m)
#pragma unroll
                    for (int n = 0; n < 2; ++n) acc[a][b][m][n] = (f32x4){0.f, 0.f, 0.f, 0.f};
        cur = nxt; cA = nA; cB = nB; ++ui;
        if constexpr (GATHER) { cga[0][0] = nga[0][0]; cga[0][1] = nga[0][1]; cga[1][0] = nga[1][0]; cga[1][1] = nga[1][1]; }
        if constexpr (ALIGN_EPI) { if (wr == 1) PG8_BAR; }
    }
    PG8_WAIT_V(0);
    if constexpr (!ALIGN_EPI) { if (wr == 0) PG8_BAR; }
    PG8_BAR;
    if constexpr (Epi::AFTER_DRAIN) { E.fused(acc, cur, wr, wc, fr, fq, lds, wid, lane); S.done(cur); }
#undef PG8_SA
#undef PG8_SB
#undef PG8_STAGE
#undef PG8_STAGE_A
#undef PG8_GATH
#undef PG8_LDA
#undef PG8_LDB
#undef PG8_MMA
#undef PG8_WAIT_V
#undef PG8_WAIT_L
#undef PG8_BAR
#undef PG8_SCHED
#undef PG8_XR
#undef PG8_ACCJ
#undef PG8_XISSUE
#undef PG8_XCASE
#undef PG8_XADD
#undef PG8_WAIT_VK
}
}
#include <hip/hip_bf16.h>
#include <cmath>
namespace attn_body {
using bf16=__hip_bfloat16;
using bf16x8=__attribute__((ext_vector_type(8)))short;
using s16x4=__attribute__((ext_vector_type(4)))short;
using f32x16=__attribute__((ext_vector_type(16)))float;
using u32x4=__attribute__((ext_vector_type(4)))unsigned;
constexpr int BATCH=2,NHEAD=16,SEQ=8192,D=64,DM=NHEAD*D,KVSEQ=SEQ+64;
constexpr int NW=8,QBLK=32,QB=QBLK*NW,KVBLK=64,NQB=SEQ/QB;
constexpr int ATTN_PITCH=DM, ATTN_UNIT_ROWS=QB;
__device__ __forceinline__ int crow(int r,int hi){return (r&3)+8*(r>>2)+4*hi;}
#define SBAR() __builtin_amdgcn_sched_barrier(0)
__device__ __forceinline__ void cmask(f32x16&p0,f32x16&p1,int jb,int qrel,int hi){
  const float NEG=-INFINITY; int kb=64*jb+4*hi;
  #pragma unroll
  for(int r=0;r<16;++r){int kv=kb+(r&3)+8*(r>>2); if(kv>qrel)p0[r]=NEG; if(kv+32>qrel)p1[r]=NEG;}
}

constexpr int NSLOT=3, SLOTB=8192;
constexpr int LDS_K=0, LDS_V=NSLOT*SLOTB, LDS_WS=2*NSLOT*SLOTB, LDS_OST=LDS_WS+NW*64*4, LDS_BYTES=LDS_OST+NW*4096;
constexpr float C2=0.125f*1.4426950408889634f;
__device__ __forceinline__ void glds16(const void*gsrc,unsigned lds_dst){unsigned keep;
  asm volatile("s_mov_b32 %0, m0\n\ts_mov_b32 m0, %2\n\ts_nop 0\n\tglobal_load_lds_dwordx4 %1, off\n\ts_mov_b32 m0, %0":"=&s"(keep):"v"(gsrc),"s"(lds_dst):"memory");}
__device__ __forceinline__ float max3f(float a,float b,float c){float r;asm("v_max3_f32 %0, %1, %2, %3":"=v"(r):"v"(a),"v"(b),"v"(c));return r;}
__device__ __forceinline__ float max2f(float a,float b){float r;asm("v_max_f32_e32 %0, %1, %2":"=v"(r):"v"(a),"v"(b));return r;}
__device__ __forceinline__ float fadd_s(float a,float b){float r;asm("v_add_f32_e32 %0, %1, %2":"=v"(r):"v"(a),"v"(b));return r;}
__device__ __forceinline__ float fsub_s(float a,float b){float r;asm("v_sub_f32_e32 %0, %1, %2":"=v"(r):"v"(a),"v"(b));return r;}
typedef float f32x2_t __attribute__((ext_vector_type(2))); typedef __bf16 bf16x2_t __attribute__((ext_vector_type(2)));
__device__ __forceinline__ unsigned cvtpk_s(float lo,float hi){f32x2_t v={lo,hi};bf16x2_t b=__builtin_convertvector(v,bf16x2_t);return __builtin_bit_cast(unsigned,b);}
#define WAIT_BAR(N) asm volatile("s_waitcnt vmcnt(" #N ") lgkmcnt(0)\n\ts_barrier":::"memory")

__device__ __forceinline__ void qkt(f32x16&p0,f32x16&p1,const char*Kslot,const bf16x8*qr,const f32x16&negm,int r32,int hi){
  const char*kb=Kslot+hi*1024+r32*16;
  #pragma unroll
  for(int d0=0;d0<4;++d0){
    const bf16x8 b0=*reinterpret_cast<const bf16x8*>(kb+d0*2048);
    const bf16x8 b1=*reinterpret_cast<const bf16x8*>(kb+d0*2048+512);
    if(d0==0){p0=__builtin_amdgcn_mfma_f32_32x32x16_bf16(b0,qr[0],negm,0,0,0);p1=__builtin_amdgcn_mfma_f32_32x32x16_bf16(b1,qr[0],negm,0,0,0);}
    else{p0=__builtin_amdgcn_mfma_f32_32x32x16_bf16(b0,qr[d0],p0,0,0,0);p1=__builtin_amdgcn_mfma_f32_32x32x16_bf16(b1,qr[d0],p1,0,0,0);}}
}
typedef __attribute__((address_space(3))) const char* lds_cptr;
typedef short v4i16_t __attribute__((ext_vector_type(4)));
__device__ __forceinline__ void kload8(bf16x8*kf,lds_cptr kp){
  kf[0]=*(const __attribute__((address_space(3))) bf16x8*)(kp);      kf[1]=*(const __attribute__((address_space(3))) bf16x8*)(kp+512);
  kf[2]=*(const __attribute__((address_space(3))) bf16x8*)(kp+2048); kf[3]=*(const __attribute__((address_space(3))) bf16x8*)(kp+2560);
  kf[4]=*(const __attribute__((address_space(3))) bf16x8*)(kp+4096); kf[5]=*(const __attribute__((address_space(3))) bf16x8*)(kp+4608);
  kf[6]=*(const __attribute__((address_space(3))) bf16x8*)(kp+6144); kf[7]=*(const __attribute__((address_space(3))) bf16x8*)(kp+6656);
}
__device__ __forceinline__ void kload2(bf16x8*kf,lds_cptr kp,int j){ kf[2*j]=*(const __attribute__((address_space(3))) bf16x8*)(kp+j*2048); kf[2*j+1]=*(const __attribute__((address_space(3))) bf16x8*)(kp+j*2048+512); }
__device__ __forceinline__ s16x4 vtr(lds_cptr p){ return __builtin_bit_cast(s16x4,__builtin_amdgcn_ds_read_tr16_b64_v4i16((__attribute__((address_space(3))) v4i16_t*)p)); }
__device__ __forceinline__ float rowmax(const f32x16&p0,const f32x16&p1){
  float a=max3f(p0[0],p0[1],p1[0]),b=max3f(p0[2],p0[3],p1[1]);a=max3f(a,p1[2],p1[3]);
  #pragma unroll
  for(int r=4;r<16;r+=4){a=max3f(a,p0[r],p0[r+1]);b=max3f(b,p0[r+2],p0[r+3]);a=max3f(a,p1[r],p1[r+1]);b=max3f(b,p1[r+2],p1[r+3]);}
  const float m=max2f(a,b);
  auto rr=__builtin_amdgcn_permlane32_swap(__float_as_uint(m),__float_as_uint(m),false,false);
  return max2f(__uint_as_float(rr[0]),__uint_as_float(rr[1]));
}
__device__ __forceinline__ void pv(f32x16*o,int vb,bf16x8 pa0,bf16x8 pa1,bf16x8 pa2,bf16x8 pa3){
  #pragma unroll
  for(int d0=0;d0<2;++d0){s16x4 lo[4],hi[4];
    #pragma unroll
    for(int ks=0;ks<4;++ks){
      asm volatile("ds_read_b64_tr_b16 %0,%1 offset:%c2":"=&v"(lo[ks]):"v"(vb),"i"(d0*4096+ks*1024):"memory");
      asm volatile("ds_read_b64_tr_b16 %0,%1 offset:%c2":"=&v"(hi[ks]):"v"(vb),"i"(d0*4096+ks*1024+512):"memory");}
    asm volatile("s_waitcnt lgkmcnt(0)":::"memory");SBAR();
    #define PK(k) (bf16x8){lo[k][0],lo[k][1],lo[k][2],lo[k][3],hi[k][0],hi[k][1],hi[k][2],hi[k][3]}
    o[d0]=__builtin_amdgcn_mfma_f32_32x32x16_bf16(pa0,PK(0),o[d0],0,0,0);
    o[d0]=__builtin_amdgcn_mfma_f32_32x32x16_bf16(pa1,PK(1),o[d0],0,0,0);
    o[d0]=__builtin_amdgcn_mfma_f32_32x32x16_bf16(pa2,PK(2),o[d0],0,0,0);
    o[d0]=__builtin_amdgcn_mfma_f32_32x32x16_bf16(pa3,PK(3),o[d0],0,0,0);
    #undef PK
  }
}

#ifndef ATTN_STORE16
#define ATTN_STORE16(p,v) (*(u32x4*)(p)=(v))
#endif
template<int THRL> __device__ __forceinline__ void attn_unit(int b,int h,int qb,const bf16*Q,const bf16*__restrict__ K,const bf16*__restrict__ V,bf16*O,char*shm){
  const int tid=threadIdx.x,lane=tid&63,r32=lane&31,hi=lane>>5; const int wid=__builtin_amdgcn_readfirstlane(tid>>6);
  const long rowbase=(long)b*SEQ; const int q0=qb*QB;
  const bf16*Qw=Q+(rowbase+q0+wid*QBLK)*DM+h*D;
  const bf16*Kh=K+(long)b*KVSEQ*DM+h*D,*Vh=V+(long)b*KVSEQ*DM+h*D;
  const unsigned lds0=(unsigned)(uintptr_t)shm;
  float*wsf=(float*)(shm+LDS_WS)+wid*64;
  const bf16*ksrc=Kh+(long)lane*DM+wid*8;
  const bf16*vsrc=Vh+(long)(16*(wid&3)+(lane>>2))*DM+(wid>>2)*32+(lane&3)*8;
  const unsigned kdst=lds0+LDS_K+wid*1024, vdst=lds0+LDS_V+wid*1024;
  #define DMA_K(t,slot) glds16(ksrc+(long)(t)*KVBLK*DM,(unsigned)__builtin_amdgcn_readfirstlane(kdst+(slot)))
  #define DMA_V(t,slot) glds16(vsrc+(long)(t)*KVBLK*DM,(unsigned)__builtin_amdgcn_readfirstlane(vdst+(slot)))
  const int vb0=(int)(lds0+LDS_V)+((lane>>4)&1)*32+(lane&3)*8+(4*hi+((lane&15)>>2))*64;
  const char*Kbase=shm+LDS_K; bf16x8 kf[8];
  const lds_cptr shm3=(lds_cptr)shm; const lds_cptr kp0=shm3+LDS_K+hi*1024+r32*16; const lds_cptr vp0=shm3+LDS_V+((lane>>4)&1)*32+(lane&3)*8+(4*hi+((lane&15)>>2))*64;
  const int NT=(q0+QB)/KVBLK+1;
  DMA_K(0,0);DMA_V(0,0);DMA_K(1,SLOTB);
  bf16x8 qr[4];
  #pragma unroll
  for(int d0=0;d0<4;++d0)qr[d0]=*reinterpret_cast<const bf16x8*>(&Qw[(long)r32*DM+d0*16+hi*8]);
  float mhat=0.f,l_reg=0.f;f32x16 o[2];o[0]=f32x16{};o[1]=f32x16{};f32x16 negm=f32x16{};asm volatile("":"+v"(negm));
  const int qrel=wid*QBLK+r32;
  #define CMASK(P0,P1,t) do{int jb_=(t)-(NT-4); if(jb_>=0)cmask(P0,P1,jb_,qrel,hi);}while(0)
  bool resc=false;
  #define START(P0,P1) do{ const float rm=rowmax(P0,P1); resc=false; \
    { const float dl=rm; mhat=fadd_s(mhat,dl); \
      _Pragma("unroll") for(int r=0;r<16;++r){P0[r]=fsub_s(P0[r],dl);P1[r]=fsub_s(P1[r],dl);} \
      _Pragma("unroll") for(int r=0;r<16;++r)negm[r]=-mhat; asm volatile("":"+v"(negm)); } \
    _Pragma("unroll") for(int r=0;r<16;++r)P0[r]=__builtin_amdgcn_exp2f(P0[r]); }while(0)
  #define RESC() do{ if(resc){ asm volatile("s_waitcnt lgkmcnt(0)":::"memory"); \
      _Pragma("unroll") for(int d_=0;d_<2;++d_) _Pragma("unroll") for(int r=0;r<16;++r)o[d_][r]*=wsf[crow(r,hi)]; } }while(0)
  f32x16 pA0,pA1,pB0,pB1;
  int sl_prev=0,sl_cur=0,sl_next=SLOTB;
  #define ROT() do{sl_prev=sl_cur;sl_cur=sl_next;sl_next=(sl_next==(NSLOT-1)*SLOTB)?0:sl_next+SLOTB;}while(0)
  DMA_K(2,2*SLOTB);
  WAIT_BAR(3);
  qkt(pA0,pA1,Kbase,qr,negm,r32,hi);asm volatile("s_nop 15\n\ts_nop 7":"+v"(pA0),"+v"(pA1));CMASK(pA0,pA1,0);
  _Pragma("unroll") for(int r=0;r<16;++r){ pA0[r]=-INFINITY; if(r<8)pA1[r]=-INFINITY; }
  START(pA0,pA1);
  _Pragma("unroll") for(int r=0;r<16;++r)pA1[r]=__builtin_amdgcn_exp2f(pA1[r]);
  WAIT_BAR(0);
  DMA_K(3,0);DMA_V(1,SLOTB);
  ROT();
  kload8(kf,kp0+sl_cur);
  WAIT_BAR(2);
  s16x4 vlo[8],vhi[8]; u32x4 pw0,pw1,pw2,pw3;
  #define PKW(P,B) cvtpk_s(P[B],P[B+1])
  #define PAF(k) __builtin_bit_cast(bf16x8,pw##k)
  #define VFR(i) (bf16x8){vlo[i][0],vlo[i][1],vlo[i][2],vlo[i][3],vhi[i][0],vhi[i][1],vhi[i][2],vhi[i][3]}
  #define PIN(x) asm volatile("":"+v"(x))
  #define MX3(a,b,c) __builtin_fmaxf(__builtin_fmaxf((a),(b)),(c))
  #define GAPA(MF,A0,A1,A2,A3,W0,W1,PW) do{ MF; sacc+=A0; sacc+=A1; sacc+=A2; sacc+=A3; PIN(sacc); W0; W1; PIN(PW); SBAR(); }while(0)
  #define EX(v) __builtin_amdgcn_exp2f(v)
  #define GAPB(MF,X,B) do{ MF; X[B]=EX(X[B]); X[B+1]=EX(X[B+1]); X[B+2]=EX(X[B+2]); X[B+3]=EX(X[B+3]); PIN(X); SBAR(); }while(0)
  #define VRD(i) do{ vlo[i]=vtr(vp_+(((i)>>2)*4096+((i)&3)*1024)); vhi[i]=vtr(vp_+(((i)>>2)*4096+((i)&3)*1024+512)); }while(0)
  #define KRD(G,j) do{ if(G){ kload2(kf,kp0+sl_next,j); SBAR(); } }while(0)
  #define STEP(C0,C1,P0,P1,t,GK,GV,GL) do{ SBAR(); \
    const lds_cptr vp_=vp0+sl_prev; \
    VRD(0); SBAR(); float sacc=(P0[0]+P0[1]); \
    GAPA(C0=__builtin_amdgcn_mfma_f32_32x32x16_bf16(kf[0],qr[0],negm,0,0,0), P0[2],P0[3],P0[4],P0[5],     pw0[0]=PKW(P0,0), pw0[1]=PKW(P0,2), pw0); \
    VRD(4); SBAR(); GAPA(C1=__builtin_amdgcn_mfma_f32_32x32x16_bf16(kf[1],qr[0],negm,0,0,0), P0[6],P0[7],P0[8],P0[9],     pw0[2]=PKW(P0,4), pw0[3]=PKW(P0,6), pw0); \
    VRD(1); SBAR(); GAPA(C0=__builtin_amdgcn_mfma_f32_32x32x16_bf16(kf[2],qr[1],C0,0,0,0),   P0[10],P0[11],P0[12],P0[13], pw1[0]=PKW(P0,8), pw1[1]=PKW(P0,10), pw1); \
    VRD(5); SBAR(); GAPA(C1=__builtin_amdgcn_mfma_f32_32x32x16_bf16(kf[3],qr[1],C1,0,0,0),   P0[14],P0[15],P1[0],P1[1],   pw1[2]=PKW(P0,12),pw1[3]=PKW(P0,14), pw1); \
    VRD(2); SBAR(); GAPA(C0=__builtin_amdgcn_mfma_f32_32x32x16_bf16(kf[4],qr[2],C0,0,0,0),   P1[2],P1[3],P1[4],P1[5],     pw2[0]=PKW(P1,0), pw2[1]=PKW(P1,2), pw2); \
    VRD(6); SBAR(); GAPA(C1=__builtin_amdgcn_mfma_f32_32x32x16_bf16(kf[5],qr[2],C1,0,0,0),   P1[6],P1[7],P1[8],P1[9],     pw2[2]=PKW(P1,4), pw2[3]=PKW(P1,6), pw2); \
    VRD(3); SBAR(); GAPA(C0=__builtin_amdgcn_mfma_f32_32x32x16_bf16(kf[6],qr[3],C0,0,0,0),   P1[10],P1[11],P1[12],P1[13], pw3[0]=PKW(P1,8), pw3[1]=PKW(P1,10), pw3); \
    VRD(7); SBAR(); GAPA(C1=__builtin_amdgcn_mfma_f32_32x32x16_bf16(kf[7],qr[3],C1,0,0,0),   P1[14],P1[15],0.f,0.f,       pw3[2]=PKW(P1,12),pw3[3]=PKW(P1,14), pw3); \
    l_reg+=sacc; \
    if(GK){DMA_K((t)+3,sl_cur);} if(GV){DMA_V((t)+1,sl_next);} \
    CMASK(C0,C1,t); \
    { float a=MX3(C0[0],C0[1],C1[0]),b=MX3(C0[2],C0[3],C1[1]); a=MX3(a,C1[2],C1[3]); \
      _Pragma("unroll") for(int r=4;r<16;r+=4){a=MX3(a,C0[r],C0[r+1]);b=MX3(b,C0[r+2],C0[r+3]);a=MX3(a,C1[r],C1[r+1]);b=MX3(b,C1[r+2],C1[r+3]);} \
      float rm=__builtin_fmaxf(a,b); { auto rr=__builtin_amdgcn_permlane32_swap(__float_as_uint(rm),__float_as_uint(rm),false,false); rm=__builtin_fmaxf(__uint_as_float(rr[0]),__uint_as_float(rr[1])); } \
      resc=false; \
      if(__builtin_expect(__any(rm>(float)THRL),0)){ const float dl=__builtin_fmaxf(rm,0.f); mhat+=dl; \
        _Pragma("unroll") for(int r=0;r<16;++r){C0[r]-=dl;C1[r]-=dl;} \
        _Pragma("unroll") for(int r=0;r<16;++r)negm[r]=-mhat; asm volatile("":"+v"(negm)); \
        const float f=__builtin_amdgcn_exp2f(-dl); l_reg*=f; if(hi==0)wsf[r32]=f; resc=true; } } \
    SBAR(); \
    GAPB(o[0]=__builtin_amdgcn_mfma_f32_32x32x16_bf16(PAF(0),VFR(0),o[0],0,0,0), C0,0); \
    GAPB(o[1]=__builtin_amdgcn_mfma_f32_32x32x16_bf16(PAF(0),VFR(4),o[1],0,0,0), C0,4); \
    KRD(GL,0); GAPB(o[0]=__builtin_amdgcn_mfma_f32_32x32x16_bf16(PAF(1),VFR(1),o[0],0,0,0), C0,8); \
    KRD(GL,1); GAPB(o[1]=__builtin_amdgcn_mfma_f32_32x32x16_bf16(PAF(1),VFR(5),o[1],0,0,0), C0,12); \
    KRD(GL,2); GAPB(o[0]=__builtin_amdgcn_mfma_f32_32x32x16_bf16(PAF(2),VFR(2),o[0],0,0,0), C1,0); \
    KRD(GL,3); GAPB(o[1]=__builtin_amdgcn_mfma_f32_32x32x16_bf16(PAF(2),VFR(6),o[1],0,0,0), C1,4); \
    GAPB(o[0]=__builtin_amdgcn_mfma_f32_32x32x16_bf16(PAF(3),VFR(3),o[0],0,0,0), C1,8); \
    GAPB(o[1]=__builtin_amdgcn_mfma_f32_32x32x16_bf16(PAF(3),VFR(7),o[1],0,0,0), C1,12); \
    }while(0)
  int t=1;
  #undef CMASK
  #define CMASK(P0,P1,t) do{}while(0)
  for(;t+5<NT;t+=2){
    STEP(pB0,pB1,pA0,pA1,t,true,true,true);     WAIT_BAR(2); RESC(); ROT();
    STEP(pA0,pA1,pB0,pB1,t+1,true,true,true);   WAIT_BAR(2); RESC(); ROT();
  }
  #undef CMASK
  #define CMASK(P0,P1,t) do{int jb_=(t)-(NT-4); if(jb_>=0)cmask(P0,P1,jb_,qrel,hi);}while(0)
  #define ENDW(tt) do{ if((tt)+3<NT){WAIT_BAR(2);} else if((tt)+2<NT){WAIT_BAR(1);} else {WAIT_BAR(0);} }while(0)
  for(;t+2<NT;t+=2){
    STEP(pB0,pB1,pA0,pA1,t,(t+3<NT),(t+1<NT),(t+1<NT));       ENDW(t);   RESC(); ROT();
    STEP(pA0,pA1,pB0,pB1,t+1,(t+4<NT),(t+2<NT),(t+2<NT));     ENDW(t+1); RESC(); ROT();
  }
  STEP(pB0,pB1,pA0,pA1,t,false,true,true); WAIT_BAR(0); RESC(); ROT();
  STEP(pA0,pA1,pB0,pB1,NT-1,false,false,false); RESC();
  { float sacc=pA0[0]+pA0[1]; _Pragma("unroll") for(int r=2;r<16;++r)sacc+=pA0[r]; _Pragma("unroll") for(int r=0;r<16;++r)sacc+=pA1[r]; l_reg+=sacc;
    pw0=(u32x4){PKW(pA0,0),PKW(pA0,2),PKW(pA0,4),PKW(pA0,6)};pw1=(u32x4){PKW(pA0,8),PKW(pA0,10),PKW(pA0,12),PKW(pA0,14)};pw2=(u32x4){PKW(pA1,0),PKW(pA1,2),PKW(pA1,4),PKW(pA1,6)};pw3=(u32x4){PKW(pA1,8),PKW(pA1,10),PKW(pA1,12),PKW(pA1,14)};
    SBAR(); pv(o,vb0+sl_cur,PAF(0),PAF(1),PAF(2),PAF(3)); }
  #undef PKW
  #undef PAF
  #undef VFR
  #undef PIN
  #undef MX3
  #undef GAPA
  #undef GAPB
  #undef EX
  #undef VRD
  #undef KRD
  #undef STEP
  #undef ENDW
  {auto rr=__builtin_amdgcn_permlane32_swap(__float_as_uint(l_reg),__float_as_uint(l_reg),false,false);l_reg=__uint_as_float(rr[0])+__uint_as_float(rr[1]);}
  if(hi==0)wsf[32+r32]=l_reg;asm volatile("s_waitcnt lgkmcnt(0)":::"memory");
  float rli[16];
  #pragma unroll
  for(int r=0;r<16;++r)rli[r]=__builtin_amdgcn_rcpf(wsf[32+crow(r,hi)]);
  bf16*Ow=O+(rowbase+q0+wid*QBLK)*DM+h*D;
  { bf16*stg=(bf16*)(shm+LDS_OST)+wid*2048;
    #pragma unroll
    for(int r=0;r<16;++r){const int orow=crow(r,hi);
      #pragma unroll
      for(int d0=0;d0<2;++d0)stg[orow*64+d0*32+r32]=__float2bfloat16(o[d0][r]*rli[r]);}
    asm volatile("s_waitcnt lgkmcnt(0)":::"memory");
    #pragma unroll
    for(int i=0;i<4;++i){const int row=i*8+(lane>>3),ch=lane&7; const u32x4 v=*(const u32x4*)(stg+row*64+ch*8); ATTN_STORE16(Ow+(long)row*DM+ch*8,v);} }
  asm volatile("s_waitcnt lgkmcnt(0)\n\ts_barrier":::"memory");
  #undef DMA_K
  #undef DMA_V
  #undef CMASK
  #undef START
  #undef RESC
  #undef ROT
}
constexpr int ATTN_LDS_BYTES=LDS_BYTES;
struct AttnTensors { const bf16* Q; const bf16* K; const bf16* V; bf16* O; };
struct AttnUnit { int bh; int qb; };
struct StaticOrder {
  int vcu;
  __device__ __forceinline__ explicit StaticOrder(int grid,int block):vcu((block%8)*(grid/8)+block/8){}
  __device__ __forceinline__ bool next(int i,AttnUnit&u)const{ if(i>=4)return false; const int s=vcu&7; u.bh=vcu>>3; u.qb=(i==0)?s:(i==1)?15-s:(i==2)?16+s:31-s; return true; }
  __device__ __forceinline__ void a_ready(const AttnUnit&)const{}
  __device__ __forceinline__ void done(const AttnUnit&)const{}
};
template<class Sched,int THRL=8> __device__ __forceinline__ void attn_phase(char*lds,const AttnTensors&T,const Sched&S){
  AttnUnit u;
  for(int i=0;S.next(i,u);++i){ S.a_ready(u); attn_unit<THRL>(u.bh/NHEAD,u.bh%NHEAD,u.qb,T.Q,T.K,T.V,T.O,lds); S.done(u); }
}
#undef SBAR
#undef WAIT_BAR
}
namespace attn2 {
using bf16=__hip_bfloat16;
using bf16x8=__attribute__((ext_vector_type(8)))short;
using s16x4=__attribute__((ext_vector_type(4)))short;
using f32x16=__attribute__((ext_vector_type(16)))float;
using u32x4=__attribute__((ext_vector_type(4)))unsigned;
constexpr int BATCH=2,NHEAD=8,SEQ=8192,D=64,DQK=NHEAD*D,DVP=512,DOP=1024,DM=DQK,KVSEQ=SEQ+64;
constexpr int NW=8,QBLK=32,QB=QBLK*NW,KVBLK=64,NQB=SEQ/QB;
constexpr int ATTN_PITCH=DM, ATTN_UNIT_ROWS=QB;
__device__ __forceinline__ int crow(int r,int hi){return (r&3)+8*(r>>2)+4*hi;}
#define SBAR() __builtin_amdgcn_sched_barrier(0)
__device__ __forceinline__ void cmask(f32x16&p0,f32x16&p1,int jb,int qrel,int hi){
  const float NEG=-INFINITY; int kb=64*jb+4*hi;
  #pragma unroll
  for(int r=0;r<16;++r){int kv=kb+(r&3)+8*(r>>2); if(kv>qrel)p0[r]=NEG; if(kv+32>qrel)p1[r]=NEG;}
}

constexpr int NSLOT=3, SLOTB=8192;
constexpr int LDS_K=0, LDS_V=NSLOT*SLOTB, LDS_WS=3*NSLOT*SLOTB, LDS_OST=LDS_WS+NW*64*4, LDS_BYTES=LDS_OST+NW*8192;
constexpr float C2=0.125f*1.4426950408889634f;
__device__ __forceinline__ void glds16(const void*gsrc,unsigned lds_dst){unsigned keep;
  asm volatile("s_mov_b32 %0, m0\n\ts_mov_b32 m0, %2\n\ts_nop 0\n\tglobal_load_lds_dwordx4 %1, off\n\ts_mov_b32 m0, %0":"=&s"(keep):"v"(gsrc),"s"(lds_dst):"memory");}
__device__ __forceinline__ float max3f(float a,float b,float c){float r;asm("v_max3_f32 %0, %1, %2, %3":"=v"(r):"v"(a),"v"(b),"v"(c));return r;}
__device__ __forceinline__ float max2f(float a,float b){float r;asm("v_max_f32_e32 %0, %1, %2":"=v"(r):"v"(a),"v"(b));return r;}
__device__ __forceinline__ float fadd_s(float a,float b){float r;asm("v_add_f32_e32 %0, %1, %2":"=v"(r):"v"(a),"v"(b));return r;}
__device__ __forceinline__ float fsub_s(float a,float b){float r;asm("v_sub_f32_e32 %0, %1, %2":"=v"(r):"v"(a),"v"(b));return r;}
typedef float f32x2_t __attribute__((ext_vector_type(2))); typedef __bf16 bf16x2_t __attribute__((ext_vector_type(2)));
__device__ __forceinline__ unsigned cvtpk_s(float lo,float hi){f32x2_t v={lo,hi};bf16x2_t b=__builtin_convertvector(v,bf16x2_t);return __builtin_bit_cast(unsigned,b);}
#define WAIT_BAR(N) asm volatile("s_waitcnt vmcnt(" #N ") lgkmcnt(0)\n\ts_barrier":::"memory")

__device__ __forceinline__ void qkt(f32x16&p0,f32x16&p1,const char*Kslot,const bf16x8*qr,const f32x16&negm,int r32,int hi){
  const char*kb=Kslot+hi*1024+r32*16;
  #pragma unroll
  for(int d0=0;d0<4;++d0){
    const bf16x8 b0=*reinterpret_cast<const bf16x8*>(kb+d0*2048);
    const bf16x8 b1=*reinterpret_cast<const bf16x8*>(kb+d0*2048+512);
    if(d0==0){p0=__builtin_amdgcn_mfma_f32_32x32x16_bf16(b0,qr[0],negm,0,0,0);p1=__builtin_amdgcn_mfma_f32_32x32x16_bf16(b1,qr[0],negm,0,0,0);}
    else{p0=__builtin_amdgcn_mfma_f32_32x32x16_bf16(b0,qr[d0],p0,0,0,0);p1=__builtin_amdgcn_mfma_f32_32x32x16_bf16(b1,qr[d0],p1,0,0,0);}}
}
typedef __attribute__((address_space(3))) const char* lds_cptr;
typedef short v4i16_t __attribute__((ext_vector_type(4)));
__device__ __forceinline__ void kload8(bf16x8*kf,lds_cptr kp){
  kf[0]=*(const __attribute__((address_space(3))) bf16x8*)(kp);      kf[1]=*(const __attribute__((address_space(3))) bf16x8*)(kp+512);
  kf[2]=*(const __attribute__((address_space(3))) bf16x8*)(kp+2048); kf[3]=*(const __attribute__((address_space(3))) bf16x8*)(kp+2560);
  kf[4]=*(const __attribute__((address_space(3))) bf16x8*)(kp+4096); kf[5]=*(const __attribute__((address_space(3))) bf16x8*)(kp+4608);
  kf[6]=*(const __attribute__((address_space(3))) bf16x8*)(kp+6144); kf[7]=*(const __attribute__((address_space(3))) bf16x8*)(kp+6656);
}
__device__ __forceinline__ void kload2(bf16x8*kf,lds_cptr kp,int j){ kf[2*j]=*(const __attribute__((address_space(3))) bf16x8*)(kp+j*2048); kf[2*j+1]=*(const __attribute__((address_space(3))) bf16x8*)(kp+j*2048+512); }
__device__ __forceinline__ s16x4 vtr(lds_cptr p){ return __builtin_bit_cast(s16x4,__builtin_amdgcn_ds_read_tr16_b64_v4i16((__attribute__((address_space(3))) v4i16_t*)p)); }
__device__ __forceinline__ float rowmax(const f32x16&p0,const f32x16&p1){
  float a=max3f(p0[0],p0[1],p1[0]),b=max3f(p0[2],p0[3],p1[1]);a=max3f(a,p1[2],p1[3]);
  #pragma unroll
  for(int r=4;r<16;r+=4){a=max3f(a,p0[r],p0[r+1]);b=max3f(b,p0[r+2],p0[r+3]);a=max3f(a,p1[r],p1[r+1]);b=max3f(b,p1[r+2],p1[r+3]);}
  const float m=max2f(a,b);
  auto rr=__builtin_amdgcn_permlane32_swap(__float_as_uint(m),__float_as_uint(m),false,false);
  return max2f(__uint_as_float(rr[0]),__uint_as_float(rr[1]));
}
__device__ __forceinline__ void pv(f32x16*o,int vb,bf16x8 pa0,bf16x8 pa1,bf16x8 pa2,bf16x8 pa3){
  #pragma unroll
  for(int d0=0;d0<4;++d0){s16x4 lo[4],hi[4];
    #pragma unroll
    for(int ks=0;ks<4;++ks){
      asm volatile("ds_read_b64_tr_b16 %0,%1 offset:%c2":"=&v"(lo[ks]):"v"(vb),"i"(d0*4096+ks*1024):"memory");
      asm volatile("ds_read_b64_tr_b16 %0,%1 offset:%c2":"=&v"(hi[ks]):"v"(vb),"i"(d0*4096+ks*1024+512):"memory");}
    asm volatile("s_waitcnt lgkmcnt(0)":::"memory");SBAR();
    #define PK(k) (bf16x8){lo[k][0],lo[k][1],lo[k][2],lo[k][3],hi[k][0],hi[k][1],hi[k][2],hi[k][3]}
    o[d0]=__builtin_amdgcn_mfma_f32_32x32x16_bf16(pa0,PK(0),o[d0],0,0,0);
    o[d0]=__builtin_amdgcn_mfma_f32_32x32x16_bf16(pa1,PK(1),o[d0],0,0,0);
    o[d0]=__builtin_amdgcn_mfma_f32_32x32x16_bf16(pa2,PK(2),o[d0],0,0,0);
    o[d0]=__builtin_amdgcn_mfma_f32_32x32x16_bf16(pa3,PK(3),o[d0],0,0,0);
    #undef PK
  }
}

#ifndef ATTN_STORE16
#define ATTN_STORE16(p,v) (*(u32x4*)(p)=(v))
#endif
template<int THRL> __device__ __forceinline__ void attn_unit(int b,int h,int qb,const bf16*Q,const bf16*__restrict__ K,const bf16*__restrict__ V,bf16*O,char*shm){
  int tid=threadIdx.x; asm volatile("":"+v"(tid));
  const int lane=tid&63,r32=lane&31,hi=lane>>5; const int wid=__builtin_amdgcn_readfirstlane(tid>>6);
  const long rowbase=(long)b*SEQ; const int q0=qb*QB;
  const bf16*Qw=Q+(rowbase+q0+wid*QBLK)*DQK+h*D;
  const bf16*Kh=K+(long)b*KVSEQ*DQK+h*D,*Vh=V+(long)b*KVSEQ*DVP+(h>>1)*128;
  const unsigned lds0=(unsigned)(uintptr_t)shm;
  float*wsf=(float*)(shm+LDS_WS)+wid*64;
  const bf16*ksrc=Kh+(long)lane*DQK+wid*8;
  const bf16*vsrc=Vh+(long)(16*(wid&3)+(lane>>2))*DVP+(wid>>2)*32+(lane&3)*8;
  const unsigned kdst=lds0+LDS_K+wid*1024, vdst=lds0+LDS_V+wid*1024;
  #define DMA_K(t,slot) glds16(ksrc+(long)(t)*KVBLK*DQK,(unsigned)__builtin_amdgcn_readfirstlane(kdst+(slot)))
  #define DMA_V(t,slot) do{ glds16(vsrc+(long)(t)*KVBLK*DVP,(unsigned)__builtin_amdgcn_readfirstlane(vdst+2*(slot))); glds16(vsrc+(long)(t)*KVBLK*DVP+64,(unsigned)__builtin_amdgcn_readfirstlane(vdst+2*(slot)+8192)); }while(0)
  const int vb0=(int)(lds0+LDS_V)+((lane>>4)&1)*32+(lane&3)*8+(4*hi+((lane&15)>>2))*64;
  const char*Kbase=shm+LDS_K; bf16x8 kf[8];
  const lds_cptr shm3=(lds_cptr)shm; const lds_cptr kp0=shm3+LDS_K+hi*1024+r32*16; const lds_cptr vp0=shm3+LDS_V+((lane>>4)&1)*32+(lane&3)*8+(4*hi+((lane&15)>>2))*64;
  const int NT=(q0+QB)/KVBLK+1;
  DMA_K(0,0);DMA_V(0,0);DMA_K(1,SLOTB);
  bf16x8 qr[4];
  #pragma unroll
  for(int d0=0;d0<4;++d0)qr[d0]=*reinterpret_cast<const bf16x8*>(&Qw[(long)r32*DQK+d0*16+hi*8]);
  float mhat=0.f,l_reg=0.f;f32x16 o[4];o[0]=f32x16{};o[1]=f32x16{};o[2]=f32x16{};o[3]=f32x16{};const f32x16 zero16=f32x16{};
  const int qrel=wid*QBLK+r32;
  #define CMASK(P0,P1,t) do{int jb_=(t)-(NT-4); if(jb_>=0)cmask(P0,P1,jb_,qrel,hi);}while(0)
  bool resc=false;
  #define START(P0,P1) do{ const float rm=rowmax(P0,P1); resc=false; \
    { const float dl=rm; mhat=fadd_s(mhat,dl); \
      _Pragma("unroll") for(int r=0;r<16;++r){P0[r]=fsub_s(P0[r],dl);P1[r]=fsub_s(P1[r],dl);} \
      } \
    _Pragma("unroll") for(int r=0;r<16;++r)P0[r]=__builtin_amdgcn_exp2f(P0[r]); }while(0)
  #define RESC() do{ if(resc){ asm volatile("s_waitcnt lgkmcnt(0)":::"memory"); \
      _Pragma("unroll") for(int d_=0;d_<4;++d_) _Pragma("unroll") for(int r=0;r<16;++r)o[d_][r]*=wsf[crow(r,hi)]; } }while(0)
  f32x16 pA0,pA1,pB0,pB1;
  int sl_prev=0,sl_cur=0,sl_next=SLOTB;
  #define ROT() do{sl_prev=sl_cur;sl_cur=sl_next;sl_next=(sl_next==(NSLOT-1)*SLOTB)?0:sl_next+SLOTB;}while(0)
  DMA_K(2,2*SLOTB);
  WAIT_BAR(4);
  qkt(pA0,pA1,Kbase,qr,zero16,r32,hi);asm volatile("s_nop 15\n\ts_nop 7":"+v"(pA0),"+v"(pA1));CMASK(pA0,pA1,0);
  _Pragma("unroll") for(int r=0;r<16;++r){ pA0[r]=-INFINITY; if(r<8)pA1[r]=-INFINITY; }
  _Pragma("unroll") for(int r=0;r<16;++r)pA0[r]=__builtin_amdgcn_exp2f(pA0[r]);
  _Pragma("unroll") for(int r=0;r<16;++r)pA1[r]=__builtin_amdgcn_exp2f(pA1[r]);
  WAIT_BAR(0);
  DMA_K(3,0);DMA_V(1,SLOTB);
  ROT();
  kload8(kf,kp0+sl_cur);
  WAIT_BAR(3);
  s16x4 vlo[4],vhi[4]; u32x4 pwa0,pwa1,pwa2,pwa3,pwb0,pwb1,pwb2,pwb3;
  #define PKW(P,B) cvtpk_s(P[B],P[B+1])
  #define PAFX(P,k) __builtin_bit_cast(bf16x8,P##k)
  #define VFR(i) (bf16x8){vlo[i][0],vlo[i][1],vlo[i][2],vlo[i][3],vhi[i][0],vhi[i][1],vhi[i][2],vhi[i][3]}
  #define PIN(x) asm volatile("":"+v"(x))
  #define MX3(a,b,c) __builtin_fmaxf(__builtin_fmaxf((a),(b)),(c))
  #define EX(v) __builtin_amdgcn_exp2f(v)
  #define VRD(s,i) do{ vlo[s]=vtr(vp_+(((i)>>2)*4096+((i)&3)*1024)); vhi[s]=vtr(vp_+(((i)>>2)*4096+((i)&3)*1024+512)); }while(0)
  #define KRD(G,j) do{ if(G){ kload2(kf,kp0+sl_next,j); SBAR(); } }while(0)
  #define GAPA(MF) do{ MF; SBAR(); }while(0)
  #define GAPB(MF,RD,X,B,PV_,W) do{ MF; RD; X[B]=EX(X[B]); X[B+1]=EX(X[B+1]); sacc+=X[B]; sacc+=X[B+1]; PIN(sacc); PV_[W]=cvtpk_s(X[B],X[B+1]); PIN(PV_); SBAR(); }while(0)
  #define STEP(C0,C1,PP,PC,t,GK,GV,GL) do{ SBAR(); \
    const lds_cptr vp_=vp0+2*sl_prev; \
    GAPA(C0=__builtin_amdgcn_mfma_f32_32x32x16_bf16(kf[0],qr[0],zero16,0,0,0)); GAPA(C1=__builtin_amdgcn_mfma_f32_32x32x16_bf16(kf[1],qr[0],zero16,0,0,0)); GAPA(C0=__builtin_amdgcn_mfma_f32_32x32x16_bf16(kf[2],qr[1],C0,0,0,0)); GAPA(C1=__builtin_amdgcn_mfma_f32_32x32x16_bf16(kf[3],qr[1],C1,0,0,0)); VRD(0,0); SBAR(); GAPA(C0=__builtin_amdgcn_mfma_f32_32x32x16_bf16(kf[4],qr[2],C0,0,0,0)); VRD(1,4); SBAR(); GAPA(C1=__builtin_amdgcn_mfma_f32_32x32x16_bf16(kf[5],qr[2],C1,0,0,0)); VRD(2,8); SBAR(); GAPA(C0=__builtin_amdgcn_mfma_f32_32x32x16_bf16(kf[6],qr[3],C0,0,0,0)); VRD(3,12); SBAR(); GAPA(C1=__builtin_amdgcn_mfma_f32_32x32x16_bf16(kf[7],qr[3],C1,0,0,0)); \
    if(GK){DMA_K((t)+3,sl_cur);} if(GV){DMA_V((t)+1,sl_next);} \
    CMASK(C0,C1,t); \
    SBAR(); float sacc=0.f; \
    GAPB(o[0]=__builtin_amdgcn_mfma_f32_32x32x16_bf16(PAFX(PP,0),VFR(0),o[0],0,0,0), VRD(0,1), C0,0, PC##0,0); \
    GAPB(o[1]=__builtin_amdgcn_mfma_f32_32x32x16_bf16(PAFX(PP,0),VFR(1),o[1],0,0,0), VRD(1,5), C0,2, PC##0,1); \
    GAPB(o[2]=__builtin_amdgcn_mfma_f32_32x32x16_bf16(PAFX(PP,0),VFR(2),o[2],0,0,0), VRD(2,9), C0,4, PC##0,2); \
    GAPB(o[3]=__builtin_amdgcn_mfma_f32_32x32x16_bf16(PAFX(PP,0),VFR(3),o[3],0,0,0), VRD(3,13), C0,6, PC##0,3); \
    GAPB(o[0]=__builtin_amdgcn_mfma_f32_32x32x16_bf16(PAFX(PP,1),VFR(0),o[0],0,0,0), VRD(0,2), C0,8, PC##1,0); \
    GAPB(o[1]=__builtin_amdgcn_mfma_f32_32x32x16_bf16(PAFX(PP,1),VFR(1),o[1],0,0,0), VRD(1,6), C0,10, PC##1,1); \
    GAPB(o[2]=__builtin_amdgcn_mfma_f32_32x32x16_bf16(PAFX(PP,1),VFR(2),o[2],0,0,0), VRD(2,10), C0,12, PC##1,2); \
    GAPB(o[3]=__builtin_amdgcn_mfma_f32_32x32x16_bf16(PAFX(PP,1),VFR(3),o[3],0,0,0), VRD(3,14), C0,14, PC##1,3); \
    GAPB(o[0]=__builtin_amdgcn_mfma_f32_32x32x16_bf16(PAFX(PP,2),VFR(0),o[0],0,0,0), VRD(0,3), C1,0, PC##2,0); \
    GAPB(o[1]=__builtin_amdgcn_mfma_f32_32x32x16_bf16(PAFX(PP,2),VFR(1),o[1],0,0,0), VRD(1,7), C1,2, PC##2,1); \
    GAPB(o[2]=__builtin_amdgcn_mfma_f32_32x32x16_bf16(PAFX(PP,2),VFR(2),o[2],0,0,0), VRD(2,11), C1,4, PC##2,2); \
    GAPB(o[3]=__builtin_amdgcn_mfma_f32_32x32x16_bf16(PAFX(PP,2),VFR(3),o[3],0,0,0), VRD(3,15), C1,6, PC##2,3); \
    KRD(GL,0); GAPB(o[0]=__builtin_amdgcn_mfma_f32_32x32x16_bf16(PAFX(PP,3),VFR(0),o[0],0,0,0), (void)0, C1,8, PC##3,0); \
    KRD(GL,1); GAPB(o[1]=__builtin_amdgcn_mfma_f32_32x32x16_bf16(PAFX(PP,3),VFR(1),o[1],0,0,0), (void)0, C1,10, PC##3,1); \
    KRD(GL,2); GAPB(o[2]=__builtin_amdgcn_mfma_f32_32x32x16_bf16(PAFX(PP,3),VFR(2),o[2],0,0,0), (void)0, C1,12, PC##3,2); \
    KRD(GL,3); GAPB(o[3]=__builtin_amdgcn_mfma_f32_32x32x16_bf16(PAFX(PP,3),VFR(3),o[3],0,0,0), (void)0, C1,14, PC##3,3); \
    l_reg+=sacc; \
    }while(0)
  { float sacc=pA0[0]+pA0[1]; _Pragma("unroll") for(int r=2;r<16;++r)sacc+=pA0[r]; _Pragma("unroll") for(int r=0;r<16;++r)sacc+=pA1[r]; l_reg+=sacc;
    pwa0=(u32x4){PKW(pA0,0),PKW(pA0,2),PKW(pA0,4),PKW(pA0,6)};pwa1=(u32x4){PKW(pA0,8),PKW(pA0,10),PKW(pA0,12),PKW(pA0,14)};pwa2=(u32x4){PKW(pA1,0),PKW(pA1,2),PKW(pA1,4),PKW(pA1,6)};pwa3=(u32x4){PKW(pA1,8),PKW(pA1,10),PKW(pA1,12),PKW(pA1,14)}; }
  pwb0=pwa0;pwb1=pwa1;pwb2=pwa2;pwb3=pwa3;
  int t=1;
  #undef CMASK
  #define CMASK(P0,P1,t) do{int jb_=(t)-(NT-4); if(jb_>=0)cmask(P0,P1,jb_,qrel,hi);}while(0)
  #define ENDW(tt) do{ if((tt)+3<NT){WAIT_BAR(3);} else if((tt)+2<NT){WAIT_BAR(2);} else {WAIT_BAR(0);} }while(0)
  for(;t+2<NT;t+=2){
    STEP(pA0,pA1,pwa,pwb,t,(t+3<NT),(t+1<NT),(t+1<NT));       ENDW(t);   ROT();
    STEP(pA0,pA1,pwb,pwa,t+1,(t+4<NT),(t+2<NT),(t+2<NT));     ENDW(t+1); ROT();
  }
  STEP(pA0,pA1,pwa,pwb,t,false,true,true); WAIT_BAR(0); ROT();
  STEP(pA0,pA1,pwb,pwa,NT-1,false,false,false);
  SBAR(); pv(o,vb0+2*sl_cur,PAFX(pwa,0),PAFX(pwa,1),PAFX(pwa,2),PAFX(pwa,3));
  #undef PAFX
  #undef PKW
  #undef VFR
  #undef PIN
  #undef MX3
  #undef GAPA
  #undef GAPB
  #undef EX
  #undef VRD
  #undef KRD
  #undef STEP
  #undef ENDW
  {auto rr=__builtin_amdgcn_permlane32_swap(__float_as_uint(l_reg),__float_as_uint(l_reg),false,false);l_reg=__uint_as_float(rr[0])+__uint_as_float(rr[1]);}
  if(hi==0)wsf[32+r32]=l_reg;asm volatile("s_waitcnt lgkmcnt(0)":::"memory");
  float rli[16];
  #pragma unroll
  for(int r=0;r<16;++r)rli[r]=__builtin_amdgcn_rcpf(wsf[32+crow(r,hi)]);
  bf16*Ow=O+(rowbase+q0+wid*QBLK)*DOP+h*128;
  { bf16*stg=(bf16*)(shm+LDS_OST)+wid*4096;
    #pragma unroll
    for(int r=0;r<16;++r){const int orow=crow(r,hi);
      #pragma unroll
      for(int d0=0;d0<4;++d0)stg[orow*128+d0*32+r32]=__float2bfloat16(o[d0][r]*rli[r]);}
    asm volatile("s_waitcnt lgkmcnt(0)":::"memory");
    #pragma unroll
    for(int i=0;i<8;++i){const int row=i*4+(lane>>4),ch=lane&15; const u32x4 v=*(const u32x4*)(stg+row*128+ch*8); ATTN_STORE16(Ow+(long)row*DOP+ch*8,v);} }
  asm volatile("s_waitcnt lgkmcnt(0)\n\ts_barrier":::"memory");
  #undef DMA_K
  #undef DMA_V
  #undef CMASK
  #undef START
  #undef RESC
  #undef ROT
}
constexpr int ATTN_LDS_BYTES=LDS_BYTES;
struct AttnTensors { const bf16* Q; const bf16* K; const bf16* V; bf16* O; };
struct AttnUnit { int bh; int qb; };
struct StaticOrder {
  int vcu;
  __device__ __forceinline__ explicit StaticOrder(int grid,int block):vcu((block%8)*(grid/8)+block/8){}
  __device__ __forceinline__ bool next(int i,AttnUnit&u)const{ if(i>=2)return false; const int s=vcu&15; u.bh=vcu>>4; u.qb=(i==0)?31-s:s; return true; }
  __device__ __forceinline__ void a_ready(const AttnUnit&)const{}
  __device__ __forceinline__ void done(const AttnUnit&)const{}
};
template<class Sched,int THRL=8> __device__ __forceinline__ void attn_phase(char*lds,const AttnTensors&T,const Sched&S){
  AttnUnit u;
  _Pragma("unroll 1") for(int i=0;S.next(i,u);++i){ S.a_ready(u); attn_unit<THRL>(u.bh/NHEAD,u.bh%NHEAD,u.qb,T.Q,T.K,T.V,T.O,lds); S.done(u); }
}
#undef SBAR
#undef WAIT_BAR
}
#define GAS __attribute__((address_space(1)))
typedef unsigned v4u __attribute__((ext_vector_type(4)));
#define LDS_WAIT() asm volatile("s_waitcnt lgkmcnt(0)" ::: "memory")

#ifndef T_GEMM_Z
#define T_GEMM_Z 1
#endif
#ifndef T_GEMM_GLU
#define T_GEMM_GLU 1
#endif
#ifndef T_GEMM_MIX
#define T_GEMM_MIX 1
#endif
#ifndef T_GEMM_WO
#define T_GEMM_WO 1
#endif
#ifndef T_MOE
#define T_MOE 1
#endif
#ifndef T_WOK
#define T_WOK 1
#endif
#ifndef CP_DEPTH
#define CP_DEPTH 1
#endif
#ifndef CB_UNR
#define CB_UNR 4
#endif
#ifndef XN_UNR
#define XN_UNR 4
#endif
#ifndef T_S5
#define T_S5 1
#endif
#ifndef T_ATTN
#define T_ATTN 2
#endif
#ifndef T_ROUTER
#define T_ROUTER 1
#endif
#ifndef COOP_LAUNCH
#define COOP_LAUNCH 0
#endif
#ifndef T_GATE8
#define T_GATE8 0
#endif
#ifndef T_WO8
#define T_WO8 0
#endif
#ifndef T_MIXCAT
#define T_MIXCAT 1
#endif
#ifndef T_H1B
#define T_H1B 0
#endif
#ifndef DN_LATE
#define DN_LATE 16
#endif
#ifndef DN_MID
#define DN_MID 8
#endif
#ifndef T_FP8
#define T_FP8 1
#endif

template <bool GATHER>
__device__ __forceinline__ void gemm_core(f32x4 (&acc)[2][2], bool act, const bf16_t* __restrict__ A, int lda, const int* __restrict__ rowidx, int m0,
                                          const float* __restrict__ B, int ldb, int n0, int K, bf16_t* As, bf16_t* Bs) {
    const int tid = threadIdx.x & 255, lane = tid & 63, w = tid >> 6, wm = w >> 1, wn = w & 1;
    const int ar = tid >> 2, ak = (tid & 3) * 8, bk = tid >> 3, bn = (tid & 7) * 8;
    int arow = m0 + ar; if (GATHER) arow = act ? rowidx[m0 + ar] : -1;
#pragma unroll
    for (int i = 0; i < 2; ++i)
#pragma unroll
        for (int j = 0; j < 2; ++j) acc[i][j] = (f32x4){0.f, 0.f, 0.f, 0.f};
    for (int k0 = 0; k0 < K; k0 += 32) {
        uint4 av = make_uint4(0, 0, 0, 0); f32x4 b0 = (f32x4){0.f, 0.f, 0.f, 0.f}, b1 = b0;
        if (act) {
            if (arow >= 0) av = *(const uint4*)(A + (size_t)arow * lda + k0 + ak);
            b0 = *(const f32x4*)(B + (size_t)(k0 + bk) * ldb + n0 + bn); b1 = *(const f32x4*)(B + (size_t)(k0 + bk) * ldb + n0 + bn + 4);
        }
        __syncthreads();
        *(uint4*)(As + ar * 40 + ak) = av;
#pragma unroll
        for (int i = 0; i < 4; ++i) { Bs[(bn + i) * 40 + bk] = (bf16_t)f2bf(b0[i]); Bs[(bn + 4 + i) * 40 + bk] = (bf16_t)f2bf(b1[i]); }
        __syncthreads();
        bf16x8 a[2], b[2];
#pragma unroll
        for (int i = 0; i < 2; ++i) { a[i] = *(const bf16x8*)(As + (wm * 32 + i * 16 + (lane & 15)) * 40 + 8 * (lane >> 4)); b[i] = *(const bf16x8*)(Bs + (wn * 32 + i * 16 + (lane & 15)) * 40 + 8 * (lane >> 4)); }
#pragma unroll
        for (int i = 0; i < 2; ++i)
#pragma unroll
            for (int j = 0; j < 2; ++j) acc[i][j] = __builtin_amdgcn_mfma_f32_16x16x32_bf16(a[i], b[j], acc[i][j], 0, 0, 0);
    }
}
#define SG_LOOP(ntm, ntn) \
    bf16_t* As = (bf16_t*)(F.lds + (F.tid >> 8) * 16384); bf16_t* Bs = As + 64 * 40; \
    const int ntiles_ = (ntm) * (ntn), stride_ = 2 * F.G; \
    for (int it_ = 0; it_ * stride_ < ntiles_; ++it_) { \
        int t_ = it_ * stride_ + F.vcu * 2 + (F.tid >> 8); const bool act = t_ < ntiles_; if (!act) t_ = ntiles_ - 1; \
        const int m0 = (t_ / (ntn)) * 64, n0 = (t_ % (ntn)) * 64; (void)m0; (void)n0;
#define SG_END } __syncthreads();
#define EPI_LOOP(...) \
    if (act) { const int lane_ = threadIdx.x & 63, w_ = (threadIdx.x >> 6) & 3, wm_ = w_ >> 1, wn_ = w_ & 1; \
      _Pragma("unroll") for (int mi = 0; mi < 2; ++mi) _Pragma("unroll") for (int ni = 0; ni < 2; ++ni) _Pragma("unroll") for (int r = 0; r < 4; ++r) { \
        const int row = m0 + wm_ * 32 + mi * 16 + (lane_ >> 4) * 4 + r, col = n0 + wn_ * 32 + ni * 16 + (lane_ & 15); __VA_ARGS__ } }

struct CpItem { const float* src; bf16_t* dst; };
__device__ __forceinline__ void cp_load(const CpItem& c, int N, float (&wv)[32], int lane) {
#pragma unroll
    for (int i = 0; i < 32; ++i) wv[i] = __builtin_nontemporal_load(c.src + (size_t)(2 * i + (lane >> 5)) * N + (lane & 31));
}
__device__ __forceinline__ void cp_store(const CpItem& c, int K, const float (&wv)[32], LAS float* scr, int lane) {
#pragma unroll
    for (int i = 0; i < 32; ++i) scr[(2 * i + (lane >> 5)) * 33 + (lane & 31)] = wv[i];
    LDS_WAIT(); asm volatile("" ::: "memory");
    const int cc = lane & 7;
#pragma unroll
    for (int j = 0; j < 4; ++j) { const int n = (lane >> 3) + 8 * j; const LAS float* sp = scr + (8 * cc) * 33 + n;
        v4u o; o.x = pk2(sp[0 * 33], sp[1 * 33]); o.y = pk2(sp[2 * 33], sp[3 * 33]); o.z = pk2(sp[4 * 33], sp[5 * 33]); o.w = pk2(sp[6 * 33], sp[7 * 33]);
        *(GAS v4u*)(c.dst + (size_t)n * K + 8 * cc) = o; }
    LDS_WAIT(); asm volatile("" ::: "memory");
}
__device__ __forceinline__ void cp_store8(const CpItem& c, int K, const float (&wv)[32], LAS float* scr, int lane) {
#pragma unroll
    for (int i = 0; i < 32; ++i) scr[(2 * i + (lane >> 5)) * 33 + (lane & 31)] = wv[i] * 32.f;
    LDS_WAIT(); asm volatile("" ::: "memory");
    const int cc = lane & 3;
#pragma unroll
    for (int j = 0; j < 2; ++j) { const int n = (lane >> 2) + 16 * j; const LAS float* sp = scr + (16 * cc) * 33 + n;
        v4u o; o.x = pg8::pk4_fp8(sp[0 * 33], sp[1 * 33], sp[2 * 33], sp[3 * 33]); o.y = pg8::pk4_fp8(sp[4 * 33], sp[5 * 33], sp[6 * 33], sp[7 * 33]);
        o.z = pg8::pk4_fp8(sp[8 * 33], sp[9 * 33], sp[10 * 33], sp[11 * 33]); o.w = pg8::pk4_fp8(sp[12 * 33], sp[13 * 33], sp[14 * 33], sp[15 * 33]);
        __builtin_nontemporal_store(o, (GAS v4u*)((unsigned char*)c.dst + (size_t)n * K + 16 * cc)); }
    LDS_WAIT(); asm volatile("" ::: "memory");
}
template <int MODE, bool FP8 = false>
__device__ __forceinline__ void cp_set(Frame& F, const float* W, int K, int N, bf16_t* WT, int ne, int ncols = 0, int dpitch = 0, int koff = 0, int gwo = -1, int ngwo = 0) {
    const int gw = gwo >= 0 ? gwo : F.vcu * NWAVES + F.wave, NGW = gwo >= 0 ? ngwo : F.G * NWAVES, lane = F.lane;
    LAS float* scr = (LAS float*)(F.lds3 + F.wave * 16384);
    const int nbn = (ncols ? ncols : N) / 32, ipm = (K / 64) * nbn, nitems = ne * ipm;
    auto dec = [&](int it) { CpItem c; const int e = it / ipm, q = it % ipm, kb = q / nbn, n0 = 32 * (q % nbn);
        const size_t drow = MODE == 0 ? (size_t)e * N + n0 : (size_t)e * 2048 + 256 * (n0 / 128) + 128 * (MODE - 1) + (n0 % 128);
        c.src = W + (size_t)e * K * N + (size_t)(64 * kb) * N + n0; c.dst = FP8 ? (bf16_t*)((unsigned char*)WT + drow * K + 64 * kb) : WT + drow * (dpitch ? dpitch : K) + koff + 64 * kb; return c; };
    int it = gw; if (it >= nitems) return;
#if CP_DEPTH == 2
    CpItem c0 = dec(it), c1 = c0; float wa[32], wb[32], wc[32];
    cp_load(c0, N, wa, lane);
    bool h1 = it + NGW < nitems;
    if (h1) { c1 = dec(it + NGW); cp_load(c1, N, wb, lane); }
    for (;;) {
        const int it2 = it + 2 * NGW; const bool h2 = it2 < nitems; CpItem c2 = c1;
        if (h2) { c2 = dec(it2); cp_load(c2, N, wc, lane); }
        if constexpr (FP8) cp_store8(c0, K, wa, scr, lane); else cp_store(c0, dpitch ? dpitch : K, wa, scr, lane);
        if (!h1) break;
#pragma unroll
        for (int i = 0; i < 32; ++i) { wa[i] = wb[i]; wb[i] = wc[i]; }
        c0 = c1; c1 = c2; h1 = h2; it += NGW;
    }
#else
    CpItem c0 = dec(it); float wa[32], wb[32];
    cp_load(c0, N, wa, lane);
    for (;;) {
        const int itn = it + NGW; const bool hn = itn < nitems; CpItem c1 = c0;
        if (hn) { c1 = dec(itn); cp_load(c1, N, wb, lane); }
        if constexpr (FP8) cp_store8(c0, K, wa, scr, lane); else cp_store(c0, dpitch ? dpitch : K, wa, scr, lane);
        if (!hn) break;
#pragma unroll
        for (int i = 0; i < 32; ++i) wa[i] = wb[i];
        c0 = c1; it = itn;
    }
#endif
}
__device__ __forceinline__ void cp_all(Frame& F) {
    cp_set<0>(F, F.w_in, D, INW, F.Wt_in, 1); if (T_GATE8) cp_set<0, true>(F, F.w_in + 2048, D, INW, F.Wt_in8, 1, 2048); cp_set<0>(F, F.w_glu, SW, SW, F.Wt_glu, 1); if (T_MIXCAT) { cp_set<0>(F, F.w_ao, AW, D, F.Wt_so, 1, 0, 1024, 0); cp_set<0>(F, F.w_so, SW, D, F.Wt_so, 1, 0, 1024, 512); }
    else { cp_set<0>(F, F.w_so, SW, D, F.Wt_so, 1); cp_set<0>(F, F.w_ao, AW, D, F.Wt_ao, 1); } cp_set<0, T_WO8>(F, F.w_o, D, D, F.Wt_o, 1);
    if (T_MOE) { cp_set<1, T_FP8>(F, F.w_gate, D, D, F.Wt_gu, NE); cp_set<2, T_FP8>(F, F.w_up, D, D, F.Wt_gu, NE); cp_set<0, T_FP8>(F, F.w_down, D, D, F.Wt_dn, NE - (T_GEMM_GLU ? DN_LATE : 0) - DN_MID); }
}
__device__ __forceinline__ void p0_meta(Frame& F) {
    float* xm = (float*)F.lds;
    float* red = xm + 16 * 1025;
    const int c = F.tid & 15, kq = F.tid >> 4;
    float wv[32];
    if (F.vcu < INW / 16) {
#pragma unroll
        for (int i = 0; i < 32; ++i) wv[i] = F.w_in[(size_t)(32 * kq + i) * INW + 16 * F.vcu + c]; }
    for (int rr = 0; rr < 2; ++rr) {
        const int row = 2 * F.wave + rr; const float* src = F.meta + (size_t)row * D;
        f32x4 v[4]; float ss = 0.f;
#pragma unroll
        for (int j = 0; j < 4; ++j) { v[j] = *(const f32x4*)(src + 256 * j + 4 * F.lane); ss += v[j][0] * v[j][0] + v[j][1] * v[j][1] + v[j][2] * v[j][2] + v[j][3] * v[j][3]; }
        ss = wave_sum(ss);
        const float rs = rsqrtf(ss * (1.f / D) + EPS);
#pragma unroll
        for (int j = 0; j < 4; ++j) { const f32x4 gg = *(const f32x4*)(F.norm_mix_g + 256 * j + 4 * F.lane);
#pragma unroll
            for (int q = 0; q < 4; ++q) xm[row * 1025 + 256 * j + 4 * F.lane + q] = v[j][q] * rs * gg[q]; }
    }
    __syncthreads();
    for (int cgp = F.vcu; cgp < INW / 16; cgp += F.G) {
        const int col = 16 * cgp + c;
        if (cgp != F.vcu) {
#pragma unroll
            for (int i = 0; i < 32; ++i) wv[i] = F.w_in[(size_t)(32 * kq + i) * INW + col]; }
        float acc[16];
#pragma unroll
        for (int r = 0; r < 16; ++r) acc[r] = 0.f;
#pragma unroll
        for (int i = 0; i < 32; ++i)
#pragma unroll
            for (int r = 0; r < 16; ++r) acc[r] += xm[r * 1025 + 32 * kq + i] * wv[i];
#pragma unroll
        for (int r = 0; r < 16; ++r) red[(kq * 16 + r) * 16 + c] = acc[r];
        __syncthreads();
        if (F.tid < 256) { float v = 0.f;
#pragma unroll
            for (int q = 0; q < 32; ++q) v += red[q * 256 + F.tid];
            F.ZM[(F.tid >> 4) * INW + 16 * cgp + (F.tid & 15)] = (bf16_t)f2bf(v); }
        __syncthreads();
    }
}
__device__ __forceinline__ void s_prologue(Frame& F) {
    if (!(F.mode & 4)) p0_meta(F);
    const int gw = F.vcu * NWAVES + F.wave, NGW = F.G * NWAVES, lane = F.lane;
    if (!(F.mode & 8)) cp_all(F);
    if (!(F.mode & 16)) {
      f32x4 gg[4];
#pragma unroll
      for (int j = 0; j < 4; ++j) gg[j] = *(const f32x4*)(F.norm_mix_g + 256 * j + 4 * lane);
      for (int row0 = gw; row0 < M; row0 += XN_UNR * NGW) {
        f32x4 v[XN_UNR][4];
#pragma unroll
        for (int u = 0; u < XN_UNR; ++u)
#pragma unroll
            for (int j = 0; j < 4; ++j) v[u][j] = __builtin_nontemporal_load((const f32x4*)(F.x + (size_t)(row0 + u * NGW) * D + 256 * j + 4 * lane));
#pragma unroll
        for (int u = 0; u < XN_UNR; ++u) { const int row = row0 + u * NGW; float ss = 0.f;
#pragma unroll
            for (int j = 0; j < 4; ++j) ss += v[u][j][0] * v[u][j][0] + v[u][j][1] * v[u][j][1] + v[u][j][2] * v[u][j][2] + v[u][j][3] * v[u][j][3];
            ss = wave_sum(ss);
            const float rs = rsqrtf(ss * (1.f / D) + EPS);
#pragma unroll
            for (int j = 0; j < 4; ++j) {
                *(uint2*)(F.XN + (size_t)row * D + 256 * j + 4 * lane) = make_uint2(pk2(v[u][j][0] * rs * gg[j][0], v[u][j][1] * rs * gg[j][1]), pk2(v[u][j][2] * rs * gg[j][2], v[u][j][3] * rs * gg[j][3]));
                if (T_GATE8) *(unsigned*)((unsigned char*)F.XN8 + (size_t)row * D + 256 * j + 4 * lane) = pg8::pk4_fp8(v[u][j][0] * rs * gg[j][0], v[u][j][1] * rs * gg[j][1], v[u][j][2] * rs * gg[j][2], v[u][j][3] * rs * gg[j][3]);
            } }
      }
    }
    const int gt = F.vcu * NTHR + F.tid, NGT = F.G * NTHR;
    for (int idx = gt; idx < NG * NP * NC; idx += NGT) {
        const int gp = idx / NC, c = idx % NC, g = gp / NP, p = gp % NP;
        const float lr = fminf(F.a_re[gp], -1e-4f), li = F.a_im[gp], dt = expf(F.log_dt[g]);
        const float mag = expf(lr * dt), ar = mag * cosf(li * dt), ai = mag * sinf(li * dt);
        const float den = lr * lr + li * li, fr = ((ar - 1.f) * lr + ai * li) / den, fi = (ai * lr - (ar - 1.f) * li) / den;
        const float br = F.b_re[gp * NC + c], bi = F.b_im[gp * NC + c]; const float bbr = fr * br - fi * bi, bbi = fr * bi + fi * br;
        F.BB[gp * 32 + c] = bbr; F.BB[gp * 32 + 16 + c] = bbi; F.BBH[gp * 32 + c] = (bf16_t)f2bf(bbr); F.BBH[gp * 32 + 16 + c] = (bf16_t)f2bf(bbi);
        F.CMT[(g * NC + c) * 128 + 2 * p] = (bf16_t)f2bf(F.c_re[(g * NC + c) * NP + p]); F.CMT[(g * NC + c) * 128 + 2 * p + 1] = (bf16_t)f2bf(-F.c_im[(g * NC + c) * NP + p]);
        if (c == 0) { float pr = ar, pi = ai;
            for (int i = 0; i < 6; ++i) { const float nr = pr * pr - pi * pi, ni = 2.f * pr * pi; pr = nr; pi = ni; }
            F.AA[gp * 4 + 0] = ar; F.AA[gp * 4 + 1] = ai; F.AA[gp * 4 + 2] = pr; F.AA[gp * 4 + 3] = pi; }
    }
    if (gt == 0) { float s1 = 0.f, s2 = 0.f; for (int i = 0; i < 64; ++i) { s1 += F.lq1[i] * F.lk1[i]; s2 += F.lq2[i] * F.lk2[i]; } F.LAM[0] = expf(s1) - expf(s2) + 0.2f; }
    for (int i = gt; i < MOE_ROWS; i += NGT) { F.ROWTOK[i] = 0; F.ROWTK[i] = -1; }
}
__device__ __forceinline__ void s_gemm_z(Frame& F) {
    SG_LOOP(M / 64, INW / 64)
        f32x4 acc[2][2];
        gemm_core<false>(acc, act, F.XN, D, nullptr, m0, F.w_in, INW, n0, D, As, Bs);
        EPI_LOOP({ F.Z[(size_t)row * INW + col] = (bf16_t)f2bf(acc[mi][ni][r]); })
    SG_END
}
template <bool FINAL>
__device__ __forceinline__ void s_s5_scan(Frame& F) {
    const int gw = F.vcu * NWAVES + F.wave, NGW = F.G * NWAVES, p = F.lane;
    for (int it = gw; it < BATCH * NCHUNK * NG; it += NGW) {
        const int bc = it / NG, g = it % NG, gp = g * NP + p;
        const int row0 = bc * 64;
        float bbr[16], bbi[16];
#pragma unroll
        for (int c = 0; c < 16; ++c) { bbr[c] = F.BB[gp * 32 + c]; bbi[c] = F.BB[gp * 32 + 16 + c]; }
        const float ar = F.AA[gp * 4], ai = F.AA[gp * 4 + 1];
        float sr = 0.f, si = 0.f;
        const size_t eidx = ((size_t)bc * NG + g) * NP + p;
        float cr[16], ci[16]; float dd = 0.f;
        if (FINAL) { sr = F.SIN[eidx * 2]; si = F.SIN[eidx * 2 + 1];
#pragma unroll
            for (int c = 0; c < 16; ++c) { cr[c] = F.c_re[(g * NC + c) * NP + p]; ci[c] = F.c_im[(g * NC + c) * NP + p]; }
            dd = F.ssm_d[g * NC + (p & 15)]; }
        for (int t = 0; t < 64; ++t) {
            const bf16_t* zr = F.Z + (size_t)(row0 + t) * INW + g * NC;
            const uint4 u0 = *(const uint4*)zr, u1 = *(const uint4*)(zr + 8);
            const unsigned uw[8] = {u0.x, u0.y, u0.z, u0.w, u1.x, u1.y, u1.z, u1.w};
            float bur = 0.f, bui = 0.f;
#pragma unroll
            for (int c = 0; c < 8; ++c) { const float ua = bf2f(uw[c] & 0xffffu), ub = bf2f(uw[c] >> 16); bur += bbr[2 * c] * ua + bbr[2 * c + 1] * ub; bui += bbi[2 * c] * ua + bbi[2 * c + 1] * ub; }
            const float nr = ar * sr - ai * si + bur, ni = ar * si + ai * sr + bui; sr = nr; si = ni;
            if (FINAL) {
                float ymine = 0.f;
#pragma unroll
                for (int c = 0; c < 16; ++c) { const float yc = wave_sum(cr[c] * sr - ci[c] * si); if ((p & 15) == c) ymine = yc; }
                if (p < 16) { const float uu = bf2f(F.Z[(size_t)(row0 + t) * INW + g * NC + p]); F.YS[(size_t)(row0 + t) * SW + g * NC + p] = (bf16_t)f2bf(gelu_tanh(ymine + dd * uu)); }
            }
        }
        if (!FINAL) { F.E[eidx * 2] = sr; F.E[eidx * 2 + 1] = si; }
    }
}
__device__ __forceinline__ void s_s5_carry(Frame& F) {
    const int gt = F.vcu * NTHR + F.tid;
    if (gt < BATCH * NG * NP) {
        const int b = gt / (NG * NP), gp = gt % (NG * NP), g = gp / NP;
        const float ar = F.AA[gp * 4], ai = F.AA[gp * 4 + 1], a64r = F.AA[gp * 4 + 2], a64i = F.AA[gp * 4 + 3];
        float sr = 0.f, si = 0.f;
        for (int t = 0; t < NMETA; ++t) {
            float bur = 0.f, bui = 0.f;
            for (int c = 0; c < NC; ++c) { const float u = bf2f(F.ZM[t * INW + g * NC + c]); bur += F.BB[gp * 32 + c] * u; bui += F.BB[gp * 32 + 16 + c] * u; }
            const float nr = ar * sr - ai * si + bur, ni = ar * si + ai * sr + bui; sr = nr; si = ni;
        }
        for (int c = 0; c < NCHUNK; ++c) {
            const size_t e = ((size_t)(b * NCHUNK + c) * NG * NP + gp) * 2;
            F.SIN[e] = sr; F.SIN[e + 1] = si;
            const float er = F.E[e], ei = F.E[e + 1];
            const float nr = a64r * sr - a64i * si + er, ni = a64r * si + a64i * sr + ei; sr = nr; si = ni;
        }
    }
}
__device__ __forceinline__ void s_qkn(Frame& F) {
    const int gw = F.vcu * NWAVES + F.wave, NGW = F.G * NWAVES, lane = F.lane;
    for (int row = gw; row < M + NMETA; row += NGW) {
        const bf16_t* zr = (row < M ? F.Z + (size_t)row * INW : F.ZM + (size_t)(row - M) * INW) + 512 + 16 * lane;
        const uint4 u0 = *(const uint4*)zr, u1 = *(const uint4*)(zr + 8);
        const unsigned uw[8] = {u0.x, u0.y, u0.z, u0.w, u1.x, u1.y, u1.z, u1.w};
        float v[16]; float ss = 0.f;
#pragma unroll
        for (int c = 0; c < 8; ++c) { v[2 * c] = bf2f(uw[c] & 0xffffu); v[2 * c + 1] = bf2f(uw[c] >> 16); ss += v[2 * c] * v[2 * c] + v[2 * c + 1] * v[2 * c + 1]; }
        ss += __shfl_xor(ss, 1); ss += __shfl_xor(ss, 2);
        const float rs = rsqrtf(ss * (1.f / 64.f) + EPS);
        const float* gg = (lane < 32 ? F.q_g : F.k_g) + 16 * (lane & 3);
        unsigned o[8];
#pragma unroll
        for (int c = 0; c < 8; ++c) o[c] = pk2(v[2 * c] * rs * gg[2 * c], v[2 * c + 1] * rs * gg[2 * c + 1]);
        bf16_t* qr = (row < M ? F.QKN + (size_t)row * D : F.QKNM + (size_t)(row - M) * D) + 16 * lane;
        *(uint4*)qr = make_uint4(o[0], o[1], o[2], o[3]); *(uint4*)(qr + 8) = make_uint4(o[4], o[5], o[6], o[7]);
    }
}
__device__ __forceinline__ void s_attn(Frame& F) {
    const int half = F.tid >> 8, tid = F.tid & 255, qrow = tid >> 2, part = tid & 3;
    float* Ks = (float*)(F.lds + half * 67584); float* Vs = Ks + 64 * 132;
    constexpr int NQB = SEQ / 64;
    for (int it = F.vcu; it < NQB * 2 * BATCH; it += F.G) {
        const int qb = NQB - 1 - it / (2 * BATCH), h = (it & 1) * 2 + half, b = (it >> 1) & 1;
        const int lq = qb * 64 + qrow + NMETA;
        const size_t tq = (size_t)b * SEQ + qb * 64 + qrow;
        float q0[16], q1[16];
        {
            const bf16_t* qp = F.QKN + tq * D + h * 128 + 16 * part;
#pragma unroll
            for (int d = 0; d < 16; ++d) { q0[d] = bf2f(qp[d]) * 0.125f; q1[d] = bf2f(qp[64 + d]) * 0.125f; }
        }
        float m0 = -1e30f, m1 = -1e30f, l0 = 0.f, l1 = 0.f, o0[32], o1[32];
#pragma unroll
        for (int d = 0; d < 32; ++d) { o0[d] = 0.f; o1[d] = 0.f; }
        for (int kt = 0; kt <= qb + 1; ++kt) {
            __syncthreads();
            for (int i = tid; i < 64 * 128; i += 256) {
                const int j = i >> 7, c = i & 127, lk = kt * 64 + j;
                float kv = 0.f, vv = 0.f;
                if (lk < NMETA) { kv = bf2f(F.QKNM[lk * D + 512 + h * 128 + c]); vv = bf2f(F.ZM[lk * INW + 1536 + h * 128 + c]); }
                else if (lk < NMETA + SEQ) { const size_t tk = (size_t)b * SEQ + lk - NMETA; kv = bf2f(F.QKN[tk * D + 512 + h * 128 + c]); vv = bf2f(F.Z[tk * INW + 1536 + h * 128 + c]); }
                Ks[j * 132 + c] = kv; Vs[j * 132 + c] = vv;
            }
            __syncthreads();
            for (int j = 0; j < 64; ++j) {
                const int lk = kt * 64 + j;
                float s0 = 0.f, s1 = 0.f;
#pragma unroll
                for (int d = 0; d < 16; ++d) { s0 += q0[d] * Ks[j * 132 + 16 * part + d]; s1 += q1[d] * Ks[j * 132 + 64 + 16 * part + d]; }
                s0 += __shfl_xor(s0, 1); s0 += __shfl_xor(s0, 2); s1 += __shfl_xor(s1, 1); s1 += __shfl_xor(s1, 2);
                if (lk <= lq) {
                    if (s0 > m0) { const float sc = __expf(m0 - s0); l0 *= sc;
#pragma unroll
                        for (int d = 0; d < 32; ++d) o0[d] *= sc; m0 = s0; }
                    if (s1 > m1) { const float sc = __expf(m1 - s1); l1 *= sc;
#pragma unroll
                        for (int d = 0; d < 32; ++d) o1[d] *= sc; m1 = s1; }
                    const float p0 = __expf(s0 - m0), p1 = __expf(s1 - m1); l0 += p0; l1 += p1;
#pragma unroll
                    for (int d = 0; d < 32; ++d) { const float v = Vs[j * 132 + 32 * part + d]; o0[d] += p0 * v; o1[d] += p1 * v; }
                }
            }
        }
        const float lam = F.LAM[0], i0 = 1.f / l0, i1 = lam / l1;
        float ss = 0.f;
#pragma unroll
        for (int d = 0; d < 32; ++d) { o0[d] = o0[d] * i0 - o1[d] * i1; ss += o0[d] * o0[d]; }
        ss += __shfl_xor(ss, 1); ss += __shfl_xor(ss, 2);
        const float rs = rsqrtf(ss * (1.f / 128.f) + EPS) * 0.8f;
        bf16_t* op = F.YA + tq * AW + h * 128 + 32 * part;
#pragma unroll
        for (int d = 0; d < 32; ++d) op[d] = (bf16_t)f2bf(o0[d] * rs * F.sub_g[32 * part + d]);
    }
    __syncthreads();
}
__device__ __forceinline__ void s_gemm_glu(Frame& F) {
    SG_LOOP(M / 64, SW / 64)
        f32x4 acc[2][2];
        gemm_core<false>(acc, act, F.YS, SW, nullptr, m0, F.w_glu, SW, n0, SW, As, Bs);
        EPI_LOOP({ const float ys = bf2f(F.YS[(size_t)row * SW + col]); F.YS2[(size_t)row * SW + col] = (bf16_t)f2bf(ys * sigmoidf_(acc[mi][ni][r] + F.b_glu[col])); })
    SG_END
}
__device__ __forceinline__ void s_gemm_mix(Frame& F) {
    SG_LOOP(M / 64, D / 64)
        f32x4 acc[2][2], acc2[2][2];
        gemm_core<false>(acc, act, F.YS2, SW, nullptr, m0, F.w_so, D, n0, SW, As, Bs);
        gemm_core<false>(acc2, act, F.YA, AW, nullptr, m0, F.w_ao, D, n0, AW, As, Bs);
        EPI_LOOP({ const float g0 = sigmoidf_(bf2f(F.Z[(size_t)row * INW + 2048 + col])), g1 = sigmoidf_(bf2f(F.Z[(size_t)row * INW + 3072 + col]));
                   F.MIX[(size_t)row * D + col] = (bf16_t)f2bf(g0 * acc[mi][ni][r] + g1 * acc2[mi][ni][r]); })
    SG_END
}
__device__ __forceinline__ void s_gemm_wo(Frame& F) {
    SG_LOOP(M / 64, D / 64)
        f32x4 acc[2][2];
        gemm_core<false>(acc, act, F.MIX, D, nullptr, m0, F.w_o, D, n0, D, As, Bs);
        EPI_LOOP({ const size_t o = (size_t)row * D + col; F.out[o] = F.x[o] + acc[mi][ni][r]; })
    SG_END
}
__device__ __forceinline__ void s_router(Frame& F) {
    const int gw = F.vcu * NWAVES + F.wave, NGW = F.G * NWAVES, lane = F.lane;
    for (int t = gw; t < M; t += NGW) {
        const float* hr = F.out + (size_t)t * D;
        float ss = 0.f;
#pragma unroll
        for (int j = 0; j < 4; ++j) { const f32x4 a = *(const f32x4*)(hr + 256 * j + 4 * lane); ss += a[0] * a[0] + a[1] * a[1] + a[2] * a[2] + a[3] * a[3]; }
        ss = wave_sum(ss);
        const float rs = rsqrtf(ss * (1.f / D) + EPS);
        float lg[NE];
#pragma unroll
        for (int e = 0; e < NE; ++e) lg[e] = 0.f;
#pragma unroll 1
        for (int j = 0; j < 4; ++j) {
            const f32x4 a = *(const f32x4*)(hr + 256 * j + 4 * lane), gg = *(const f32x4*)(F.norm_ffn_g + 256 * j + 4 * lane);
            const f32x4 v = a * rs * gg;
            *(uint2*)(F.XN2 + (size_t)t * D + 256 * j + 4 * lane) = make_uint2(pk2(v[0], v[1]), pk2(v[2], v[3]));
            const float* wr = F.w_router + (size_t)(256 * j + 4 * lane) * NE;
#pragma unroll
            for (int q = 0; q < 4; ++q)
#pragma unroll
                for (int e = 0; e < NE; e += 4) { const f32x4 w4 = *(const f32x4*)(wr + q * NE + e); lg[e] += v[q] * w4[0]; lg[e + 1] += v[q] * w4[1]; lg[e + 2] += v[q] * w4[2]; lg[e + 3] += v[q] * w4[3]; }
        }
#pragma unroll
        for (int e = 0; e < NE; ++e) lg[e] = wave_sum(lg[e]) + F.b_router[e];
        if (lane == 0) {
            int id[4]; float tv[4];
#pragma unroll
            for (int k = 0; k < 4; ++k) {
                float best = -3.4e38f; int bi = 0;
#pragma unroll
                for (int e = 0; e < NE; ++e) { const bool taken = (k > 0 && id[0] == e) || (k > 1 && id[1] == e) || (k > 2 && id[2] == e); if (!taken && lg[e] > best) { best = lg[e]; bi = e; } }
                id[k] = bi; tv[k] = best;
            }
            const float e0 = 1.f, e1 = __expf(tv[1] - tv[0]), e2 = __expf(tv[2] - tv[0]), e3 = __expf(tv[3] - tv[0]), inv = 1.f / (e0 + e1 + e2 + e3);
            const float gw4[4] = {e0 * inv, e1 * inv, e2 * inv, e3 * inv};
#pragma unroll
            for (int k = 0; k < 4; ++k) { F.IDX[t * 4 + k] = id[k]; F.GATE[t * 4 + k] = gw4[k]; F.POS[t * 4 + k] = atomicAdd(&F.CNT[id[k]], 1); }
        }
    }
}
__device__ __forceinline__ void s_scatter(Frame& F) {
    int* offs = (int*)F.lds;
    if (F.tid == 0) { int o = 0; for (int e = 0; e < NE; ++e) { offs[e] = o; o += (F.CNT[e] + 255) / 256 * 256; } offs[NE] = o; }
    __syncthreads();
    if (F.vcu == 0 && F.tid <= NE) F.OFF[F.tid] = offs[F.tid];
    if (F.vcu == 0) for (int mt = F.tid; mt < MOE_ROWS / 256; mt += NTHR) { int e = 0; while (e < NE - 1 && offs[e + 1] <= mt * 256) ++e; F.TEXP[mt] = e; }
    const int gt = F.vcu * NTHR + F.tid, NGT = F.G * NTHR;
    for (int a = gt; a < NASSIGN; a += NGT) { const int r = offs[F.IDX[a]] + F.POS[a]; F.ROWTOK[r] = a >> 2; F.ROWTK[r] = a; }
    __syncthreads();
}
__device__ __forceinline__ void t_scatter(Frame& F) {
    int* psum = (int*)F.lds;
    int* offs = psum + 512;
    int* base = offs + 64;
    int* red = base + 32;
    { const int e = F.tid & 31, part = F.tid >> 5; int sacc = 0;
#pragma unroll
      for (int i = 0; i < 32; ++i) sacc += F.TCNT[(part * 32 + i) * NE + e];
      psum[part * 32 + e] = sacc; }
    __syncthreads();
    if (F.tid < 64) {
        const int e = F.tid & 31; int tot = 0;
#pragma unroll
        for (int p = 0; p < 16; ++p) tot += psum[p * 32 + e];
        const int pad = (tot + 255) / 256 * 256; int inc = pad;
#pragma unroll
        for (int d = 1; d < 32; d <<= 1) { const int u = __shfl_up(inc, d, 32); if (e >= d) inc += u; }
        if (F.tid < 32) { offs[e] = inc - pad; if (e == NE - 1) offs[NE] = inc; }
    }
    __syncthreads();
    if (F.vcu == 0 && F.tid <= NE) F.OFF[F.tid] = offs[F.tid];
    if (F.vcu == 0) for (int mt = F.tid; mt < MOE_ROWS / 256; mt += NTHR) { int e = 0; while (e < NE - 1 && offs[e + 1] <= mt * 256) ++e; F.TEXP[mt] = e; }
    for (int tile = F.vcu; tile < M / 32; tile += F.G) {
        const int part = tile >> 5, li = tile & 31;
        { const int e = F.tid & 31, i = F.tid >> 5;
          int v = 0; if (i < li) v = F.TCNT[(part * 32 + i) * NE + e]; if (i + 16 < li) v += F.TCNT[(part * 32 + i + 16) * NE + e];
          red[i * 32 + e] = v; }
        __syncthreads();
        if (F.tid < 32) { int b = offs[F.tid];
            for (int p = 0; p < part; ++p) b += psum[p * 32 + F.tid];
#pragma unroll
            for (int i = 0; i < 16; ++i) b += red[i * 32 + F.tid];
            base[F.tid] = b; }
        __syncthreads();
        if (F.tid < 128) { const int a = tile * 128 + F.tid, r = base[F.IDX[a]] + F.POS[a]; F.ROWTOK[r] = a >> 2; F.ROWTK[r] = a; }
        __syncthreads();
    }
}
__device__ __forceinline__ int tile_expert(const int* OFF, int m0) { int e = 0; while (e < NE - 1 && OFF[e + 1] <= m0) ++e; return e; }
__device__ __forceinline__ void s_moe1(Frame& F) {
    const int nrows = F.OFF[NE];
    SG_LOOP(nrows / 64, D / 64)
        const int e = tile_expert(F.OFF, m0);
        f32x4 acc[2][2], acc2[2][2];
        gemm_core<true>(acc, act, F.XN2, D, F.ROWTOK, m0, F.w_gate + (size_t)e * D * D, D, n0, D, As, Bs);
        gemm_core<true>(acc2, act, F.XN2, D, F.ROWTOK, m0, F.w_up + (size_t)e * D * D, D, n0, D, As, Bs);
        EPI_LOOP({ const float gg = fminf(acc[mi][ni][r] + F.b_gate[e * D + col], 7.f), uu = fminf(fmaxf(acc2[mi][ni][r] + F.b_up[e * D + col], -7.f), 7.f);
                   F.ACT[(size_t)row * D + col] = (bf16_t)f2bf((uu + 1.f) * (gg * sigmoidf_(1.702f * gg))); })
    SG_END
}
__device__ __forceinline__ void s_moe2(Frame& F) {
    const int nrows = F.OFF[NE];
    SG_LOOP(nrows / 64, D / 64)
        const int e = tile_expert(F.OFF, m0);
        f32x4 acc[2][2];
        gemm_core<false>(acc, act, F.ACT, D, nullptr, m0, F.w_down + (size_t)e * D * D, D, n0, D, As, Bs);
        EPI_LOOP({ const int tk = F.ROWTK[row]; if (tk >= 0) F.Y2[(size_t)tk * D + col] = (bf16_t)f2bf(acc[mi][ni][r] + F.b_down[e * D + col]); })
    SG_END
}
__device__ __forceinline__ void s_combine(Frame& F) {
    const int gw = F.vcu * NWAVES + F.wave, NGW = F.G * NWAVES, c = F.lane * 16;
    for (int t0 = gw * CB_UNR; t0 < M; t0 += NGW * CB_UNR) {
        f32x4 o[CB_UNR][4]; uint4 y[CB_UNR][4][2]; float gwt[CB_UNR][4];
#pragma unroll
        for (int u = 0; u < CB_UNR; ++u) { const int t = t0 + u;
            if (T_H1B) { const uint4 h0 = *(const uint4*)(F.H1B + (size_t)t * D + c), h1 = *(const uint4*)(F.H1B + (size_t)t * D + c + 8);
                o[u][0] = (f32x4){bf2f(h0.x & 0xffffu), bf2f(h0.x >> 16), bf2f(h0.y & 0xffffu), bf2f(h0.y >> 16)}; o[u][1] = (f32x4){bf2f(h0.z & 0xffffu), bf2f(h0.z >> 16), bf2f(h0.w & 0xffffu), bf2f(h0.w >> 16)};
                o[u][2] = (f32x4){bf2f(h1.x & 0xffffu), bf2f(h1.x >> 16), bf2f(h1.y & 0xffffu), bf2f(h1.y >> 16)}; o[u][3] = (f32x4){bf2f(h1.z & 0xffffu), bf2f(h1.z >> 16), bf2f(h1.w & 0xffffu), bf2f(h1.w >> 16)}; }
            else
#pragma unroll
            for (int q = 0; q < 4; ++q) o[u][q] = *(const f32x4*)(F.out + (size_t)t * D + c + 4 * q);
#pragma unroll
            for (int k = 0; k < 4; ++k) { gwt[u][k] = F.GATE[t * 4 + k];
                if (T_FP8) { const v4u yv = __builtin_nontemporal_load((const v4u*)((const unsigned char*)F.Y2 + (size_t)(t * 4 + k) * D + c)); y[u][k][0] = make_uint4(yv[0], yv[1], yv[2], yv[3]); y[u][k][1] = y[u][k][0]; }
                else { y[u][k][0] = *(const uint4*)(F.Y2 + (size_t)(t * 4 + k) * D + c); y[u][k][1] = *(const uint4*)(F.Y2 + (size_t)(t * 4 + k) * D + c + 8); } } }
#pragma unroll
        for (int u = 0; u < CB_UNR; ++u) { const int t = t0 + u;
#pragma unroll
            for (int k = 0; k < 4; ++k) { const float gk = gwt[u][k];
                if (T_FP8) { const uint4 v = y[u][k][0]; const unsigned wv[4] = {v.x, v.y, v.z, v.w};
#pragma unroll
                    for (int q = 0; q < 4; ++q) { typedef float f32x2_ __attribute__((ext_vector_type(2)));
                        const f32x2_ lo = __builtin_amdgcn_cvt_pk_f32_fp8((int)wv[q], false), hi = __builtin_amdgcn_cvt_pk_f32_fp8((int)wv[q], true);
                        o[u][q][0] += gk * lo[0]; o[u][q][1] += gk * lo[1]; o[u][q][2] += gk * hi[0]; o[u][q][3] += gk * hi[1]; } }
                else {
#pragma unroll
                for (int hh = 0; hh < 2; ++hh) { const uint4 v = y[u][k][hh]; const unsigned wv[4] = {v.x, v.y, v.z, v.w};
#pragma unroll
                    for (int q = 0; q < 4; ++q) { o[u][2 * hh + (q >> 1)][2 * (q & 1)] += gk * bf2f(wv[q] & 0xffffu); o[u][2 * hh + (q >> 1)][2 * (q & 1) + 1] += gk * bf2f(wv[q] >> 16); } } } }
#pragma unroll
            for (int q = 0; q < 4; ++q) __builtin_nontemporal_store(o[u][q], (f32x4*)(F.out + (size_t)t * D + c + 4 * q)); }
    }
}

typedef float f32x16 __attribute__((ext_vector_type(16)));
__device__ __forceinline__ void cmul(float ar, float ai, float br, float bi, float& cr, float& ci) { cr = ar * br - ai * bi; ci = ar * bi + ai * br; }
template <bool FINAL>
__device__ __forceinline__ void t_s5_pass(Frame& F) {
    const int gw = F.vcu * NWAVES + F.wave, NGW = F.G * NWAVES, lane = F.lane, r32 = lane & 31, hi = lane >> 5;
    LAS unsigned char* sl = F.lds3 + F.wave * 17408;
    const int wpg = NGW / NG, g = gw / wpg, w0 = gw % wpg;
    if (g >= NG) return;
    bf16x8 bfr[4];
#pragma unroll
    for (int nt = 0; nt < 4; ++nt) bfr[nt] = *(const bf16x8*)(F.BBH + (size_t)(g * NP + 32 * (nt & 1) + r32) * 32 + 16 * (nt >> 1) + 8 * hi);
    float aar[2], aai[2];
#pragma unroll
    for (int set = 0; set < 2; ++set) { aar[set] = F.AA[(g * NP + 32 * set + r32) * 4]; aai[set] = F.AA[(g * NP + 32 * set + r32) * 4 + 1]; }
    bf16x8 afn[2];
    if (w0 < BATCH * NCHUNK) { afn[0] = *(const bf16x8*)(F.Z + ((size_t)w0 * 64 + r32) * INW + g * NC + 8 * hi); afn[1] = *(const bf16x8*)(F.Z + ((size_t)w0 * 64 + 32 + r32) * INW + g * NC + 8 * hi); }
    const int c16 = lane & 15, q = lane >> 4;
    bf16x8 cfr[4]; f32x4 dv = {};
    if (FINAL) {
#pragma unroll
        for (int ks = 0; ks < 4; ++ks) cfr[ks] = *(const bf16x8*)(F.CMT + (size_t)(g * NC + c16) * 128 + ks * 32 + 8 * q);
        dv = *(const f32x4*)(F.ssm_d + g * NC + 4 * q); }
    for (int bc = w0; bc < BATCH * NCHUNK; bc += wpg) {
        const size_t tok0 = (size_t)bc * 64;
        uint2 uu[4]; float sin0[2][2] = {{0.f, 0.f}, {0.f, 0.f}};
        if (FINAL) {
#pragma unroll
            for (int set = 0; set < 2; ++set) { const size_t e = ((size_t)bc * NG * NP + g * NP + 32 * set + r32) * 2; sin0[set][0] = F.SIN[e]; sin0[set][1] = F.SIN[e + 1]; }
#pragma unroll
            for (int t4 = 0; t4 < 4; ++t4) uu[t4] = *(const uint2*)(F.Z + (tok0 + 16 * t4 + c16) * INW + g * NC + 4 * q); }
        const bf16x8 afr0 = afn[0], afr1 = afn[1];
        if (bc + wpg < BATCH * NCHUNK) { const size_t tn = (size_t)(bc + wpg) * 64; afn[0] = *(const bf16x8*)(F.Z + (tn + r32) * INW + g * NC + 8 * hi); afn[1] = *(const bf16x8*)(F.Z + (tn + 32 + r32) * INW + g * NC + 8 * hi); }
        f32x16 bu[2][4];
#pragma unroll
        for (int nt = 0; nt < 4; ++nt) { f32x16 z = {}; bu[0][nt] = __builtin_amdgcn_mfma_f32_32x32x16_bf16(afr0, bfr[nt], z, 0, 0, 0); bu[1][nt] = __builtin_amdgcn_mfma_f32_32x32x16_bf16(afr1, bfr[nt], z, 0, 0, 0); }
        float ssr[2][2][16], ssi[2][2][16];
#pragma unroll
        for (int set = 0; set < 2; ++set) {
            const int p = 32 * set + r32, gp = g * NP + p;
            const float ar = aar[set], ai = aai[set];
            float a2r, a2i, a3r, a3i, a4r, a4i; cmul(ar, ai, ar, ai, a2r, a2i); cmul(a2r, a2i, ar, ai, a3r, a3i); cmul(a2r, a2i, a2r, a2i, a4r, a4i);
            float lr[8][4], li[8][4];
#pragma unroll
            for (int jj = 0; jj < 8; ++jj) {
                const int tt = jj >> 2, rb = jj & 3; float sr = 0.f, si = 0.f;
#pragma unroll
                for (int i = 0; i < 4; ++i) { const float br = bu[tt][set][4 * rb + i], bi = bu[tt][2 + set][4 * rb + i]; const float nr = ar * sr - ai * si + br, ni = ar * si + ai * sr + bi; sr = nr; si = ni; lr[jj][i] = sr; li[jj][i] = si; }
            }
            float cr = 0.f, ci = 0.f, sinr[8] = {0.f, 0.f, 0.f, 0.f, 0.f, 0.f, 0.f, 0.f}, sini[8] = {0.f, 0.f, 0.f, 0.f, 0.f, 0.f, 0.f, 0.f};
            if (FINAL) { cr = sin0[set][0]; ci = sin0[set][1]; }
#pragma unroll
            for (int j = 0; j < 16; ++j) {
                const int jj = j >> 1; const bool mine = (hi == (j & 1));
                sinr[jj] = mine ? cr : sinr[jj]; sini[jj] = mine ? ci : sini[jj];
                const float mr = a4r * cr - a4i * ci + lr[jj][3], mi = a4r * ci + a4i * cr + li[jj][3];
                const auto sr2 = __builtin_amdgcn_permlane32_swap(__float_as_uint(mr), __float_as_uint(mr), false, false), si2 = __builtin_amdgcn_permlane32_swap(__float_as_uint(mi), __float_as_uint(mi), false, false);
                cr = __uint_as_float(sr2[j & 1]); ci = __uint_as_float(si2[j & 1]);
            }
            if (!FINAL) { if (hi == 0) { const size_t e = (((size_t)(bc / NCHUNK) * NG * NP + gp) * NCHUNK + (bc % NCHUNK)) * 2; F.E[e] = cr; F.E[e + 1] = ci; } }
            else {
#pragma unroll
                for (int jj = 0; jj < 8; ++jj) {
                    const int tt = jj >> 2, rb = jj & 3;
                    const float pw_r[4] = {ar, a2r, a3r, a4r}, pw_i[4] = {ai, a2i, a3i, a4i};
#pragma unroll
                    for (int i = 0; i < 4; ++i) { ssr[set][tt][4 * rb + i] = lr[jj][i] + pw_r[i] * sinr[jj] - pw_i[i] * sini[jj]; ssi[set][tt][4 * rb + i] = li[jj][i] + pw_r[i] * sini[jj] + pw_i[i] * sinr[jj]; }
                }
            }
        }
        if (FINAL) {
#pragma unroll
            for (int set = 0; set < 2; ++set)
#pragma unroll
                for (int tt = 0; tt < 2; ++tt)
#pragma unroll
                    for (int r = 0; r < 16; ++r) { const int t = 32 * tt + 8 * (r >> 2) + 4 * hi + (r & 3);
                        *(LAS unsigned*)(sl + t * 272 + (32 * set + r32) * 4) = pk2(ssr[set][tt][r], ssi[set][tt][r]); }
            LDS_WAIT();
            f32x4 yacc[4];
#pragma unroll
            for (int t4 = 0; t4 < 4; ++t4) yacc[t4] = (f32x4){0.f, 0.f, 0.f, 0.f};
#pragma unroll
            for (int ks = 0; ks < 4; ++ks) {
                const bf16x8 cf = cfr[ks];
#pragma unroll
                for (int t4 = 0; t4 < 4; ++t4) { const bf16x8 sf = *(const LAS bf16x8*)(sl + (16 * t4 + c16) * 272 + (ks * 32 + 8 * q) * 2);
                    yacc[t4] = __builtin_amdgcn_mfma_f32_16x16x32_bf16(cf, sf, yacc[t4], 0, 0, 0); }
            }
            LDS_WAIT();
#pragma unroll
            for (int t4 = 0; t4 < 4; ++t4) {
                const size_t tok = tok0 + 16 * t4 + c16;
                const float y0 = gelu_tanh(yacc[t4][0] + dv[0] * bf2f(uu[t4].x & 0xffffu)), y1 = gelu_tanh(yacc[t4][1] + dv[1] * bf2f(uu[t4].x >> 16)),
                            y2 = gelu_tanh(yacc[t4][2] + dv[2] * bf2f(uu[t4].y & 0xffffu)), y3 = gelu_tanh(yacc[t4][3] + dv[3] * bf2f(uu[t4].y >> 16));
                *(uint2*)(F.YS + tok * SW + g * NC + 4 * q) = make_uint2(pk2(y0, y1), pk2(y2, y3));
            }
        }
    }
}
__device__ __forceinline__ void t_s5_carry(Frame& F) {
    const int gw = F.vcu * NWAVES + F.wave, NGW = F.G * NWAVES, lane = F.lane;
    for (int ch = gw; ch < BATCH * NG * NP; ch += NGW) {
        const int b = ch / (NG * NP), gp = ch % (NG * NP), g = gp / NP;
        const float ar = F.AA[gp * 4], ai = F.AA[gp * 4 + 1], Ar = F.AA[gp * 4 + 2], Ai = F.AA[gp * 4 + 3];
        const float* e = F.E + (size_t)ch * NCHUNK * 2;
        float v0r = e[2 * lane], v0i = e[2 * lane + 1], v1r = e[2 * (64 + lane)], v1i = e[2 * (64 + lane) + 1];
        float mr, mi;
        { const int tm = lane >> 2, cq = lane & 3;
          const uint2 zz = *(const uint2*)(F.ZM + (size_t)tm * INW + g * NC + 4 * cq);
          const f32x4 bbr = *(const f32x4*)(F.BB + gp * 32 + 4 * cq), bbi = *(const f32x4*)(F.BB + gp * 32 + 16 + 4 * cq);
          const float u0 = bf2f(zz.x & 0xffffu), u1 = bf2f(zz.x >> 16), u2 = bf2f(zz.y & 0xffffu), u3 = bf2f(zz.y >> 16);
          float bur = bbr[0] * u0 + bbr[1] * u1 + bbr[2] * u2 + bbr[3] * u3, bui = bbi[0] * u0 + bbi[1] * u1 + bbi[2] * u2 + bbi[3] * u3;
          bur += __shfl_xor(bur, 1); bui += __shfl_xor(bui, 1); bur += __shfl_xor(bur, 2); bui += __shfl_xor(bui, 2);
          float wr = 1.f, wi = 0.f, xr = ar, xi = ai;
#pragma unroll
          for (int bit = 0; bit < 4; ++bit) { if (((NMETA - 1 - tm) >> bit) & 1) { const float nr = wr * xr - wi * xi, ni = wr * xi + wi * xr; wr = nr; wi = ni; } const float nr = xr * xr - xi * xi, ni = 2.f * xr * xi; xr = nr; xi = ni; }
          float cr_ = cq ? 0.f : wr * bur - wi * bui, ci_ = cq ? 0.f : wr * bui + wi * bur;
          mr = wave_sum(cr_); mi = wave_sum(ci_); }
        float pr = Ar, pi = Ai;
#pragma unroll
        for (int d = 1; d < 64; d <<= 1) {
            const float u0r = __shfl_up(v0r, d), u0i = __shfl_up(v0i, d), u1r = __shfl_up(v1r, d), u1i = __shfl_up(v1i, d);
            if (lane >= d) { v0r += pr * u0r - pi * u0i; v0i += pr * u0i + pi * u0r; v1r += pr * u1r - pi * u1i; v1i += pr * u1i + pi * u1r; }
            const float nr = pr * pr - pi * pi, ni = 2.f * pr * pi; pr = nr; pi = ni;
        }
        float qr = 1.f, qi = 0.f, br_ = Ar, bi_ = Ai;
#pragma unroll
        for (int bit = 0; bit < 7; ++bit) { if (((lane + 1) >> bit) & 1) { const float nr = qr * br_ - qi * bi_, ni = qr * bi_ + qi * br_; qr = nr; qi = ni; } const float nr = br_ * br_ - bi_ * bi_, ni = 2.f * br_ * bi_; br_ = nr; bi_ = ni; }
        const float x0r = v0r + qr * mr - qi * mi, x0i = v0i + qr * mi + qi * mr;
        const float t0r = __shfl(x0r, 63), t0i = __shfl(x0i, 63);
        const float x1r = v1r + qr * t0r - qi * t0i, x1i = v1i + qr * t0i + qi * t0r;
        float* so = F.SIN + ((size_t)b * NCHUNK * NG * NP + gp) * 2;
        const size_t cs = (size_t)NG * NP * 2;
        if (lane == 0) { so[0] = mr; so[1] = mi; }
        so[(size_t)(lane + 1) * cs] = x0r; so[(size_t)(lane + 1) * cs + 1] = x0i;
        if (lane < 63) { so[(size_t)(lane + 65) * cs] = x1r; so[(size_t)(lane + 65) * cs + 1] = x1i; }
    }
}

__device__ __forceinline__ void rt_split(const f32x4& x0, const f32x4& x1, bf16x8& hi, bf16x8& lo) {
    unsigned hw[4], lw[4];
#pragma unroll
    for (int p = 0; p < 4; ++p) { const float a = p < 2 ? x0[2 * p] : x1[2 * p - 4], b = p < 2 ? x0[2 * p + 1] : x1[2 * p - 3];
        const unsigned ha = f2bf(a), hb = f2bf(b); hw[p] = ha | (hb << 16); lw[p] = pk2(a - bf2f(ha), b - bf2f(hb)); }
    hi = __builtin_bit_cast(bf16x8, (v4u){hw[0], hw[1], hw[2], hw[3]}); lo = __builtin_bit_cast(bf16x8, (v4u){lw[0], lw[1], lw[2], lw[3]});
}
#ifndef T_ROUTER2
#define T_ROUTER2 1
#endif
#ifndef T_ALT
#define T_ALT 1
#endif
#if T_ROUTER2
__device__ __forceinline__ void t_router(Frame& F) {
    const int lane = F.lane, w = F.wave, i32 = lane & 31, h = lane >> 5, kb = 128 * w + 64 * h;
    constexpr int TP = 1028;
    float* tileb = (float*)F.lds;
    float* part = tileb;
    float* lgs = tileb + 32 * TP;
    float* rsv = lgs + 2 * 32 * 33;
    int* cntl = (int*)(rsv + 64);
    bf16x8 bhi[8], blo[8];
#pragma unroll
    for (int s8 = 0; s8 < 8; ++s8) { f32x4 b0, b1;
#pragma unroll
        for (int q = 0; q < 4; ++q) { b0[q] = F.norm_ffn_g[kb + 8 * s8 + q] * F.w_router[(size_t)(kb + 8 * s8 + q) * NE + i32]; b1[q] = F.norm_ffn_g[kb + 8 * s8 + 4 + q] * F.w_router[(size_t)(kb + 8 * s8 + 4 + q) * NE + i32]; }
        rt_split(b0, b1, bhi[s8], blo[s8]); }
    f32x4 gg[4];
#pragma unroll
    for (int j = 0; j < 4; ++j) gg[j] = *(const f32x4*)(F.norm_ffn_g + 256 * j + 4 * lane);
    f32x4 R[16];
    auto ld = [&](int tile) {
#pragma unroll
        for (int r = 0; r < 4; ++r)
#pragma unroll
            for (int j = 0; j < 4; ++j) R[4 * r + j] = *(const f32x4*)(F.out + (size_t)(tile * 32 + 4 * w + r) * D + 256 * j + 4 * lane); };
    if (F.vcu < M / 32) ld(F.vcu);
    for (int t0 = F.vcu; t0 < M / 32; t0 += 2 * F.G) {
        const int t1 = t0 + F.G; const bool has1 = t1 < M / 32;
        if (F.tid < 64) cntl[F.tid] = 0;
        for (int tl = 0; tl < 2; ++tl) {
            if (tl == 1 && !has1) break;
            const int tile = tl ? t1 : t0;
#pragma unroll
            for (int r = 0; r < 4; ++r) { float ss = 0.f;
#pragma unroll
                for (int j = 0; j < 4; ++j) { const f32x4 v = R[4 * r + j]; ss += v[0] * v[0] + v[1] * v[1] + v[2] * v[2] + v[3] * v[3]; *(f32x4*)(tileb + (4 * w + r) * TP + 256 * j + 4 * lane) = v; }
                ss = wave_sum(ss);
                const float rs = rsqrtf(ss * (1.f / D) + EPS);
                if (lane == 0) rsv[tl * 32 + 4 * w + r] = rs;
                if (!(F.mode & 2)) { const size_t tok = (size_t)tile * 32 + 4 * w + r;
#pragma unroll
                    for (int j = 0; j < 4; ++j) { const f32x4 xv = R[4 * r + j] * rs * gg[j];
                        if (T_FP8) *(unsigned*)((unsigned char*)F.XN2 + tok * D + 256 * j + 4 * lane) = pg8::pk4_fp8(xv[0], xv[1], xv[2], xv[3]);
                        else *(uint2*)(F.XN2 + tok * D + 256 * j + 4 * lane) = make_uint2(pk2(xv[0], xv[1]), pk2(xv[2], xv[3])); } }
            }
            { const int nt = tl == 0 ? (has1 ? t1 : -1) : (t0 + 2 * F.G < M / 32 ? t0 + 2 * F.G : -1); if (nt >= 0) ld(nt); }
            __syncthreads();
            f32x16 acc = {};
#pragma unroll
            for (int s8 = 0; s8 < 8; ++s8) { const float* ap = tileb + i32 * TP + kb + 8 * s8; bf16x8 ahi, alo; rt_split(*(const f32x4*)ap, *(const f32x4*)(ap + 4), ahi, alo);
                acc = __builtin_amdgcn_mfma_f32_32x32x16_bf16(ahi, bhi[s8], acc, 0, 0, 0); acc = __builtin_amdgcn_mfma_f32_32x32x16_bf16(ahi, blo[s8], acc, 0, 0, 0); acc = __builtin_amdgcn_mfma_f32_32x32x16_bf16(alo, bhi[s8], acc, 0, 0, 0); }
            __syncthreads();
#pragma unroll
            for (int r = 0; r < 16; ++r) part[(w * 32 + (r & 3) + 8 * (r >> 2) + 4 * h) * 33 + i32] = acc[r];
            __syncthreads();
#pragma unroll
            for (int rep = 0; rep < 2; ++rep) { const int idx = F.tid + 512 * rep, ti = idx >> 5, tj = idx & 31; float v = 0.f;
#pragma unroll
                for (int ww = 0; ww < 8; ++ww) v += part[(ww * 32 + ti) * 33 + tj];
                lgs[(tl * 32 + ti) * 33 + tj] = v; }
            __syncthreads();
        }
        if (w == 0 && (h == 0 || has1) && !(F.mode & 1)) {
            const int tile = h ? t1 : t0, t = tile * 32 + i32; const float rs = rsv[lane];
            float lg[NE];
#pragma unroll
            for (int e = 0; e < NE; ++e) lg[e] = lgs[lane * 33 + e] * rs + F.b_router[e];
            int id[4]; float tv[4];
#pragma unroll
            for (int k = 0; k < 4; ++k) {
                float best = -3.4e38f; int bi = 0;
#pragma unroll
                for (int e = 0; e < NE; ++e) { const bool taken = (k > 0 && id[0] == e) || (k > 1 && id[1] == e) || (k > 2 && id[2] == e); if (!taken && lg[e] > best) { best = lg[e]; bi = e; } }
                id[k] = bi; tv[k] = best;
            }
            const float e0 = 1.f, e1 = __expf(tv[1] - tv[0]), e2 = __expf(tv[2] - tv[0]), e3 = __expf(tv[3] - tv[0]), inv = 1.f / (e0 + e1 + e2 + e3);
            const float gw4[4] = {e0 * inv, e1 * inv, e2 * inv, e3 * inv};
#pragma unroll
            for (int k = 0; k < 4; ++k) { F.IDX[t * 4 + k] = id[k]; F.GATE[t * 4 + k] = gw4[k]; F.POS[t * 4 + k] = atomicAdd(&cntl[32 * h + id[k]], 1); }
            F.TCNT[tile * NE + i32] = cntl[lane];
        }
        __syncthreads();
    }
}
#else
__device__ __forceinline__ void t_router(Frame& F) {
    const int lane = F.lane, w = F.wave, i32 = lane & 31, h = lane >> 5, kb = 128 * w + 64 * h;
    float* part = (float*)F.lds;
    float* ssp = part + 8 * 32 * 33;
    float* lgs = ssp + 8 * 64;
    float* rsv = lgs + 32 * 33;
    int* cntl = (int*)(rsv + 32);
    bf16x8 bhi[8], blo[8];
#pragma unroll
    for (int s8 = 0; s8 < 8; ++s8) { f32x4 b0, b1;
#pragma unroll
        for (int q = 0; q < 4; ++q) { b0[q] = F.norm_ffn_g[kb + 8 * s8 + q] * F.w_router[(size_t)(kb + 8 * s8 + q) * NE + i32]; b1[q] = F.norm_ffn_g[kb + 8 * s8 + 4 + q] * F.w_router[(size_t)(kb + 8 * s8 + 4 + q) * NE + i32]; }
        rt_split(b0, b1, bhi[s8], blo[s8]); }
    f32x4 a[16];
    for (int tile = F.vcu; tile < M / 32; tile += F.G) {
        const int tok0 = tile * 32;
        if (T_H1B) { const bf16_t* hb = F.H1B + (size_t)(tok0 + i32) * D + kb;
#pragma unroll
          for (int q = 0; q < 8; ++q) { const uint4 v = *(const uint4*)(hb + 8 * q);
              a[2 * q] = (f32x4){bf2f(v.x & 0xffffu), bf2f(v.x >> 16), bf2f(v.y & 0xffffu), bf2f(v.y >> 16)}; a[2 * q + 1] = (f32x4){bf2f(v.z & 0xffffu), bf2f(v.z >> 16), bf2f(v.w & 0xffffu), bf2f(v.w >> 16)}; } }
        else { const float* hr = F.out + (size_t)(tok0 + i32) * D + kb;
#pragma unroll
          for (int q = 0; q < 16; ++q) a[q] = *(const f32x4*)(hr + 4 * q); }
        float ss = 0.f;
#pragma unroll
        for (int q = 0; q < 16; ++q) ss += a[q][0] * a[q][0] + a[q][1] * a[q][1] + a[q][2] * a[q][2] + a[q][3] * a[q][3];
        f32x16 acc = {};
#pragma unroll
        for (int s8 = 0; s8 < 8; ++s8) { bf16x8 ahi, alo; rt_split(a[2 * s8], a[2 * s8 + 1], ahi, alo);
            acc = __builtin_amdgcn_mfma_f32_32x32x16_bf16(ahi, bhi[s8], acc, 0, 0, 0); acc = __builtin_amdgcn_mfma_f32_32x32x16_bf16(ahi, blo[s8], acc, 0, 0, 0); acc = __builtin_amdgcn_mfma_f32_32x32x16_bf16(alo, bhi[s8], acc, 0, 0, 0); }
#pragma unroll
        for (int r = 0; r < 16; ++r) part[(w * 32 + (r & 3) + 8 * (r >> 2) + 4 * h) * 33 + i32] = acc[r];
        ssp[w * 64 + lane] = ss;
        if (F.tid < 32) cntl[F.tid] = 0;
        __syncthreads();
#pragma unroll
        for (int rep = 0; rep < 2; ++rep) { const int idx = F.tid + 512 * rep, ti = idx >> 5, tj = idx & 31; float v = 0.f;
#pragma unroll
            for (int ww = 0; ww < 8; ++ww) v += part[(ww * 32 + ti) * 33 + tj];
            lgs[ti * 33 + tj] = v; }
        if (F.tid < 32) { float v = 0.f;
#pragma unroll
            for (int ww = 0; ww < 8; ++ww) v += ssp[ww * 64 + F.tid] + ssp[ww * 64 + 32 + F.tid];
            rsv[F.tid] = rsqrtf(v * (1.f / D) + EPS); }
        __syncthreads();
        const float rs = rsv[i32];
        if (w == 0 && lane < 32 && !(F.mode & 1)) {
            const int t = tok0 + lane;
            float lg[NE];
#pragma unroll
            for (int e = 0; e < NE; ++e) lg[e] = lgs[lane * 33 + e] * rs + F.b_router[e];
            int id[4]; float tv[4];
#pragma unroll
            for (int k = 0; k < 4; ++k) {
                float best = -3.4e38f; int bi = 0;
#pragma unroll
                for (int e = 0; e < NE; ++e) { const bool taken = (k > 0 && id[0] == e) || (k > 1 && id[1] == e) || (k > 2 && id[2] == e); if (!taken && lg[e] > best) { best = lg[e]; bi = e; } }
                id[k] = bi; tv[k] = best;
            }
            const float e0 = 1.f, e1 = __expf(tv[1] - tv[0]), e2 = __expf(tv[2] - tv[0]), e3 = __expf(tv[3] - tv[0]), inv = 1.f / (e0 + e1 + e2 + e3);
            const float gw4[4] = {e0 * inv, e1 * inv, e2 * inv, e3 * inv};
#pragma unroll
            for (int k = 0; k < 4; ++k) { F.IDX[t * 4 + k] = id[k]; F.GATE[t * 4 + k] = gw4[k]; F.POS[t * 4 + k] = atomicAdd(&cntl[id[k]], 1); }
            F.TCNT[tile * NE + lane] = cntl[lane];
        }
        if (!(F.mode & 2)) {
            bf16_t* xo = F.XN2 + (size_t)(tok0 + i32) * D + kb;
#pragma unroll
            for (int q = 0; q < 16; q += 4) { f32x4 xv[4];
#pragma unroll
                for (int u = 0; u < 4; ++u) xv[u] = a[q + u] * rs * *(const f32x4*)(F.norm_ffn_g + kb + 4 * (q + u));
                if (T_FP8) *(uint4*)((unsigned char*)F.XN2 + (size_t)(tok0 + i32) * D + kb + 4 * q) = make_uint4(pg8::pk4_fp8(xv[0][0], xv[0][1], xv[0][2], xv[0][3]), pg8::pk4_fp8(xv[1][0], xv[1][1], xv[1][2], xv[1][3]),
                                                                                                               pg8::pk4_fp8(xv[2][0], xv[2][1], xv[2][2], xv[2][3]), pg8::pk4_fp8(xv[3][0], xv[3][1], xv[3][2], xv[3][3]));
                else { *(uint4*)(xo + 4 * q) = make_uint4(pk2(xv[0][0], xv[0][1]), pk2(xv[0][2], xv[0][3]), pk2(xv[1][0], xv[1][1]), pk2(xv[1][2], xv[1][3]));
                       *(uint4*)(xo + 4 * q + 8) = make_uint4(pk2(xv[2][0], xv[2][1]), pk2(xv[2][2], xv[2][3]), pk2(xv[3][0], xv[3][1]), pk2(xv[3][2], xv[3][3])); } }
        }
        __syncthreads();
    }
}

#endif
__device__ __forceinline__ void t_qkv_prep(Frame& F) {
    const int gw = F.vcu * NWAVES + F.wave, NGW = F.G * NWAVES, lane = F.lane;
    bf16_t* Qd = F.QKN; bf16_t* Kd = F.YS; bf16_t* Vd = F.YS2;
    for (int row = gw; row < M + BATCH * 64; row += NGW) {
        const bf16_t* zr; bf16_t *qo = nullptr, *ko, *vo; bool zero = false;
        if (row < M) { const int b = row / SEQ, i = row % SEQ; zr = F.Z + (size_t)row * INW; qo = Qd + (size_t)row * D; ko = Kd + ((size_t)b * KVS + 64 + i) * D; vo = Vd + ((size_t)b * KVS + 64 + i) * D; }
        else { const int r = row - M, b = r / 64, l = r % 64; zero = l < 48; zr = F.ZM + (size_t)(zero ? 0 : l - 48) * INW; ko = Kd + ((size_t)b * KVS + l) * D; vo = Vd + ((size_t)b * KVS + l) * D; }
        {
            const uint4 u0 = *(const uint4*)(zr + 512 + 16 * lane), u1 = *(const uint4*)(zr + 512 + 16 * lane + 8);
            const unsigned uw[8] = {u0.x, u0.y, u0.z, u0.w, u1.x, u1.y, u1.z, u1.w};
            float v[16]; float ss = 0.f;
#pragma unroll
            for (int c = 0; c < 8; ++c) { v[2 * c] = bf2f(uw[c] & 0xffffu); v[2 * c + 1] = bf2f(uw[c] >> 16); ss += v[2 * c] * v[2 * c] + v[2 * c + 1] * v[2 * c + 1]; }
            ss += __shfl_xor(ss, 1); ss += __shfl_xor(ss, 2);
            float rs = rsqrtf(ss * (1.f / 64.f) + EPS); if (lane < 32) rs *= 0.125f * 1.4426950408889634f; if (zero) rs = 0.f;
            const float* gg = (lane < 32 ? F.q_g : F.k_g) + 16 * (lane & 3);
            unsigned o[8];
#pragma unroll
            for (int c = 0; c < 8; ++c) o[c] = pk2(v[2 * c] * rs * gg[2 * c], v[2 * c + 1] * rs * gg[2 * c + 1]);
            const int sh = (lane & 31) >> 2, h = sh >> 1, j = sh & 1;
            bf16_t* dst = (lane < 32) ? qo : ko;
            if (dst) {
#pragma unroll
                for (int vh = 0; vh < 2; ++vh) { bf16_t* d = dst + (4 * h + 2 * j + vh) * 64 + 16 * (lane & 3); *(uint4*)d = make_uint4(o[0], o[1], o[2], o[3]); *(uint4*)(d + 8) = make_uint4(o[4], o[5], o[6], o[7]); }
            }
        }
        {
            uint4 u = *(const uint4*)(zr + 1536 + 8 * lane); if (zero) u = make_uint4(0, 0, 0, 0);
            const int h = lane >> 4, dv = 8 * (lane & 15), vh = dv >> 6, d = dv & 63;
#pragma unroll
            for (int j = 0; j < 2; ++j) *(uint4*)(vo + (4 * h + 2 * j + vh) * 64 + d) = u;
        }
    }
}
#ifndef T_UNR
#define T_UNR 4
#endif
struct PrepRow { bf16_t *qo, *ko, *vo; bool zero; uint4 u0, u1, uv; };
__device__ __forceinline__ void t_qkv_prep2(Frame& F) {
    const int gw = F.vcu * NWAVES + F.wave, NGW = F.G * NWAVES, lane = F.lane;
    bf16_t* Q2 = F.YS; bf16_t* K2 = F.YS + (size_t)M * 512; bf16_t* V2 = F.YS2;
    constexpr int NR = M + BATCH * 64;
    const float* gg = (lane < 32 ? F.q_g : F.k_g) + 16 * (lane & 3);
    f32x4 gv[4];
#pragma unroll
    for (int c = 0; c < 4; ++c) gv[c] = *(const f32x4*)(gg + 4 * c);
    for (int row0 = gw; row0 < NR; row0 += T_UNR * NGW) {
        PrepRow p[T_UNR];
#pragma unroll
        for (int j = 0; j < T_UNR; ++j) { const int row = row0 + j * NGW; if (row >= NR) break;
            const bf16_t* zr; p[j].qo = nullptr; p[j].zero = false;
            if (row < M) { const int b = row / SEQ, i = row % SEQ; zr = F.Z + (size_t)row * INW; p[j].qo = Q2 + (size_t)row * 512; p[j].ko = K2 + ((size_t)b * KVS + 64 + i) * 512; p[j].vo = V2 + ((size_t)b * KVS + 64 + i) * 512; }
            else { const int r = row - M, b = r / 64, l = r % 64; p[j].zero = l < 48; zr = F.ZM + (size_t)(p[j].zero ? 0 : l - 48) * INW; p[j].ko = K2 + ((size_t)b * KVS + l) * 512; p[j].vo = V2 + ((size_t)b * KVS + l) * 512; }
            p[j].u0 = *(const uint4*)(zr + 512 + 16 * lane); p[j].u1 = *(const uint4*)(zr + 512 + 16 * lane + 8); p[j].uv = *(const uint4*)(zr + 1536 + 8 * lane); }
#pragma unroll
        for (int j = 0; j < T_UNR; ++j) { const int row = row0 + j * NGW; if (row >= NR) break;
            const unsigned uw[8] = {p[j].u0.x, p[j].u0.y, p[j].u0.z, p[j].u0.w, p[j].u1.x, p[j].u1.y, p[j].u1.z, p[j].u1.w};
            uint4 uv = p[j].uv;
            float v[16]; float ss = 0.f;
#pragma unroll
            for (int c = 0; c < 8; ++c) { v[2 * c] = bf2f(uw[c] & 0xffffu); v[2 * c + 1] = bf2f(uw[c] >> 16); ss += v[2 * c] * v[2 * c] + v[2 * c + 1] * v[2 * c + 1]; }
            ss += __shfl_xor(ss, 1); ss += __shfl_xor(ss, 2);
            float rs = rsqrtf(ss * (1.f / 64.f) + EPS); if (lane < 32) rs *= 0.125f * 1.4426950408889634f; if (p[j].zero) { rs = 0.f; uv = make_uint4(0, 0, 0, 0); }
            unsigned o[8];
#pragma unroll
            for (int c = 0; c < 8; ++c) o[c] = pk2(v[2 * c] * rs * gv[c >> 1][(2 * c) & 3], v[2 * c + 1] * rs * gv[c >> 1][(2 * c + 1) & 3]);
            bf16_t* dst = (lane < 32) ? p[j].qo : p[j].ko;
            if (dst) { bf16_t* d = dst + 16 * (lane & 31); *(uint4*)d = make_uint4(o[0], o[1], o[2], o[3]); *(uint4*)(d + 8) = make_uint4(o[4], o[5], o[6], o[7]); }
            *(uint4*)(p[j].vo + 8 * lane) = uv; }
    }
}
__device__ __forceinline__ void t_attn_post2(Frame& F) {
    const int gw = F.vcu * NWAVES + F.wave, NGW = F.G * NWAVES, lane = F.lane;
    const bf16_t* O = F.QKN; const float lam = F.LAM[0];
    const int h = lane >> 4, dv = 8 * (lane & 15);
    const f32x4 g0 = *(const f32x4*)(F.sub_g + dv), g1 = *(const f32x4*)(F.sub_g + dv + 4);
    for (int t0 = gw; t0 < M; t0 += T_UNR * NGW) {
        uint4 a[T_UNR], b[T_UNR];
#pragma unroll
        for (int j = 0; j < T_UNR; ++j) { const int t = t0 + j * NGW; if (t >= M) break; a[j] = *(const uint4*)(O + (size_t)t * D + 256 * h + dv); b[j] = *(const uint4*)(O + (size_t)t * D + 256 * h + 128 + dv); }
#pragma unroll
        for (int j = 0; j < T_UNR; ++j) { const int t = t0 + j * NGW; if (t >= M) break;
            const unsigned aw[4] = {a[j].x, a[j].y, a[j].z, a[j].w}, bw[4] = {b[j].x, b[j].y, b[j].z, b[j].w};
            float o[8]; float ss = 0.f;
#pragma unroll
            for (int c = 0; c < 4; ++c) { o[2 * c] = bf2f(aw[c] & 0xffffu) - lam * bf2f(bw[c] & 0xffffu); o[2 * c + 1] = bf2f(aw[c] >> 16) - lam * bf2f(bw[c] >> 16); ss += o[2 * c] * o[2 * c] + o[2 * c + 1] * o[2 * c + 1]; }
            ss += __shfl_xor(ss, 1); ss += __shfl_xor(ss, 2); ss += __shfl_xor(ss, 4); ss += __shfl_xor(ss, 8);
            const float rs = rsqrtf(ss * (1.f / 128.f) + EPS) * 0.8f;
            bf16_t* yo = T_MIXCAT ? F.YS2 + (size_t)t * 1024 + 128 * h + dv : F.YA + (size_t)t * AW + 128 * h + dv;
            *(uint4*)yo = make_uint4(pk2(o[0] * rs * g0[0], o[1] * rs * g0[1]), pk2(o[2] * rs * g0[2], o[3] * rs * g0[3]), pk2(o[4] * rs * g1[0], o[5] * rs * g1[1]), pk2(o[6] * rs * g1[2], o[7] * rs * g1[3])); }
    }
}
__device__ __forceinline__ void t_attn_post(Frame& F) {
    const int gw = F.vcu * NWAVES + F.wave, NGW = F.G * NWAVES, lane = F.lane;
    const bf16_t* O = F.QKN; const float lam = F.LAM[0];
    const int h = lane >> 4, dv = 8 * (lane & 15), vh = dv >> 6, d = dv & 63;
    const f32x4 g0 = *(const f32x4*)(F.sub_g + dv), g1 = *(const f32x4*)(F.sub_g + dv + 4);
    for (int t = gw; t < M; t += NGW) {
        const uint4 a = *(const uint4*)(O + (size_t)t * D + (4 * h + vh) * 64 + d), b = *(const uint4*)(O + (size_t)t * D + (4 * h + 2 + vh) * 64 + d);
        const unsigned aw[4] = {a.x, a.y, a.z, a.w}, bw[4] = {b.x, b.y, b.z, b.w};
        float o[8]; float ss = 0.f;
#pragma unroll
        for (int c = 0; c < 4; ++c) { o[2 * c] = bf2f(aw[c] & 0xffffu) - lam * bf2f(bw[c] & 0xffffu); o[2 * c + 1] = bf2f(aw[c] >> 16) - lam * bf2f(bw[c] >> 16); ss += o[2 * c] * o[2 * c] + o[2 * c + 1] * o[2 * c + 1]; }
        ss += __shfl_xor(ss, 1); ss += __shfl_xor(ss, 2); ss += __shfl_xor(ss, 4); ss += __shfl_xor(ss, 8);
        const float rs = rsqrtf(ss * (1.f / 128.f) + EPS) * 0.8f;
        *(uint4*)(F.YA + (size_t)t * AW + 128 * h + dv) = make_uint4(pk2(o[0] * rs * g0[0], o[1] * rs * g0[1]), pk2(o[2] * rs * g0[2], o[3] * rs * g0[3]), pk2(o[4] * rs * g1[0], o[5] * rs * g1[1]), pk2(o[6] * rs * g1[2], o[7] * rs * g1[3]));
    }
}

__device__ __forceinline__ void t_gemm_z(Frame& F) {
    if (T_GATE8) {
        { pg8::Gemm g{F.XN, F.Wt_in, M, 2048, D}; pg8::StaticOrder S; S.init(M, 2048, F.G, (int)blockIdx.x);
          pg8::EpiBf16<0> E{F.Z, INW, nullptr, 0, 0, 1.f, 0};
          pg8::gemm_phase<pg8::EpiBf16<0>, pg8::StaticOrder, true, true>(F.lds3, g, S, E); }
        { pg8::Gemm g{F.XN8, F.Wt_in8, M, 2048, D / 2}; pg8::StaticOrder S; S.init(M, 2048, F.G, (int)blockIdx.x);
          pg8::EpiScaleBf16 E{F.Z + 2048, INW, 0.03125f};
          pg8::gemm_phase<pg8::EpiScaleBf16, pg8::StaticOrder, true, true, false, true>(F.lds3, g, S, E); }
        return;
    }
    pg8::Gemm g{F.XN, F.Wt_in, M, INW, D}; pg8::StaticOrder S; S.init(M, INW, F.G, (int)blockIdx.x);
    pg8::EpiBf16<0> E{F.Z, INW, nullptr, 0, 0, 1.f, 0};
    pg8::gemm_phase<pg8::EpiBf16<0>, pg8::StaticOrder, true, true>(F.lds3, g, S, E);
}
__device__ __forceinline__ void t_gemm_glu(Frame& F) {
    pg8::Gemm g{F.YS, F.Wt_glu, M, SW, SW}; pg8::StaticOrder S; S.init(M, SW, F.G, (int)blockIdx.x);
    pg8::EpiGlu E{F.YS, T_MIXCAT ? F.YS2 + 512 : F.YS2, F.b_glu, SW, T_MIXCAT ? 1024 : SW};
    pg8::gemm_phase<pg8::EpiGlu, pg8::StaticOrder, true, true>(F.lds3, g, S, E);
    if (T_MOE && DN_LATE > 0) {
        const int nun = (M / 256) * (SW / 256), idle = F.G - nun;
        if (idle > 0 && (int)blockIdx.x >= nun) { const int j = (int)blockIdx.x - nun; const size_t eo = (size_t)(NE - DN_LATE);
            cp_set<0, T_FP8>(F, F.w_down + eo * D * D, D, D, T_FP8 ? (bf16_t*)((unsigned char*)F.Wt_dn + eo * D * D) : F.Wt_dn + eo * D * D, DN_LATE, 0, 0, 0, j * NWAVES + F.wave, idle * NWAVES); }
        else if (idle <= 0) cp_set<0, T_FP8>(F, F.w_down + (size_t)(NE - DN_LATE) * D * D, D, D, T_FP8 ? (bf16_t*)((unsigned char*)F.Wt_dn + (size_t)(NE - DN_LATE) * D * D) : F.Wt_dn + (size_t)(NE - DN_LATE) * D * D, DN_LATE);
    }
}
__device__ __forceinline__ void t_gemm_mix(Frame& F) {
    if (T_MIXCAT) { pg8::Gemm g{F.YS2, F.Wt_so, M, D, D}; pg8::StaticOrder S; S.init(M, D, F.G, (int)blockIdx.x);
        pg8::EpiMixCat E{F.Z, F.MIX};
        pg8::gemm_phase<pg8::EpiMixCat, pg8::StaticOrder, true, true, false, false, true>(F.lds3, g, S, E); return; }
    { pg8::Gemm g{F.YS2, F.Wt_so, M, D, SW}; pg8::StaticOrder S; S.init(M, D, F.G, (int)blockIdx.x);
      pg8::EpiMix<true> E{F.Z + 2048, F.MIX, nullptr};
      pg8::gemm_phase<pg8::EpiMix<true>, pg8::StaticOrder, true, true>(F.lds3, g, S, E); }
    asm volatile("s_waitcnt vmcnt(0)" ::: "memory"); __syncthreads();
    { pg8::Gemm g{F.YA, F.Wt_ao, M, D, AW}; pg8::StaticOrder S; S.init(M, D, F.G, (int)blockIdx.x);
      pg8::EpiMix<false, T_WO8> E{F.Z + 3072, F.MIX, (unsigned char*)F.YS2 + (size_t)M * SW * 2};
      pg8::gemm_phase<pg8::EpiMix<false, T_WO8>, pg8::StaticOrder, true, true>(F.lds3, g, S, E); }
}
__device__ __forceinline__ void t_gemm_wo(Frame& F) {
    if (T_H1B) { pg8::Gemm g{F.MIX, F.Wt_o, M, D, D}; pg8::StaticOrder S; S.init(M, D, F.G, (int)blockIdx.x);
        pg8::EpiWoB E{F.x, F.H1B};
        pg8::gemm_phase<pg8::EpiWoB, pg8::StaticOrder, true, true>(F.lds3, g, S, E); return; }
    if (T_WOK && !T_WO8) { pg8::Gemm g{F.MIX, F.Wt_o, M, D, D}; pg8::StaticOrder S; S.init(M, D, F.G, (int)blockIdx.x);
        pg8::EpiWoK E{F.x, F.out};
        pg8::gemm_phase<pg8::EpiWoK, pg8::StaticOrder, true, true, false, false, false, true>(F.lds3, g, S, E); return; }
    pg8::Gemm g{T_WO8 ? (const bf16_t*)((unsigned char*)F.YS2 + (size_t)M * SW * 2) : F.MIX, F.Wt_o, M, D, T_WO8 ? D / 2 : D}; pg8::StaticOrder S; S.init(M, D, F.G, (int)blockIdx.x);
    pg8::EpiWo E{F.x, F.out, T_WO8 ? 0.03125f : 1.f, (F.mode >> 15) & 3};
    pg8::gemm_phase<pg8::EpiWo, pg8::StaticOrder, true, true, false, T_WO8>(F.lds3, g, S, E);
}

__device__ __forceinline__ void t_moe1(Frame& F) {
    const int ntiles = F.OFF[NE] / 256;
    pg8::MoeOrder S{F.TEXP, ntiles, 8, F.G, F.vcu};
    LAS int* idx = (LAS int*)(F.lds3 + 131072);
    { pg8::Unit u; for (int i = 0; i < 12 && S.next(i, u); ++i) if (F.tid < 256) idx[i * 256 + F.tid] = F.ROWTOK[u.pm * 256 + F.tid]; }
    __syncthreads();
    pg8::Gemm g{F.XN2, F.Wt_gu, MOE_ROWS, NE * 2048, T_FP8 ? D / 2 : D, idx};
    pg8::EpiMoe1<T_FP8> E{F.ACT, F.b_gate, F.b_up};
    pg8::gemm_phase<pg8::EpiMoe1<T_FP8>, pg8::MoeOrder, true, true, true, T_FP8>(F.lds3, g, S, E);
    if (DN_MID > 0) {
        const int nu = ntiles * 8, rem = nu % F.G, nidle = rem ? F.G - rem : F.G, j = rem ? F.vcu - rem : F.vcu;
        if (j >= 0) { const size_t eo = (size_t)(NE - (T_GEMM_GLU ? DN_LATE : 0) - DN_MID);
            cp_set<0, T_FP8>(F, F.w_down + eo * D * D, D, D, T_FP8 ? (bf16_t*)((unsigned char*)F.Wt_dn + eo * D * D) : F.Wt_dn + eo * D * D, DN_MID, 0, 0, 0, j * NWAVES + F.wave, nidle * NWAVES); }
    }
}
__device__ __forceinline__ void t_moe2(Frame& F) {
    const int ntiles = F.OFF[NE] / 256;
    pg8::MoeOrder S{F.TEXP, ntiles, 4, F.G, F.vcu};
    pg8::Gemm g{F.ACT, F.Wt_dn, MOE_ROWS, NE * 1024, T_FP8 ? D / 2 : D, nullptr};
    pg8::EpiMoe2<T_FP8> E{F.Y2, F.b_down, F.ROWTK};
    pg8::gemm_phase<pg8::EpiMoe2<T_FP8>, pg8::MoeOrder, true, true, false, T_FP8>(F.lds3, g, S, E);
}

constexpr int NPHASE = 13;
__global__ void __launch_bounds__(NTHR, 2) mk_fwd(Args args) {
    extern __shared__ __attribute__((aligned(16))) unsigned char lds[];
    Frame F;
    F.lds = lds; F.lds3 = (LAS unsigned char*)lds; F.tid = threadIdx.x; F.lane = F.tid & 63; F.wave = __builtin_amdgcn_readfirstlane(F.tid >> 6);
    F.mode = args.mode; F.G = gridDim.x; { const int bx = blockIdx.x; F.vcu = (F.G % 8 == 0) ? (bx % 8) * (F.G / 8) + bx / 8 : bx; }
    const float* const* in = args.in;
    F.x = in[0]; F.meta = in[1]; F.norm_mix_g = in[2]; F.w_in = in[3]; F.a_re = in[4]; F.a_im = in[5]; F.log_dt = in[6]; F.b_re = in[7]; F.b_im = in[8]; F.c_re = in[9]; F.c_im = in[10]; F.ssm_d = in[11];
    F.w_glu = in[12]; F.b_glu = in[13]; F.q_g = in[14]; F.k_g = in[15]; F.lq1 = in[16]; F.lk1 = in[17]; F.lq2 = in[18]; F.lk2 = in[19]; F.sub_g = in[20]; F.w_so = in[21]; F.w_ao = in[22]; F.w_o = in[23];
    F.norm_ffn_g = in[24]; F.w_router = in[25]; F.b_router = in[26]; F.w_gate = in[27]; F.b_gate = in[28]; F.w_up = in[29]; F.b_up = in[30]; F.w_down = in[31]; F.b_down = in[32];
    F.out = args.out;
    unsigned char* ws = args.ws;
    F.XN = (bf16_t*)(ws + WS_R0); F.QKN = (bf16_t*)(ws + WS_R0); F.MIX = (bf16_t*)(ws + WS_R0);
    F.YS = (bf16_t*)(ws + WS_R1); F.YA = (bf16_t*)(ws + WS_R1 + (size_t)M * SW * 2); F.XN2 = (bf16_t*)(ws + WS_R1);
    F.YS2 = (bf16_t*)(ws + WS_R2); F.Z = (bf16_t*)(ws + WS_R3); F.ACT = (bf16_t*)(ws + WS_R3); F.Y2 = (bf16_t*)(ws + WS_WGU);
    F.Wt_in = (bf16_t*)(ws + WS_WD + WD_IN); F.Wt_glu = (bf16_t*)(ws + WS_WD + WD_GLU); F.Wt_so = (bf16_t*)(ws + WS_WD + WD_SO); F.Wt_ao = (bf16_t*)(ws + WS_WD + WD_AO); F.Wt_o = (bf16_t*)(ws + WS_WD + WD_O);
    F.XN8 = (bf16_t*)(ws + WS_R2); F.H1B = (bf16_t*)(ws + WS_R2); F.Wt_in8 = (bf16_t*)(ws + WS_WGU + 64 * MiB);     F.Wt_gu = (bf16_t*)(ws + WS_WGU); F.Wt_dn = (bf16_t*)(ws + WS_WDN);
    unsigned char* sm = ws + WS_SM;
    F.BB = (float*)(sm + SM_BB); F.AA = (float*)(sm + SM_AA); F.E = (float*)(sm + SM_E); F.SIN = (float*)(sm + SM_SIN); F.LAM = (float*)(sm + SM_LAM); F.GATE = (float*)(sm + SM_GATE);
    F.IDX = (int*)(sm + SM_IDX); F.POS = (int*)(sm + SM_POS); F.OFF = (int*)(sm + SM_OFF); F.ROWTOK = (int*)(sm + SM_ROWTOK); F.ROWTK = (int*)(sm + SM_ROWTK); F.TEXP = (int*)(sm + SM_TEXP); F.TCNT = (int*)(sm + SM_TCNT);
    F.ZM = (bf16_t*)(sm + SM_ZM); F.QKNM = (bf16_t*)(sm + SM_QKNM); F.BBH = (bf16_t*)(sm + SM_BBH); F.CMT = (bf16_t*)(sm + SM_CMT);
    unsigned* ctl = (unsigned*)(ws + WS_CTL);
    F.CNT = (int*)(ctl + CW_CNT);
    volatile LAS unsigned* MISC = (volatile LAS unsigned*)((LAS unsigned char*)lds + MISC_OFF);
    for (int u = F.tid; u < 64; u += NTHR) MISC[u] = 0u;
    __syncthreads();
    XcdBarrier bar = xcd_barrier_post(ctl + CW_BAR, MISC + 8);
#if COOP_LAUNCH
    cg::grid_group grid = cg::this_grid();
#endif
    const int lo = args.ph_lo, hi = args.ph_hi;
    bool first_seam = true; (void)first_seam;
#if COOP_LAUNCH
#define SEAM(k) do { if ((k) + 1 < hi) { if (first_seam) { grid.sync(); first_seam = false; } else xcd_barrier(bar); } } while (0)
#else
#define SEAM(k) do { if ((k) + 1 < hi) xcd_barrier(bar); } while (0)
#endif
#define IN(k) (lo <= (k) && (k) < hi)
#ifdef PROBE_LO
    if (F.mode & 2048) { for (int i = 0; i < 20; ++i) xcd_barrier(bar); }
#endif
    if (IN(0)) { s_prologue(F); SEAM(0); }
    if (IN(1)) { if (T_GEMM_Z) t_gemm_z(F); else s_gemm_z(F); SEAM(1); }
#if T_S5 && T_ATTN == 2 && T_ALT
    if (IN(2)) { if (F.wave & 1) { t_qkv_prep2(F); t_s5_pass<false>(F); } else { t_s5_pass<false>(F); t_qkv_prep2(F); } SEAM(2); }
#else
    if (IN(2)) { if (T_S5) { if (!(F.mode & 32)) t_s5_pass<false>(F); } else s_s5_scan<false>(F); if (F.mode & 64) {} else if (T_ATTN == 2) t_qkv_prep2(F); else if (T_ATTN) t_qkv_prep(F); else s_qkn(F); SEAM(2); }
#endif
    if (IN(3)) { if (T_S5) t_s5_carry(F); else s_s5_carry(F);
        if (T_ATTN == 2) { const attn2::AttnTensors AT{(const attn2::bf16*)F.YS, (const attn2::bf16*)(F.YS + (size_t)M * 512), (const attn2::bf16*)F.YS2, (attn2::bf16*)F.QKN};
                      const attn2::StaticOrder S((int)F.G, (int)blockIdx.x);
#ifdef PROBE_LO
                      if (F.mode & 256) attn2::attn_phase<attn2::StaticOrder, 8, 1>((char*)lds, AT, S); else if (F.mode & 512) attn2::attn_phase<attn2::StaticOrder, 8, 2>((char*)lds, AT, S); else if (F.mode & 1024) attn2::attn_phase<attn2::StaticOrder, 8, 4>((char*)lds, AT, S); else if (F.mode & 4096) attn2::attn_phase<attn2::StaticOrder, 8, 8>((char*)lds, AT, S); else if (F.mode & 8192) attn2::attn_phase<attn2::StaticOrder, 8, 16>((char*)lds, AT, S); else if (F.mode & 16384) attn2::attn_phase<attn2::StaticOrder, 8, 32>((char*)lds, AT, S); else
#endif
                      attn2::attn_phase<attn2::StaticOrder>((char*)lds, AT, S); }
        else if (T_ATTN) { const attn_body::AttnTensors AT{(const attn_body::bf16*)F.QKN, (const attn_body::bf16*)F.YS, (const attn_body::bf16*)F.YS2, (attn_body::bf16*)F.QKN};
                      const attn_body::StaticOrder S((int)F.G, (int)blockIdx.x); attn_body::attn_phase<attn_body::StaticOrder>((char*)lds, AT, S); }
        else s_attn(F);
        SEAM(3); }
#if T_S5 && T_ATTN == 2 && T_ALT
    if (IN(4)) { if (F.wave & 1) { t_attn_post2(F); t_s5_pass<true>(F); } else { t_s5_pass<true>(F); t_attn_post2(F); } SEAM(4); }
#else
    if (IN(4)) { if (T_S5) { if (!(F.mode & 32)) t_s5_pass<true>(F); } else s_s5_scan<true>(F); if (F.mode & 64) {} else if (T_ATTN == 2) t_attn_post2(F); else if (T_ATTN) t_attn_post(F); SEAM(4); }
#endif
    if (IN(5)) { if (T_GEMM_GLU) t_gemm_glu(F); else s_gemm_glu(F); SEAM(5); }
    if (IN(6)) { if (T_GEMM_MIX) t_gemm_mix(F); else s_gemm_mix(F); SEAM(6); }
    if (IN(7)) { if (T_GEMM_WO) t_gemm_wo(F); else s_gemm_wo(F); SEAM(7); }
#if defined(PROBE_DUP) && PROBE_DUP == 8
    if (IN(8)) {
#pragma unroll 1
        for (int rep = 0; rep < 2; ++rep) { t_router(F); if (rep == 0) xcd_barrier(bar); }
        SEAM(8); }
#else
    if (IN(8)) { if (T_ROUTER) t_router(F); else s_router(F); SEAM(8); }
#endif
    if (IN(9)) { if (T_ROUTER) t_scatter(F); else s_scatter(F); SEAM(9); }
    if (IN(10)) { if (T_MOE) t_moe1(F); else s_moe1(F); SEAM(10); }
    if (IN(11)) { if (T_MOE) t_moe2(F); else s_moe2(F); SEAM(11); }
#if defined(PROBE_DUP) && PROBE_DUP == 11
    if (IN(11)) { t_moe2(F); xcd_barrier(bar); }
#endif
#if defined(PROBE_DUP) && PROBE_DUP == 10
    if (IN(10)) { t_moe1(F); xcd_barrier(bar); }
#endif
    if (IN(12)) { s_combine(F); }
#undef IN
#undef SEAM
}

extern "C" void kernel_launch(void* const* d_in, const int* in_sizes, int n_in, void* d_out, int out_size, void* d_ws, size_t ws_size, hipStream_t stream) {
    static int grid = 0;
    if (grid == 0) {
        if (n_in != 33 || ws_size < WS_END || out_size != M * D) { fprintf(stderr, "kernel_launch: need 33 inputs, out %d and %zu bytes of workspace (got %d, %d, %zu)\n", M * D, (size_t)WS_END, n_in, out_size, ws_size); grid = -1; return; }
        int dev = 0, cus = 0, per_cu = 0;
        if (hipGetDevice(&dev) != hipSuccess || hipDeviceGetAttribute(&cus, hipDeviceAttributeMultiprocessorCount, dev) != hipSuccess) { grid = -1; return; }
        if (hipFuncSetAttribute((const void*)mk_fwd, hipFuncAttributeMaxDynamicSharedMemorySize, LDS_BYTES) != hipSuccess) { fprintf(stderr, "kernel_launch: hipFuncSetAttribute failed\n"); grid = -1; return; }
        if (hipOccupancyMaxActiveBlocksPerMultiprocessor(&per_cu, (const void*)mk_fwd, NTHR, LDS_BYTES) != hipSuccess || per_cu < 1) { fprintf(stderr, "kernel_launch: occupancy query failed (%d)\n", per_cu); (void)hipGetLastError(); grid = -1; return; }
        grid = cus * (per_cu < 1 ? 1 : 1);
    }
    if (grid < 0) return;
    (void)hipMemsetAsync((char*)d_ws + WS_CTL, 0, CTL_ZERO_BYTES, stream);
    Args a{};
    for (int i = 0; i < 33; ++i) a.in[i] = (const float*)d_in[i];
    a.out = (float*)d_out; a.ws = (unsigned char*)d_ws; a.ph_lo = 0; a.ph_hi = NPHASE;
    void* kargs[] = {&a};
#if COOP_LAUNCH
    const hipError_t e = hipLaunchCooperativeKernel((const void*)mk_fwd, dim3(grid), dim3(NTHR), kargs, LDS_BYTES, stream);
#else
    (void)kargs; hipLaunchKernelGGL(mk_fwd, dim3(grid), dim3(NTHR), LDS_BYTES, stream, a);
    const hipError_t e = hipPeekAtLastError();
#endif
    if (e != hipSuccess) fprintf(stderr, "kernel_launch: launch failed: %s (grid %d)\n", hipGetErrorString(e), grid);
#ifdef PROBE_LO
    a.ph_lo = PROBE_LO; a.ph_hi = PROBE_HI; a.mode = PROBE_MODE;
    (void)hipMemsetAsync((char*)d_ws + WS_CTL + CW_BAR * 4, 0, XCD_BAR_WORDS * 4, stream);
#if COOP_LAUNCH
    (void)hipLaunchCooperativeKernel((const void*)mk_fwd, dim3(grid), dim3(NTHR), kargs, LDS_BYTES, stream);
#else
    hipLaunchKernelGGL(mk_fwd, dim3(grid), dim3(NTHR), LDS_BYTES, stream, a);
#endif
#endif
}
```
